# Optimizing an MI355X kernel written in HIP

```python
import math
import jax, jax.numpy as jnp
from jax import lax
import numpy as np

D_MODEL = 2048
BATCH = 8
SEQ = 2048
DEPTH = 4

N_MIXERS = 3
EPS = 1e-6
BLOCK = 128
NEG_INF = -1e30

N_BUCKETS = 32
MAX_DISTANCE = 128
N_BIAS_HEADS = 32

MEM_LEN = 256
MEM_HEADS = 4
MEM_HEAD_DIM = 256
MEM_WIDTH = MEM_HEADS * MEM_HEAD_DIM

SELF_WIDTH = D_MODEL
BRANCH_WIDTH = SELF_WIDTH + MEM_WIDTH

A_HEADS = 16
A_Q_LORA = 1536
A_KV_LORA = 512
A_NOPE = 128
A_ROPE = 64
A_V = 128
ROPE_THETA = 10000.0
A_IN = A_Q_LORA + A_KV_LORA + A_ROPE + MEM_WIDTH + BRANCH_WIDTH

B_HEADS = N_BIAS_HEADS
B_KV_HEADS = 4
B_HEAD_DIM = 64
IDX_HEADS = 16
IDX_DIM = 64
IDX_TOPK_MAX = 256
B_IN = (B_HEADS * B_HEAD_DIM + 2 * B_KV_HEADS * B_HEAD_DIM + IDX_HEADS * IDX_DIM
        + IDX_DIM + IDX_HEADS + MEM_WIDTH + BRANCH_WIDTH)

C_HEADS = N_BIAS_HEADS
C_KV_HEADS = 4
C_HEAD_DIM = 64
WINDOW = 128
C_IN = C_HEADS * C_HEAD_DIM + 2 * C_KV_HEADS * C_HEAD_DIM + MEM_WIDTH + BRANCH_WIDTH

N_A = (DEPTH + 2) // 3
N_B = (DEPTH + 1) // 3
N_C = DEPTH // 3

kernel_name = "hybrid_mla_dsa_swa_interleaved"


def _rmsnorm(x, g):
    xf = x.astype(jnp.float32)
    y = xf * lax.rsqrt(jnp.mean(xf * xf, axis=-1, keepdims=True) + EPS)
    return (y * g.astype(jnp.float32)).astype(x.dtype)


def _split(h, sizes):
    offs = [int(v) for v in np.cumsum(sizes)[:-1]]
    return jnp.split(h, offs, axis=-1)


def _rope(x):
    S, d = x.shape[1], x.shape[-1]
    inv = 1.0 / (ROPE_THETA ** (jnp.arange(0, d, 2, dtype=jnp.float32) / d))
    ang = jnp.arange(S, dtype=jnp.float32)[:, None] * inv[None, :]
    if x.ndim == 4:
        ang = ang[:, None, :]
    cos, sin = jnp.cos(ang), jnp.sin(ang)
    xf = x.astype(jnp.float32)
    x1, x2 = xf[..., : d // 2], xf[..., d // 2:]
    return jnp.concatenate([x1 * cos - x2 * sin, x2 * cos + x1 * sin], axis=-1).astype(x.dtype)


def _t5_bucket(rel):
    n = jnp.maximum(rel, 0)
    max_exact = N_BUCKETS // 2
    nf = jnp.maximum(n, 1).astype(jnp.float32)
    large = max_exact + (jnp.log(nf / max_exact) / math.log(MAX_DISTANCE / max_exact)
                         * (N_BUCKETS - max_exact)).astype(jnp.int32)
    large = jnp.minimum(large, N_BUCKETS - 1)
    return jnp.where(n < max_exact, n, large)


def _to_blocks(t):
    B, S = t.shape[0], t.shape[1]
    return t.reshape((B, S // BLOCK, BLOCK) + t.shape[2:]).swapaxes(0, 1)


def _from_blocks(o):
    nb, B = o.shape[0], o.shape[1]
    return o.swapaxes(0, 1).reshape((B, nb * BLOCK) + o.shape[3:])


def _mla_branch(h, w_in, q_norm, w_uq, kv_norm, w_ukv):
    B, S, _ = h.shape
    nb = S // BLOCK
    c_q, c_kv, k_rope, mq, gate = _split(h @ w_in, [A_Q_LORA, A_KV_LORA, A_ROPE, MEM_WIDTH, BRANCH_WIDTH])
    q = (_rmsnorm(c_q, q_norm) @ w_uq).reshape(B, S, A_HEADS, A_NOPE + A_ROPE)
    kv = (_rmsnorm(c_kv, kv_norm) @ w_ukv).reshape(B, S, A_HEADS, A_NOPE + A_V)
    q_nope, q_rope = q[..., :A_NOPE], _rope(q[..., A_NOPE:])
    k_nope, v = kv[..., :A_NOPE], kv[..., A_NOPE:]
    k_rope = _rope(k_rope)
    scale = (A_NOPE + A_ROPE) ** -0.5
    key_idx = jnp.arange(S)

    def block(args):
        qn, qr, start = args
        s = (jnp.einsum('bqhd,bkhd->bhqk', qn, k_nope, preferred_element_type=jnp.float32)
             + jnp.einsum('bqhd,bkd->bhqk', qr, k_rope, preferred_element_type=jnp.float32)) * scale
        causal = (start + jnp.arange(BLOCK))[:, None] >= key_idx[None, :]
        p = jax.nn.softmax(jnp.where(causal, s, NEG_INF), axis=-1)
        return jnp.einsum('bhqk,bkhd->bqhd', p.astype(v.dtype), v)

    o = lax.map(block, (_to_blocks(q_nope), _to_blocks(q_rope), jnp.arange(nb) * BLOCK))
    return _from_blocks(o).reshape(B, S, A_HEADS * A_V), mq, gate


def _dsa_branch(h, w_in, rel_bias):
    B, S, _ = h.shape
    nb = S // BLOCK
    k_top = min(IDX_TOPK_MAX, S // 4)
    G = B_HEADS // B_KV_HEADS
    q, k, v, iq, ik, iw, mq, gate = _split(h @ w_in, [
        B_HEADS * B_HEAD_DIM, B_KV_HEADS * B_HEAD_DIM, B_KV_HEADS * B_HEAD_DIM,
        IDX_HEADS * IDX_DIM, IDX_DIM, IDX_HEADS, MEM_WIDTH, BRANCH_WIDTH])
    q = q.reshape(B, S, B_KV_HEADS, G, B_HEAD_DIM)
    k = k.reshape(B, S, B_KV_HEADS, B_HEAD_DIM)
    v = v.reshape(B, S, B_KV_HEADS, B_HEAD_DIM)
    iq = iq.reshape(B, S, IDX_HEADS, IDX_DIM)
    key_idx = jnp.arange(S)
    gather = jax.vmap(lambda t, i: t[i])

    def block(args):
        qb, iqb, iwb, start = args
        qi = start + jnp.arange(BLOCK)
        dots = jnp.einsum('bqhd,bkd->bqhk', iqb, ik, preferred_element_type=jnp.float32) * IDX_DIM ** -0.5
        score = jnp.einsum('bqhk,bqh->bqk', jax.nn.relu(dots), iwb.astype(jnp.float32)) * IDX_HEADS ** -0.5
        score = jnp.where(qi[:, None] >= key_idx[None, :], score, NEG_INF)
        _, sel = lax.top_k(score, k_top)
        kg = gather(k, sel)
        vg = gather(v, sel)
        rel = qi[None, :, None] - sel
        bias = rel_bias[_t5_bucket(rel)].astype(jnp.float32)
        bias = bias.reshape(B, BLOCK, k_top, B_KV_HEADS, G).transpose(0, 1, 3, 4, 2)
        s = jnp.einsum('bqgjd,bqkgd->bqgjk', qb, kg, preferred_element_type=jnp.float32) * B_HEAD_DIM ** -0.5 + bias
        s = jnp.where((rel >= 0)[:, :, None, None, :], s, NEG_INF)
        p = jax.nn.softmax(s, axis=-1)
        return jnp.einsum('bqgjk,bqkgd->bqgjd', p.astype(vg.dtype), vg)

    o = lax.map(block, (_to_blocks(q), _to_blocks(iq), _to_blocks(iw), jnp.arange(nb) * BLOCK))
    return _from_blocks(o).reshape(B, S, B_HEADS * B_HEAD_DIM), mq, gate


def _swa_branch(h, w_in, sinks, rel_bias):
    B, S, _ = h.shape
    nb = S // BLOCK
    G = C_HEADS // C_KV_HEADS
    q, k, v, mq, gate = _split(h @ w_in, [
        C_HEADS * C_HEAD_DIM, C_KV_HEADS * C_HEAD_DIM, C_KV_HEADS * C_HEAD_DIM, MEM_WIDTH, BRANCH_WIDTH])
    q = q.reshape(B, S, C_KV_HEADS, G, C_HEAD_DIM)

    def band(t):
        tb = t.reshape(B, nb, BLOCK, C_KV_HEADS, C_HEAD_DIM)
        prev = jnp.concatenate([jnp.zeros_like(tb[:, :1]), tb[:, :-1]], axis=1)
        return jnp.concatenate([prev, tb], axis=2).swapaxes(0, 1)

    qi = jnp.arange(BLOCK)
    kj = jnp.arange(2 * BLOCK)
    rel = qi[:, None] + BLOCK - kj[None, :]
    in_window = (rel >= 0) & (rel < WINDOW)
    bias = rel_bias[_t5_bucket(rel)].astype(jnp.float32)
    bias = bias.reshape(BLOCK, 2 * BLOCK, C_KV_HEADS, G).transpose(2, 3, 0, 1)
    sink = sinks.astype(jnp.float32).reshape(C_KV_HEADS, G)[None, :, :, None, None]
    scale = C_HEAD_DIM ** -0.5

    def block(args):
        qb, kb, vb, start = args
        valid = in_window & ((start - BLOCK + kj) >= 0)[None, :]
        s = jnp.einsum('bqgjd,bkgd->bgjqk', qb, kb, preferred_element_type=jnp.float32) * scale + bias
        s = jnp.where(valid, s, NEG_INF)
        m = jnp.maximum(jnp.max(s, axis=-1, keepdims=True), sink)
        e = jnp.exp(s - m)
        p = e / (jnp.sum(e, axis=-1, keepdims=True) + jnp.exp(sink - m))
        return jnp.einsum('bgjqk,bkgd->bqgjd', p.astype(vb.dtype), vb)

    o = lax.map(block, (_to_blocks(q), band(k), band(v), jnp.arange(nb) * BLOCK))
    return _from_blocks(o).reshape(B, S, C_HEADS * C_HEAD_DIM), mq, gate


def _memory_attention(mq, mem_kv):
    B, S, _ = mq.shape
    mk, mv = jnp.split(mem_kv, 2, axis=-1)
    mq = mq.reshape(B, S, MEM_HEADS, MEM_HEAD_DIM)
    mk = mk.reshape(B, -1, MEM_HEADS, MEM_HEAD_DIM)
    mv = mv.reshape(B, -1, MEM_HEADS, MEM_HEAD_DIM)
    s = jnp.einsum('bqhd,bkhd->bhqk', mq, mk, preferred_element_type=jnp.float32) * MEM_HEAD_DIM ** -0.5
    p = jax.nn.softmax(s, axis=-1)
    return jnp.einsum('bhqk,bkhd->bqhd', p.astype(mv.dtype), mv).reshape(B, S, MEM_WIDTH)


def setup_inputs(seed: int = 0) -> dict:
    key = jax.random.key(seed)
    ks = jax.random.split(key, 16)
    nrm = jax.random.normal
    f32 = jnp.float32
    return {
        "x": nrm(ks[0], (BATCH, SEQ, D_MODEL), f32),
        "mem": nrm(ks[1], (BATCH, MEM_LEN, D_MODEL), f32),
        "norm_in": 1.0 + 0.02 * nrm(ks[2], (DEPTH, D_MODEL), f32),
        "final_norm": 1.0 + 0.02 * nrm(ks[3], (D_MODEL,), f32),
        "mem_norm": 1.0 + 0.02 * nrm(ks[4], (D_MODEL,), f32),
        "rel_bias": 0.2 * nrm(ks[5], (N_BUCKETS, N_BIAS_HEADS), f32),
        "w_in_a": nrm(ks[6], (N_A, D_MODEL, A_IN), f32) * D_MODEL ** -0.5,
        "a_q_norm": 1.0 + 0.02 * nrm(ks[7], (N_A, A_Q_LORA), f32),
        "w_uq": nrm(ks[8], (N_A, A_Q_LORA, A_HEADS * (A_NOPE + A_ROPE)), f32) * A_Q_LORA ** -0.5,
        "a_kv_norm": 1.0 + 0.02 * nrm(ks[9], (N_A, A_KV_LORA), f32),
        "w_ukv": nrm(ks[10], (N_A, A_KV_LORA, A_HEADS * (A_NOPE + A_V)), f32) * A_KV_LORA ** -0.5,
        "w_in_b": nrm(ks[11], (N_B, D_MODEL, B_IN), f32) * D_MODEL ** -0.5,
        "w_in_c": nrm(ks[12], (N_C, D_MODEL, C_IN), f32) * D_MODEL ** -0.5,
        "c_sinks": nrm(ks[13], (N_C, C_HEADS), f32),
        "w_mem_kv": nrm(ks[14], (DEPTH, D_MODEL, 2 * MEM_WIDTH), f32) * D_MODEL ** -0.5,
        "w_out": nrm(ks[15], (DEPTH, BRANCH_WIDTH, D_MODEL), f32) * BRANCH_WIDTH ** -0.5,
    }


def reference(x, mem, norm_in, final_norm, mem_norm, rel_bias, w_in_a, a_q_norm, w_uq,
              a_kv_norm, w_ukv, w_in_b, w_in_c, c_sinks, w_mem_kv, w_out):
    mem_n = _rmsnorm(mem, mem_norm)
    for i in range(DEPTH):
        h = _rmsnorm(x, norm_in[i])
        kind, j = i % N_MIXERS, i // N_MIXERS
        if kind == 0:
            self_out, mq, gate = _mla_branch(h, w_in_a[j], a_q_norm[j], w_uq[j], a_kv_norm[j], w_ukv[j])
        elif kind == 1:
            self_out, mq, gate = _dsa_branch(h, w_in_b[j], rel_bias)
        else:
            self_out, mq, gate = _swa_branch(h, w_in_c[j], c_sinks[j], rel_bias)
        mem_out = _memory_attention(mq, mem_n @ w_mem_kv[i])
        y = jnp.concatenate([self_out, mem_out], axis=-1) * jax.nn.silu(gate)
        x = x + y @ w_out[i]
    return _rmsnorm(x, final_norm)
```

```cpp
#include <hip/hip_runtime.h>
#include <hip/hip_cooperative_groups.h>
#include <stdint.h>
namespace cg = cooperative_groups;

typedef unsigned short u16;
typedef __attribute__((ext_vector_type(8))) short bf16x8;
typedef __attribute__((ext_vector_type(4))) short s16x4;
typedef __attribute__((ext_vector_type(16))) float f32x16;
typedef __attribute__((ext_vector_type(4))) float f32x4;
typedef __attribute__((ext_vector_type(2))) float f32x2;
typedef __attribute__((ext_vector_type(4))) unsigned u32x4;
typedef __attribute__((ext_vector_type(2))) unsigned u32x2;
typedef __attribute__((ext_vector_type(2))) __bf16 bf16x2_t;
typedef short v4i16_t __attribute__((ext_vector_type(4)));
#define DI __device__ __forceinline__
#define MFMA(a, b, c) __builtin_amdgcn_mfma_f32_32x32x16_bf16((a), (b), (c), 0, 0, 0)

constexpr int SEQ = 2048, NTOK = 16384;
constexpr int LDS_LUT = 133120, LDS_ITEM = LDS_LUT + 32 * 528, LDS_BYTES = LDS_ITEM + 64;
constexpr float LOG2E = 1.4426950408889634f;
constexpr float NEGV = -1e30f;

constexpr size_t OFF_Y = 0;
constexpr size_t OFF_H = 100663296;
constexpr size_t OFF_KV = 201326592;
constexpr size_t OFF_MG = 335544320;
constexpr size_t OFF_KR = 469762048;
constexpr size_t OFF_P = 167772160;
constexpr size_t OFF_WIN = 471859200;
constexpr size_t OFF_WUQ = OFF_WIN + 32505856;
constexpr size_t OFF_WUKV = OFF_WUQ + 9437184;
constexpr size_t OFF_WOUT = OFF_WUKV + 4194304;
constexpr size_t OFF_MEMN = OFF_WOUT + 12582912;
constexpr size_t OFF_MEMKV = OFF_MEMN + 8388608;
constexpr size_t OFF_MASK = OFF_MEMKV + 33554432;
constexpr size_t OFF_ROPE = OFF_MASK + 4194304;
constexpr size_t OFF_LUT = OFF_ROPE + 524288;
constexpr size_t OFF_CTR = OFF_LUT + 32768;

struct Params {
  const float *x, *mem, *norm_in, *final_norm, *mem_norm, *rel_bias, *w_in_a, *a_q_norm, *w_uq, *a_kv_norm, *w_ukv,
      *w_in_b, *w_in_c, *c_sinks, *w_mem_kv, *w_out;
  float* out;
  char* ws;
};

DI float bf2f(unsigned b) { return __uint_as_float(b << 16); }
DI unsigned pk2(float a, float b) {
  f32x2 v = {a, b};
  return __builtin_bit_cast(unsigned, __builtin_convertvector(v, bf16x2_t));
}
DI u16 f2bf(float a) { return (u16)(pk2(a, 0.f) & 0xffffu); }
DI float wave_sum(float v) {
#pragma unroll
  for (int o = 32; o; o >>= 1) v += __shfl_xor(v, o);
  return v;
}
DI int crow(int reg, int hi) { return (reg & 3) + 8 * (reg >> 2) + 4 * hi; }
DI float xhalf_max(float m) {
  auto rr = __builtin_amdgcn_permlane32_swap(__float_as_uint(m), __float_as_uint(m), false, false);
  return fmaxf(__uint_as_float(rr[0]), __uint_as_float(rr[1]));
}
DI float xhalf_sum(float m) {
  auto rr = __builtin_amdgcn_permlane32_swap(__float_as_uint(m), __float_as_uint(m), false, false);
  return __uint_as_float(rr[0]) + __uint_as_float(rr[1]);
}
typedef __attribute__((address_space(3))) v4i16_t* lds_v4p;
DI s16x4 vtr(const char* p) {
  return __builtin_bit_cast(s16x4, __builtin_amdgcn_ds_read_tr16_b64_v4i16((lds_v4p)(p)));
}

template <int PERM>
DI void convert_wt(const float* __restrict__ W, int K, int N, int Npad, u16* __restrict__ Wt, char* smem) {
  float* tile = (float*)smem;
  int tid = threadIdx.x; asm volatile("" : "+v"(tid));
  const int ntk = K / 64, ntn = Npad / 64;
  for (int t = blockIdx.x; t < ntk * ntn; t += gridDim.x) {
    const int tk = t % ntk, tn = t / ntk, k0 = tk * 64, n0 = tn * 64;
    __syncthreads();
#pragma unroll
    for (int i = 0; i < 2; ++i) {
      const int id = tid + 512 * i, kr = id >> 4, n4 = (id & 15) * 4;
      f32x4 v = {0.f, 0.f, 0.f, 0.f};
      if (n0 + n4 < N) v = *(const f32x4*)(W + (size_t)(k0 + kr) * N + n0 + n4);
      tile[kr * 65 + n4 + 0] = v[0]; tile[kr * 65 + n4 + 1] = v[1]; tile[kr * 65 + n4 + 2] = v[2]; tile[kr * 65 + n4 + 3] = v[3];
    }
    __syncthreads();
    {
      const int n = tid >> 3, c = tid & 7;
      bool rot = false;
      if (PERM == 1) rot = (n0 == 2048);
      if (PERM == 2) rot = ((tn % 3) == 2);
      const int ns = rot ? ((n >> 1) + 32 * (n & 1)) : n;
      u32x4 o;
#pragma unroll
      for (int j = 0; j < 4; ++j) o[j] = pk2(tile[(c * 8 + 2 * j) * 65 + ns], tile[(c * 8 + 2 * j + 1) * 65 + ns]);
      *(u32x4*)(Wt + (size_t)(n0 + n) * K + k0 + c * 8) = o;
    }
  }
}

template <bool F32OUT>
DI void rmsnorm_rows(const float* X, const float* __restrict__ g, void* outp, int nrows) {
  int tidx = threadIdx.x; asm volatile("" : "+v"(tidx));
  const int lane = tidx & 63, gw = blockIdx.x * 8 + (tidx >> 6), nw = gridDim.x * 8;
  for (int row = gw; row < nrows; row += nw) {
    const f32x4* xr = (const f32x4*)(X + (size_t)row * 2048);
    f32x4 v[8];
    float ss = 0.f;
#pragma unroll
    for (int i = 0; i < 8; ++i) { v[i] = xr[lane + 64 * i]; ss += v[i][0] * v[i][0] + v[i][1] * v[i][1] + v[i][2] * v[i][2] + v[i][3] * v[i][3]; }
    ss = wave_sum(ss);
    const float r = rsqrtf(ss * (1.f / 2048.f) + 1e-6f);
#pragma unroll
    for (int i = 0; i < 8; ++i) {
      const f32x4 gg = ((const f32x4*)g)[lane + 64 * i];
      f32x4 o = {v[i][0] * r * gg[0], v[i][1] * r * gg[1], v[i][2] * r * gg[2], v[i][3] * r * gg[3]};
      if (F32OUT) ((f32x4*)((float*)outp + (size_t)row * 2048))[lane + 64 * i] = o;
      else { u32x2 pk = {pk2(o[0], o[1]), pk2(o[2], o[3])}; ((u32x2*)((u16*)outp + (size_t)row * 2048))[lane + 64 * i] = pk; }
    }
  }
}

DI void anorm_phase(u16* C, const float* __restrict__ gq, const float* __restrict__ gkv) {
  int tidx = threadIdx.x; asm volatile("" : "+v"(tidx));
  const int lane = tidx & 63, gw = blockIdx.x * 8 + (tidx >> 6), nw = gridDim.x * 8;
  for (int row = gw; row < NTOK; row += nw) {
    u32x4* cr = (u32x4*)(C + (size_t)row * 2048);
    u32x4 v[4];
    float sq = 0.f, skv = 0.f;
#pragma unroll
    for (int i = 0; i < 4; ++i) {
      v[i] = cr[lane + 64 * i];
      float s = 0.f;
#pragma unroll
      for (int j = 0; j < 4; ++j) { float a = bf2f(v[i][j] & 0xffffu), b = bf2f(v[i][j] >> 16); s += a * a + b * b; }
      if (i < 3) sq += s; else skv += s;
    }
    sq = wave_sum(sq); skv = wave_sum(skv);
    const float rq = rsqrtf(sq * (1.f / 1536.f) + 1e-6f), rkv = rsqrtf(skv * (1.f / 512.f) + 1e-6f);
#pragma unroll
    for (int i = 0; i < 4; ++i) {
      const int col = (lane + 64 * i) * 8;
      const float* gp = (i < 3) ? (gq + col) : (gkv + col - 1536);
      const float r = (i < 3) ? rq : rkv;
      const f32x4 g0 = *(const f32x4*)gp, g1 = *(const f32x4*)(gp + 4);
      u32x4 o;
      o[0] = pk2(bf2f(v[i][0] & 0xffffu) * r * g0[0], bf2f(v[i][0] >> 16) * r * g0[1]);
      o[1] = pk2(bf2f(v[i][1] & 0xffffu) * r * g0[2], bf2f(v[i][1] >> 16) * r * g0[3]);
      o[2] = pk2(bf2f(v[i][2] & 0xffffu) * r * g1[0], bf2f(v[i][2] >> 16) * r * g1[1]);
      o[3] = pk2(bf2f(v[i][3] & 0xffffu) * r * g1[2], bf2f(v[i][3] >> 16) * r * g1[3]);
      cr[lane + 64 * i] = o;
    }
  }
}

namespace pg8 {
#define PG8_LAS __attribute__((address_space(3)))
constexpr int BM = 256, BK = 64, HALF = 128, HTB = HALF * BK * 2, STAGE_BYTES = 8 * HTB, NXCD = 8, WGM = 8;
DI int lds_byte(int r, int c) { const int st = (r >> 4) * 2 + (c >> 5), rr = r & 15, cc = c & 31, ob = rr * 64 + cc * 2; return st * 1024 + (ob ^ (((ob >> 9) & 1) << 5)); }
DI void stage_rc(int b, int& R, int& C) { const int st = b / 1024, sb = b % 1024, swz = sb ^ (((sb >> 9) & 1) << 5); R = (st >> 1) * 16 + swz / 64; C = (st & 1) * 32 + (swz % 64) / 2; }
DI int perm32(int rho) { const int n = rho >> 4, i = rho & 15; return 8 * (i >> 2) + 4 * n + (i & 3); }
struct Unit { int pm, pn; };
struct Gemm { const u16* A; const u16* Bt; int M, N, K, lda; };
struct StaticOrder {
  int nM, nN, nwg, G, c;
  DI void init(int M, int N, int G_, int c_) { nM = M / BM; nN = N / BM; nwg = nM * nN; G = G_; c = c_; }
  DI bool next(int i, Unit& u) const {
    const long L = (long)i * G + c; if (L >= nwg) return false;
    int wgid = (int)L; { const int q = nwg / NXCD, r = nwg % NXCD, xcd = wgid % NXCD, off = wgid / NXCD; wgid = (xcd < r ? xcd * (q + 1) : r * (q + 1) + (xcd - r) * q) + off; }
    const int nig = WGM * nN, gid = wgid / nig, fm = gid * WGM, gsz = (nM - fm) < WGM ? (nM - fm) : WGM;
    u.pm = fm + ((wgid % nig) % gsz); u.pn = (wgid % nig) / gsz; return true;
  }
  DI void a_ready(const Unit&) const {}
  DI void done(const Unit&) const {}
};
template <class Epi, class Sched>
__device__ __forceinline__ void gemm_phase(PG8_LAS unsigned char* lds, const Gemm g, const Sched& S, const Epi& E) {
    int tid = threadIdx.x; asm volatile("" : "+v"(tid));
    const int wid = __builtin_amdgcn_readfirstlane(tid >> 6), lane = tid & 63, wr = wid >> 2, wc = wid & 3, fr = lane & 15, fq = lane >> 4;
    const int K = g.K, nt = K / BK;
    unsigned voffA[2], voffB[2];
#pragma unroll
    for (int i = 0; i < 2; ++i) { int R, C; stage_rc(tid * 16 + i * 8192, R, C); const int Rb = Epi::PERM ? ((R & ~31) + perm32(R & 31)) : R;
        voffA[i] = (unsigned)(R * g.lda + C) * 2u; voffB[i] = (unsigned)(Rb * K + C) * 2u; }
    const size_t kstep = (size_t)(BK * 2);
    const size_t hstep = (size_t)HALF * K * 2, hstepA = (size_t)HALF * g.lda * 2;
    const size_t tstep = 2 * hstep, tstepA = 2 * hstepA;
    const unsigned ldsw = (unsigned)wid * 1024u;
    const int aoff = lds_byte(wr * 64 + fr, fq * 8), boff = lds_byte(wc * 32 + fr, fq * 8);
#define PG8_SA(b, h) (((b) * 2 + (h)) * HTB)
#define PG8_SB(b, h) ((4 + (b) * 2 + (h)) * HTB)
#define PG8_STAGE(bufoff, gbase, voff) do { _Pragma("unroll") for (int _i = 0; _i < 2; ++_i) \
        __builtin_amdgcn_global_load_lds((const unsigned*)((const char*)(gbase) + (voff)[_i]), (PG8_LAS unsigned*)(lds + (bufoff) + ldsw + _i * 8192), 16, 0, 0); } while (0)
#define PG8_LDA(dst, b, h) do { _Pragma("unroll") for (int m = 0; m < 4; ++m) _Pragma("unroll") for (int k = 0; k < 2; ++k) dst[m][k] = *(const PG8_LAS bf16x8*)(lds + PG8_SA(b, h) + aoff + m * 2048 + k * 1024); } while (0)
#define PG8_LDB(dst, b, h) do { _Pragma("unroll") for (int n = 0; n < 2; ++n) _Pragma("unroll") for (int k = 0; k < 2; ++k) dst[n][k] = *(const PG8_LAS bf16x8*)(lds + PG8_SB(b, h) + boff + n * 2048 + k * 1024); } while (0)
#define PG8_MMA(ai, bj, At, Bt) do { __builtin_amdgcn_s_setprio(1); _Pragma("unroll") for (int m = 0; m < 4; ++m) _Pragma("unroll") for (int n = 0; n < 2; ++n) _Pragma("unroll") for (int k = 0; k < 2; ++k) \
        acc[ai][bj][m][n] = __builtin_amdgcn_mfma_f32_16x16x32_bf16(Bt[n][k], At[m][k], acc[ai][bj][m][n], 0, 0, 0); __builtin_amdgcn_s_setprio(0); } while (0)
#define PG8_WAIT_V(n) asm volatile("s_waitcnt vmcnt(" #n ")" ::: "memory")
#define PG8_WAIT_L(n) asm volatile("s_waitcnt lgkmcnt(" #n ")" ::: "memory")
#define PG8_BAR __builtin_amdgcn_s_barrier()
#define PG8_SCHED __builtin_amdgcn_sched_barrier(0)
    Unit cur, nxt; int ui = 0;
    if (!S.next(0, cur)) return;
    f32x4 acc[2][2][4][2];
#pragma unroll
    for (int a = 0; a < 2; ++a)
#pragma unroll
        for (int b = 0; b < 2; ++b)
#pragma unroll
            for (int m = 0; m < 4; ++m)
#pragma unroll
                for (int n = 0; n < 2; ++n) acc[a][b][m][n] = (f32x4){0.f, 0.f, 0.f, 0.f};
    bf16x8 At[4][2], B0[2][2], B1[2][2];
    const char* cA = (const char*)g.A + (size_t)cur.pm * tstepA; const char* cB = (const char*)g.Bt + (size_t)cur.pn * tstep;
    S.a_ready(cur);
    PG8_STAGE(PG8_SB(0, 0), cB, voffB); PG8_STAGE(PG8_SA(0, 0), cA, voffA); PG8_STAGE(PG8_SB(0, 1), cB + hstep, voffB); PG8_STAGE(PG8_SA(0, 1), cA + hstepA, voffA);
    if (wr == 1) PG8_BAR;
    PG8_WAIT_V(4); PG8_BAR;
    PG8_STAGE(PG8_SB(1, 0), cB + kstep, voffB); PG8_STAGE(PG8_SA(1, 0), cA + kstep, voffA); PG8_STAGE(PG8_SB(1, 1), cB + hstep + kstep, voffB);
    PG8_WAIT_V(6); PG8_BAR;
    for (;;) {
        const bool has_next = S.next(ui + 1, nxt);
        const char* nA = has_next ? (const char*)g.A + (size_t)nxt.pm * tstepA : cA; const char* nB = has_next ? (const char*)g.Bt + (size_t)nxt.pn * tstep : cB;
        for (int t = 0; t < nt; t += 2) {
            const bool last = (t == nt - 2);
            const char* a1 = cA + (size_t)(t + 1) * kstep;
            const char* a2 = last ? nA : cA + (size_t)(t + 2) * kstep; const char* b2 = last ? nB : cB + (size_t)(t + 2) * kstep;
            const char* a3 = a2 + kstep; const char* b3 = b2 + kstep;
            if (last && has_next) S.a_ready(nxt);
            PG8_LDB(B0, 0, 0); PG8_SCHED; PG8_LDA(At, 0, 0); PG8_STAGE(PG8_SA(1, 1), a1 + hstepA, voffA);
            PG8_WAIT_L(8); PG8_BAR; PG8_WAIT_L(0); PG8_MMA(0, 0, At, B0); PG8_BAR; PG8_SCHED;
            PG8_LDB(B1, 0, 1); PG8_STAGE(PG8_SB(0, 0), b2, voffB);
            PG8_BAR; PG8_WAIT_L(0); PG8_MMA(0, 1, At, B1); PG8_BAR;
            PG8_LDA(At, 0, 1); PG8_STAGE(PG8_SA(0, 0), a2, voffA);
            PG8_BAR; PG8_WAIT_L(0); PG8_MMA(1, 0, At, B0); PG8_BAR; PG8_SCHED;
            PG8_STAGE(PG8_SB(0, 1), b2 + hstep, voffB);
            PG8_WAIT_V(6); PG8_BAR; PG8_MMA(1, 1, At, B1); PG8_BAR;
            PG8_LDB(B0, 1, 0); PG8_SCHED; PG8_LDA(At, 1, 0); PG8_STAGE(PG8_SA(0, 1), a2 + hstepA, voffA);
            PG8_WAIT_L(8); PG8_BAR; PG8_WAIT_L(0); PG8_MMA(0, 0, At, B0); PG8_BAR; PG8_SCHED;
            PG8_LDB(B1, 1, 1); PG8_STAGE(PG8_SB(1, 0), b3, voffB);
            PG8_BAR; PG8_WAIT_L(0); PG8_MMA(0, 1, At, B1); PG8_BAR;
            PG8_LDA(At, 1, 1); PG8_STAGE(PG8_SA(1, 0), a3, voffA);
            PG8_BAR; PG8_WAIT_L(0); PG8_MMA(1, 0, At, B0); PG8_BAR; PG8_SCHED;
            PG8_STAGE(PG8_SB(1, 1), b3 + hstep, voffB);
            PG8_WAIT_V(6); PG8_BAR; PG8_MMA(1, 1, At, B1); PG8_BAR;
        }
        if constexpr (!Epi::AFTER_DRAIN) { E(acc, cur, wr, wc, fr, fq); S.done(cur); }
        if (!has_next) break;
#pragma unroll
        for (int a = 0; a < 2; ++a)
#pragma unroll
            for (int b = 0; b < 2; ++b)
#pragma unroll
                for (int m = 0; m < 4; ++m)
#pragma unroll
                    for (int n = 0; n < 2; ++n) acc[a][b][m][n] = (f32x4){0.f, 0.f, 0.f, 0.f};
        cur = nxt; cA = nA; cB = nB; ++ui;
    }
    PG8_WAIT_V(0);
    if (wr == 0) PG8_BAR;
    PG8_BAR;
    if constexpr (Epi::AFTER_DRAIN) { E.fused(acc, cur, wr, wc, fr, fq, lds, wid, lane); S.done(cur); }
#undef PG8_SA
#undef PG8_SB
#undef PG8_STAGE
#undef PG8_LDA
#undef PG8_LDB
#undef PG8_MMA
#undef PG8_WAIT_V
#undef PG8_WAIT_L
#undef PG8_BAR
#undef PG8_SCHED
}

}

struct EpiResid {
  static constexpr bool PERM = false, AFTER_DRAIN = false;
  const float* xin; float* xout;
  DI void operator()(const f32x4 (&acc)[2][2][4][2], const pg8::Unit& u, int wr, int wc, int fr, int fq) const {
    const int row0 = u.pm * 256 + wr * 64 + fr, col0 = u.pn * 256 + wc * 32 + 4 * fq;
#pragma unroll
    for (int ai = 0; ai < 2; ++ai)
#pragma unroll
      for (int m = 0; m < 4; ++m) {
        const size_t ro = (size_t)(row0 + ai * 128 + m * 16) * 2048 + col0;
#pragma unroll
        for (int bj = 0; bj < 2; ++bj)
#pragma unroll
          for (int n = 0; n < 2; ++n) {
            const size_t o = ro + bj * 128 + n * 16;
            const f32x4 xv = *(const f32x4*)(xin + o);
            *(f32x4*)(xout + o) = xv + acc[ai][bj][m][n];
          }
        asm volatile("" ::: "memory");
      }
  }
};
template <int MODE>
struct EpiBf {
  static constexpr bool PERM = true, AFTER_DRAIN = false;
  u16* d0; int ld0; int N; u16* d1; u16* d2; const f32x2* rope;
  DI void rot(f32x4& v0, f32x4& v1, int row, int col) const {
    const f32x4* cp = (const f32x4*)(rope + (row & 2047) * 32 + ((col & 63) >> 1));
    const f32x4 c01 = cp[0], c23 = cp[1];
    const f32x4 a = {v0[0] * c01[0] - v0[1] * c01[1], v0[1] * c01[0] + v0[0] * c01[1], v0[2] * c01[2] - v0[3] * c01[3], v0[3] * c01[2] + v0[2] * c01[3]};
    const f32x4 b = {v1[0] * c23[0] - v1[1] * c23[1], v1[1] * c23[0] + v1[0] * c23[1], v1[2] * c23[2] - v1[3] * c23[3], v1[3] * c23[2] + v1[2] * c23[3]};
    v0 = a; v1 = b;
  }
  DI void operator()(const f32x4 (&acc)[2][2][4][2], const pg8::Unit& u, int wr, int wc, int fr, int fq) const {
    const int row0 = u.pm * 256 + wr * 64 + fr, colb = u.pn * 256 + wc * 32 + 8 * fq;
#pragma unroll
    for (int ai = 0; ai < 2; ++ai)
#pragma unroll
      for (int m = 0; m < 4; ++m) {
        const int row = row0 + ai * 128 + m * 16;
#pragma unroll
        for (int bj = 0; bj < 2; ++bj) {
          const int col = colb + bj * 128;
          f32x4 v0 = acc[ai][bj][m][0], v1 = acc[ai][bj][m][1];
          u16* dst = nullptr;
          if (MODE == 0) { if (col < N) dst = d0 + (size_t)row * ld0 + col; }
          else if (MODE == 1) {
            if (col < 2048) dst = d0 + (size_t)row * 2048 + col;
            else if (col < 2112) { rot(v0, v1, row, col); dst = d2 + (size_t)row * 64 + (col - 2048); }
            else if (col < 6208) dst = d1 + (size_t)row * 4096 + (col - 2112);
          } else {
            if (((col >> 6) % 3) == 2) rot(v0, v1, row, col);
            dst = d0 + (size_t)row * 3072 + col;
          }
          if (dst) { u32x4 w = {pk2(v0[0], v0[1]), pk2(v0[2], v0[3]), pk2(v1[0], v1[1]), pk2(v1[2], v1[3])}; *(u32x4*)dst = w; }
        }
        asm volatile("" ::: "memory");
      }
  }
};

template <class Epi>
DI void run_gemm(const u16* A, int lda, const u16* Bt, int M, int N, int K, const Epi& e, char* smem) {
  __syncthreads();
  pg8::Gemm g{A, Bt, M, N, K, lda};
  pg8::StaticOrder S; S.init(M, N, gridDim.x, blockIdx.x);
  pg8::gemm_phase(( __attribute__((address_space(3))) unsigned char*)smem, g, S, e);
  __syncthreads();
}

typedef __attribute__((address_space(3))) unsigned* lds_u32p;
template <int OFF> DI void rd4(bf16x8 (&f)[4], unsigned addr) {
  asm volatile("ds_read_b128 %0, %4 offset:%5\n\tds_read_b128 %1, %4 offset:%6\n\tds_read_b128 %2, %4 offset:%7\n\tds_read_b128 %3, %4 offset:%8\n\ts_waitcnt lgkmcnt(0)"
               : "=&v"(f[0]), "=&v"(f[1]), "=&v"(f[2]), "=&v"(f[3]) : "v"(addr), "i"(OFF), "i"(OFF + 32), "i"(OFF + 64), "i"(OFF + 96) : "memory");
}
template <int OFF> DI void rdv8(s16x4 (&v)[8], unsigned addr) {
  asm volatile("ds_read_b64_tr_b16 %0, %8 offset:%9\n\tds_read_b64_tr_b16 %1, %8 offset:%10\n\tds_read_b64_tr_b16 %2, %8 offset:%11\n\tds_read_b64_tr_b16 %3, %8 offset:%12\n\t"
               "ds_read_b64_tr_b16 %4, %8 offset:%13\n\tds_read_b64_tr_b16 %5, %8 offset:%14\n\tds_read_b64_tr_b16 %6, %8 offset:%15\n\tds_read_b64_tr_b16 %7, %8 offset:%16\n\ts_waitcnt lgkmcnt(0)"
               : "=&v"(v[0]), "=&v"(v[1]), "=&v"(v[2]), "=&v"(v[3]), "=&v"(v[4]), "=&v"(v[5]), "=&v"(v[6]), "=&v"(v[7])
               : "v"(addr), "i"(OFF), "i"(OFF + 512), "i"(OFF + 1024), "i"(OFF + 1536), "i"(OFF + 2048), "i"(OFF + 2560), "i"(OFF + 3072), "i"(OFF + 3584) : "memory");
}
template <int KSTR, int ND, int N>
DI f32x16 s_block(unsigned kaddr, const bf16x8* qf) {
  const f32x16 z16 = {0.f, 0.f, 0.f, 0.f, 0.f, 0.f, 0.f, 0.f, 0.f, 0.f, 0.f, 0.f, 0.f, 0.f, 0.f, 0.f};
  bf16x8 f[4];
  rd4<N * 32 * KSTR>(f, kaddr);
  f32x16 a = MFMA(f[0], qf[0], z16); a = MFMA(f[1], qf[1], a); a = MFMA(f[2], qf[2], a); a = MFMA(f[3], qf[3], a);
  if constexpr (ND > 4) { rd4<N * 32 * KSTR + 128>(f, kaddr); a = MFMA(f[0], qf[4], a); a = MFMA(f[1], qf[5], a); a = MFMA(f[2], qf[6], a); a = MFMA(f[3], qf[7], a); }
  if constexpr (ND > 8) { rd4<N * 32 * KSTR + 256>(f, kaddr); a = MFMA(f[0], qf[8], a); a = MFMA(f[1], qf[9], a); a = MFMA(f[2], qf[10], a); a = MFMA(f[3], qf[11], a); }
  if constexpr (ND > 12) { rd4<N * 32 * KSTR + 384>(f, kaddr); a = MFMA(f[0], qf[12], a); a = MFMA(f[1], qf[13], a); a = MFMA(f[2], qf[14], a); a = MFMA(f[3], qf[15], a); }
  return a;
}
template <int CB> DI void pv_block(f32x16& o, unsigned vaddr, const bf16x8 (&pb)[2][2]) {
  s16x4 v[8];
  rdv8<CB * 4096>(v, vaddr);
#pragma unroll
  for (int q = 0; q < 4; ++q) {
    const bf16x8 vf = {v[2 * q][0], v[2 * q][1], v[2 * q][2], v[2 * q][3], v[2 * q + 1][0], v[2 * q + 1][1], v[2 * q + 1][2], v[2 * q + 1][3]};
    o = MFMA(vf, pb[q >> 1][q & 1], o);
  }
}
template <int DQK, int W1, int DV, int VW, int MODE>
DI void attn_core(const u16* __restrict__ k1, int ldk1, const u16* __restrict__ k2, int ldk2, const u16* __restrict__ vsrc, int ldv,
                  int kv_len, int kbase0, int ntiles, const u16* qrow, int tq, int tq0, float c2, int vcb0, u16* yrow,
                  const u16* grow, const unsigned* maskrow, const float* lutw, float bias_far, float m_init, float l_init, char* smem) {
  constexpr int KSTR = DQK * 2 + 16, KCH = DQK / 8;
  constexpr int ND = DQK / 16, NCB = DV / 32, BUF = 64 * KSTR + (VW / 32) * 4096;
  constexpr int NKI = KSTR / 16, NVI = VW / 8;
  static_assert(ND % 4 == 0 && NCB <= 4, "fragment batches");
  int tid0 = threadIdx.x; asm volatile("" : "+v"(tid0));
  const int lane = tid0 & 63, r32 = lane & 31, hi = lane >> 5;
  const int wv = __builtin_amdgcn_readfirstlane(tid0 >> 6);
  const unsigned lds0 = (unsigned)(uintptr_t)smem;
  bf16x8 qf[ND];
#pragma unroll
  for (int d0 = 0; d0 < ND; ++d0) qf[d0] = *(const bf16x8*)(qrow + d0 * 16 + hi * 8);
  f32x16 o[NCB];
#pragma unroll
  for (int cb = 0; cb < NCB; ++cb)
#pragma unroll
    for (int r = 0; r < 16; ++r) o[cb][r] = 0.f;
  float m = m_init, l = l_init;
  const unsigned klane = (unsigned)(r32 * KSTR + hi * 16);
  const unsigned vlane = (unsigned)(64 * KSTR + vcb0 * 4096 + ((lane >> 4) & 1) * 32 + (lane & 3) * 8 + (4 * hi + ((lane & 15) >> 2)) * 64);
  unsigned mwn[2] = {0u, 0u};
  auto stage_tile = [&](int kb, int buf) {
    int ln = threadIdx.x & 63; asm volatile("" : "+v"(ln));
    const unsigned bofs = (unsigned)(buf * BUF);
#pragma unroll
    for (int ii = 0; ii < (NKI + 7) / 8; ++ii) {
      const int i = wv + 8 * ii;
      if (i < NKI) {
        const int ob = i * 1024 + ln * 16, row = ob / KSTR;
        int c = (ob - row * KSTR) >> 4; c = (c >= KCH) ? 0 : c;
        int key = kb + row; key = key < 0 ? 0 : (key >= kv_len ? kv_len - 1 : key);
        const u16* src = (c < W1 / 8) ? (k1 + (key * ldk1 + c * 8)) : (k2 + (key * ldk2 + (c - W1 / 8) * 8));
        __builtin_amdgcn_global_load_lds((const unsigned*)src, (lds_u32p)(smem + bofs + i * 1024), 16, 0, 0);
      }
    }
#pragma unroll
    for (int ii = 0; ii < (NVI + 7) / 8; ++ii) {
      const int i = wv + 8 * ii;
      if (i < NVI) {
        const int ob = i * 1024 + ln * 16, cbk = ob >> 12, row = (ob & 4095) >> 6, cw = (ob & 63) >> 4;
        int key = kb + row; key = key < 0 ? 0 : (key >= kv_len ? kv_len - 1 : key);
        __builtin_amdgcn_global_load_lds((const unsigned*)(vsrc + (key * ldv + (cbk * 4 + cw) * 8)), (lds_u32p)(smem + bofs + 64 * KSTR + i * 1024), 16, 0, 0);
      }
    }
    if (MODE == 1) { mwn[0] = maskrow[(kb >> 5)]; mwn[1] = maskrow[(kb >> 5) + 1]; }
  };
  stage_tile(kbase0, 0);
  asm volatile("s_waitcnt vmcnt(0)" ::: "memory");
  __syncthreads();
  for (int t = 0; t < ntiles; ++t) {
    const int kb = kbase0 + t * 64;
    const unsigned bufa = lds0 + (unsigned)((t & 1) * BUF);
    const unsigned mw0 = mwn[0], mw1 = mwn[1];
    if (t + 1 < ntiles) stage_tile(kb + 64, (t + 1) & 1);
    if (!(MODE == 0 && kb > tq0 + 31)) {
      f32x16 s[2];
      {
        constexpr int BPN = ND / 4, NBT = 2 * BPN;
        const char* kp = smem + (t & 1) * BUF + klane;
        bf16x8 kfr[2][4];
#pragma unroll
        for (int j = 0; j < 4; ++j) kfr[0][j] = *(const bf16x8*)(kp + j * 32);
#pragma unroll
        for (int bt = 0; bt < NBT; ++bt) {
          if (bt + 1 < NBT) {
            const int nn = (bt + 1) / BPN, qq = ((bt + 1) % BPN) * 4;
#pragma unroll
            for (int j = 0; j < 4; ++j) kfr[(bt + 1) & 1][j] = *(const bf16x8*)(kp + nn * 32 * KSTR + (qq + j) * 32);
          }
          __builtin_amdgcn_sched_barrier(0);
          const int n = bt / BPN, q0 = (bt % BPN) * 4;
          if (q0 == 0) { const f32x16 z16 = {0.f, 0.f, 0.f, 0.f, 0.f, 0.f, 0.f, 0.f, 0.f, 0.f, 0.f, 0.f, 0.f, 0.f, 0.f, 0.f}; s[n] = MFMA(kfr[bt & 1][0], qf[0], z16); }
          else s[n] = MFMA(kfr[bt & 1][0], qf[q0], s[n]);
#pragma unroll
          for (int j = 1; j < 4; ++j) s[n] = MFMA(kfr[bt & 1][j], qf[q0 + j], s[n]);
          __builtin_amdgcn_sched_barrier(0);
        }
      }
      if (MODE == 0) {
        const bool diag = kb + 63 > tq0;
#pragma unroll
        for (int n = 0; n < 2; ++n)
#pragma unroll
          for (int i = 0; i < 16; ++i) {
            float v = s[n][i] * c2;
            if (diag) { const int key = kb + 32 * n + crow(i, hi); if (key > tq) v = NEGV; }
            s[n][i] = v;
          }
      } else if (MODE == 1) {
        const bool far = (tq0 - (kb + 63)) >= 128;
#pragma unroll
        for (int n = 0; n < 2; ++n) {
          const unsigned wb = (n ? mw1 : mw0) >> (4 * hi);
          if (far) {
#pragma unroll
            for (int i = 0; i < 16; ++i) {
              const float v = fmaf(s[n][i], c2, bias_far);
              s[n][i] = ((wb >> ((i & 3) + 8 * (i >> 2))) & 1u) ? v : NEGV;
            }
          } else {
#pragma unroll
            for (int i = 0; i < 16; ++i) {
              const int key = kb + 32 * n + crow(i, hi);
              int rel = tq - key; rel = rel < 0 ? 0 : (rel > 128 ? 128 : rel);
              const float v = fmaf(s[n][i], c2, lutw[rel]);
              s[n][i] = ((wb >> ((i & 3) + 8 * (i >> 2))) & 1u) ? v : NEGV;
            }
          }
        }
      } else if (MODE == 2) {
#pragma unroll
        for (int n = 0; n < 2; ++n)
#pragma unroll
          for (int i = 0; i < 16; ++i) {
            const int key = kb + 32 * n + crow(i, hi), rel = tq - key;
            const bool ok = ((unsigned)rel < 128u) && (key >= 0);
            const float v = fmaf(s[n][i], c2, lutw[rel & 127]);
            s[n][i] = ok ? v : NEGV;
          }
      } else {
#pragma unroll
        for (int n = 0; n < 2; ++n)
#pragma unroll
          for (int i = 0; i < 16; ++i) s[n][i] *= c2;
      }
      float mx = s[0][0];
#pragma unroll
      for (int i = 1; i < 16; ++i) mx = fmaxf(mx, s[0][i]);
#pragma unroll
      for (int i = 0; i < 16; ++i) mx = fmaxf(mx, s[1][i]);
      mx = xhalf_max(mx);
      if (__any(mx - m > 8.0f)) {
        const float mnew = fmaxf(m, mx), alpha = __builtin_amdgcn_exp2f(m - mnew);
        m = mnew; l *= alpha;
#pragma unroll
        for (int cb = 0; cb < NCB; ++cb)
#pragma unroll
          for (int r = 0; r < 16; ++r) o[cb][r] *= alpha;
      }
      float ps = 0.f;
#pragma unroll
      for (int n = 0; n < 2; ++n)
#pragma unroll
        for (int i = 0; i < 16; ++i) { const float p = __builtin_amdgcn_exp2f(s[n][i] - m); ps += p; s[n][i] = p; }
      l += ps;
      bf16x8 pb[2][2];
#pragma unroll
      for (int n = 0; n < 2; ++n)
#pragma unroll
        for (int s2 = 0; s2 < 2; ++s2) {
          u32x4 pw = {pk2(s[n][8 * s2 + 0], s[n][8 * s2 + 1]), pk2(s[n][8 * s2 + 2], s[n][8 * s2 + 3]),
                      pk2(s[n][8 * s2 + 4], s[n][8 * s2 + 5]), pk2(s[n][8 * s2 + 6], s[n][8 * s2 + 7])};
          pb[n][s2] = __builtin_bit_cast(bf16x8, pw);
        }
      {
        const char* vp = smem + (t & 1) * BUF + vlane;
        s16x4 vfr[2][8];
#pragma unroll
        for (int k = 0; k < 8; ++k) vfr[0][k] = vtr(vp + 512 * k);
#pragma unroll
        for (int cb = 0; cb < NCB; ++cb) {
          if (cb + 1 < NCB) {
#pragma unroll
            for (int k = 0; k < 8; ++k) vfr[(cb + 1) & 1][k] = vtr(vp + (cb + 1) * 4096 + 512 * k);
          }
          __builtin_amdgcn_sched_barrier(0);
#pragma unroll
          for (int q = 0; q < 4; ++q) {
            const s16x4 lo = vfr[cb & 1][2 * q], hi4 = vfr[cb & 1][2 * q + 1];
            const bf16x8 vf = {lo[0], lo[1], lo[2], lo[3], hi4[0], hi4[1], hi4[2], hi4[3]};
            o[cb] = MFMA(vf, pb[q >> 1][q & 1], o[cb]);
          }
          __builtin_amdgcn_sched_barrier(0);
        }
      }
    }
    asm volatile("s_waitcnt vmcnt(0)" ::: "memory");
    __syncthreads();
  }
  const float inv = 1.f / xhalf_sum(l);
#pragma unroll
  for (int cb = 0; cb < NCB; ++cb)
#pragma unroll
    for (int g = 0; g < 4; ++g) {
      const int dv = 32 * cb + 8 * g + 4 * hi;
      const u32x2 gg = *(const u32x2*)(grow + dv);
      float gv[4] = {bf2f(gg[0] & 0xffffu), bf2f(gg[0] >> 16), bf2f(gg[1] & 0xffffu), bf2f(gg[1] >> 16)};
      float ov[4];
#pragma unroll
      for (int j = 0; j < 4; ++j) {
        const float sg = gv[j] / (1.f + __expf(-gv[j]));
        ov[j] = o[cb][4 * g + j] * inv * sg;
      }
      u32x2 st = {pk2(ov[0], ov[1]), pk2(ov[2], ov[3])};
      *(u32x2*)(yrow + dv) = st;
      __builtin_amdgcn_sched_barrier(0);
    }
}

DI unsigned ordkey(float f) { const unsigned b = __float_as_uint(f); return b ^ ((unsigned)((int)b >> 31) | 0x80000000u); }
DI void indexer_phase(const u16* __restrict__ P, unsigned* __restrict__ mask) {
  int tidx = threadIdx.x; asm volatile("" : "+v"(tidx));
  const int lane = tidx & 63, r32 = lane & 31, hi = lane >> 5;
  const int gw = blockIdx.x * 8 + (tidx >> 6), nw = gridDim.x * 8;
  for (int item = gw; item < 8192; item += nw) {
    const int b = item & 7, t0 = (1023 - (item >> 3)) * 2;
    const size_t brow = (size_t)b * SEQ;
    const int g = (r32 >> 2) & 1, head = 4 * (r32 >> 3) + (r32 & 3);
    bf16x8 aq[4];
#pragma unroll
    for (int s = 0; s < 4; ++s) aq[s] = *(const bf16x8*)(P + (brow + t0 + g) * 7808 + 2560 + head * 64 + 16 * s + 8 * hi);
    float wv[16];
    {
      const u32x4 w0 = *(const u32x4*)(P + (brow + t0 + hi) * 7808 + 3648), w1 = *(const u32x4*)(P + (brow + t0 + hi) * 7808 + 3656);
#pragma unroll
      for (int j = 0; j < 4; ++j) { wv[2 * j] = bf2f(w0[j] & 0xffffu); wv[2 * j + 1] = bf2f(w0[j] >> 16); wv[8 + 2 * j] = bf2f(w1[j] & 0xffffu); wv[8 + 2 * j + 1] = bf2f(w1[j] >> 16); }
    }
    const int tme = t0 + hi, kbmax = (t0 + 1) >> 5;
    unsigned sc[64];
#pragma unroll
    for (int kb = 0; kb < 64; ++kb) {
      unsigned u = 0u;
      if (kb <= kbmax) {
        f32x16 a;
#pragma unroll
        for (int r = 0; r < 16; ++r) a[r] = 0.f;
        const u16* kp = P + (brow + 32 * kb + r32) * 7808 + 3584 + 8 * hi;
#pragma unroll
        for (int s = 0; s < 4; ++s) { const bf16x8 bk = *(const bf16x8*)(kp + 16 * s); a = MFMA(aq[s], bk, a); }
        float v = 0.f;
#pragma unroll
        for (int i = 0; i < 16; ++i) v = fmaf(wv[i], fmaxf(a[i], 0.f), v);
        u = (32 * kb + r32 <= tme) ? ordkey(v) : 0u;
      }
      sc[kb] = u;
    }
    const int target = (tme + 1 < 256) ? tme + 1 : 256;
    unsigned T = 0u;
    for (int bit = 31; bit >= 0; --bit) {
      const unsigned Tp = T | (1u << bit);
      int cnt = 0;
#pragma unroll
      for (int kb = 0; kb < 64; ++kb) cnt += (sc[kb] >= Tp) ? 1 : 0;
#pragma unroll
      for (int o = 16; o; o >>= 1) cnt += __shfl_xor(cnt, o);
      if (cnt >= target) T = Tp;
    }
    unsigned w0 = 0u, w1 = 0u;
#pragma unroll
    for (int kb = 0; kb < 64; ++kb) {
      const bool pred = (sc[kb] >= T) && (sc[kb] != 0u);
      const unsigned long long bal = __ballot(pred);
      const unsigned wd = (unsigned)(bal >> (32 * hi));
      if ((kb & 31) == r32) { if (kb < 32) w0 = wd; else w1 = wd; }
    }
    mask[(brow + tme) * 64 + r32] = w0;
    mask[(brow + tme) * 64 + 32 + r32] = w1;
  }
}

DI void gbar(unsigned* cnt, unsigned target) {
  asm volatile("s_waitcnt vmcnt(0)" ::: "memory");
  __syncthreads();
  if (threadIdx.x == 0) {
    __builtin_amdgcn_fence(__ATOMIC_RELEASE, "agent");
    asm volatile("s_waitcnt vmcnt(0)" ::: "memory");
    __hip_atomic_fetch_add(cnt, 1u, __ATOMIC_RELAXED, __HIP_MEMORY_SCOPE_AGENT);
    while (__hip_atomic_load(cnt, __ATOMIC_RELAXED, __HIP_MEMORY_SCOPE_AGENT) < target) __builtin_amdgcn_s_sleep(1);
    __builtin_amdgcn_fence(__ATOMIC_ACQUIRE, "agent");
    asm volatile("s_waitcnt vmcnt(0)" ::: "memory");
  }
  __syncthreads();
}
#define GSYNC() do { ++bar_gen; gbar(BAR, bar_gen * gridDim.x); } while (0)
__global__ void __launch_bounds__(512, 2) mega(Params p) {
  cg::grid_group grid = cg::this_grid();
  extern __shared__ __attribute__((aligned(16))) char smem[];
  volatile int* s_item = (volatile int*)(smem + LDS_ITEM);
  char* ws = p.ws;
  u16* Y = (u16*)(ws + OFF_Y); u16* H = (u16*)(ws + OFF_H); u16* Cb = (u16*)(ws + OFF_Y); u16* Qb = (u16*)(ws + OFF_H);
  u16* KV = (u16*)(ws + OFF_KV); u16* MG = (u16*)(ws + OFF_MG); u16* KR = (u16*)(ws + OFF_KR); u16* Pb = (u16*)(ws + OFF_P);
  u16* WIN = (u16*)(ws + OFF_WIN); u16* WUQ = (u16*)(ws + OFF_WUQ); u16* WUKV = (u16*)(ws + OFF_WUKV); u16* WOUT = (u16*)(ws + OFF_WOUT);
  u16* WMEMALL = (u16*)(ws + OFF_KV); u16* MEMN = (u16*)(ws + OFF_MEMN); u16* MEMKV = (u16*)(ws + OFF_MEMKV);
  unsigned* MASK = (unsigned*)(ws + OFF_MASK); f32x2* ROPE = (f32x2*)(ws + OFF_ROPE); float* LUT = (float*)(ws + OFF_LUT);
  int* CTR = (int*)(ws + OFF_CTR);
  unsigned* BAR = (unsigned*)(ws + OFF_CTR) + 64;
  unsigned bar_gen = 0;
  const int tid = threadIdx.x, lane = tid & 63, wv = __builtin_amdgcn_readfirstlane(tid >> 6), r32 = lane & 31, hi = lane >> 5;
  const int gtid = blockIdx.x * 512 + tid, gthreads = gridDim.x * 512;

  for (int i = gtid; i < 2048 * 32; i += gthreads) {
    const int pos = i >> 5, j = i & 31;
    const float inv = 1.0f / powf(10000.0f, (float)(2 * j) / 64.0f);
    const float ang = (float)pos * inv;
    const float k = rintf(ang * 0.15915494309189535f);
    float r = fmaf(-k, 6.28318548202514648f, ang);
    r = fmaf(-k, -1.74845553e-7f, r);
    f32x2 cs = {__cosf(r), __sinf(r)};
    ROPE[i] = cs;
  }
  for (int i = gtid; i < 129 * 32; i += gthreads) {
    const int rel = i >> 5, h = i & 31;
    int bucket;
    if (rel < 16) bucket = rel;
    else { const int lg = 16 + (int)(logf((float)rel / 16.0f) / 2.0794415416798357f * 16.0f); bucket = lg < 31 ? lg : 31; }
    LUT[i] = p.rel_bias[bucket * 32 + h] * LOG2E;
  }
  rmsnorm_rows<false>(p.mem, p.mem_norm, MEMN, 2048);
#pragma unroll 1
  for (int l = 0; l < 4; ++l) convert_wt<0>(p.w_mem_kv + (size_t)l * 2048 * 2048, 2048, 2048, 2048, WMEMALL + (size_t)l * 2048 * 2048, smem);

#pragma unroll 1
  for (int layer = 0; layer < 4; ++layer) {
    const int kind = layer % 3, j = layer / 3;
    const float* xin = (layer == 0) ? p.x : p.out;
    rmsnorm_rows<false>(xin, p.norm_in + layer * 2048, H, NTOK);
    if (kind == 0) {
      convert_wt<1>(p.w_in_a + (size_t)j * 2048 * 6208, 2048, 6208, 6400, WIN, smem);
      convert_wt<2>(p.w_uq + (size_t)j * 1536 * 3072, 1536, 3072, 3072, WUQ, smem);
      convert_wt<0>(p.w_ukv + (size_t)j * 512 * 4096, 512, 4096, 4096, WUKV, smem);
    } else if (kind == 1) convert_wt<0>(p.w_in_b, 2048, 7760, 7936, WIN, smem);
    else convert_wt<0>(p.w_in_c, 2048, 6656, 6656, WIN, smem);
    convert_wt<0>(p.w_out + (size_t)layer * 3072 * 2048, 3072, 2048, 2048, WOUT, smem);
    if (layer == 0) { __builtin_amdgcn_fence(__ATOMIC_RELEASE, "agent"); grid.sync(); __builtin_amdgcn_fence(__ATOMIC_ACQUIRE, "agent"); asm volatile("s_waitcnt vmcnt(0)" ::: "memory"); }
    else GSYNC();

    if (kind == 0) { EpiBf<1> e{Cb, 2048, 6208, MG, KR, ROPE}; run_gemm(H, 2048, WIN, NTOK, 6400, 2048, e, smem); }
    else if (kind == 1) { EpiBf<0> e{Pb, 7808, 7760, nullptr, nullptr, nullptr}; run_gemm(H, 2048, WIN, NTOK, 7936, 2048, e, smem); }
    else { EpiBf<0> e{Pb, 6656, 6656, nullptr, nullptr, nullptr}; run_gemm(H, 2048, WIN, NTOK, 6656, 2048, e, smem); }
    if (layer == 0) { EpiBf<0> e{MEMKV, 8192, 8192, nullptr, nullptr, nullptr}; run_gemm(MEMN, 2048, WMEMALL, 2048, 8192, 2048, e, smem); }
    GSYNC();

    if (kind == 0) {
      anorm_phase(Cb, p.a_q_norm + j * 1536, p.a_kv_norm + j * 512);
      GSYNC();
      { EpiBf<2> e{Qb, 3072, 3072, nullptr, nullptr, ROPE}; run_gemm(Cb, 2048, WUQ, NTOK, 3072, 1536, e, smem); }
      { EpiBf<0> e{KV, 4096, 4096, nullptr, nullptr, nullptr}; run_gemm(Cb + 1536, 2048, WUKV, NTOK, 4096, 512, e, smem); }
      GSYNC();
    } else if (kind == 1) {
      indexer_phase(Pb, MASK);
      GSYNC();
    }

    {
      const int nself = (kind == 0) ? 1024 : 2048, total = nself + 512;
      const u16* mgb = (kind == 0) ? MG : Pb;
      const int ldmg = (kind == 0) ? 4096 : (kind == 1 ? 7808 : 6656);
      const int mqcol = (kind == 0) ? 0 : (kind == 1 ? 3664 : 2560);
      const int gatecol = (kind == 0) ? 1024 : (kind == 1 ? 4688 : 3584);
      const u16* memkv = MEMKV + layer * 2048;
      float* lut_all = (float*)(smem + LDS_LUT);
      if (kind != 0) {
        for (int i = tid; i < 32 * 129; i += 512) { const int h = i / 129, r = i - h * 129; lut_all[h * 132 + r] = LUT[r * 32 + h]; }
      }
      if (tid == 0) s_item[0] = atomicAdd(&CTR[layer], 1);
      __syncthreads();
      for (int par = 0;; par ^= 1) {
        const int item = __builtin_amdgcn_readfirstlane(s_item[par]);
        if (item >= total) break;
        if (tid == 0) s_item[par ^ 1] = atomicAdd(&CTR[layer], 1);
        if (item < nself) {
          if (kind == 0) {
            const int qblk = 7 - item / 128, rem = item % 128, b = rem / 16, head = rem % 16;
            const size_t brow = (size_t)b * SEQ;
            const int tq0 = qblk * 256 + 32 * wv, tq = tq0 + r32;
            attn_core<192, 128, 128, 128, 0>(KV + brow * 4096 + head * 256, 4096, KR + brow * 64, 64, KV + brow * 4096 + head * 256 + 128, 4096,
                                            SEQ, 0, 4 * qblk + 4, Qb + (brow + tq) * 3072 + head * 192, tq, tq0, 0.07216878364870322f * LOG2E, 0,
                                            Y + (brow + tq) * 3072 + head * 128, mgb + (brow + tq) * ldmg + gatecol + head * 128,
                                            nullptr, nullptr, 0.f, -1e29f, 0.f, smem);
          } else {
            const int qb = 63 - item / 32, rem = item % 32, b = rem / 4, kvh = rem % 4;
            const size_t brow = (size_t)b * SEQ;
            const int head = kvh * 8 + wv, tq0 = qb * 32, tq = tq0 + r32;
            const float* lutw = lut_all + head * 132;
            if (kind == 1) {
              attn_core<64, 64, 64, 64, 1>(Pb + brow * 7808 + 2048 + kvh * 64, 7808, nullptr, 0, Pb + brow * 7808 + 2304 + kvh * 64, 7808,
                                          SEQ, 0, (tq0 + 31) / 64 + 1, Pb + (brow + tq) * 7808 + head * 64, tq, tq0, 0.125f * LOG2E, 0,
                                          Y + (brow + tq) * 3072 + head * 64, Pb + (brow + tq) * 7808 + gatecol + head * 64,
                                          MASK + (brow + tq) * 64, lutw, lutw[128], -1e29f, 0.f, smem);
            } else {
              const float sink = p.c_sinks[j * 32 + head] * LOG2E;
              attn_core<64, 64, 64, 64, 2>(Pb + brow * 6656 + 2048 + kvh * 64, 6656, nullptr, 0, Pb + brow * 6656 + 2304 + kvh * 64, 6656,
                                          SEQ, tq0 - 128, 3, Pb + (brow + tq) * 6656 + head * 64, tq, tq0, 0.125f * LOG2E, 0,
                                          Y + (brow + tq) * 3072 + head * 64, Pb + (brow + tq) * 6656 + gatecol + head * 64,
                                          nullptr, lutw, 0.f, sink, hi == 0 ? 1.f : 0.f, smem);
            }
          }
        } else {
          const int it = item - nself, b = it / 64, mh = (it % 64) / 16, qb = it % 16;
          const size_t brow = (size_t)b * SEQ;
          const int tq0 = qb * 128 + 32 * (wv >> 1), tq = tq0 + r32, vh = wv & 1;
          attn_core<256, 256, 128, 256, 3>(memkv + (size_t)b * 256 * 8192 + mh * 256, 8192, nullptr, 0, memkv + (size_t)b * 256 * 8192 + 1024 + mh * 256, 8192,
                                          256, 0, 4, mgb + (brow + tq) * ldmg + mqcol + mh * 256, tq, tq0, 0.0625f * LOG2E, 4 * vh,
                                          Y + (brow + tq) * 3072 + 2048 + mh * 256 + 128 * vh, mgb + (brow + tq) * ldmg + gatecol + 2048 + mh * 256 + 128 * vh,
                                          nullptr, nullptr, 0.f, -1e29f, 0.f, smem);
        }
      }
    }
    GSYNC();

    { EpiResid e{xin, p.out}; run_gemm(Y, 3072, WOUT, NTOK, 2048, 3072, e, smem); }
    GSYNC();
  }
  rmsnorm_rows<true>(p.out, p.final_norm, p.out, NTOK);
}

extern "C" void kernel_launch(void* const* d_in, const int* in_sizes, int n_in, void* d_out, int out_size,
                              void* d_ws, size_t ws_size, hipStream_t stream) {
  static int grid_blocks = 0;
  if (!grid_blocks) {
    int dev = 0, cus = 0, per_cu = 0;
    (void)hipGetDevice(&dev);
    (void)hipDeviceGetAttribute(&cus, hipDeviceAttributeMultiprocessorCount, dev);
    (void)hipFuncSetAttribute((const void*)mega, hipFuncAttributeMaxDynamicSharedMemorySize, LDS_BYTES);
    (void)hipOccupancyMaxActiveBlocksPerMultiprocessor(&per_cu, mega, 512, LDS_BYTES);
    if (per_cu > 1) per_cu = 1;
    grid_blocks = cus * per_cu;
  }
  Params p{};
  p.x = (const float*)d_in[0]; p.mem = (const float*)d_in[1]; p.norm_in = (const float*)d_in[2]; p.final_norm = (const float*)d_in[3];
  p.mem_norm = (const float*)d_in[4]; p.rel_bias = (const float*)d_in[5]; p.w_in_a = (const float*)d_in[6]; p.a_q_norm = (const float*)d_in[7];
  p.w_uq = (const float*)d_in[8]; p.a_kv_norm = (const float*)d_in[9]; p.w_ukv = (const float*)d_in[10]; p.w_in_b = (const float*)d_in[11];
  p.w_in_c = (const float*)d_in[12]; p.c_sinks = (const float*)d_in[13]; p.w_mem_kv = (const float*)d_in[14]; p.w_out = (const float*)d_in[15];
  p.out = (float*)d_out; p.ws = (char*)d_ws;
  (void)hipMemsetAsync((char*)d_ws + OFF_CTR, 0, 1024, stream);
  void* args[] = {&p};
  (void)hipLaunchCooperativeKernel((void*)mega, dim3(grid_blocks), dim3(512), args, LDS_BYTES, stream);
}
```

```cpp
#include <hip/hip_runtime.h>
#include <hip/hip_cooperative_groups.h>
#include <stdint.h>
namespace cg = cooperative_groups;

typedef unsigned short u16;
typedef __attribute__((ext_vector_type(8))) short bf16x8;
typedef __attribute__((ext_vector_type(4))) short s16x4;
typedef __attribute__((ext_vector_type(16))) float f32x16;
typedef __attribute__((ext_vector_type(4))) float f32x4;
typedef __attribute__((ext_vector_type(2))) float f32x2;
typedef __attribute__((ext_vector_type(4))) unsigned u32x4;
typedef __attribute__((ext_vector_type(2))) unsigned u32x2;
typedef __attribute__((ext_vector_type(2))) __bf16 bf16x2_t;
typedef short v4i16_t __attribute__((ext_vector_type(4)));
#define DI __device__ __forceinline__
#define MFMA(a, b, c) __builtin_amdgcn_mfma_f32_32x32x16_bf16((a), (b), (c), 0, 0, 0)

constexpr int SEQ = 2048, NTOK = 16384;
constexpr int LDS_LUT = 133120, LDS_ITEM = LDS_LUT + 32 * 528, LDS_BYTES = LDS_ITEM + 64;
constexpr float LOG2E = 1.4426950408889634f;
constexpr float NEGV = -1e30f;
constexpr float Y_SCALE = 16.f, WOUT_SCALE = 256.f;

constexpr size_t OFF_Y = 0;
constexpr size_t OFF_H = 100663296;
constexpr size_t OFF_KV = 201326592;
constexpr size_t OFF_MG = 335544320;
constexpr size_t OFF_KR = 469762048;
constexpr size_t OFF_P = 167772160;
constexpr size_t OFF_WIN = 471859200;
constexpr size_t OFF_WUQ = OFF_WIN + 32505856;
constexpr size_t OFF_WUKV = OFF_WUQ + 9437184;
constexpr size_t OFF_WOUT = OFF_WUKV + 4194304;
constexpr size_t OFF_MEMN = OFF_WOUT + 12582912;
constexpr size_t OFF_MEMKV = OFF_MEMN + 8388608;
constexpr size_t OFF_MASK = OFF_MEMKV + 33554432;
constexpr size_t OFF_ROPE = OFF_MASK + 4194304;
constexpr size_t OFF_LUT = OFF_ROPE + 524288;
constexpr size_t OFF_CTR = OFF_LUT + 32768;

struct Params {
  const float *x, *mem, *norm_in, *final_norm, *mem_norm, *rel_bias, *w_in_a, *a_q_norm, *w_uq, *a_kv_norm, *w_ukv,
      *w_in_b, *w_in_c, *c_sinks, *w_mem_kv, *w_out;
  float* out;
  char* ws;
};

DI float bf2f(unsigned b) { return __uint_as_float(b << 16); }
DI unsigned pk2(float a, float b) {
  f32x2 v = {a, b};
  return __builtin_bit_cast(unsigned, __builtin_convertvector(v, bf16x2_t));
}
DI float clamp8(float x) { return fminf(fmaxf(x, -448.f), 448.f); }
DI unsigned pk4_fp8(float a, float b, float c, float d) {
  int w = 0;
  w = __builtin_amdgcn_cvt_pk_fp8_f32(clamp8(a), clamp8(b), w, false);
  w = __builtin_amdgcn_cvt_pk_fp8_f32(clamp8(c), clamp8(d), w, true);
  return (unsigned)w;
}
DI u16 f2bf(float a) { return (u16)(pk2(a, 0.f) & 0xffffu); }
DI float wave_sum(float v) {
#pragma unroll
  for (int o = 32; o; o >>= 1) v += __shfl_xor(v, o);
  return v;
}
DI int crow(int reg, int hi) { return (reg & 3) + 8 * (reg >> 2) + 4 * hi; }
DI float xhalf_max(float m) {
  auto rr = __builtin_amdgcn_permlane32_swap(__float_as_uint(m), __float_as_uint(m), false, false);
  return fmaxf(__uint_as_float(rr[0]), __uint_as_float(rr[1]));
}
DI float xhalf_sum(float m) {
  auto rr = __builtin_amdgcn_permlane32_swap(__float_as_uint(m), __float_as_uint(m), false, false);
  return __uint_as_float(rr[0]) + __uint_as_float(rr[1]);
}
typedef __attribute__((address_space(3))) v4i16_t* lds_v4p;
DI s16x4 vtr(const char* p) {
  return __builtin_bit_cast(s16x4, __builtin_amdgcn_ds_read_tr16_b64_v4i16((lds_v4p)(p)));
}

template <int PERM, bool FP8 = false>
DI void convert_wt(const float* __restrict__ W, int K, int N, int Npad, u16* __restrict__ Wt, char* smem, float wscale = 1.f) {
  float* tile = (float*)smem;
  int tid = threadIdx.x; asm volatile("" : "+v"(tid));
  const int ntk = K / 64, ntn = Npad / 64;
  for (int t = blockIdx.x; t < ntk * ntn; t += gridDim.x) {
    const int tk = t % ntk, tn = t / ntk, k0 = tk * 64, n0 = tn * 64;
    __syncthreads();
#pragma unroll
    for (int i = 0; i < 2; ++i) {
      const int id = tid + 512 * i, kr = id >> 4, n4 = (id & 15) * 4;
      f32x4 v = {0.f, 0.f, 0.f, 0.f};
      if (n0 + n4 < N) v = *(const f32x4*)(W + (size_t)(k0 + kr) * N + n0 + n4);
      tile[kr * 65 + n4 + 0] = v[0]; tile[kr * 65 + n4 + 1] = v[1]; tile[kr * 65 + n4 + 2] = v[2]; tile[kr * 65 + n4 + 3] = v[3];
    }
    __syncthreads();
    {
      const int n = tid >> 3, c = tid & 7;
      bool rot = false;
      if (PERM == 1) rot = (n0 == 2048);
      if (PERM == 2) rot = ((tn % 3) == 2);
      const int ns = rot ? ((n >> 1) + 32 * (n & 1)) : n;
      if (FP8) {
        float f[8];
#pragma unroll
        for (int j = 0; j < 8; ++j) f[j] = tile[(c * 8 + j) * 65 + ns] * wscale;
        u32x2 o = {pk4_fp8(f[0], f[1], f[2], f[3]), pk4_fp8(f[4], f[5], f[6], f[7])};
        *(u32x2*)((unsigned char*)Wt + (size_t)(n0 + n) * K + k0 + c * 8) = o;
      } else {
        u32x4 o;
#pragma unroll
        for (int j = 0; j < 4; ++j) o[j] = pk2(tile[(c * 8 + 2 * j) * 65 + ns], tile[(c * 8 + 2 * j + 1) * 65 + ns]);
        *(u32x4*)(Wt + (size_t)(n0 + n) * K + k0 + c * 8) = o;
      }
    }
  }
}

template <bool F32OUT>
DI void rmsnorm_rows(const float* X, const float* __restrict__ g, void* outp, int nrows) {
  int tidx = threadIdx.x; asm volatile("" : "+v"(tidx));
  const int lane = tidx & 63, gw = blockIdx.x * 8 + (tidx >> 6), nw = gridDim.x * 8;
  for (int row = gw; row < nrows; row += nw) {
    const f32x4* xr = (const f32x4*)(X + (size_t)row * 2048);
    f32x4 v[8];
    float ss = 0.f;
#pragma unroll
    for (int i = 0; i < 8; ++i) { v[i] = xr[lane + 64 * i]; ss += v[i][0] * v[i][0] + v[i][1] * v[i][1] + v[i][2] * v[i][2] + v[i][3] * v[i][3]; }
    ss = wave_sum(ss);
    const float r = rsqrtf(ss * (1.f / 2048.f) + 1e-6f);
#pragma unroll
    for (int i = 0; i < 8; ++i) {
      const f32x4 gg = ((const f32x4*)g)[lane + 64 * i];
      f32x4 o = {v[i][0] * r * gg[0], v[i][1] * r * gg[1], v[i][2] * r * gg[2], v[i][3] * r * gg[3]};
      if (F32OUT) ((f32x4*)((float*)outp + (size_t)row * 2048))[lane + 64 * i] = o;
      else { u32x2 pk = {pk2(o[0], o[1]), pk2(o[2], o[3])}; ((u32x2*)((u16*)outp + (size_t)row * 2048))[lane + 64 * i] = pk; }
    }
  }
}

DI void anorm_phase(u16* C, const float* __restrict__ gq, const float* __restrict__ gkv) {
  int tidx = threadIdx.x; asm volatile("" : "+v"(tidx));
  const int lane = tidx & 63, gw = blockIdx.x * 8 + (tidx >> 6), nw = gridDim.x * 8;
  for (int row = gw; row < NTOK; row += nw) {
    u32x4* cr = (u32x4*)(C + (size_t)row * 2048);
    u32x4 v[4];
    float sq = 0.f, skv = 0.f;
#pragma unroll
    for (int i = 0; i < 4; ++i) {
      v[i] = cr[lane + 64 * i];
      float s = 0.f;
#pragma unroll
      for (int j = 0; j < 4; ++j) { float a = bf2f(v[i][j] & 0xffffu), b = bf2f(v[i][j] >> 16); s += a * a + b * b; }
      if (i < 3) sq += s; else skv += s;
    }
    sq = wave_sum(sq); skv = wave_sum(skv);
    const float rq = rsqrtf(sq * (1.f / 1536.f) + 1e-6f), rkv = rsqrtf(skv * (1.f / 512.f) + 1e-6f);
#pragma unroll
    for (int i = 0; i < 4; ++i) {
      const int col = (lane + 64 * i) * 8;
      const float* gp = (i < 3) ? (gq + col) : (gkv + col - 1536);
      const float r = (i < 3) ? rq : rkv;
      const f32x4 g0 = *(const f32x4*)gp, g1 = *(const f32x4*)(gp + 4);
      u32x4 o;
      o[0] = pk2(bf2f(v[i][0] & 0xffffu) * r * g0[0], bf2f(v[i][0] >> 16) * r * g0[1]);
      o[1] = pk2(bf2f(v[i][1] & 0xffffu) * r * g0[2], bf2f(v[i][1] >> 16) * r * g0[3]);
      o[2] = pk2(bf2f(v[i][2] & 0xffffu) * r * g1[0], bf2f(v[i][2] >> 16) * r * g1[1]);
      o[3] = pk2(bf2f(v[i][3] & 0xffffu) * r * g1[2], bf2f(v[i][3] >> 16) * r * g1[3]);
      cr[lane + 64 * i] = o;
    }
  }
}

namespace pg8 {
#define PG8_LAS __attribute__((address_space(3)))
constexpr int BM = 256, BK = 64, HALF = 128, HTB = HALF * BK * 2, STAGE_BYTES = 8 * HTB, NXCD = 8, WGM = 8;
DI int lds_byte(int r, int c) { const int st = (r >> 4) * 2 + (c >> 5), rr = r & 15, cc = c & 31, ob = rr * 64 + cc * 2; return st * 1024 + (ob ^ (((ob >> 9) & 1) << 5)); }
DI void stage_rc(int b, int& R, int& C) { const int st = b / 1024, sb = b % 1024, swz = sb ^ (((sb >> 9) & 1) << 5); R = (st >> 1) * 16 + swz / 64; C = (st & 1) * 32 + (swz % 64) / 2; }
DI int perm32(int rho) { const int n = rho >> 4, i = rho & 15; return 8 * (i >> 2) + 4 * n + (i & 3); }
typedef int i32x4v __attribute__((ext_vector_type(4)));
typedef int i32x8 __attribute__((ext_vector_type(8)));
DI i32x8 cat8(bf16x8 a, bf16x8 b) { const i32x4v x = __builtin_bit_cast(i32x4v, a), y = __builtin_bit_cast(i32x4v, b); return __builtin_shufflevector(x, y, 0, 1, 2, 3, 4, 5, 6, 7); }
struct Unit { int pm, pn; };
struct Gemm { const u16* A; const u16* Bt; int M, N, K, lda; };
struct StaticOrder {
  int nM, nN, nwg, G, c;
  DI void init(int M, int N, int G_, int c_) { nM = M / BM; nN = N / BM; nwg = nM * nN; G = G_; c = c_; }
  DI bool next(int i, Unit& u) const {
    const long L = (long)i * G + c; if (L >= nwg) return false;
    int wgid = (int)L; { const int q = nwg / NXCD, r = nwg % NXCD, xcd = wgid % NXCD, off = wgid / NXCD; wgid = (xcd < r ? xcd * (q + 1) : r * (q + 1) + (xcd - r) * q) + off; }
    const int nig = WGM * nN, gid = wgid / nig, fm = gid * WGM, gsz = (nM - fm) < WGM ? (nM - fm) : WGM;
    u.pm = fm + ((wgid % nig) % gsz); u.pn = (wgid % nig) / gsz; return true;
  }
  DI void a_ready(const Unit&) const {}
  DI void done(const Unit&) const {}
};
template <bool FP8, class Epi, class Sched>
__device__ __forceinline__ void gemm_phase(PG8_LAS unsigned char* lds, const Gemm g, const Sched& S, const Epi& E) {
    int tid = threadIdx.x; asm volatile("" : "+v"(tid));
    const int wid = __builtin_amdgcn_readfirstlane(tid >> 6), lane = tid & 63, wr = wid >> 2, wc = wid & 3, fr = lane & 15, fq = lane >> 4;
    const int K = g.K, nt = K / BK;
    unsigned voffA[2], voffB[2];
#pragma unroll
    for (int i = 0; i < 2; ++i) { int R, C; stage_rc(tid * 16 + i * 8192, R, C); const int Rb = Epi::PERM ? ((R & ~31) + perm32(R & 31)) : R;
        voffA[i] = (unsigned)(R * g.lda + C) * 2u; voffB[i] = (unsigned)(Rb * K + C) * 2u; }
    const size_t kstep = (size_t)(BK * 2);
    const size_t hstep = (size_t)HALF * K * 2, hstepA = (size_t)HALF * g.lda * 2;
    const size_t tstep = 2 * hstep, tstepA = 2 * hstepA;
    const unsigned ldsw = (unsigned)wid * 1024u;
    const int aoff = lds_byte(wr * 64 + fr, fq * 8), boff = lds_byte(wc * 32 + fr, fq * 8);
#define PG8_SA(b, h) (((b) * 2 + (h)) * HTB)
#define PG8_SB(b, h) ((4 + (b) * 2 + (h)) * HTB)
#define PG8_STAGE(bufoff, gbase, voff) do { _Pragma("unroll") for (int _i = 0; _i < 2; ++_i) \
        __builtin_amdgcn_global_load_lds((const unsigned*)((const char*)(gbase) + (voff)[_i]), (PG8_LAS unsigned*)(lds + (bufoff) + ldsw + _i * 8192), 16, 0, 0); } while (0)
#define PG8_LDA(dst, b, h) do { _Pragma("unroll") for (int m = 0; m < 4; ++m) _Pragma("unroll") for (int k = 0; k < 2; ++k) dst[m][k] = *(const PG8_LAS bf16x8*)(lds + PG8_SA(b, h) + aoff + m * 2048 + k * 1024); } while (0)
#define PG8_LDB(dst, b, h) do { _Pragma("unroll") for (int n = 0; n < 2; ++n) _Pragma("unroll") for (int k = 0; k < 2; ++k) dst[n][k] = *(const PG8_LAS bf16x8*)(lds + PG8_SB(b, h) + boff + n * 2048 + k * 1024); } while (0)
#define PG8_MMA(ai, bj, At, Bt) do { __builtin_amdgcn_s_setprio(1); _Pragma("unroll") for (int m = 0; m < 4; ++m) _Pragma("unroll") for (int n = 0; n < 2; ++n) { \
        if constexpr (FP8) { const i32x8 bv_ = cat8(Bt[n][0], Bt[n][1]), av_ = cat8(At[m][0], At[m][1]); \
            asm volatile("s_nop 1\n\tv_mfma_scale_f32_16x16x128_f8f6f4 %0, %1, %2, %0, %3, %3 op_sel_hi:[0,0,0]" : "+v"(acc[ai][bj][m][n]) : "v"(bv_), "v"(av_), "v"(sc127)); } \
        else { _Pragma("unroll") for (int k = 0; k < 2; ++k) acc[ai][bj][m][n] = __builtin_amdgcn_mfma_f32_16x16x32_bf16(Bt[n][k], At[m][k], acc[ai][bj][m][n], 0, 0, 0); } } \
        __builtin_amdgcn_s_setprio(0); } while (0)
#define PG8_WAIT_V(n) asm volatile("s_waitcnt vmcnt(" #n ")" ::: "memory")
#define PG8_WAIT_L(n) asm volatile("s_waitcnt lgkmcnt(" #n ")" ::: "memory")
#define PG8_BAR __builtin_amdgcn_s_barrier()
#define PG8_SCHED __builtin_amdgcn_sched_barrier(0)
    Unit cur, nxt; int ui = 0;
    if (!S.next(0, cur)) return;
    f32x4 acc[2][2][4][2];
#pragma unroll
    for (int a = 0; a < 2; ++a)
#pragma unroll
        for (int b = 0; b < 2; ++b)
#pragma unroll
            for (int m = 0; m < 4; ++m)
#pragma unroll
                for (int n = 0; n < 2; ++n) acc[a][b][m][n] = (f32x4){0.f, 0.f, 0.f, 0.f};
    bf16x8 At[4][2], B0[2][2], B1[2][2];
    int sc127 = 0x7F7F7F7F; asm volatile("" : "+v"(sc127));
    const char* cA = (const char*)g.A + (size_t)cur.pm * tstepA; const char* cB = (const char*)g.Bt + (size_t)cur.pn * tstep;
    S.a_ready(cur);
    PG8_STAGE(PG8_SB(0, 0), cB, voffB); PG8_STAGE(PG8_SA(0, 0), cA, voffA); PG8_STAGE(PG8_SB(0, 1), cB + hstep, voffB); PG8_STAGE(PG8_SA(0, 1), cA + hstepA, voffA);
    if (wr == 1) PG8_BAR;
    PG8_WAIT_V(4); PG8_BAR;
    PG8_STAGE(PG8_SB(1, 0), cB + kstep, voffB); PG8_STAGE(PG8_SA(1, 0), cA + kstep, voffA); PG8_STAGE(PG8_SB(1, 1), cB + hstep + kstep, voffB);
    PG8_WAIT_V(6); PG8_BAR;
    for (;;) {
        const bool has_next = S.next(ui + 1, nxt);
        const char* nA = has_next ? (const char*)g.A + (size_t)nxt.pm * tstepA : cA; const char* nB = has_next ? (const char*)g.Bt + (size_t)nxt.pn * tstep : cB;
        for (int t = 0; t < nt; t += 2) {
            const bool last = (t == nt - 2);
            const char* a1 = cA + (size_t)(t + 1) * kstep;
            const char* a2 = last ? nA : cA + (size_t)(t + 2) * kstep; const char* b2 = last ? nB : cB + (size_t)(t + 2) * kstep;
            const char* a3 = a2 + kstep; const char* b3 = b2 + kstep;
            if (last && has_next) S.a_ready(nxt);
            PG8_LDB(B0, 0, 0); PG8_SCHED; PG8_LDA(At, 0, 0); PG8_STAGE(PG8_SA(1, 1), a1 + hstepA, voffA);
            PG8_WAIT_L(8); PG8_BAR; PG8_WAIT_L(0); PG8_MMA(0, 0, At, B0); PG8_BAR; PG8_SCHED;
            PG8_LDB(B1, 0, 1); PG8_STAGE(PG8_SB(0, 0), b2, voffB);
            PG8_BAR; PG8_WAIT_L(0); PG8_MMA(0, 1, At, B1); PG8_BAR;
            PG8_LDA(At, 0, 1); PG8_STAGE(PG8_SA(0, 0), a2, voffA);
            PG8_BAR; PG8_WAIT_L(0); PG8_MMA(1, 0, At, B0); PG8_BAR; PG8_SCHED;
            PG8_STAGE(PG8_SB(0, 1), b2 + hstep, voffB);
            PG8_WAIT_V(6); PG8_BAR; PG8_MMA(1, 1, At, B1); PG8_BAR;
            PG8_LDB(B0, 1, 0); PG8_SCHED; PG8_LDA(At, 1, 0); PG8_STAGE(PG8_SA(0, 1), a2 + hstepA, voffA);
            PG8_WAIT_L(8); PG8_BAR; PG8_WAIT_L(0); PG8_MMA(0, 0, At, B0); PG8_BAR; PG8_SCHED;
            PG8_LDB(B1, 1, 1); PG8_STAGE(PG8_SB(1, 0), b3, voffB);
            PG8_BAR; PG8_WAIT_L(0); PG8_MMA(0, 1, At, B1); PG8_BAR;
            PG8_LDA(At, 1, 1); PG8_STAGE(PG8_SA(1, 0), a3, voffA);
            PG8_BAR; PG8_WAIT_L(0); PG8_MMA(1, 0, At, B0); PG8_BAR; PG8_SCHED;
            PG8_STAGE(PG8_SB(1, 1), b3 + hstep, voffB);
            PG8_WAIT_V(6); PG8_BAR; PG8_MMA(1, 1, At, B1); PG8_BAR;
        }
        if constexpr (FP8) asm volatile("s_nop 15\n\ts_nop 15" ::: "memory");
        if constexpr (!Epi::AFTER_DRAIN) { E(acc, cur, wr, wc, fr, fq); S.done(cur); }
        if (!has_next) break;
#pragma unroll
        for (int a = 0; a < 2; ++a)
#pragma unroll
            for (int b = 0; b < 2; ++b)
#pragma unroll
                for (int m = 0; m < 4; ++m)
#pragma unroll
                    for (int n = 0; n < 2; ++n) acc[a][b][m][n] = (f32x4){0.f, 0.f, 0.f, 0.f};
        cur = nxt; cA = nA; cB = nB; ++ui;
    }
    PG8_WAIT_V(0);
    if (wr == 0) PG8_BAR;
    PG8_BAR;
    if constexpr (Epi::AFTER_DRAIN) { E.fused(acc, cur, wr, wc, fr, fq, lds, wid, lane); S.done(cur); }
#undef PG8_SA
#undef PG8_SB
#undef PG8_STAGE
#undef PG8_LDA
#undef PG8_LDB
#undef PG8_MMA
#undef PG8_WAIT_V
#undef PG8_WAIT_L
#undef PG8_BAR
#undef PG8_SCHED
}

}

struct EpiResid {
  static constexpr bool PERM = false, AFTER_DRAIN = false;
  const float* xin; float* xout; float sc;
  DI void operator()(const f32x4 (&acc)[2][2][4][2], const pg8::Unit& u, int wr, int wc, int fr, int fq) const {
    const int row0 = u.pm * 256 + wr * 64 + fr, col0 = u.pn * 256 + wc * 32 + 4 * fq;
#pragma unroll
    for (int ai = 0; ai < 2; ++ai)
#pragma unroll
      for (int m = 0; m < 4; ++m) {
        const size_t ro = (size_t)(row0 + ai * 128 + m * 16) * 2048 + col0;
#pragma unroll
        for (int bj = 0; bj < 2; ++bj)
#pragma unroll
          for (int n = 0; n < 2; ++n) {
            const size_t o = ro + bj * 128 + n * 16;
            const f32x4 xv = *(const f32x4*)(xin + o);
            *(f32x4*)(xout + o) = xv + acc[ai][bj][m][n] * sc;
          }
        asm volatile("" ::: "memory");
      }
  }
};
template <int MODE>
struct EpiBf {
  static constexpr bool PERM = true, AFTER_DRAIN = false;
  u16* d0; int ld0; int N; u16* d1; u16* d2; const f32x2* rope;
  DI void rot(f32x4& v0, f32x4& v1, int row, int col) const {
    const f32x4* cp = (const f32x4*)(rope + (row & 2047) * 32 + ((col & 63) >> 1));
    const f32x4 c01 = cp[0], c23 = cp[1];
    const f32x4 a = {v0[0] * c01[0] - v0[1] * c01[1], v0[1] * c01[0] + v0[0] * c01[1], v0[2] * c01[2] - v0[3] * c01[3], v0[3] * c01[2] + v0[2] * c01[3]};
    const f32x4 b = {v1[0] * c23[0] - v1[1] * c23[1], v1[1] * c23[0] + v1[0] * c23[1], v1[2] * c23[2] - v1[3] * c23[3], v1[3] * c23[2] + v1[2] * c23[3]};
    v0 = a; v1 = b;
  }
  DI void operator()(const f32x4 (&acc)[2][2][4][2], const pg8::Unit& u, int wr, int wc, int fr, int fq) const {
    const int row0 = u.pm * 256 + wr * 64 + fr, colb = u.pn * 256 + wc * 32 + 8 * fq;
#pragma unroll
    for (int ai = 0; ai < 2; ++ai)
#pragma unroll
      for (int m = 0; m < 4; ++m) {
        const int row = row0 + ai * 128 + m * 16;
#pragma unroll
        for (int bj = 0; bj < 2; ++bj) {
          const int col = colb + bj * 128;
          f32x4 v0 = acc[ai][bj][m][0], v1 = acc[ai][bj][m][1];
          u16* dst = nullptr;
          if (MODE == 0) { if (col < N) dst = d0 + (size_t)row * ld0 + col; }
          else if (MODE == 1) {
            if (col < 2048) dst = d0 + (size_t)row * 2048 + col;
            else if (col < 2112) { rot(v0, v1, row, col); dst = d2 + (size_t)row * 64 + (col - 2048); }
            else if (col < 6208) dst = d1 + (size_t)row * 4096 + (col - 2112);
          } else {
            if (((col >> 6) % 3) == 2) rot(v0, v1, row, col);
            dst = d0 + (size_t)row * 3072 + col;
          }
          if (dst) { u32x4 w = {pk2(v0[0], v0[1]), pk2(v0[2], v0[3]), pk2(v1[0], v1[1]), pk2(v1[2], v1[3])}; *(u32x4*)dst = w; }
        }
        asm volatile("" ::: "memory");
      }
  }
};

template <bool FP8 = false, class Epi>
DI void run_gemm(const u16* A, int lda, const u16* Bt, int M, int N, int K, const Epi& e, char* smem) {
  __syncthreads();
  pg8::Gemm g{A, Bt, M, N, K, lda};
  pg8::StaticOrder S; S.init(M, N, gridDim.x, blockIdx.x);
  pg8::gemm_phase<FP8>(( __attribute__((address_space(3))) unsigned char*)smem, g, S, e);
  __syncthreads();
}

typedef __attribute__((address_space(3))) unsigned* lds_u32p;
template <int OFF> DI void rd4(bf16x8 (&f)[4], unsigned addr) {
  asm volatile("ds_read_b128 %0, %4 offset:%5\n\tds_read_b128 %1, %4 offset:%6\n\tds_read_b128 %2, %4 offset:%7\n\tds_read_b128 %3, %4 offset:%8\n\ts_waitcnt lgkmcnt(0)"
               : "=&v"(f[0]), "=&v"(f[1]), "=&v"(f[2]), "=&v"(f[3]) : "v"(addr), "i"(OFF), "i"(OFF + 32), "i"(OFF + 64), "i"(OFF + 96) : "memory");
}
template <int OFF> DI void rdv8(s16x4 (&v)[8], unsigned addr) {
  asm volatile("ds_read_b64_tr_b16 %0, %8 offset:%9\n\tds_read_b64_tr_b16 %1, %8 offset:%10\n\tds_read_b64_tr_b16 %2, %8 offset:%11\n\tds_read_b64_tr_b16 %3, %8 offset:%12\n\t"
               "ds_read_b64_tr_b16 %4, %8 offset:%13\n\tds_read_b64_tr_b16 %5, %8 offset:%14\n\tds_read_b64_tr_b16 %6, %8 offset:%15\n\tds_read_b64_tr_b16 %7, %8 offset:%16\n\ts_waitcnt lgkmcnt(0)"
               : "=&v"(v[0]), "=&v"(v[1]), "=&v"(v[2]), "=&v"(v[3]), "=&v"(v[4]), "=&v"(v[5]), "=&v"(v[6]), "=&v"(v[7])
               : "v"(addr), "i"(OFF), "i"(OFF + 512), "i"(OFF + 1024), "i"(OFF + 1536), "i"(OFF + 2048), "i"(OFF + 2560), "i"(OFF + 3072), "i"(OFF + 3584) : "memory");
}
template <int KSTR, int ND, int N>
DI f32x16 s_block(unsigned kaddr, const bf16x8* qf) {
  const f32x16 z16 = {0.f, 0.f, 0.f, 0.f, 0.f, 0.f, 0.f, 0.f, 0.f, 0.f, 0.f, 0.f, 0.f, 0.f, 0.f, 0.f};
  bf16x8 f[4];
  rd4<N * 32 * KSTR>(f, kaddr);
  f32x16 a = MFMA(f[0], qf[0], z16); a = MFMA(f[1], qf[1], a); a = MFMA(f[2], qf[2], a); a = MFMA(f[3], qf[3], a);
  if constexpr (ND > 4) { rd4<N * 32 * KSTR + 128>(f, kaddr); a = MFMA(f[0], qf[4], a); a = MFMA(f[1], qf[5], a); a = MFMA(f[2], qf[6], a); a = MFMA(f[3], qf[7], a); }
  if constexpr (ND > 8) { rd4<N * 32 * KSTR + 256>(f, kaddr); a = MFMA(f[0], qf[8], a); a = MFMA(f[1], qf[9], a); a = MFMA(f[2], qf[10], a); a = MFMA(f[3], qf[11], a); }
  if constexpr (ND > 12) { rd4<N * 32 * KSTR + 384>(f, kaddr); a = MFMA(f[0], qf[12], a); a = MFMA(f[1], qf[13], a); a = MFMA(f[2], qf[14], a); a = MFMA(f[3], qf[15], a); }
  return a;
}
template <int CB> DI void pv_block(f32x16& o, unsigned vaddr, const bf16x8 (&pb)[2][2]) {
  s16x4 v[8];
  rdv8<CB * 4096>(v, vaddr);
#pragma unroll
  for (int q = 0; q < 4; ++q) {
    const bf16x8 vf = {v[2 * q][0], v[2 * q][1], v[2 * q][2], v[2 * q][3], v[2 * q + 1][0], v[2 * q + 1][1], v[2 * q + 1][2], v[2 * q + 1][3]};
    o = MFMA(vf, pb[q >> 1][q & 1], o);
  }
}
template <int DQK, int W1, int DV, int VW, int MODE>
DI void attn_core(const u16* __restrict__ k1, int ldk1, const u16* __restrict__ k2, int ldk2, const u16* __restrict__ vsrc, int ldv,
                  int kv_len, int kbase0, int ntiles, const u16* qrow, int tq, int tq0, float c2, int vcb0, u16* yrow,
                  const u16* grow, const unsigned* maskrow, const float* lutw, float bias_far, float m_init, float l_init, char* smem) {
  constexpr int KSTR = DQK * 2 + 16, KCH = DQK / 8;
  constexpr int ND = DQK / 16, NCB = DV / 32, BUF = 64 * KSTR + (VW / 32) * 4096;
  constexpr int NKI = KSTR / 16, NVI = VW / 8;
  static_assert(ND % 4 == 0 && NCB <= 4, "fragment batches");
  int tid0 = threadIdx.x; asm volatile("" : "+v"(tid0));
  const int lane = tid0 & 63, r32 = lane & 31, hi = lane >> 5;
  const int wv = __builtin_amdgcn_readfirstlane(tid0 >> 6);
  const unsigned lds0 = (unsigned)(uintptr_t)smem;
  bf16x8 qf[ND];
#pragma unroll
  for (int d0 = 0; d0 < ND; ++d0) qf[d0] = *(const bf16x8*)(qrow + d0 * 16 + hi * 8);
  f32x16 o[NCB];
#pragma unroll
  for (int cb = 0; cb < NCB; ++cb)
#pragma unroll
    for (int r = 0; r < 16; ++r) o[cb][r] = 0.f;
  float m = m_init, l = l_init;
  const unsigned klane = (unsigned)(r32 * KSTR + hi * 16);
  const unsigned vlane = (unsigned)(64 * KSTR + vcb0 * 4096 + ((lane >> 4) & 1) * 32 + (lane & 3) * 8 + (4 * hi + ((lane & 15) >> 2)) * 64);
  unsigned mwn[2] = {0u, 0u};
  auto stage_tile = [&](int kb, int buf) {
    int ln = threadIdx.x & 63; asm volatile("" : "+v"(ln));
    const unsigned bofs = (unsigned)(buf * BUF);
#pragma unroll
    for (int ii = 0; ii < (NKI + 7) / 8; ++ii) {
      const int i = wv + 8 * ii;
      if (i < NKI) {
        const int ob = i * 1024 + ln * 16, row = ob / KSTR;
        int c = (ob - row * KSTR) >> 4; c = (c >= KCH) ? 0 : c;
        int key = kb + row; key = key < 0 ? 0 : (key >= kv_len ? kv_len - 1 : key);
        const u16* src = (c < W1 / 8) ? (k1 + (key * ldk1 + c * 8)) : (k2 + (key * ldk2 + (c - W1 / 8) * 8));
        __builtin_amdgcn_global_load_lds((const unsigned*)src, (lds_u32p)(smem + bofs + i * 1024), 16, 0, 0);
      }
    }
#pragma unroll
    for (int ii = 0; ii < (NVI + 7) / 8; ++ii) {
      const int i = wv + 8 * ii;
      if (i < NVI) {
        const int ob = i * 1024 + ln * 16, cbk = ob >> 12, row = (ob & 4095) >> 6, cw = (ob & 63) >> 4;
        int key = kb + row; key = key < 0 ? 0 : (key >= kv_len ? kv_len - 1 : key);
        __builtin_amdgcn_global_load_lds((const unsigned*)(vsrc + (key * ldv + (cbk * 4 + cw) * 8)), (lds_u32p)(smem + bofs + 64 * KSTR + i * 1024), 16, 0, 0);
      }
    }
    if (MODE == 1) { mwn[0] = maskrow[(kb >> 5)]; mwn[1] = maskrow[(kb >> 5) + 1]; }
  };
  stage_tile(kbase0, 0);
  asm volatile("s_waitcnt vmcnt(0)" ::: "memory");
  __syncthreads();
  for (int t = 0; t < ntiles; ++t) {
    const int kb = kbase0 + t * 64;
    const unsigned bufa = lds0 + (unsigned)((t & 1) * BUF);
    const unsigned mw0 = mwn[0], mw1 = mwn[1];
    if (t + 1 < ntiles) stage_tile(kb + 64, (t + 1) & 1);
    if (!(MODE == 0 && kb > tq0 + 31)) {
      f32x16 s[2];
      s[0] = s_block<KSTR, ND, 0>(bufa + klane, qf);
      s[1] = s_block<KSTR, ND, 1>(bufa + klane, qf);
      if (MODE == 0) {
        const bool diag = kb + 63 > tq0;
#pragma unroll
        for (int n = 0; n < 2; ++n)
#pragma unroll
          for (int i = 0; i < 16; ++i) {
            float v = s[n][i] * c2;
            if (diag) { const int key = kb + 32 * n + crow(i, hi); if (key > tq) v = NEGV; }
            s[n][i] = v;
          }
      } else if (MODE == 1) {
        const bool far = (tq0 - (kb + 63)) >= 128;
#pragma unroll
        for (int n = 0; n < 2; ++n) {
          const unsigned wb = (n ? mw1 : mw0) >> (4 * hi);
          if (far) {
#pragma unroll
            for (int i = 0; i < 16; ++i) {
              const float v = fmaf(s[n][i], c2, bias_far);
              s[n][i] = ((wb >> ((i & 3) + 8 * (i >> 2))) & 1u) ? v : NEGV;
            }
          } else {
#pragma unroll
            for (int i = 0; i < 16; ++i) {
              const int key = kb + 32 * n + crow(i, hi);
              int rel = tq - key; rel = rel < 0 ? 0 : (rel > 128 ? 128 : rel);
              const float v = fmaf(s[n][i], c2, lutw[rel]);
              s[n][i] = ((wb >> ((i & 3) + 8 * (i >> 2))) & 1u) ? v : NEGV;
            }
          }
        }
      } else if (MODE == 2) {
#pragma unroll
        for (int n = 0; n < 2; ++n)
#pragma unroll
          for (int i = 0; i < 16; ++i) {
            const int key = kb + 32 * n + crow(i, hi), rel = tq - key;
            const bool ok = ((unsigned)rel < 128u) && (key >= 0);
            const float v = fmaf(s[n][i], c2, lutw[rel & 127]);
            s[n][i] = ok ? v : NEGV;
          }
      } else {
#pragma unroll
        for (int n = 0; n < 2; ++n)
#pragma unroll
          for (int i = 0; i < 16; ++i) s[n][i] *= c2;
      }
      float mx = s[0][0];
#pragma unroll
      for (int i = 1; i < 16; ++i) mx = fmaxf(mx, s[0][i]);
#pragma unroll
      for (int i = 0; i < 16; ++i) mx = fmaxf(mx, s[1][i]);
      mx = xhalf_max(mx);
      if (__any(mx - m > 8.0f)) {
        const float mnew = fmaxf(m, mx), alpha = __builtin_amdgcn_exp2f(m - mnew);
        m = mnew; l *= alpha;
#pragma unroll
        for (int cb = 0; cb < NCB; ++cb)
#pragma unroll
          for (int r = 0; r < 16; ++r) o[cb][r] *= alpha;
      }
      float ps = 0.f;
#pragma unroll
      for (int n = 0; n < 2; ++n)
#pragma unroll
        for (int i = 0; i < 16; ++i) { const float p = __builtin_amdgcn_exp2f(s[n][i] - m); ps += p; s[n][i] = p; }
      l += ps;
      bf16x8 pb[2][2];
#pragma unroll
      for (int n = 0; n < 2; ++n)
#pragma unroll
        for (int s2 = 0; s2 < 2; ++s2) {
          u32x4 pw = {pk2(s[n][8 * s2 + 0], s[n][8 * s2 + 1]), pk2(s[n][8 * s2 + 2], s[n][8 * s2 + 3]),
                      pk2(s[n][8 * s2 + 4], s[n][8 * s2 + 5]), pk2(s[n][8 * s2 + 6], s[n][8 * s2 + 7])};
          pb[n][s2] = __builtin_bit_cast(bf16x8, pw);
        }
      pv_block<0>(o[0], bufa + vlane, pb);
      if constexpr (NCB > 1) pv_block<1>(o[1], bufa + vlane, pb);
      if constexpr (NCB > 2) pv_block<2>(o[2], bufa + vlane, pb);
      if constexpr (NCB > 3) pv_block<3>(o[3], bufa + vlane, pb);
    }
    asm volatile("s_waitcnt vmcnt(0)" ::: "memory");
    __syncthreads();
  }
  const float inv = 1.f / xhalf_sum(l);
#pragma unroll
  for (int cb = 0; cb < NCB; ++cb)
#pragma unroll
    for (int g = 0; g < 4; ++g) {
      const int dv = 32 * cb + 8 * g + 4 * hi;
      const u32x2 gg = *(const u32x2*)(grow + dv);
      float gv[4] = {bf2f(gg[0] & 0xffffu), bf2f(gg[0] >> 16), bf2f(gg[1] & 0xffffu), bf2f(gg[1] >> 16)};
      float ov[4];
#pragma unroll
      for (int j = 0; j < 4; ++j) {
        const float sg = gv[j] / (1.f + __expf(-gv[j]));
        ov[j] = o[cb][4 * g + j] * inv * sg;
      }
      *(unsigned*)((unsigned char*)yrow + dv) = pk4_fp8(ov[0] * Y_SCALE, ov[1] * Y_SCALE, ov[2] * Y_SCALE, ov[3] * Y_SCALE);
      __builtin_amdgcn_sched_barrier(0);
    }
}

DI unsigned ordkey(float f) { const unsigned b = __float_as_uint(f); return b ^ ((unsigned)((int)b >> 31) | 0x80000000u); }
DI void indexer_phase(const u16* __restrict__ P, unsigned* __restrict__ mask) {
  int tidx = threadIdx.x; asm volatile("" : "+v"(tidx));
  const int lane = tidx & 63, r32 = lane & 31, hi = lane >> 5;
  const int gw = blockIdx.x * 8 + (tidx >> 6), nw = gridDim.x * 8;
  for (int item = gw; item < 8192; item += nw) {
    const int b = item & 7, t0 = (1023 - (item >> 3)) * 2;
    const size_t brow = (size_t)b * SEQ;
    const int g = (r32 >> 2) & 1, head = 4 * (r32 >> 3) + (r32 & 3);
    bf16x8 aq[4];
#pragma unroll
    for (int s = 0; s < 4; ++s) aq[s] = *(const bf16x8*)(P + (brow + t0 + g) * 7808 + 2560 + head * 64 + 16 * s + 8 * hi);
    float wv[16];
    {
      const u32x4 w0 = *(const u32x4*)(P + (brow + t0 + hi) * 7808 + 3648), w1 = *(const u32x4*)(P + (brow + t0 + hi) * 7808 + 3656);
#pragma unroll
      for (int j = 0; j < 4; ++j) { wv[2 * j] = bf2f(w0[j] & 0xffffu); wv[2 * j + 1] = bf2f(w0[j] >> 16); wv[8 + 2 * j] = bf2f(w1[j] & 0xffffu); wv[8 + 2 * j + 1] = bf2f(w1[j] >> 16); }
    }
    const int tme = t0 + hi, kbmax = (t0 + 1) >> 5;
    unsigned sc[64];
#pragma unroll
    for (int kb = 0; kb < 64; ++kb) {
      unsigned u = 0u;
      if (kb <= kbmax) {
        f32x16 a;
#pragma unroll
        for (int r = 0; r < 16; ++r) a[r] = 0.f;
        const u16* kp = P + (brow + 32 * kb + r32) * 7808 + 3584 + 8 * hi;
#pragma unroll
        for (int s = 0; s < 4; ++s) { const bf16x8 bk = *(const bf16x8*)(kp + 16 * s); a = MFMA(aq[s], bk, a); }
        float v = 0.f;
#pragma unroll
        for (int i = 0; i < 16; ++i) v = fmaf(wv[i], fmaxf(a[i], 0.f), v);
        u = (32 * kb + r32 <= tme) ? ordkey(v) : 0u;
      }
      sc[kb] = u;
    }
    const int target = (tme + 1 < 256) ? tme + 1 : 256;
    unsigned T = 0u;
    for (int bit = 31; bit >= 0; --bit) {
      const unsigned Tp = T | (1u << bit);
      int cnt = 0;
#pragma unroll
      for (int kb = 0; kb < 64; ++kb) cnt += (sc[kb] >= Tp) ? 1 : 0;
#pragma unroll
      for (int o = 16; o; o >>= 1) cnt += __shfl_xor(cnt, o);
      if (cnt >= target) T = Tp;
    }
    unsigned w0 = 0u, w1 = 0u;
#pragma unroll
    for (int kb = 0; kb < 64; ++kb) {
      const bool pred = (sc[kb] >= T) && (sc[kb] != 0u);
      const unsigned long long bal = __ballot(pred);
      const unsigned wd = (unsigned)(bal >> (32 * hi));
      if ((kb & 31) == r32) { if (kb < 32) w0 = wd; else w1 = wd; }
    }
    mask[(brow + tme) * 64 + r32] = w0;
    mask[(brow + tme) * 64 + 32 + r32] = w1;
  }
}

DI void gbar(unsigned* cnt, unsigned target) {
  asm volatile("s_waitcnt vmcnt(0)" ::: "memory");
  __syncthreads();
  if (threadIdx.x == 0) {
    __builtin_amdgcn_fence(__ATOMIC_RELEASE, "agent");
    asm volatile("s_waitcnt vmcnt(0)" ::: "memory");
    __hip_atomic_fetch_add(cnt, 1u, __ATOMIC_RELAXED, __HIP_MEMORY_SCOPE_AGENT);
    while (__hip_atomic_load(cnt, __ATOMIC_RELAXED, __HIP_MEMORY_SCOPE_AGENT) < target) __builtin_amdgcn_s_sleep(1);
    __builtin_amdgcn_fence(__ATOMIC_ACQUIRE, "agent");
    asm volatile("s_waitcnt vmcnt(0)" ::: "memory");
  }
  __syncthreads();
}
#define GSYNC() do { ++bar_gen; gbar(BAR, bar_gen * gridDim.x); } while (0)
__global__ void __launch_bounds__(512, 2) mega(Params p) {
  cg::grid_group grid = cg::this_grid();
  extern __shared__ __attribute__((aligned(16))) char smem[];
  volatile int* s_item = (volatile int*)(smem + LDS_ITEM);
  char* ws = p.ws;
  unsigned char* Y8 = (unsigned char*)(ws + OFF_Y); u16* H = (u16*)(ws + OFF_H); u16* Cb = (u16*)(ws + OFF_Y); u16* Qb = (u16*)(ws + OFF_H);
  u16* KV = (u16*)(ws + OFF_KV); u16* MG = (u16*)(ws + OFF_MG); u16* KR = (u16*)(ws + OFF_KR); u16* Pb = (u16*)(ws + OFF_P);
  u16* WIN = (u16*)(ws + OFF_WIN); u16* WUQ = (u16*)(ws + OFF_WUQ); u16* WUKV = (u16*)(ws + OFF_WUKV); u16* WOUT = (u16*)(ws + OFF_WOUT);
  u16* WMEMALL = (u16*)(ws + OFF_KV); u16* MEMN = (u16*)(ws + OFF_MEMN); u16* MEMKV = (u16*)(ws + OFF_MEMKV);
  unsigned* MASK = (unsigned*)(ws + OFF_MASK); f32x2* ROPE = (f32x2*)(ws + OFF_ROPE); float* LUT = (float*)(ws + OFF_LUT);
  int* CTR = (int*)(ws + OFF_CTR);
  unsigned* BAR = (unsigned*)(ws + OFF_CTR) + 64;
  unsigned bar_gen = 0;
  const int tid = threadIdx.x, lane = tid & 63, wv = __builtin_amdgcn_readfirstlane(tid >> 6), r32 = lane & 31, hi = lane >> 5;
  const int gtid = blockIdx.x * 512 + tid, gthreads = gridDim.x * 512;

  for (int i = gtid; i < 2048 * 32; i += gthreads) {
    const int pos = i >> 5, j = i & 31;
    const float inv = 1.0f / powf(10000.0f, (float)(2 * j) / 64.0f);
    const float ang = (float)pos * inv;
    const float k = rintf(ang * 0.15915494309189535f);
    float r = fmaf(-k, 6.28318548202514648f, ang);
    r = fmaf(-k, -1.74845553e-7f, r);
    f32x2 cs = {__cosf(r), __sinf(r)};
    ROPE[i] = cs;
  }
  for (int i = gtid; i < 129 * 32; i += gthreads) {
    const int rel = i >> 5, h = i & 31;
    int bucket;
    if (rel < 16) bucket = rel;
    else { const int lg = 16 + (int)(logf((float)rel / 16.0f) / 2.0794415416798357f * 16.0f); bucket = lg < 31 ? lg : 31; }
    LUT[i] = p.rel_bias[bucket * 32 + h] * LOG2E;
  }
  rmsnorm_rows<false>(p.mem, p.mem_norm, MEMN, 2048);
#pragma unroll 1
  for (int l = 0; l < 4; ++l) convert_wt<0>(p.w_mem_kv + (size_t)l * 2048 * 2048, 2048, 2048, 2048, WMEMALL + (size_t)l * 2048 * 2048, smem);

#pragma unroll 1
  for (int layer = 0; layer < 4; ++layer) {
    const int kind = layer % 3, j = layer / 3;
    const float* xin = (layer == 0) ? p.x : p.out;
    rmsnorm_rows<false>(xin, p.norm_in + layer * 2048, H, NTOK);
    if (kind == 0) {
      convert_wt<1>(p.w_in_a + (size_t)j * 2048 * 6208, 2048, 6208, 6400, WIN, smem);
      convert_wt<2>(p.w_uq + (size_t)j * 1536 * 3072, 1536, 3072, 3072, WUQ, smem);
      convert_wt<0>(p.w_ukv + (size_t)j * 512 * 4096, 512, 4096, 4096, WUKV, smem);
    } else if (kind == 1) convert_wt<0>(p.w_in_b, 2048, 7760, 7936, WIN, smem);
    else convert_wt<0>(p.w_in_c, 2048, 6656, 6656, WIN, smem);
    convert_wt<0, true>(p.w_out + (size_t)layer * 3072 * 2048, 3072, 2048, 2048, WOUT, smem, WOUT_SCALE);
    if (layer == 0) { __builtin_amdgcn_fence(__ATOMIC_RELEASE, "agent"); grid.sync(); __builtin_amdgcn_fence(__ATOMIC_ACQUIRE, "agent"); asm volatile("s_waitcnt vmcnt(0)" ::: "memory"); }
    else GSYNC();

    if (kind == 0) { EpiBf<1> e{Cb, 2048, 6208, MG, KR, ROPE}; run_gemm(H, 2048, WIN, NTOK, 6400, 2048, e, smem); }
    else if (kind == 1) { EpiBf<0> e{Pb, 7808, 7760, nullptr, nullptr, nullptr}; run_gemm(H, 2048, WIN, NTOK, 7936, 2048, e, smem); }
    else { EpiBf<0> e{Pb, 6656, 6656, nullptr, nullptr, nullptr}; run_gemm(H, 2048, WIN, NTOK, 6656, 2048, e, smem); }
    if (layer == 0) { EpiBf<0> e{MEMKV, 8192, 8192, nullptr, nullptr, nullptr}; run_gemm(MEMN, 2048, WMEMALL, 2048, 8192, 2048, e, smem); }
    GSYNC();

    if (kind == 0) {
      anorm_phase(Cb, p.a_q_norm + j * 1536, p.a_kv_norm + j * 512);
      GSYNC();
      { EpiBf<2> e{Qb, 3072, 3072, nullptr, nullptr, ROPE}; run_gemm(Cb, 2048, WUQ, NTOK, 3072, 1536, e, smem); }
      { EpiBf<0> e{KV, 4096, 4096, nullptr, nullptr, nullptr}; run_gemm(Cb + 1536, 2048, WUKV, NTOK, 4096, 512, e, smem); }
      GSYNC();
    } else if (kind == 1) {
      indexer_phase(Pb, MASK);
      GSYNC();
    }

    {
      const int nself = (kind == 0) ? 1024 : 2048, total = nself + 512;
      const u16* mgb = (kind == 0) ? MG : Pb;
      const int ldmg = (kind == 0) ? 4096 : (kind == 1 ? 7808 : 6656);
      const int mqcol = (kind == 0) ? 0 : (kind == 1 ? 3664 : 2560);
      const int gatecol = (kind == 0) ? 1024 : (kind == 1 ? 4688 : 3584);
      const u16* memkv = MEMKV + layer * 2048;
      float* lut_all = (float*)(smem + LDS_LUT);
      if (kind != 0) {
        for (int i = tid; i < 32 * 129; i += 512) { const int h = i / 129, r = i - h * 129; lut_all[h * 132 + r] = LUT[r * 32 + h]; }
      }
      if (tid == 0) s_item[0] = atomicAdd(&CTR[layer], 1);
      __syncthreads();
      for (int par = 0;; par ^= 1) {
        const int item = __builtin_amdgcn_readfirstlane(s_item[par]);
        if (item >= total) break;
        if (tid == 0) s_item[par ^ 1] = atomicAdd(&CTR[layer], 1);
        if (item < nself) {
          if (kind == 0) {
            const int qblk = 7 - item / 128, rem = item % 128, b = rem / 16, head = rem % 16;
            const size_t brow = (size_t)b * SEQ;
            const int tq0 = qblk * 256 + 32 * wv, tq = tq0 + r32;
            attn_core<192, 128, 128, 128, 0>(KV + brow * 4096 + head * 256, 4096, KR + brow * 64, 64, KV + brow * 4096 + head * 256 + 128, 4096,
                                            SEQ, 0, 4 * qblk + 4, Qb + (brow + tq) * 3072 + head * 192, tq, tq0, 0.07216878364870322f * LOG2E, 0,
                                            (u16*)(Y8 + (brow + tq) * 3072 + head * 128), mgb + (brow + tq) * ldmg + gatecol + head * 128,
                                            nullptr, nullptr, 0.f, -1e29f, 0.f, smem);
          } else {
            const int qb = 63 - item / 32, rem = item % 32, b = rem / 4, kvh = rem % 4;
            const size_t brow = (size_t)b * SEQ;
            const int head = kvh * 8 + wv, tq0 = qb * 32, tq = tq0 + r32;
            const float* lutw = lut_all + head * 132;
            if (kind == 1) {
              attn_core<64, 64, 64, 64, 1>(Pb + brow * 7808 + 2048 + kvh * 64, 7808, nullptr, 0, Pb + brow * 7808 + 2304 + kvh * 64, 7808,
                                          SEQ, 0, (tq0 + 31) / 64 + 1, Pb + (brow + tq) * 7808 + head * 64, tq, tq0, 0.125f * LOG2E, 0,
                                          (u16*)(Y8 + (brow + tq) * 3072 + head * 64), Pb + (brow + tq) * 7808 + gatecol + head * 64,
                                          MASK + (brow + tq) * 64, lutw, lutw[128], -1e29f, 0.f, smem);
            } else {
              const float sink = p.c_sinks[j * 32 + head] * LOG2E;
              attn_core<64, 64, 64, 64, 2>(Pb + brow * 6656 + 2048 + kvh * 64, 6656, nullptr, 0, Pb + brow * 6656 + 2304 + kvh * 64, 6656,
                                          SEQ, tq0 - 128, 3, Pb + (brow + tq) * 6656 + head * 64, tq, tq0, 0.125f * LOG2E, 0,
                                          (u16*)(Y8 + (brow + tq) * 3072 + head * 64), Pb + (brow + tq) * 6656 + gatecol + head * 64,
                                          nullptr, lutw, 0.f, sink, hi == 0 ? 1.f : 0.f, smem);
            }
          }
        } else {
          const int it = item - nself, b = it / 64, mh = (it % 64) / 16, qb = it % 16;
          const size_t brow = (size_t)b * SEQ;
          const int tq0 = qb * 128 + 32 * (wv >> 1), tq = tq0 + r32, vh = wv & 1;
          attn_core<256, 256, 128, 256, 3>(memkv + (size_t)b * 256 * 8192 + mh * 256, 8192, nullptr, 0, memkv + (size_t)b * 256 * 8192 + 1024 + mh * 256, 8192,
                                          256, 0, 4, mgb + (brow + tq) * ldmg + mqcol + mh * 256, tq, tq0, 0.0625f * LOG2E, 4 * vh,
                                          (u16*)(Y8 + (brow + tq) * 3072 + 2048 + mh * 256 + 128 * vh), mgb + (brow + tq) * ldmg + gatecol + 2048 + mh * 256 + 128 * vh,
                                          nullptr, nullptr, 0.f, -1e29f, 0.f, smem);
        }
      }
    }
    GSYNC();

    { EpiResid e{xin, p.out, 1.f / (Y_SCALE * WOUT_SCALE)}; run_gemm<true>((const u16*)Y8, 1536, WOUT, NTOK, 2048, 1536, e, smem); }
    GSYNC();
  }
  rmsnorm_rows<true>(p.out, p.final_norm, p.out, NTOK);
}

extern "C" void kernel_launch(void* const* d_in, const int* in_sizes, int n_in, void* d_out, int out_size,
                              void* d_ws, size_t ws_size, hipStream_t stream) {
  static int grid_blocks = 0;
  if (!grid_blocks) {
    int dev = 0, cus = 0, per_cu = 0;
    (void)hipGetDevice(&dev);
    (void)hipDeviceGetAttribute(&cus, hipDeviceAttributeMultiprocessorCount, dev);
    (void)hipFuncSetAttribute((const void*)mega, hipFuncAttributeMaxDynamicSharedMemorySize, LDS_BYTES);
    (void)hipOccupancyMaxActiveBlocksPerMultiprocessor(&per_cu, mega, 512, LDS_BYTES);
    if (per_cu > 1) per_cu = 1;
    grid_blocks = cus * per_cu;
  }
  Params p{};
  p.x = (const float*)d_in[0]; p.mem = (const float*)d_in[1]; p.norm_in = (const float*)d_in[2]; p.final_norm = (const float*)d_in[3];
  p.mem_norm = (const float*)d_in[4]; p.rel_bias = (const float*)d_in[5]; p.w_in_a = (const float*)d_in[6]; p.a_q_norm = (const float*)d_in[7];
  p.w_uq = (const float*)d_in[8]; p.a_kv_norm = (const float*)d_in[9]; p.w_ukv = (const float*)d_in[10]; p.w_in_b = (const float*)d_in[11];
  p.w_in_c = (const float*)d_in[12]; p.c_sinks = (const float*)d_in[13]; p.w_mem_kv = (const float*)d_in[14]; p.w_out = (const float*)d_in[15];
  p.out = (float*)d_out; p.ws = (char*)d_ws;
  (void)hipMemsetAsync((char*)d_ws + OFF_CTR, 0, 1024, stream);
  void* args[] = {&p};
  (void)hipLaunchCooperativeKernel((void*)mega, dim3(grid_blocks), dim3(512), args, LDS_BYTES, stream);
}
```

```cpp
#include <hip/hip_runtime.h>
#include <hip/hip_cooperative_groups.h>
#include <stdint.h>
namespace cg = cooperative_groups;

typedef unsigned short u16;
typedef __attribute__((ext_vector_type(8))) short bf16x8;
typedef __attribute__((ext_vector_type(4))) short s16x4;
typedef __attribute__((ext_vector_type(16))) float f32x16;
typedef __attribute__((ext_vector_type(4))) float f32x4;
typedef __attribute__((ext_vector_type(2))) float f32x2;
typedef __attribute__((ext_vector_type(4))) unsigned u32x4;
typedef __attribute__((ext_vector_type(2))) unsigned u32x2;
typedef __attribute__((ext_vector_type(2))) __bf16 bf16x2_t;
typedef short v4i16_t __attribute__((ext_vector_type(4)));
#define DI __device__ __forceinline__
#define MFMA(a, b, c) __builtin_amdgcn_mfma_f32_32x32x16_bf16((a), (b), (c), 0, 0, 0)

constexpr int SEQ = 2048, NTOK = 16384;
constexpr int LDS_LUT = 133120, LDS_ITEM = LDS_LUT + 32 * 528, LDS_BYTES = LDS_ITEM + 64;
constexpr float LOG2E = 1.4426950408889634f;
constexpr float NEGV = -1e30f;
constexpr float Y_SCALE = 16.f, WOUT_SCALE = 256.f, CQ_SCALE = 16.f, WUQ_SCALE = 256.f;

constexpr size_t OFF_Y = 0;
constexpr size_t OFF_H = 100663296;
constexpr size_t OFF_KV = 201326592;
constexpr size_t OFF_MG = 335544320;
constexpr size_t OFF_KR = 469762048;
constexpr size_t OFF_P = 167772160;
constexpr size_t OFF_WIN = 471859200;
constexpr size_t OFF_WUQ = OFF_WIN + 32505856;
constexpr size_t OFF_WUKV = OFF_WUQ + 9437184;
constexpr size_t OFF_WOUT = OFF_WUKV + 4194304;
constexpr size_t OFF_MEMN = OFF_WOUT + 12582912;
constexpr size_t OFF_MEMKV = OFF_MEMN + 8388608;
constexpr size_t OFF_MASK = OFF_MEMKV + 33554432;
constexpr size_t OFF_ROPE = OFF_MASK + 4194304;
constexpr size_t OFF_LUT = OFF_ROPE + 524288;
constexpr size_t OFF_CTR = OFF_LUT + 32768;

struct Params {
  const float *x, *mem, *norm_in, *final_norm, *mem_norm, *rel_bias, *w_in_a, *a_q_norm, *w_uq, *a_kv_norm, *w_ukv,
      *w_in_b, *w_in_c, *c_sinks, *w_mem_kv, *w_out;
  float* out;
  char* ws;
};

DI float bf2f(unsigned b) { return __uint_as_float(b << 16); }
DI unsigned pk2(float a, float b) {
  f32x2 v = {a, b};
  return __builtin_bit_cast(unsigned, __builtin_convertvector(v, bf16x2_t));
}
DI float clamp8(float x) { return fminf(fmaxf(x, -448.f), 448.f); }
DI unsigned pk4_fp8(float a, float b, float c, float d) {
  int w = 0;
  w = __builtin_amdgcn_cvt_pk_fp8_f32(clamp8(a), clamp8(b), w, false);
  w = __builtin_amdgcn_cvt_pk_fp8_f32(clamp8(c), clamp8(d), w, true);
  return (unsigned)w;
}
DI u16 f2bf(float a) { return (u16)(pk2(a, 0.f) & 0xffffu); }
DI float wave_sum(float v) {
#pragma unroll
  for (int o = 32; o; o >>= 1) v += __shfl_xor(v, o);
  return v;
}
DI int crow(int reg, int hi) { return (reg & 3) + 8 * (reg >> 2) + 4 * hi; }
DI float xhalf_max(float m) {
  auto rr = __builtin_amdgcn_permlane32_swap(__float_as_uint(m), __float_as_uint(m), false, false);
  return fmaxf(__uint_as_float(rr[0]), __uint_as_float(rr[1]));
}
DI float xhalf_sum(float m) {
  auto rr = __builtin_amdgcn_permlane32_swap(__float_as_uint(m), __float_as_uint(m), false, false);
  return __uint_as_float(rr[0]) + __uint_as_float(rr[1]);
}
typedef __attribute__((address_space(3))) v4i16_t* lds_v4p;
DI s16x4 vtr(const char* p) {
  return __builtin_bit_cast(s16x4, __builtin_amdgcn_ds_read_tr16_b64_v4i16((lds_v4p)(p)));
}

template <int PERM, bool FP8 = false>
DI void convert_wt(const float* __restrict__ W, int K, int N, int Npad, u16* __restrict__ Wt, char* smem, float wscale = 1.f) {
  float* tile = (float*)smem;
  int tid = threadIdx.x; asm volatile("" : "+v"(tid));
  const int ntk = K / 64, ntn = Npad / 64;
  for (int t = blockIdx.x; t < ntk * ntn; t += gridDim.x) {
    const int tk = t % ntk, tn = t / ntk, k0 = tk * 64, n0 = tn * 64;
    __syncthreads();
#pragma unroll
    for (int i = 0; i < 2; ++i) {
      const int id = tid + 512 * i, kr = id >> 4, n4 = (id & 15) * 4;
      f32x4 v = {0.f, 0.f, 0.f, 0.f};
      if (n0 + n4 < N) v = *(const f32x4*)(W + (size_t)(k0 + kr) * N + n0 + n4);
      tile[kr * 65 + n4 + 0] = v[0]; tile[kr * 65 + n4 + 1] = v[1]; tile[kr * 65 + n4 + 2] = v[2]; tile[kr * 65 + n4 + 3] = v[3];
    }
    __syncthreads();
    {
      const int n = tid >> 3, c = tid & 7;
      bool rot = false;
      if (PERM == 1) rot = (n0 == 2048);
      if (PERM == 2) rot = ((tn % 3) == 2);
      const int ns = rot ? ((n >> 1) + 32 * (n & 1)) : n;
      if (FP8) {
        float f[8];
#pragma unroll
        for (int j = 0; j < 8; ++j) f[j] = tile[(c * 8 + j) * 65 + ns] * wscale;
        u32x2 o = {pk4_fp8(f[0], f[1], f[2], f[3]), pk4_fp8(f[4], f[5], f[6], f[7])};
        *(u32x2*)((unsigned char*)Wt + (size_t)(n0 + n) * K + k0 + c * 8) = o;
      } else {
        u32x4 o;
#pragma unroll
        for (int j = 0; j < 4; ++j) o[j] = pk2(tile[(c * 8 + 2 * j) * 65 + ns], tile[(c * 8 + 2 * j + 1) * 65 + ns]);
        *(u32x4*)(Wt + (size_t)(n0 + n) * K + k0 + c * 8) = o;
      }
    }
  }
}

template <bool F32OUT>
DI void rmsnorm_rows(const float* X, const float* __restrict__ g, void* outp, int nrows) {
  int tidx = threadIdx.x; asm volatile("" : "+v"(tidx));
  const int lane = tidx & 63, gw = blockIdx.x * 8 + (tidx >> 6), nw = gridDim.x * 8;
  for (int row = gw; row < nrows; row += nw) {
    const f32x4* xr = (const f32x4*)(X + (size_t)row * 2048);
    f32x4 v[8];
    float ss = 0.f;
#pragma unroll
    for (int i = 0; i < 8; ++i) { v[i] = xr[lane + 64 * i]; ss += v[i][0] * v[i][0] + v[i][1] * v[i][1] + v[i][2] * v[i][2] + v[i][3] * v[i][3]; }
    ss = wave_sum(ss);
    const float r = rsqrtf(ss * (1.f / 2048.f) + 1e-6f);
#pragma unroll
    for (int i = 0; i < 8; ++i) {
      const f32x4 gg = ((const f32x4*)g)[lane + 64 * i];
      f32x4 o = {v[i][0] * r * gg[0], v[i][1] * r * gg[1], v[i][2] * r * gg[2], v[i][3] * r * gg[3]};
      if (F32OUT) ((f32x4*)((float*)outp + (size_t)row * 2048))[lane + 64 * i] = o;
      else { u32x2 pk = {pk2(o[0], o[1]), pk2(o[2], o[3])}; ((u32x2*)((u16*)outp + (size_t)row * 2048))[lane + 64 * i] = pk; }
    }
  }
}

DI void anorm_phase(u16* C, const float* __restrict__ gq, const float* __restrict__ gkv, unsigned char* __restrict__ cq8) {
  int tidx = threadIdx.x; asm volatile("" : "+v"(tidx));
  const int lane = tidx & 63, gw = blockIdx.x * 8 + (tidx >> 6), nw = gridDim.x * 8;
  for (int row = gw; row < NTOK; row += nw) {
    u32x4* cr = (u32x4*)(C + (size_t)row * 2048);
    u32x4 v[4];
    float sq = 0.f, skv = 0.f;
#pragma unroll
    for (int i = 0; i < 4; ++i) {
      v[i] = cr[lane + 64 * i];
      float s = 0.f;
#pragma unroll
      for (int j = 0; j < 4; ++j) { float a = bf2f(v[i][j] & 0xffffu), b = bf2f(v[i][j] >> 16); s += a * a + b * b; }
      if (i < 3) sq += s; else skv += s;
    }
    sq = wave_sum(sq); skv = wave_sum(skv);
    const float rq = rsqrtf(sq * (1.f / 1536.f) + 1e-6f), rkv = rsqrtf(skv * (1.f / 512.f) + 1e-6f);
#pragma unroll
    for (int i = 0; i < 4; ++i) {
      const int col = (lane + 64 * i) * 8;
      const float* gp = (i < 3) ? (gq + col) : (gkv + col - 1536);
      const float r = (i < 3) ? rq : rkv;
      const f32x4 g0 = *(const f32x4*)gp, g1 = *(const f32x4*)(gp + 4);
      u32x4 o;
      o[0] = pk2(bf2f(v[i][0] & 0xffffu) * r * g0[0], bf2f(v[i][0] >> 16) * r * g0[1]);
      o[1] = pk2(bf2f(v[i][1] & 0xffffu) * r * g0[2], bf2f(v[i][1] >> 16) * r * g0[3]);
      o[2] = pk2(bf2f(v[i][2] & 0xffffu) * r * g1[0], bf2f(v[i][2] >> 16) * r * g1[1]);
      o[3] = pk2(bf2f(v[i][3] & 0xffffu) * r * g1[2], bf2f(v[i][3] >> 16) * r * g1[3]);
      cr[lane + 64 * i] = o;
      if (i < 3) {
        const float q0 = bf2f(v[i][0] & 0xffffu) * r * g0[0] * CQ_SCALE, q1 = bf2f(v[i][0] >> 16) * r * g0[1] * CQ_SCALE;
        const float q2 = bf2f(v[i][1] & 0xffffu) * r * g0[2] * CQ_SCALE, q3 = bf2f(v[i][1] >> 16) * r * g0[3] * CQ_SCALE;
        const float q4 = bf2f(v[i][2] & 0xffffu) * r * g1[0] * CQ_SCALE, q5 = bf2f(v[i][2] >> 16) * r * g1[1] * CQ_SCALE;
        const float q6 = bf2f(v[i][3] & 0xffffu) * r * g1[2] * CQ_SCALE, q7 = bf2f(v[i][3] >> 16) * r * g1[3] * CQ_SCALE;
        u32x2 w8 = {pk4_fp8(q0, q1, q2, q3), pk4_fp8(q4, q5, q6, q7)};
        *(u32x2*)(cq8 + (size_t)row * 1536 + col) = w8;
      }
    }
  }
}

namespace pg8 {
#define PG8_LAS __attribute__((address_space(3)))
constexpr int BM = 256, BK = 64, HALF = 128, HTB = HALF * BK * 2, STAGE_BYTES = 8 * HTB, NXCD = 8, WGM = 8;
DI int lds_byte(int r, int c) { const int st = (r >> 4) * 2 + (c >> 5), rr = r & 15, cc = c & 31, ob = rr * 64 + cc * 2; return st * 1024 + (ob ^ (((ob >> 9) & 1) << 5)); }
DI void stage_rc(int b, int& R, int& C) { const int st = b / 1024, sb = b % 1024, swz = sb ^ (((sb >> 9) & 1) << 5); R = (st >> 1) * 16 + swz / 64; C = (st & 1) * 32 + (swz % 64) / 2; }
DI int perm32(int rho) { const int n = rho >> 4, i = rho & 15; return 8 * (i >> 2) + 4 * n + (i & 3); }
typedef int i32x4v __attribute__((ext_vector_type(4)));
typedef int i32x8 __attribute__((ext_vector_type(8)));
DI i32x8 cat8(bf16x8 a, bf16x8 b) { const i32x4v x = __builtin_bit_cast(i32x4v, a), y = __builtin_bit_cast(i32x4v, b); return __builtin_shufflevector(x, y, 0, 1, 2, 3, 4, 5, 6, 7); }
struct Unit { int pm, pn; };
struct Gemm { const u16* A; const u16* Bt; int M, N, K, lda; };
struct StaticOrder {
  int nM, nN, nwg, G, c;
  DI void init(int M, int N, int G_, int c_) { nM = M / BM; nN = N / BM; nwg = nM * nN; G = G_; c = c_; }
  DI bool next(int i, Unit& u) const {
    const long L = (long)i * G + c; if (L >= nwg) return false;
    int wgid = (int)L; { const int q = nwg / NXCD, r = nwg % NXCD, xcd = wgid % NXCD, off = wgid / NXCD; wgid = (xcd < r ? xcd * (q + 1) : r * (q + 1) + (xcd - r) * q) + off; }
    const int nig = WGM * nN, gid = wgid / nig, fm = gid * WGM, gsz = (nM - fm) < WGM ? (nM - fm) : WGM;
    u.pm = fm + ((wgid % nig) % gsz); u.pn = (wgid % nig) / gsz; return true;
  }
  DI void a_ready(const Unit&) const {}
  DI void done(const Unit&) const {}
};
template <bool FP8, class Epi, class Sched>
__device__ __forceinline__ void gemm_phase(PG8_LAS unsigned char* lds, const Gemm g, const Sched& S, const Epi& E) {
    int tid = threadIdx.x; asm volatile("" : "+v"(tid));
    const int wid = __builtin_amdgcn_readfirstlane(tid >> 6), lane = tid & 63, wr = wid >> 2, wc = wid & 3, fr = lane & 15, fq = lane >> 4;
    const int K = g.K, nt = K / BK;
    unsigned voffA[2], voffB[2];
#pragma unroll
    for (int i = 0; i < 2; ++i) { int R, C; stage_rc(tid * 16 + i * 8192, R, C); const int Rb = Epi::PERM ? ((R & ~31) + perm32(R & 31)) : R;
        voffA[i] = (unsigned)(R * g.lda + C) * 2u; voffB[i] = (unsigned)(Rb * K + C) * 2u; }
    const size_t kstep = (size_t)(BK * 2);
    const size_t hstep = (size_t)HALF * K * 2, hstepA = (size_t)HALF * g.lda * 2;
    const size_t tstep = 2 * hstep, tstepA = 2 * hstepA;
    const unsigned ldsw = (unsigned)wid * 1024u;
    const int aoff = lds_byte(wr * 64 + fr, fq * 8), boff = lds_byte(wc * 32 + fr, fq * 8);
#define PG8_SA(b, h) (((b) * 2 + (h)) * HTB)
#define PG8_SB(b, h) ((4 + (b) * 2 + (h)) * HTB)
#define PG8_STAGE(bufoff, gbase, voff) do { _Pragma("unroll") for (int _i = 0; _i < 2; ++_i) \
        __builtin_amdgcn_global_load_lds((const unsigned*)((const char*)(gbase) + (voff)[_i]), (PG8_LAS unsigned*)(lds + (bufoff) + ldsw + _i * 8192), 16, 0, 0); } while (0)
#define PG8_LDA(dst, b, h) do { _Pragma("unroll") for (int m = 0; m < 4; ++m) _Pragma("unroll") for (int k = 0; k < 2; ++k) dst[m][k] = *(const PG8_LAS bf16x8*)(lds + PG8_SA(b, h) + aoff + m * 2048 + k * 1024); } while (0)
#define PG8_LDB(dst, b, h) do { _Pragma("unroll") for (int n = 0; n < 2; ++n) _Pragma("unroll") for (int k = 0; k < 2; ++k) dst[n][k] = *(const PG8_LAS bf16x8*)(lds + PG8_SB(b, h) + boff + n * 2048 + k * 1024); } while (0)
#define PG8_MMA(ai, bj, At, Bt) do { __builtin_amdgcn_s_setprio(1); _Pragma("unroll") for (int m = 0; m < 4; ++m) _Pragma("unroll") for (int n = 0; n < 2; ++n) { \
        if constexpr (FP8) { const i32x8 bv_ = cat8(Bt[n][0], Bt[n][1]), av_ = cat8(At[m][0], At[m][1]); \
            asm volatile("s_nop 1\n\tv_mfma_scale_f32_16x16x128_f8f6f4 %0, %1, %2, %0, %3, %3 op_sel_hi:[0,0,0]" : "+v"(acc[ai][bj][m][n]) : "v"(bv_), "v"(av_), "v"(sc127)); } \
        else { _Pragma("unroll") for (int k = 0; k < 2; ++k) acc[ai][bj][m][n] = __builtin_amdgcn_mfma_f32_16x16x32_bf16(Bt[n][k], At[m][k], acc[ai][bj][m][n], 0, 0, 0); } } \
        __builtin_amdgcn_s_setprio(0); } while (0)
#define PG8_WAIT_V(n) asm volatile("s_waitcnt vmcnt(" #n ")" ::: "memory")
#define PG8_WAIT_L(n) asm volatile("s_waitcnt lgkmcnt(" #n ")" ::: "memory")
#define PG8_BAR __builtin_amdgcn_s_barrier()
#define PG8_SCHED __builtin_amdgcn_sched_barrier(0)
    Unit cur, nxt; int ui = 0;
    if (!S.next(0, cur)) return;
    f32x4 acc[2][2][4][2];
#pragma unroll
    for (int a = 0; a < 2; ++a)
#pragma unroll
        for (int b = 0; b < 2; ++b)
#pragma unroll
            for (int m = 0; m < 4; ++m)
#pragma unroll
                for (int n = 0; n < 2; ++n) acc[a][b][m][n] = (f32x4){0.f, 0.f, 0.f, 0.f};
    bf16x8 At[4][2], B0[2][2], B1[2][2];
    int sc127 = 0x7F7F7F7F; asm volatile("" : "+v"(sc127));
    const char* cA = (const char*)g.A + (size_t)cur.pm * tstepA; const char* cB = (const char*)g.Bt + (size_t)cur.pn * tstep;
    S.a_ready(cur);
    PG8_STAGE(PG8_SB(0, 0), cB, voffB); PG8_STAGE(PG8_SA(0, 0), cA, voffA); PG8_STAGE(PG8_SB(0, 1), cB + hstep, voffB); PG8_STAGE(PG8_SA(0, 1), cA + hstepA, voffA);
    if (wr == 1) PG8_BAR;
    PG8_WAIT_V(4); PG8_BAR;
    PG8_STAGE(PG8_SB(1, 0), cB + kstep, voffB); PG8_STAGE(PG8_SA(1, 0), cA + kstep, voffA); PG8_STAGE(PG8_SB(1, 1), cB + hstep + kstep, voffB);
    PG8_WAIT_V(6); PG8_BAR;
    for (;;) {
        const bool has_next = S.next(ui + 1, nxt);
        const char* nA = has_next ? (const char*)g.A + (size_t)nxt.pm * tstepA : cA; const char* nB = has_next ? (const char*)g.Bt + (size_t)nxt.pn * tstep : cB;
        for (int t = 0; t < nt; t += 2) {
            const bool last = (t == nt - 2);
            const char* a1 = cA + (size_t)(t + 1) * kstep;
            const char* a2 = last ? nA : cA + (size_t)(t + 2) * kstep; const char* b2 = last ? nB : cB + (size_t)(t + 2) * kstep;
            const char* a3 = a2 + kstep; const char* b3 = b2 + kstep;
            if (last && has_next) S.a_ready(nxt);
            PG8_LDB(B0, 0, 0); PG8_SCHED; PG8_LDA(At, 0, 0); PG8_STAGE(PG8_SA(1, 1), a1 + hstepA, voffA);
            PG8_WAIT_L(8); PG8_BAR; PG8_WAIT_L(0); PG8_MMA(0, 0, At, B0); PG8_BAR; PG8_SCHED;
            PG8_LDB(B1, 0, 1); PG8_STAGE(PG8_SB(0, 0), b2, voffB);
            PG8_BAR; PG8_WAIT_L(0); PG8_MMA(0, 1, At, B1); PG8_BAR;
            PG8_LDA(At, 0, 1); PG8_STAGE(PG8_SA(0, 0), a2, voffA);
            PG8_BAR; PG8_WAIT_L(0); PG8_MMA(1, 0, At, B0); PG8_BAR; PG8_SCHED;
            PG8_STAGE(PG8_SB(0, 1), b2 + hstep, voffB);
            PG8_WAIT_V(6); PG8_BAR; PG8_MMA(1, 1, At, B1); PG8_BAR;
            PG8_LDB(B0, 1, 0); PG8_SCHED; PG8_LDA(At, 1, 0); PG8_STAGE(PG8_SA(0, 1), a2 + hstepA, voffA);
            PG8_WAIT_L(8); PG8_BAR; PG8_WAIT_L(0); PG8_MMA(0, 0, At, B0); PG8_BAR; PG8_SCHED;
            PG8_LDB(B1, 1, 1); PG8_STAGE(PG8_SB(1, 0), b3, voffB);
            PG8_BAR; PG8_WAIT_L(0); PG8_MMA(0, 1, At, B1); PG8_BAR;
            PG8_LDA(At, 1, 1); PG8_STAGE(PG8_SA(1, 0), a3, voffA);
            PG8_BAR; PG8_WAIT_L(0); PG8_MMA(1, 0, At, B0); PG8_BAR; PG8_SCHED;
            PG8_STAGE(PG8_SB(1, 1), b3 + hstep, voffB);
            PG8_WAIT_V(6); PG8_BAR; PG8_MMA(1, 1, At, B1); PG8_BAR;
        }
        if constexpr (FP8) asm volatile("s_nop 15\n\ts_nop 15" ::: "memory");
        if constexpr (!Epi::AFTER_DRAIN) { E(acc, cur, wr, wc, fr, fq); S.done(cur); }
        if (!has_next) break;
#pragma unroll
        for (int a = 0; a < 2; ++a)
#pragma unroll
            for (int b = 0; b < 2; ++b)
#pragma unroll
                for (int m = 0; m < 4; ++m)
#pragma unroll
                    for (int n = 0; n < 2; ++n) acc[a][b][m][n] = (f32x4){0.f, 0.f, 0.f, 0.f};
        cur = nxt; cA = nA; cB = nB; ++ui;
    }
    PG8_WAIT_V(0);
    if (wr == 0) PG8_BAR;
    PG8_BAR;
    if constexpr (Epi::AFTER_DRAIN) { E.fused(acc, cur, wr, wc, fr, fq, lds, wid, lane); S.done(cur); }
#undef PG8_SA
#undef PG8_SB
#undef PG8_STAGE
#undef PG8_LDA
#undef PG8_LDB
#undef PG8_MMA
#undef PG8_WAIT_V
#undef PG8_WAIT_L
#undef PG8_BAR
#undef PG8_SCHED
}

}

struct EpiResid {
  static constexpr bool PERM = false, AFTER_DRAIN = false;
  const float* xin; float* xout; float sc;
  DI void operator()(const f32x4 (&acc)[2][2][4][2], const pg8::Unit& u, int wr, int wc, int fr, int fq) const {
    const int row0 = u.pm * 256 + wr * 64 + fr, col0 = u.pn * 256 + wc * 32 + 4 * fq;
#pragma unroll
    for (int ai = 0; ai < 2; ++ai)
#pragma unroll
      for (int m = 0; m < 4; ++m) {
        const size_t ro = (size_t)(row0 + ai * 128 + m * 16) * 2048 + col0;
#pragma unroll
        for (int bj = 0; bj < 2; ++bj)
#pragma unroll
          for (int n = 0; n < 2; ++n) {
            const size_t o = ro + bj * 128 + n * 16;
            const f32x4 xv = *(const f32x4*)(xin + o);
            *(f32x4*)(xout + o) = xv + acc[ai][bj][m][n] * sc;
          }
        asm volatile("" ::: "memory");
      }
  }
};
template <int MODE>
struct EpiBf {
  static constexpr bool PERM = true, AFTER_DRAIN = false;
  u16* d0; int ld0; int N; u16* d1; u16* d2; const f32x2* rope; float sc = 1.f;
  DI void rot(f32x4& v0, f32x4& v1, int row, int col) const {
    const f32x4* cp = (const f32x4*)(rope + (row & 2047) * 32 + ((col & 63) >> 1));
    const f32x4 c01 = cp[0], c23 = cp[1];
    const f32x4 a = {v0[0] * c01[0] - v0[1] * c01[1], v0[1] * c01[0] + v0[0] * c01[1], v0[2] * c01[2] - v0[3] * c01[3], v0[3] * c01[2] + v0[2] * c01[3]};
    const f32x4 b = {v1[0] * c23[0] - v1[1] * c23[1], v1[1] * c23[0] + v1[0] * c23[1], v1[2] * c23[2] - v1[3] * c23[3], v1[3] * c23[2] + v1[2] * c23[3]};
    v0 = a; v1 = b;
  }
  DI void operator()(const f32x4 (&acc)[2][2][4][2], const pg8::Unit& u, int wr, int wc, int fr, int fq) const {
    const int row0 = u.pm * 256 + wr * 64 + fr, colb = u.pn * 256 + wc * 32 + 8 * fq;
#pragma unroll
    for (int ai = 0; ai < 2; ++ai)
#pragma unroll
      for (int m = 0; m < 4; ++m) {
        const int row = row0 + ai * 128 + m * 16;
#pragma unroll
        for (int bj = 0; bj < 2; ++bj) {
          const int col = colb + bj * 128;
          f32x4 v0 = acc[ai][bj][m][0] * sc, v1 = acc[ai][bj][m][1] * sc;
          u16* dst = nullptr;
          if (MODE == 0) { if (col < N) dst = d0 + (size_t)row * ld0 + col; }
          else if (MODE == 1) {
            if (col < 2048) dst = d0 + (size_t)row * 2048 + col;
            else if (col < 2112) { rot(v0, v1, row, col); dst = d2 + (size_t)row * 64 + (col - 2048); }
            else if (col < 6208) dst = d1 + (size_t)row * 4096 + (col - 2112);
          } else {
            if (((col >> 6) % 3) == 2) rot(v0, v1, row, col);
            dst = d0 + (size_t)row * 3072 + col;
          }
          if (dst) { u32x4 w = {pk2(v0[0], v0[1]), pk2(v0[2], v0[3]), pk2(v1[0], v1[1]), pk2(v1[2], v1[3])}; *(u32x4*)dst = w; }
        }
        asm volatile("" ::: "memory");
      }
  }
};

template <bool FP8 = false, class Epi>
DI void run_gemm(const u16* A, int lda, const u16* Bt, int M, int N, int K, const Epi& e, char* smem) {
  __syncthreads();
  pg8::Gemm g{A, Bt, M, N, K, lda};
  pg8::StaticOrder S; S.init(M, N, gridDim.x, blockIdx.x);
  pg8::gemm_phase<FP8>(( __attribute__((address_space(3))) unsigned char*)smem, g, S, e);
  __syncthreads();
}

typedef __attribute__((address_space(3))) unsigned* lds_u32p;
template <int OFF> DI void rd4(bf16x8 (&f)[4], unsigned addr) {
  asm volatile("ds_read_b128 %0, %4 offset:%5\n\tds_read_b128 %1, %4 offset:%6\n\tds_read_b128 %2, %4 offset:%7\n\tds_read_b128 %3, %4 offset:%8\n\ts_waitcnt lgkmcnt(0)"
               : "=&v"(f[0]), "=&v"(f[1]), "=&v"(f[2]), "=&v"(f[3]) : "v"(addr), "i"(OFF), "i"(OFF + 32), "i"(OFF + 64), "i"(OFF + 96) : "memory");
}
template <int OFF> DI void rdv8(s16x4 (&v)[8], unsigned addr) {
  asm volatile("ds_read_b64_tr_b16 %0, %8 offset:%9\n\tds_read_b64_tr_b16 %1, %8 offset:%10\n\tds_read_b64_tr_b16 %2, %8 offset:%11\n\tds_read_b64_tr_b16 %3, %8 offset:%12\n\t"
               "ds_read_b64_tr_b16 %4, %8 offset:%13\n\tds_read_b64_tr_b16 %5, %8 offset:%14\n\tds_read_b64_tr_b16 %6, %8 offset:%15\n\tds_read_b64_tr_b16 %7, %8 offset:%16\n\ts_waitcnt lgkmcnt(0)"
               : "=&v"(v[0]), "=&v"(v[1]), "=&v"(v[2]), "=&v"(v[3]), "=&v"(v[4]), "=&v"(v[5]), "=&v"(v[6]), "=&v"(v[7])
               : "v"(addr), "i"(OFF), "i"(OFF + 512), "i"(OFF + 1024), "i"(OFF + 1536), "i"(OFF + 2048), "i"(OFF + 2560), "i"(OFF + 3072), "i"(OFF + 3584) : "memory");
}
template <int KSTR, int ND, int N>
DI f32x16 s_block(unsigned kaddr, const bf16x8* qf) {
  const f32x16 z16 = {0.f, 0.f, 0.f, 0.f, 0.f, 0.f, 0.f, 0.f, 0.f, 0.f, 0.f, 0.f, 0.f, 0.f, 0.f, 0.f};
  bf16x8 f[4];
  rd4<N * 32 * KSTR>(f, kaddr);
  f32x16 a = MFMA(f[0], qf[0], z16); a = MFMA(f[1], qf[1], a); a = MFMA(f[2], qf[2], a); a = MFMA(f[3], qf[3], a);
  if constexpr (ND > 4) { rd4<N * 32 * KSTR + 128>(f, kaddr); a = MFMA(f[0], qf[4], a); a = MFMA(f[1], qf[5], a); a = MFMA(f[2], qf[6], a); a = MFMA(f[3], qf[7], a); }
  if constexpr (ND > 8) { rd4<N * 32 * KSTR + 256>(f, kaddr); a = MFMA(f[0], qf[8], a); a = MFMA(f[1], qf[9], a); a = MFMA(f[2], qf[10], a); a = MFMA(f[3], qf[11], a); }
  if constexpr (ND > 12) { rd4<N * 32 * KSTR + 384>(f, kaddr); a = MFMA(f[0], qf[12], a); a = MFMA(f[1], qf[13], a); a = MFMA(f[2], qf[14], a); a = MFMA(f[3], qf[15], a); }
  return a;
}
template <int CB> DI void pv_block(f32x16& o, unsigned vaddr, const bf16x8 (&pb)[2][2]) {
  s16x4 v[8];
  rdv8<CB * 4096>(v, vaddr);
#pragma unroll
  for (int q = 0; q < 4; ++q) {
    const bf16x8 vf = {v[2 * q][0], v[2 * q][1], v[2 * q][2], v[2 * q][3], v[2 * q + 1][0], v[2 * q + 1][1], v[2 * q + 1][2], v[2 * q + 1][3]};
    o = MFMA(vf, pb[q >> 1][q & 1], o);
  }
}
template <int DQK, int W1, int DV, int VW, int MODE>
DI void attn_core(const u16* __restrict__ k1, int ldk1, const u16* __restrict__ k2, int ldk2, const u16* __restrict__ vsrc, int ldv,
                  int kv_len, int kbase0, int ntiles, const u16* qrow, int tq, int tq0, float c2, int vcb0, u16* yrow,
                  const u16* grow, const unsigned* maskrow, const float* lutw, float bias_far, float m_init, float l_init, char* smem) {
  constexpr int KSTR = DQK * 2 + 16, KCH = DQK / 8;
  constexpr int ND = DQK / 16, NCB = DV / 32, BUF = 64 * KSTR + (VW / 32) * 4096;
  constexpr int NKI = KSTR / 16, NVI = VW / 8;
  static_assert(ND % 4 == 0 && NCB <= 4, "fragment batches");
  int tid0 = threadIdx.x; asm volatile("" : "+v"(tid0));
  const int lane = tid0 & 63, r32 = lane & 31, hi = lane >> 5;
  const int wv = __builtin_amdgcn_readfirstlane(tid0 >> 6);
  const unsigned lds0 = (unsigned)(uintptr_t)smem;
  bf16x8 qf[ND];
#pragma unroll
  for (int d0 = 0; d0 < ND; ++d0) qf[d0] = *(const bf16x8*)(qrow + d0 * 16 + hi * 8);
  f32x16 o[NCB];
#pragma unroll
  for (int cb = 0; cb < NCB; ++cb)
#pragma unroll
    for (int r = 0; r < 16; ++r) o[cb][r] = 0.f;
  float m = m_init, l = l_init;
  const unsigned klane = (unsigned)(r32 * KSTR + hi * 16);
  const unsigned vlane = (unsigned)(64 * KSTR + vcb0 * 4096 + ((lane >> 4) & 1) * 32 + (lane & 3) * 8 + (4 * hi + ((lane & 15) >> 2)) * 64);
  unsigned mwn[2] = {0u, 0u};
  auto stage_tile = [&](int kb, int buf) {
    int ln = threadIdx.x & 63; asm volatile("" : "+v"(ln));
    const unsigned bofs = (unsigned)(buf * BUF);
#pragma unroll
    for (int ii = 0; ii < (NKI + 7) / 8; ++ii) {
      const int i = wv + 8 * ii;
      if (i < NKI) {
        const int ob = i * 1024 + ln * 16, row = ob / KSTR;
        int c = (ob - row * KSTR) >> 4; c = (c >= KCH) ? 0 : c;
        int key = kb + row; key = key < 0 ? 0 : (key >= kv_len ? kv_len - 1 : key);
        const u16* src = (c < W1 / 8) ? (k1 + (key * ldk1 + c * 8)) : (k2 + (key * ldk2 + (c - W1 / 8) * 8));
        __builtin_amdgcn_global_load_lds((const unsigned*)src, (lds_u32p)(smem + bofs + i * 1024), 16, 0, 0);
      }
    }
#pragma unroll
    for (int ii = 0; ii < (NVI + 7) / 8; ++ii) {
      const int i = wv + 8 * ii;
      if (i < NVI) {
        const int ob = i * 1024 + ln * 16, cbk = ob >> 12, row = (ob & 4095) >> 6, cw = (ob & 63) >> 4;
        int key = kb + row; key = key < 0 ? 0 : (key >= kv_len ? kv_len - 1 : key);
        __builtin_amdgcn_global_load_lds((const unsigned*)(vsrc + (key * ldv + (cbk * 4 + cw) * 8)), (lds_u32p)(smem + bofs + 64 * KSTR + i * 1024), 16, 0, 0);
      }
    }
    if (MODE == 1) { mwn[0] = maskrow[(kb >> 5)]; mwn[1] = maskrow[(kb >> 5) + 1]; }
  };
  stage_tile(kbase0, 0);
  asm volatile("s_waitcnt vmcnt(0)" ::: "memory");
  __syncthreads();
  for (int t = 0; t < ntiles; ++t) {
    const int kb = kbase0 + t * 64;
    const unsigned bufa = lds0 + (unsigned)((t & 1) * BUF);
    const unsigned mw0 = mwn[0], mw1 = mwn[1];
    if (t + 1 < ntiles) stage_tile(kb + 64, (t + 1) & 1);
    if (!(MODE == 0 && kb > tq0 + 31)) {
      f32x16 s[2];
      s[0] = s_block<KSTR, ND, 0>(bufa + klane, qf);
      s[1] = s_block<KSTR, ND, 1>(bufa + klane, qf);
      if (MODE == 0) {
        const bool diag = kb + 63 > tq0;
#pragma unroll
        for (int n = 0; n < 2; ++n)
#pragma unroll
          for (int i = 0; i < 16; ++i) {
            float v = s[n][i] * c2;
            if (diag) { const int key = kb + 32 * n + crow(i, hi); if (key > tq) v = NEGV; }
            s[n][i] = v;
          }
      } else if (MODE == 1) {
        const bool far = (tq0 - (kb + 63)) >= 128;
#pragma unroll
        for (int n = 0; n < 2; ++n) {
          const unsigned wb = (n ? mw1 : mw0) >> (4 * hi);
          if (far) {
#pragma unroll
            for (int i = 0; i < 16; ++i) {
              const float v = fmaf(s[n][i], c2, bias_far);
              s[n][i] = ((wb >> ((i & 3) + 8 * (i >> 2))) & 1u) ? v : NEGV;
            }
          } else {
#pragma unroll
            for (int i = 0; i < 16; ++i) {
              const int key = kb + 32 * n + crow(i, hi);
              int rel = tq - key; rel = rel < 0 ? 0 : (rel > 128 ? 128 : rel);
              const float v = fmaf(s[n][i], c2, lutw[rel]);
              s[n][i] = ((wb >> ((i & 3) + 8 * (i >> 2))) & 1u) ? v : NEGV;
            }
          }
        }
      } else if (MODE == 2) {
#pragma unroll
        for (int n = 0; n < 2; ++n)
#pragma unroll
          for (int i = 0; i < 16; ++i) {
            const int key = kb + 32 * n + crow(i, hi), rel = tq - key;
            const bool ok = ((unsigned)rel < 128u) && (key >= 0);
            const float v = fmaf(s[n][i], c2, lutw[rel & 127]);
            s[n][i] = ok ? v : NEGV;
          }
      } else {
#pragma unroll
        for (int n = 0; n < 2; ++n)
#pragma unroll
          for (int i = 0; i < 16; ++i) s[n][i] *= c2;
      }
      float mx = s[0][0];
#pragma unroll
      for (int i = 1; i < 16; ++i) mx = fmaxf(mx, s[0][i]);
#pragma unroll
      for (int i = 0; i < 16; ++i) mx = fmaxf(mx, s[1][i]);
      mx = xhalf_max(mx);
      if (__any(mx - m > 8.0f)) {
        const float mnew = fmaxf(m, mx), alpha = __builtin_amdgcn_exp2f(m - mnew);
        m = mnew; l *= alpha;
#pragma unroll
        for (int cb = 0; cb < NCB; ++cb)
#pragma unroll
          for (int r = 0; r < 16; ++r) o[cb][r] *= alpha;
      }
      float ps = 0.f;
#pragma unroll
      for (int n = 0; n < 2; ++n)
#pragma unroll
        for (int i = 0; i < 16; ++i) { const float p = __builtin_amdgcn_exp2f(s[n][i] - m); ps += p; s[n][i] = p; }
      l += ps;
      bf16x8 pb[2][2];
#pragma unroll
      for (int n = 0; n < 2; ++n)
#pragma unroll
        for (int s2 = 0; s2 < 2; ++s2) {
          u32x4 pw = {pk2(s[n][8 * s2 + 0], s[n][8 * s2 + 1]), pk2(s[n][8 * s2 + 2], s[n][8 * s2 + 3]),
                      pk2(s[n][8 * s2 + 4], s[n][8 * s2 + 5]), pk2(s[n][8 * s2 + 6], s[n][8 * s2 + 7])};
          pb[n][s2] = __builtin_bit_cast(bf16x8, pw);
        }
      pv_block<0>(o[0], bufa + vlane, pb);
      if constexpr (NCB > 1) pv_block<1>(o[1], bufa + vlane, pb);
      if constexpr (NCB > 2) pv_block<2>(o[2], bufa + vlane, pb);
      if constexpr (NCB > 3) pv_block<3>(o[3], bufa + vlane, pb);
    }
    asm volatile("s_waitcnt vmcnt(0)" ::: "memory");
    __syncthreads();
  }
  const float inv = 1.f / xhalf_sum(l);
#pragma unroll
  for (int cb = 0; cb < NCB; ++cb)
#pragma unroll
    for (int g = 0; g < 4; ++g) {
      const int dv = 32 * cb + 8 * g + 4 * hi;
      const u32x2 gg = *(const u32x2*)(grow + dv);
      float gv[4] = {bf2f(gg[0] & 0xffffu), bf2f(gg[0] >> 16), bf2f(gg[1] & 0xffffu), bf2f(gg[1] >> 16)};
      float ov[4];
#pragma unroll
      for (int j = 0; j < 4; ++j) {
        const float sg = gv[j] / (1.f + __expf(-gv[j]));
        ov[j] = o[cb][4 * g + j] * inv * sg;
      }
      *(unsigned*)((unsigned char*)yrow + dv) = pk4_fp8(ov[0] * Y_SCALE, ov[1] * Y_SCALE, ov[2] * Y_SCALE, ov[3] * Y_SCALE);
      __builtin_amdgcn_sched_barrier(0);
    }
}

DI unsigned ordkey(float f) { const unsigned b = __float_as_uint(f); return b ^ ((unsigned)((int)b >> 31) | 0x80000000u); }
DI void indexer_phase(const u16* __restrict__ P, unsigned* __restrict__ mask) {
  int tidx = threadIdx.x; asm volatile("" : "+v"(tidx));
  const int lane = tidx & 63, r32 = lane & 31, hi = lane >> 5;
  const int gw = blockIdx.x * 8 + (tidx >> 6), nw = gridDim.x * 8;
  for (int item = gw; item < 8192; item += nw) {
    const int b = item & 7, t0 = (1023 - (item >> 3)) * 2;
    const size_t brow = (size_t)b * SEQ;
    const int g = (r32 >> 2) & 1, head = 4 * (r32 >> 3) + (r32 & 3);
    bf16x8 aq[4];
#pragma unroll
    for (int s = 0; s < 4; ++s) aq[s] = *(const bf16x8*)(P + (brow + t0 + g) * 7808 + 2560 + head * 64 + 16 * s + 8 * hi);
    float wv[16];
    {
      const u32x4 w0 = *(const u32x4*)(P + (brow + t0 + hi) * 7808 + 3648), w1 = *(const u32x4*)(P + (brow + t0 + hi) * 7808 + 3656);
#pragma unroll
      for (int j = 0; j < 4; ++j) { wv[2 * j] = bf2f(w0[j] & 0xffffu); wv[2 * j + 1] = bf2f(w0[j] >> 16); wv[8 + 2 * j] = bf2f(w1[j] & 0xffffu); wv[8 + 2 * j + 1] = bf2f(w1[j] >> 16); }
    }
    const int tme = t0 + hi, kbmax = (t0 + 1) >> 5;
    unsigned sc[64];
#pragma unroll
    for (int kb = 0; kb < 64; ++kb) {
      unsigned u = 0u;
      if (kb <= kbmax) {
        f32x16 a;
#pragma unroll
        for (int r = 0; r < 16; ++r) a[r] = 0.f;
        const u16* kp = P + (brow + 32 * kb + r32) * 7808 + 3584 + 8 * hi;
#pragma unroll
        for (int s = 0; s < 4; ++s) { const bf16x8 bk = *(const bf16x8*)(kp + 16 * s); a = MFMA(aq[s], bk, a); }
        float v = 0.f;
#pragma unroll
        for (int i = 0; i < 16; ++i) v = fmaf(wv[i], fmaxf(a[i], 0.f), v);
        u = (32 * kb + r32 <= tme) ? ordkey(v) : 0u;
      }
      sc[kb] = u;
    }
    const int target = (tme + 1 < 256) ? tme + 1 : 256;
    unsigned T = 0u;
    for (int bit = 31; bit >= 0; --bit) {
      const unsigned Tp = T | (1u << bit);
      int cnt = 0;
#pragma unroll
      for (int kb = 0; kb < 64; ++kb) cnt += (sc[kb] >= Tp) ? 1 : 0;
#pragma unroll
      for (int o = 16; o; o >>= 1) cnt += __shfl_xor(cnt, o);
      if (cnt >= target) T = Tp;
    }
    unsigned w0 = 0u, w1 = 0u;
#pragma unroll
    for (int kb = 0; kb < 64; ++kb) {
      const bool pred = (sc[kb] >= T) && (sc[kb] != 0u);
      const unsigned long long bal = __ballot(pred);
      const unsigned wd = (unsigned)(bal >> (32 * hi));
      if ((kb & 31) == r32) { if (kb < 32) w0 = wd; else w1 = wd; }
    }
    mask[(brow + tme) * 64 + r32] = w0;
    mask[(brow + tme) * 64 + 32 + r32] = w1;
  }
}

DI void gbar(unsigned* cnt, unsigned target) {
  asm volatile("s_waitcnt vmcnt(0)" ::: "memory");
  __syncthreads();
  if (threadIdx.x == 0) {
    __builtin_amdgcn_fence(__ATOMIC_RELEASE, "agent");
    asm volatile("s_waitcnt vmcnt(0)" ::: "memory");
    __hip_atomic_fetch_add(cnt, 1u, __ATOMIC_RELAXED, __HIP_MEMORY_SCOPE_AGENT);
    while (__hip_atomic_load(cnt, __ATOMIC_RELAXED, __HIP_MEMORY_SCOPE_AGENT) < target) __builtin_amdgcn_s_sleep(1);
    __builtin_amdgcn_fence(__ATOMIC_ACQUIRE, "agent");
    asm volatile("s_waitcnt vmcnt(0)" ::: "memory");
  }
  __syncthreads();
}
#define GSYNC() do { ++bar_gen; gbar(BAR, bar_gen * gridDim.x); } while (0)
__global__ void __launch_bounds__(512, 2) mega(Params p) {
  cg::grid_group grid = cg::this_grid();
  extern __shared__ __attribute__((aligned(16))) char smem[];
  volatile int* s_item = (volatile int*)(smem + LDS_ITEM);
  char* ws = p.ws;
  unsigned char* Y8 = (unsigned char*)(ws + OFF_Y);
  unsigned char* CQ8 = (unsigned char*)(ws + OFF_Y + 67108864);     u16* H = (u16*)(ws + OFF_H); u16* Cb = (u16*)(ws + OFF_Y); u16* Qb = (u16*)(ws + OFF_H);
  u16* KV = (u16*)(ws + OFF_KV); u16* MG = (u16*)(ws + OFF_MG); u16* KR = (u16*)(ws + OFF_KR); u16* Pb = (u16*)(ws + OFF_P);
  u16* WIN = (u16*)(ws + OFF_WIN); u16* WUQ = (u16*)(ws + OFF_WUQ); u16* WUKV = (u16*)(ws + OFF_WUKV); u16* WOUT = (u16*)(ws + OFF_WOUT);
  u16* WMEMALL = (u16*)(ws + OFF_KV); u16* MEMN = (u16*)(ws + OFF_MEMN); u16* MEMKV = (u16*)(ws + OFF_MEMKV);
  unsigned* MASK = (unsigned*)(ws + OFF_MASK); f32x2* ROPE = (f32x2*)(ws + OFF_ROPE); float* LUT = (float*)(ws + OFF_LUT);
  int* CTR = (int*)(ws + OFF_CTR);
  unsigned* BAR = (unsigned*)(ws + OFF_CTR) + 64;
  unsigned bar_gen = 0;
  const int tid = threadIdx.x, lane = tid & 63, wv = __builtin_amdgcn_readfirstlane(tid >> 6), r32 = lane & 31, hi = lane >> 5;
  const int gtid = blockIdx.x * 512 + tid, gthreads = gridDim.x * 512;

  for (int i = gtid; i < 2048 * 32; i += gthreads) {
    const int pos = i >> 5, j = i & 31;
    const float inv = 1.0f / powf(10000.0f, (float)(2 * j) / 64.0f);
    const float ang = (float)pos * inv;
    const float k = rintf(ang * 0.15915494309189535f);
    float r = fmaf(-k, 6.28318548202514648f, ang);
    r = fmaf(-k, -1.74845553e-7f, r);
    f32x2 cs = {__cosf(r), __sinf(r)};
    ROPE[i] = cs;
  }
  for (int i = gtid; i < 129 * 32; i += gthreads) {
    const int rel = i >> 5, h = i & 31;
    int bucket;
    if (rel < 16) bucket = rel;
    else { const int lg = 16 + (int)(logf((float)rel / 16.0f) / 2.0794415416798357f * 16.0f); bucket = lg < 31 ? lg : 31; }
    LUT[i] = p.rel_bias[bucket * 32 + h] * LOG2E;
  }
  rmsnorm_rows<false>(p.mem, p.mem_norm, MEMN, 2048);
#pragma unroll 1
  for (int l = 0; l < 4; ++l) convert_wt<0>(p.w_mem_kv + (size_t)l * 2048 * 2048, 2048, 2048, 2048, WMEMALL + (size_t)l * 2048 * 2048, smem);

#pragma unroll 1
  for (int layer = 0; layer < 4; ++layer) {
    const int kind = layer % 3, j = layer / 3;
    const float* xin = (layer == 0) ? p.x : p.out;
    rmsnorm_rows<false>(xin, p.norm_in + layer * 2048, H, NTOK);
    if (kind == 0) {
      convert_wt<1>(p.w_in_a + (size_t)j * 2048 * 6208, 2048, 6208, 6400, WIN, smem);
      convert_wt<2, true>(p.w_uq + (size_t)j * 1536 * 3072, 1536, 3072, 3072, WUQ, smem, WUQ_SCALE);
      convert_wt<0>(p.w_ukv + (size_t)j * 512 * 4096, 512, 4096, 4096, WUKV, smem);
    } else if (kind == 1) convert_wt<0>(p.w_in_b, 2048, 7760, 7936, WIN, smem);
    else convert_wt<0>(p.w_in_c, 2048, 6656, 6656, WIN, smem);
    convert_wt<0, true>(p.w_out + (size_t)layer * 3072 * 2048, 3072, 2048, 2048, WOUT, smem, WOUT_SCALE);
    if (layer == 0) { __builtin_amdgcn_fence(__ATOMIC_RELEASE, "agent"); grid.sync(); __builtin_amdgcn_fence(__ATOMIC_ACQUIRE, "agent"); asm volatile("s_waitcnt vmcnt(0)" ::: "memory"); }
    else GSYNC();

    if (kind == 0) { EpiBf<1> e{Cb, 2048, 6208, MG, KR, ROPE}; run_gemm(H, 2048, WIN, NTOK, 6400, 2048, e, smem); }
    else if (kind == 1) { EpiBf<0> e{Pb, 7808, 7760, nullptr, nullptr, nullptr}; run_gemm(H, 2048, WIN, NTOK, 7936, 2048, e, smem); }
    else { EpiBf<0> e{Pb, 6656, 6656, nullptr, nullptr, nullptr}; run_gemm(H, 2048, WIN, NTOK, 6656, 2048, e, smem); }
    if (layer == 0) { EpiBf<0> e{MEMKV, 8192, 8192, nullptr, nullptr, nullptr}; run_gemm(MEMN, 2048, WMEMALL, 2048, 8192, 2048, e, smem); }
    GSYNC();

    if (kind == 0) {
      anorm_phase(Cb, p.a_q_norm + j * 1536, p.a_kv_norm + j * 512, CQ8);
      GSYNC();
      { EpiBf<2> e{Qb, 3072, 3072, nullptr, nullptr, ROPE, 1.f / (CQ_SCALE * WUQ_SCALE)}; run_gemm<true>((const u16*)CQ8, 768, WUQ, NTOK, 3072, 768, e, smem); }
      { EpiBf<0> e{KV, 4096, 4096, nullptr, nullptr, nullptr}; run_gemm(Cb + 1536, 2048, WUKV, NTOK, 4096, 512, e, smem); }
      GSYNC();
    } else if (kind == 1) {
      indexer_phase(Pb, MASK);
      GSYNC();
    }

    {
      const int nself = (kind == 0) ? 1024 : 2048, total = nself + 512;
      const u16* mgb = (kind == 0) ? MG : Pb;
      const int ldmg = (kind == 0) ? 4096 : (kind == 1 ? 7808 : 6656);
      const int mqcol = (kind == 0) ? 0 : (kind == 1 ? 3664 : 2560);
      const int gatecol = (kind == 0) ? 1024 : (kind == 1 ? 4688 : 3584);
      const u16* memkv = MEMKV + layer * 2048;
      float* lut_all = (float*)(smem + LDS_LUT);
      if (kind != 0) {
        for (int i = tid; i < 32 * 129; i += 512) { const int h = i / 129, r = i - h * 129; lut_all[h * 132 + r] = LUT[r * 32 + h]; }
      }
      if (tid == 0) s_item[0] = atomicAdd(&CTR[layer], 1);
      __syncthreads();
      for (int par = 0;; par ^= 1) {
        const int item = __builtin_amdgcn_readfirstlane(s_item[par]);
        if (item >= total) break;
        if (tid == 0) s_item[par ^ 1] = atomicAdd(&CTR[layer], 1);
        if (item < nself) {
          if (kind == 0) {
            const int qblk = 7 - item / 128, rem = item % 128, b = rem / 16, head = rem % 16;
            const size_t brow = (size_t)b * SEQ;
            const int tq0 = qblk * 256 + 32 * wv, tq = tq0 + r32;
            attn_core<192, 128, 128, 128, 0>(KV + brow * 4096 + head * 256, 4096, KR + brow * 64, 64, KV + brow * 4096 + head * 256 + 128, 4096,
                                            SEQ, 0, 4 * qblk + 4, Qb + (brow + tq) * 3072 + head * 192, tq, tq0, 0.07216878364870322f * LOG2E, 0,
                                            (u16*)(Y8 + (brow + tq) * 3072 + head * 128), mgb + (brow + tq) * ldmg + gatecol + head * 128,
                                            nullptr, nullptr, 0.f, -1e29f, 0.f, smem);
          } else {
            const int qb = 63 - item / 32, rem = item % 32, b = rem / 4, kvh = rem % 4;
            const size_t brow = (size_t)b * SEQ;
            const int head = kvh * 8 + wv, tq0 = qb * 32, tq = tq0 + r32;
            const float* lutw = lut_all + head * 132;
            if (kind == 1) {
              attn_core<64, 64, 64, 64, 1>(Pb + brow * 7808 + 2048 + kvh * 64, 7808, nullptr, 0, Pb + brow * 7808 + 2304 + kvh * 64, 7808,
                                          SEQ, 0, (tq0 + 31) / 64 + 1, Pb + (brow + tq) * 7808 + head * 64, tq, tq0, 0.125f * LOG2E, 0,
                                          (u16*)(Y8 + (brow + tq) * 3072 + head * 64), Pb + (brow + tq) * 7808 + gatecol + head * 64,
                                          MASK + (brow + tq) * 64, lutw, lutw[128], -1e29f, 0.f, smem);
            } else {
              const float sink = p.c_sinks[j * 32 + head] * LOG2E;
              attn_core<64, 64, 64, 64, 2>(Pb + brow * 6656 + 2048 + kvh * 64, 6656, nullptr, 0, Pb + brow * 6656 + 2304 + kvh * 64, 6656,
                                          SEQ, tq0 - 128, 3, Pb + (brow + tq) * 6656 + head * 64, tq, tq0, 0.125f * LOG2E, 0,
                                          (u16*)(Y8 + (brow + tq) * 3072 + head * 64), Pb + (brow + tq) * 6656 + gatecol + head * 64,
                                          nullptr, lutw, 0.f, sink, hi == 0 ? 1.f : 0.f, smem);
            }
          }
        } else {
          const int it = item - nself, b = it / 64, mh = (it % 64) / 16, qb = it % 16;
          const size_t brow = (size_t)b * SEQ;
          const int tq0 = qb * 128 + 32 * (wv >> 1), tq = tq0 + r32, vh = wv & 1;
          attn_core<256, 256, 128, 256, 3>(memkv + (size_t)b * 256 * 8192 + mh * 256, 8192, nullptr, 0, memkv + (size_t)b * 256 * 8192 + 1024 + mh * 256, 8192,
                                          256, 0, 4, mgb + (brow + tq) * ldmg + mqcol + mh * 256, tq, tq0, 0.0625f * LOG2E, 4 * vh,
                                          (u16*)(Y8 + (brow + tq) * 3072 + 2048 + mh * 256 + 128 * vh), mgb + (brow + tq) * ldmg + gatecol + 2048 + mh * 256 + 128 * vh,
                                          nullptr, nullptr, 0.f, -1e29f, 0.f, smem);
        }
      }
    }
    GSYNC();

    { EpiResid e{xin, p.out, 1.f / (Y_SCALE * WOUT_SCALE)}; run_gemm<true>((const u16*)Y8, 1536, WOUT, NTOK, 2048, 1536, e, smem); }
    GSYNC();
  }
  rmsnorm_rows<true>(p.out, p.final_norm, p.out, NTOK);
}

extern "C" void kernel_launch(void* const* d_in, const int* in_sizes, int n_in, void* d_out, int out_size,
                              void* d_ws, size_t ws_size, hipStream_t stream) {
  static int grid_blocks = 0;
  if (!grid_blocks) {
    int dev = 0, cus = 0, per_cu = 0;
    (void)hipGetDevice(&dev);
    (void)hipDeviceGetAttribute(&cus, hipDeviceAttributeMultiprocessorCount, dev);
    (void)hipFuncSetAttribute((const void*)mega, hipFuncAttributeMaxDynamicSharedMemorySize, LDS_BYTES);
    (void)hipOccupancyMaxActiveBlocksPerMultiprocessor(&per_cu, mega, 512, LDS_BYTES);
    if (per_cu > 1) per_cu = 1;
    grid_blocks = cus * per_cu;
  }
  Params p{};
  p.x = (const float*)d_in[0]; p.mem = (const float*)d_in[1]; p.norm_in = (const float*)d_in[2]; p.final_norm = (const float*)d_in[3];
  p.mem_norm = (const float*)d_in[4]; p.rel_bias = (const float*)d_in[5]; p.w_in_a = (const float*)d_in[6]; p.a_q_norm = (const float*)d_in[7];
  p.w_uq = (const float*)d_in[8]; p.a_kv_norm = (const float*)d_in[9]; p.w_ukv = (const float*)d_in[10]; p.w_in_b = (const float*)d_in[11];
  p.w_in_c = (const float*)d_in[12]; p.c_sinks = (const float*)d_in[13]; p.w_mem_kv = (const float*)d_in[14]; p.w_out = (const float*)d_in[15];
  p.out = (float*)d_out; p.ws = (char*)d_ws;
  (void)hipMemsetAsync((char*)d_ws + OFF_CTR, 0, 1024, stream);
  void* args[] = {&p};
  (void)hipLaunchCooperativeKernel((void*)mega, dim3(grid_blocks), dim3(512), args, LDS_BYTES, stream);
}
```

```cpp
#include <hip/hip_runtime.h>
#include <hip/hip_cooperative_groups.h>
#include <stdint.h>
namespace cg = cooperative_groups;

typedef unsigned short u16;
typedef __attribute__((ext_vector_type(8))) short bf16x8;
typedef __attribute__((ext_vector_type(4))) short s16x4;
typedef __attribute__((ext_vector_type(16))) float f32x16;
typedef __attribute__((ext_vector_type(4))) float f32x4;
typedef __attribute__((ext_vector_type(2))) float f32x2;
typedef __attribute__((ext_vector_type(4))) unsigned u32x4;
typedef __attribute__((ext_vector_type(2))) unsigned u32x2;
typedef __attribute__((ext_vector_type(2))) __bf16 bf16x2_t;
typedef short v4i16_t __attribute__((ext_vector_type(4)));
#define DI __device__ __forceinline__
#define MFMA(a, b, c) __builtin_amdgcn_mfma_f32_32x32x16_bf16((a), (b), (c), 0, 0, 0)

constexpr int SEQ = 2048, NTOK = 16384;
constexpr int LDS_LUT = 133120, LDS_ITEM = LDS_LUT + 32 * 528, LDS_BYTES = LDS_ITEM + 64;
constexpr float LOG2E = 1.4426950408889634f;
constexpr float NEGV = -1e30f;
constexpr float Y_SCALE = 16.f, WOUT_SCALE = 256.f, CQ_SCALE = 16.f, WUQ_SCALE = 256.f, H_SCALE = 16.f, WIN_SCALE = 256.f;

constexpr size_t OFF_Y = 0;
constexpr size_t OFF_H = 100663296;
constexpr size_t OFF_KV = 201326592;
constexpr size_t OFF_MG = 335544320;
constexpr size_t OFF_KR = 469762048;
constexpr size_t OFF_P = 167772160;
constexpr size_t OFF_WIN = 471859200;
constexpr size_t OFF_WUQ = OFF_WIN + 32505856;
constexpr size_t OFF_WUKV = OFF_WUQ + 9437184;
constexpr size_t OFF_WOUT = OFF_WUKV + 4194304;
constexpr size_t OFF_MEMN = OFF_WOUT + 12582912;
constexpr size_t OFF_MEMKV = OFF_MEMN + 8388608;
constexpr size_t OFF_MASK = OFF_MEMKV + 33554432;
constexpr size_t OFF_ROPE = OFF_MASK + 4194304;
constexpr size_t OFF_LUT = OFF_ROPE + 524288;
constexpr size_t OFF_CTR = OFF_LUT + 32768;

struct Params {
  const float *x, *mem, *norm_in, *final_norm, *mem_norm, *rel_bias, *w_in_a, *a_q_norm, *w_uq, *a_kv_norm, *w_ukv,
      *w_in_b, *w_in_c, *c_sinks, *w_mem_kv, *w_out;
  float* out;
  char* ws;
};

DI float bf2f(unsigned b) { return __uint_as_float(b << 16); }
DI unsigned pk2(float a, float b) {
  f32x2 v = {a, b};
  return __builtin_bit_cast(unsigned, __builtin_convertvector(v, bf16x2_t));
}
DI float clamp8(float x) { return fminf(fmaxf(x, -448.f), 448.f); }
DI unsigned pk4_fp8(float a, float b, float c, float d) {
  int w = 0;
  w = __builtin_amdgcn_cvt_pk_fp8_f32(clamp8(a), clamp8(b), w, false);
  w = __builtin_amdgcn_cvt_pk_fp8_f32(clamp8(c), clamp8(d), w, true);
  return (unsigned)w;
}
DI u16 f2bf(float a) { return (u16)(pk2(a, 0.f) & 0xffffu); }
DI float wave_sum(float v) {
#pragma unroll
  for (int o = 32; o; o >>= 1) v += __shfl_xor(v, o);
  return v;
}
DI int crow(int reg, int hi) { return (reg & 3) + 8 * (reg >> 2) + 4 * hi; }
DI float xhalf_max(float m) {
  auto rr = __builtin_amdgcn_permlane32_swap(__float_as_uint(m), __float_as_uint(m), false, false);
  return fmaxf(__uint_as_float(rr[0]), __uint_as_float(rr[1]));
}
DI float xhalf_sum(float m) {
  auto rr = __builtin_amdgcn_permlane32_swap(__float_as_uint(m), __float_as_uint(m), false, false);
  return __uint_as_float(rr[0]) + __uint_as_float(rr[1]);
}
typedef __attribute__((address_space(3))) v4i16_t* lds_v4p;
DI s16x4 vtr(const char* p) {
  return __builtin_bit_cast(s16x4, __builtin_amdgcn_ds_read_tr16_b64_v4i16((lds_v4p)(p)));
}

template <int PERM, bool FP8 = false>
DI void convert_wt(const float* __restrict__ W, int K, int N, int Npad, u16* __restrict__ Wt, char* smem, float wscale = 1.f,
                   int nvalid = -1, int csplit = 0, int coff1 = 0, int coff2 = 0) {
  float* tile = (float*)smem;
  int tid = threadIdx.x; asm volatile("" : "+v"(tid));
  const int ntk = K / 64, ntn = Npad / 64;
  for (int t = blockIdx.x; t < ntk * ntn; t += gridDim.x) {
    const int tk = t % ntk, tn = t / ntk, k0 = tk * 64, n0 = tn * 64;
    __syncthreads();
#pragma unroll
    for (int i = 0; i < 2; ++i) {
      const int id = tid + 512 * i, kr = id >> 4, n4 = (id & 15) * 4;
      f32x4 v = {0.f, 0.f, 0.f, 0.f};
      const int nd = n0 + n4, nsrc = (nvalid < 0) ? nd : (nd < csplit ? nd + coff1 : nd + coff2);
      if (nd < ((nvalid < 0) ? N : nvalid)) v = *(const f32x4*)(W + (size_t)(k0 + kr) * N + nsrc);
      tile[kr * 65 + n4 + 0] = v[0]; tile[kr * 65 + n4 + 1] = v[1]; tile[kr * 65 + n4 + 2] = v[2]; tile[kr * 65 + n4 + 3] = v[3];
    }
    __syncthreads();
    {
      const int n = tid >> 3, c = tid & 7;
      bool rot = false;
      if (PERM == 1) rot = (n0 == 2048);
      if (PERM == 2) rot = ((tn % 3) == 2);
      const int ns = rot ? ((n >> 1) + 32 * (n & 1)) : n;
      if (FP8) {
        float f[8];
#pragma unroll
        for (int j = 0; j < 8; ++j) f[j] = tile[(c * 8 + j) * 65 + ns] * wscale;
        u32x2 o = {pk4_fp8(f[0], f[1], f[2], f[3]), pk4_fp8(f[4], f[5], f[6], f[7])};
        *(u32x2*)((unsigned char*)Wt + (size_t)(n0 + n) * K + k0 + c * 8) = o;
      } else {
        u32x4 o;
#pragma unroll
        for (int j = 0; j < 4; ++j) o[j] = pk2(tile[(c * 8 + 2 * j) * 65 + ns], tile[(c * 8 + 2 * j + 1) * 65 + ns]);
        *(u32x4*)(Wt + (size_t)(n0 + n) * K + k0 + c * 8) = o;
      }
    }
  }
}

template <bool F32OUT>
DI void rmsnorm_rows(const float* X, const float* __restrict__ g, void* outp, int nrows, unsigned char* __restrict__ out8 = nullptr) {
  int tidx = threadIdx.x; asm volatile("" : "+v"(tidx));
  const int lane = tidx & 63, gw = blockIdx.x * 8 + (tidx >> 6), nw = gridDim.x * 8;
  for (int row = gw; row < nrows; row += nw) {
    const f32x4* xr = (const f32x4*)(X + (size_t)row * 2048);
    f32x4 v[8];
    float ss = 0.f;
#pragma unroll
    for (int i = 0; i < 8; ++i) { v[i] = xr[lane + 64 * i]; ss += v[i][0] * v[i][0] + v[i][1] * v[i][1] + v[i][2] * v[i][2] + v[i][3] * v[i][3]; }
    ss = wave_sum(ss);
    const float r = rsqrtf(ss * (1.f / 2048.f) + 1e-6f);
#pragma unroll
    for (int i = 0; i < 8; ++i) {
      const f32x4 gg = ((const f32x4*)g)[lane + 64 * i];
      f32x4 o = {v[i][0] * r * gg[0], v[i][1] * r * gg[1], v[i][2] * r * gg[2], v[i][3] * r * gg[3]};
      if (F32OUT) ((f32x4*)((float*)outp + (size_t)row * 2048))[lane + 64 * i] = o;
      else { u32x2 pk = {pk2(o[0], o[1]), pk2(o[2], o[3])}; ((u32x2*)((u16*)outp + (size_t)row * 2048))[lane + 64 * i] = pk; }
      if (!F32OUT && out8) ((unsigned*)(out8 + (size_t)row * 2048))[lane + 64 * i] = pk4_fp8(o[0] * H_SCALE, o[1] * H_SCALE, o[2] * H_SCALE, o[3] * H_SCALE);
    }
  }
}

DI void anorm_phase(u16* C, const float* __restrict__ gq, const float* __restrict__ gkv, unsigned char* __restrict__ cq8) {
  int tidx = threadIdx.x; asm volatile("" : "+v"(tidx));
  const int lane = tidx & 63, gw = blockIdx.x * 8 + (tidx >> 6), nw = gridDim.x * 8;
  for (int row = gw; row < NTOK; row += nw) {
    u32x4* cr = (u32x4*)(C + (size_t)row * 2048);
    u32x4 v[4];
    float sq = 0.f, skv = 0.f;
#pragma unroll
    for (int i = 0; i < 4; ++i) {
      v[i] = cr[lane + 64 * i];
      float s = 0.f;
#pragma unroll
      for (int j = 0; j < 4; ++j) { float a = bf2f(v[i][j] & 0xffffu), b = bf2f(v[i][j] >> 16); s += a * a + b * b; }
      if (i < 3) sq += s; else skv += s;
    }
    sq = wave_sum(sq); skv = wave_sum(skv);
    const float rq = rsqrtf(sq * (1.f / 1536.f) + 1e-6f), rkv = rsqrtf(skv * (1.f / 512.f) + 1e-6f);
#pragma unroll
    for (int i = 0; i < 4; ++i) {
      const int col = (lane + 64 * i) * 8;
      const float* gp = (i < 3) ? (gq + col) : (gkv + col - 1536);
      const float r = (i < 3) ? rq : rkv;
      const f32x4 g0 = *(const f32x4*)gp, g1 = *(const f32x4*)(gp + 4);
      u32x4 o;
      o[0] = pk2(bf2f(v[i][0] & 0xffffu) * r * g0[0], bf2f(v[i][0] >> 16) * r * g0[1]);
      o[1] = pk2(bf2f(v[i][1] & 0xffffu) * r * g0[2], bf2f(v[i][1] >> 16) * r * g0[3]);
      o[2] = pk2(bf2f(v[i][2] & 0xffffu) * r * g1[0], bf2f(v[i][2] >> 16) * r * g1[1]);
      o[3] = pk2(bf2f(v[i][3] & 0xffffu) * r * g1[2], bf2f(v[i][3] >> 16) * r * g1[3]);
      cr[lane + 64 * i] = o;
      if (i < 3) {
        const float q0 = bf2f(v[i][0] & 0xffffu) * r * g0[0] * CQ_SCALE, q1 = bf2f(v[i][0] >> 16) * r * g0[1] * CQ_SCALE;
        const float q2 = bf2f(v[i][1] & 0xffffu) * r * g0[2] * CQ_SCALE, q3 = bf2f(v[i][1] >> 16) * r * g0[3] * CQ_SCALE;
        const float q4 = bf2f(v[i][2] & 0xffffu) * r * g1[0] * CQ_SCALE, q5 = bf2f(v[i][2] >> 16) * r * g1[1] * CQ_SCALE;
        const float q6 = bf2f(v[i][3] & 0xffffu) * r * g1[2] * CQ_SCALE, q7 = bf2f(v[i][3] >> 16) * r * g1[3] * CQ_SCALE;
        u32x2 w8 = {pk4_fp8(q0, q1, q2, q3), pk4_fp8(q4, q5, q6, q7)};
        *(u32x2*)(cq8 + (size_t)row * 1536 + col) = w8;
      }
    }
  }
}

namespace pg8 {
#define PG8_LAS __attribute__((address_space(3)))
constexpr int BM = 256, BK = 64, HALF = 128, HTB = HALF * BK * 2, STAGE_BYTES = 8 * HTB, NXCD = 8, WGM = 8;
DI int lds_byte(int r, int c) { const int st = (r >> 4) * 2 + (c >> 5), rr = r & 15, cc = c & 31, ob = rr * 64 + cc * 2; return st * 1024 + (ob ^ (((ob >> 9) & 1) << 5)); }
DI void stage_rc(int b, int& R, int& C) { const int st = b / 1024, sb = b % 1024, swz = sb ^ (((sb >> 9) & 1) << 5); R = (st >> 1) * 16 + swz / 64; C = (st & 1) * 32 + (swz % 64) / 2; }
DI int perm32(int rho) { const int n = rho >> 4, i = rho & 15; return 8 * (i >> 2) + 4 * n + (i & 3); }
typedef int i32x4v __attribute__((ext_vector_type(4)));
typedef int i32x8 __attribute__((ext_vector_type(8)));
DI i32x8 cat8(bf16x8 a, bf16x8 b) { const i32x4v x = __builtin_bit_cast(i32x4v, a), y = __builtin_bit_cast(i32x4v, b); return __builtin_shufflevector(x, y, 0, 1, 2, 3, 4, 5, 6, 7); }
struct Unit { int pm, pn; };
struct Gemm { const u16* A; const u16* Bt; int M, N, K, lda; };
struct StaticOrder {
  int nM, nN, nwg, G, c;
  DI void init(int M, int N, int G_, int c_) { nM = M / BM; nN = N / BM; nwg = nM * nN; G = G_; c = c_; }
  DI bool next(int i, Unit& u) const {
    const long L = (long)i * G + c; if (L >= nwg) return false;
    int wgid = (int)L; { const int q = nwg / NXCD, r = nwg % NXCD, xcd = wgid % NXCD, off = wgid / NXCD; wgid = (xcd < r ? xcd * (q + 1) : r * (q + 1) + (xcd - r) * q) + off; }
    const int nig = WGM * nN, gid = wgid / nig, fm = gid * WGM, gsz = (nM - fm) < WGM ? (nM - fm) : WGM;
    u.pm = fm + ((wgid % nig) % gsz); u.pn = (wgid % nig) / gsz; return true;
  }
  DI void a_ready(const Unit&) const {}
  DI void done(const Unit&) const {}
};
template <bool FP8, class Epi, class Sched>
__device__ __forceinline__ void gemm_phase(PG8_LAS unsigned char* lds, const Gemm g, const Sched& S, const Epi& E) {
    int tid = threadIdx.x; asm volatile("" : "+v"(tid));
    const int wid = __builtin_amdgcn_readfirstlane(tid >> 6), lane = tid & 63, wr = wid >> 2, wc = wid & 3, fr = lane & 15, fq = lane >> 4;
    const int K = g.K, nt = K / BK;
    unsigned voffA[2], voffB[2];
#pragma unroll
    for (int i = 0; i < 2; ++i) { int R, C; stage_rc(tid * 16 + i * 8192, R, C); const int Rb = Epi::PERM ? ((R & ~31) + perm32(R & 31)) : R;
        voffA[i] = (unsigned)(R * g.lda + C) * 2u; voffB[i] = (unsigned)(Rb * K + C) * 2u; }
    const size_t kstep = (size_t)(BK * 2);
    const size_t hstep = (size_t)HALF * K * 2, hstepA = (size_t)HALF * g.lda * 2;
    const size_t tstep = 2 * hstep, tstepA = 2 * hstepA;
    const unsigned ldsw = (unsigned)wid * 1024u;
    const int aoff = lds_byte(wr * 64 + fr, fq * 8), boff = lds_byte(wc * 32 + fr, fq * 8);
#define PG8_SA(b, h) (((b) * 2 + (h)) * HTB)
#define PG8_SB(b, h) ((4 + (b) * 2 + (h)) * HTB)
#define PG8_STAGE(bufoff, gbase, voff) do { _Pragma("unroll") for (int _i = 0; _i < 2; ++_i) \
        __builtin_amdgcn_global_load_lds((const unsigned*)((const char*)(gbase) + (voff)[_i]), (PG8_LAS unsigned*)(lds + (bufoff) + ldsw + _i * 8192), 16, 0, 0); } while (0)
#define PG8_LDA(dst, b, h) do { _Pragma("unroll") for (int m = 0; m < 4; ++m) _Pragma("unroll") for (int k = 0; k < 2; ++k) dst[m][k] = *(const PG8_LAS bf16x8*)(lds + PG8_SA(b, h) + aoff + m * 2048 + k * 1024); } while (0)
#define PG8_LDB(dst, b, h) do { _Pragma("unroll") for (int n = 0; n < 2; ++n) _Pragma("unroll") for (int k = 0; k < 2; ++k) dst[n][k] = *(const PG8_LAS bf16x8*)(lds + PG8_SB(b, h) + boff + n * 2048 + k * 1024); } while (0)
#define PG8_MMA(ai, bj, At, Bt) do { __builtin_amdgcn_s_setprio(1); _Pragma("unroll") for (int m = 0; m < 4; ++m) _Pragma("unroll") for (int n = 0; n < 2; ++n) { \
        if constexpr (FP8) { const i32x8 bv_ = cat8(Bt[n][0], Bt[n][1]), av_ = cat8(At[m][0], At[m][1]); \
            asm volatile("s_nop 1\n\tv_mfma_scale_f32_16x16x128_f8f6f4 %0, %1, %2, %0, %3, %3 op_sel_hi:[0,0,0]" : "+v"(acc[ai][bj][m][n]) : "v"(bv_), "v"(av_), "v"(sc127)); } \
        else { _Pragma("unroll") for (int k = 0; k < 2; ++k) acc[ai][bj][m][n] = __builtin_amdgcn_mfma_f32_16x16x32_bf16(Bt[n][k], At[m][k], acc[ai][bj][m][n], 0, 0, 0); } } \
        __builtin_amdgcn_s_setprio(0); } while (0)
#define PG8_WAIT_V(n) asm volatile("s_waitcnt vmcnt(" #n ")" ::: "memory")
#define PG8_WAIT_L(n) asm volatile("s_waitcnt lgkmcnt(" #n ")" ::: "memory")
#define PG8_BAR __builtin_amdgcn_s_barrier()
#define PG8_SCHED __builtin_amdgcn_sched_barrier(0)
    Unit cur, nxt; int ui = 0;
    if (!S.next(0, cur)) return;
    f32x4 acc[2][2][4][2];
#pragma unroll
    for (int a = 0; a < 2; ++a)
#pragma unroll
        for (int b = 0; b < 2; ++b)
#pragma unroll
            for (int m = 0; m < 4; ++m)
#pragma unroll
                for (int n = 0; n < 2; ++n) acc[a][b][m][n] = (f32x4){0.f, 0.f, 0.f, 0.f};
    bf16x8 At[4][2], B0[2][2], B1[2][2];
    int sc127 = 0x7F7F7F7F; asm volatile("" : "+v"(sc127));
    const char* cA = (const char*)g.A + (size_t)cur.pm * tstepA; const char* cB = (const char*)g.Bt + (size_t)cur.pn * tstep;
    S.a_ready(cur);
    PG8_STAGE(PG8_SB(0, 0), cB, voffB); PG8_STAGE(PG8_SA(0, 0), cA, voffA); PG8_STAGE(PG8_SB(0, 1), cB + hstep, voffB); PG8_STAGE(PG8_SA(0, 1), cA + hstepA, voffA);
    if (wr == 1) PG8_BAR;
    PG8_WAIT_V(4); PG8_BAR;
    PG8_STAGE(PG8_SB(1, 0), cB + kstep, voffB); PG8_STAGE(PG8_SA(1, 0), cA + kstep, voffA); PG8_STAGE(PG8_SB(1, 1), cB + hstep + kstep, voffB);
    PG8_WAIT_V(6); PG8_BAR;
    for (;;) {
        const bool has_next = S.next(ui + 1, nxt);
        const char* nA = has_next ? (const char*)g.A + (size_t)nxt.pm * tstepA : cA; const char* nB = has_next ? (const char*)g.Bt + (size_t)nxt.pn * tstep : cB;
        for (int t = 0; t < nt; t += 2) {
            const bool last = (t == nt - 2);
            const char* a1 = cA + (size_t)(t + 1) * kstep;
            const char* a2 = last ? nA : cA + (size_t)(t + 2) * kstep; const char* b2 = last ? nB : cB + (size_t)(t + 2) * kstep;
            const char* a3 = a2 + kstep; const char* b3 = b2 + kstep;
            if (last && has_next) S.a_ready(nxt);
            PG8_LDB(B0, 0, 0); PG8_SCHED; PG8_LDA(At, 0, 0); PG8_STAGE(PG8_SA(1, 1), a1 + hstepA, voffA);
            PG8_WAIT_L(8); PG8_BAR; PG8_WAIT_L(0); PG8_MMA(0, 0, At, B0); PG8_BAR; PG8_SCHED;
            PG8_LDB(B1, 0, 1); PG8_STAGE(PG8_SB(0, 0), b2, voffB);
            PG8_BAR; PG8_WAIT_L(0); PG8_MMA(0, 1, At, B1); PG8_BAR;
            PG8_LDA(At, 0, 1); PG8_STAGE(PG8_SA(0, 0), a2, voffA);
            PG8_BAR; PG8_WAIT_L(0); PG8_MMA(1, 0, At, B0); PG8_BAR; PG8_SCHED;
            PG8_STAGE(PG8_SB(0, 1), b2 + hstep, voffB);
            PG8_WAIT_V(6); PG8_BAR; PG8_MMA(1, 1, At, B1); PG8_BAR;
            PG8_LDB(B0, 1, 0); PG8_SCHED; PG8_LDA(At, 1, 0); PG8_STAGE(PG8_SA(0, 1), a2 + hstepA, voffA);
            PG8_WAIT_L(8); PG8_BAR; PG8_WAIT_L(0); PG8_MMA(0, 0, At, B0); PG8_BAR; PG8_SCHED;
            PG8_LDB(B1, 1, 1); PG8_STAGE(PG8_SB(1, 0), b3, voffB);
            PG8_BAR; PG8_WAIT_L(0); PG8_MMA(0, 1, At, B1); PG8_BAR;
            PG8_LDA(At, 1, 1); PG8_STAGE(PG8_SA(1, 0), a3, voffA);
            PG8_BAR; PG8_WAIT_L(0); PG8_MMA(1, 0, At, B0); PG8_BAR; PG8_SCHED;
            PG8_STAGE(PG8_SB(1, 1), b3 + hstep, voffB);
            PG8_WAIT_V(6); PG8_BAR; PG8_MMA(1, 1, At, B1); PG8_BAR;
        }
        if constexpr (FP8) asm volatile("s_nop 15\n\ts_nop 15" ::: "memory");
        if constexpr (!Epi::AFTER_DRAIN) { E(acc, cur, wr, wc, fr, fq); S.done(cur); }
        if (!has_next) break;
#pragma unroll
        for (int a = 0; a < 2; ++a)
#pragma unroll
            for (int b = 0; b < 2; ++b)
#pragma unroll
                for (int m = 0; m < 4; ++m)
#pragma unroll
                    for (int n = 0; n < 2; ++n) acc[a][b][m][n] = (f32x4){0.f, 0.f, 0.f, 0.f};
        cur = nxt; cA = nA; cB = nB; ++ui;
    }
    PG8_WAIT_V(0);
    if (wr == 0) PG8_BAR;
    PG8_BAR;
    if constexpr (Epi::AFTER_DRAIN) { E.fused(acc, cur, wr, wc, fr, fq, lds, wid, lane); S.done(cur); }
#undef PG8_SA
#undef PG8_SB
#undef PG8_STAGE
#undef PG8_LDA
#undef PG8_LDB
#undef PG8_MMA
#undef PG8_WAIT_V
#undef PG8_WAIT_L
#undef PG8_BAR
#undef PG8_SCHED
}

}

struct EpiResid {
  static constexpr bool PERM = false, AFTER_DRAIN = false;
  const float* xin; float* xout; float sc;
  DI void operator()(const f32x4 (&acc)[2][2][4][2], const pg8::Unit& u, int wr, int wc, int fr, int fq) const {
    const int row0 = u.pm * 256 + wr * 64 + fr, col0 = u.pn * 256 + wc * 32 + 4 * fq;
#pragma unroll
    for (int ai = 0; ai < 2; ++ai)
#pragma unroll
      for (int m = 0; m < 4; ++m) {
        const size_t ro = (size_t)(row0 + ai * 128 + m * 16) * 2048 + col0;
#pragma unroll
        for (int bj = 0; bj < 2; ++bj)
#pragma unroll
          for (int n = 0; n < 2; ++n) {
            const size_t o = ro + bj * 128 + n * 16;
            const f32x4 xv = *(const f32x4*)(xin + o);
            *(f32x4*)(xout + o) = xv + acc[ai][bj][m][n] * sc;
          }
        asm volatile("" ::: "memory");
      }
  }
};
template <int MODE>
struct EpiBf {
  static constexpr bool PERM = true, AFTER_DRAIN = false;
  u16* d0; int ld0; int N; u16* d1; u16* d2; const f32x2* rope; float sc = 1.f; int csplit = 0, coff1 = 0, coff2 = 0;
  DI void rot(f32x4& v0, f32x4& v1, int row, int col) const {
    const f32x4* cp = (const f32x4*)(rope + (row & 2047) * 32 + ((col & 63) >> 1));
    const f32x4 c01 = cp[0], c23 = cp[1];
    const f32x4 a = {v0[0] * c01[0] - v0[1] * c01[1], v0[1] * c01[0] + v0[0] * c01[1], v0[2] * c01[2] - v0[3] * c01[3], v0[3] * c01[2] + v0[2] * c01[3]};
    const f32x4 b = {v1[0] * c23[0] - v1[1] * c23[1], v1[1] * c23[0] + v1[0] * c23[1], v1[2] * c23[2] - v1[3] * c23[3], v1[3] * c23[2] + v1[2] * c23[3]};
    v0 = a; v1 = b;
  }
  DI void operator()(const f32x4 (&acc)[2][2][4][2], const pg8::Unit& u, int wr, int wc, int fr, int fq) const {
    const int row0 = u.pm * 256 + wr * 64 + fr, colb = u.pn * 256 + wc * 32 + 8 * fq;
#pragma unroll
    for (int ai = 0; ai < 2; ++ai)
#pragma unroll
      for (int m = 0; m < 4; ++m) {
        const int row = row0 + ai * 128 + m * 16;
#pragma unroll
        for (int bj = 0; bj < 2; ++bj) {
          const int col = colb + bj * 128;
          f32x4 v0 = acc[ai][bj][m][0] * sc, v1 = acc[ai][bj][m][1] * sc;
          u16* dst = nullptr;
          if (MODE == 0) { if (col < N) dst = d0 + (size_t)row * ld0 + (col < csplit ? col + coff1 : col + coff2); }
          else if (MODE == 1) {
            if (col < 2048) dst = d0 + (size_t)row * 2048 + col;
            else if (col < 2112) { rot(v0, v1, row, col); dst = d2 + (size_t)row * 64 + (col - 2048); }
            else if (col < 6208) dst = d1 + (size_t)row * 4096 + (col - 2112);
          } else {
            if (((col >> 6) % 3) == 2) rot(v0, v1, row, col);
            dst = d0 + (size_t)row * 3072 + col;
          }
          if (dst) { u32x4 w = {pk2(v0[0], v0[1]), pk2(v0[2], v0[3]), pk2(v1[0], v1[1]), pk2(v1[2], v1[3])}; *(u32x4*)dst = w; }
        }
        asm volatile("" ::: "memory");
      }
  }
};

template <bool FP8 = false, class Epi>
DI void run_gemm(const u16* A, int lda, const u16* Bt, int M, int N, int K, const Epi& e, char* smem) {
  __syncthreads();
  pg8::Gemm g{A, Bt, M, N, K, lda};
  pg8::StaticOrder S; S.init(M, N, gridDim.x, blockIdx.x);
  pg8::gemm_phase<FP8>(( __attribute__((address_space(3))) unsigned char*)smem, g, S, e);
  __syncthreads();
}

typedef __attribute__((address_space(3))) unsigned* lds_u32p;
template <int OFF> DI void rd4(bf16x8 (&f)[4], unsigned addr) {
  asm volatile("ds_read_b128 %0, %4 offset:%5\n\tds_read_b128 %1, %4 offset:%6\n\tds_read_b128 %2, %4 offset:%7\n\tds_read_b128 %3, %4 offset:%8\n\ts_waitcnt lgkmcnt(0)"
               : "=&v"(f[0]), "=&v"(f[1]), "=&v"(f[2]), "=&v"(f[3]) : "v"(addr), "i"(OFF), "i"(OFF + 32), "i"(OFF + 64), "i"(OFF + 96) : "memory");
}
template <int OFF> DI void rdv8(s16x4 (&v)[8], unsigned addr) {
  asm volatile("ds_read_b64_tr_b16 %0, %8 offset:%9\n\tds_read_b64_tr_b16 %1, %8 offset:%10\n\tds_read_b64_tr_b16 %2, %8 offset:%11\n\tds_read_b64_tr_b16 %3, %8 offset:%12\n\t"
               "ds_read_b64_tr_b16 %4, %8 offset:%13\n\tds_read_b64_tr_b16 %5, %8 offset:%14\n\tds_read_b64_tr_b16 %6, %8 offset:%15\n\tds_read_b64_tr_b16 %7, %8 offset:%16\n\ts_waitcnt lgkmcnt(0)"
               : "=&v"(v[0]), "=&v"(v[1]), "=&v"(v[2]), "=&v"(v[3]), "=&v"(v[4]), "=&v"(v[5]), "=&v"(v[6]), "=&v"(v[7])
               : "v"(addr), "i"(OFF), "i"(OFF + 512), "i"(OFF + 1024), "i"(OFF + 1536), "i"(OFF + 2048), "i"(OFF + 2560), "i"(OFF + 3072), "i"(OFF + 3584) : "memory");
}
template <int KSTR, int ND, int N>
DI f32x16 s_block(unsigned kaddr, const bf16x8* qf) {
  const f32x16 z16 = {0.f, 0.f, 0.f, 0.f, 0.f, 0.f, 0.f, 0.f, 0.f, 0.f, 0.f, 0.f, 0.f, 0.f, 0.f, 0.f};
  bf16x8 f[4];
  rd4<N * 32 * KSTR>(f, kaddr);
  f32x16 a = MFMA(f[0], qf[0], z16); a = MFMA(f[1], qf[1], a); a = MFMA(f[2], qf[2], a); a = MFMA(f[3], qf[3], a);
  if constexpr (ND > 4) { rd4<N * 32 * KSTR + 128>(f, kaddr); a = MFMA(f[0], qf[4], a); a = MFMA(f[1], qf[5], a); a = MFMA(f[2], qf[6], a); a = MFMA(f[3], qf[7], a); }
  if constexpr (ND > 8) { rd4<N * 32 * KSTR + 256>(f, kaddr); a = MFMA(f[0], qf[8], a); a = MFMA(f[1], qf[9], a); a = MFMA(f[2], qf[10], a); a = MFMA(f[3], qf[11], a); }
  if constexpr (ND > 12) { rd4<N * 32 * KSTR + 384>(f, kaddr); a = MFMA(f[0], qf[12], a); a = MFMA(f[1], qf[13], a); a = MFMA(f[2], qf[14], a); a = MFMA(f[3], qf[15], a); }
  return a;
}
template <int CB> DI void pv_block(f32x16& o, unsigned vaddr, const bf16x8 (&pb)[2][2]) {
  s16x4 v[8];
  rdv8<CB * 4096>(v, vaddr);
#pragma unroll
  for (int q = 0; q < 4; ++q) {
    const bf16x8 vf = {v[2 * q][0], v[2 * q][1], v[2 * q][2], v[2 * q][3], v[2 * q + 1][0], v[2 * q + 1][1], v[2 * q + 1][2], v[2 * q + 1][3]};
    o = MFMA(vf, pb[q >> 1][q & 1], o);
  }
}
template <int DQK, int W1, int DV, int VW, int MODE>
DI void attn_core(const u16* __restrict__ k1, int ldk1, const u16* __restrict__ k2, int ldk2, const u16* __restrict__ vsrc, int ldv,
                  int kv_len, int kbase0, int ntiles, const u16* qrow, int tq, int tq0, float c2, int vcb0, u16* yrow,
                  const u16* grow, const unsigned* maskrow, const float* lutw, float bias_far, float m_init, float l_init, char* smem) {
  constexpr int KSTR = DQK * 2 + 16, KCH = DQK / 8;
  constexpr int ND = DQK / 16, NCB = DV / 32, BUF = 64 * KSTR + (VW / 32) * 4096;
  constexpr int NKI = KSTR / 16, NVI = VW / 8;
  static_assert(ND % 4 == 0 && NCB <= 4, "fragment batches");
  int tid0 = threadIdx.x; asm volatile("" : "+v"(tid0));
  const int lane = tid0 & 63, r32 = lane & 31, hi = lane >> 5;
  const int wv = __builtin_amdgcn_readfirstlane(tid0 >> 6);
  const unsigned lds0 = (unsigned)(uintptr_t)smem;
  bf16x8 qf[ND];
#pragma unroll
  for (int d0 = 0; d0 < ND; ++d0) qf[d0] = *(const bf16x8*)(qrow + d0 * 16 + hi * 8);
  f32x16 o[NCB];
#pragma unroll
  for (int cb = 0; cb < NCB; ++cb)
#pragma unroll
    for (int r = 0; r < 16; ++r) o[cb][r] = 0.f;
  float m = m_init, l = l_init;
  const unsigned klane = (unsigned)(r32 * KSTR + hi * 16);
  const unsigned vlane = (unsigned)(64 * KSTR + vcb0 * 4096 + ((lane >> 4) & 1) * 32 + (lane & 3) * 8 + (4 * hi + ((lane & 15) >> 2)) * 64);
  unsigned mwn[2] = {0u, 0u};
  auto stage_tile = [&](int kb, int buf) {
    int ln = threadIdx.x & 63; asm volatile("" : "+v"(ln));
    const unsigned bofs = (unsigned)(buf * BUF);
#pragma unroll
    for (int ii = 0; ii < (NKI + 7) / 8; ++ii) {
      const int i = wv + 8 * ii;
      if (i < NKI) {
        const int ob = i * 1024 + ln * 16, row = ob / KSTR;
        int c = (ob - row * KSTR) >> 4; c = (c >= KCH) ? 0 : c;
        int key = kb + row; key = key < 0 ? 0 : (key >= kv_len ? kv_len - 1 : key);
        const u16* src = (c < W1 / 8) ? (k1 + (key * ldk1 + c * 8)) : (k2 + (key * ldk2 + (c - W1 / 8) * 8));
        __builtin_amdgcn_global_load_lds((const unsigned*)src, (lds_u32p)(smem + bofs + i * 1024), 16, 0, 0);
      }
    }
#pragma unroll
    for (int ii = 0; ii < (NVI + 7) / 8; ++ii) {
      const int i = wv + 8 * ii;
      if (i < NVI) {
        const int ob = i * 1024 + ln * 16, cbk = ob >> 12, row = (ob & 4095) >> 6, cw = (ob & 63) >> 4;
        int key = kb + row; key = key < 0 ? 0 : (key >= kv_len ? kv_len - 1 : key);
        __builtin_amdgcn_global_load_lds((const unsigned*)(vsrc + (key * ldv + (cbk * 4 + cw) * 8)), (lds_u32p)(smem + bofs + 64 * KSTR + i * 1024), 16, 0, 0);
      }
    }
    if (MODE == 1) { mwn[0] = maskrow[(kb >> 5)]; mwn[1] = maskrow[(kb >> 5) + 1]; }
  };
  stage_tile(kbase0, 0);
  asm volatile("s_waitcnt vmcnt(0)" ::: "memory");
  __syncthreads();
  for (int t = 0; t < ntiles; ++t) {
    const int kb = kbase0 + t * 64;
    const unsigned bufa = lds0 + (unsigned)((t & 1) * BUF);
    const unsigned mw0 = mwn[0], mw1 = mwn[1];
    if (t + 1 < ntiles) stage_tile(kb + 64, (t + 1) & 1);
    if (!(MODE == 0 && kb > tq0 + 31)) {
      f32x16 s[2];
      s[0] = s_block<KSTR, ND, 0>(bufa + klane, qf);
      s[1] = s_block<KSTR, ND, 1>(bufa + klane, qf);
      if (MODE == 0) {
        const bool diag = kb + 63 > tq0;
#pragma unroll
        for (int n = 0; n < 2; ++n)
#pragma unroll
          for (int i = 0; i < 16; ++i) {
            float v = s[n][i] * c2;
            if (diag) { const int key = kb + 32 * n + crow(i, hi); if (key > tq) v = NEGV; }
            s[n][i] = v;
          }
      } else if (MODE == 1) {
        const bool far = (tq0 - (kb + 63)) >= 128;
#pragma unroll
        for (int n = 0; n < 2; ++n) {
          const unsigned wb = (n ? mw1 : mw0) >> (4 * hi);
          if (far) {
#pragma unroll
            for (int i = 0; i < 16; ++i) {
              const float v = fmaf(s[n][i], c2, bias_far);
              s[n][i] = ((wb >> ((i & 3) + 8 * (i >> 2))) & 1u) ? v : NEGV;
            }
          } else {
#pragma unroll
            for (int i = 0; i < 16; ++i) {
              const int key = kb + 32 * n + crow(i, hi);
              int rel = tq - key; rel = rel < 0 ? 0 : (rel > 128 ? 128 : rel);
              const float v = fmaf(s[n][i], c2, lutw[rel]);
              s[n][i] = ((wb >> ((i & 3) + 8 * (i >> 2))) & 1u) ? v : NEGV;
            }
          }
        }
      } else if (MODE == 2) {
#pragma unroll
        for (int n = 0; n < 2; ++n)
#pragma unroll
          for (int i = 0; i < 16; ++i) {
            const int key = kb + 32 * n + crow(i, hi), rel = tq - key;
            const bool ok = ((unsigned)rel < 128u) && (key >= 0);
            const float v = fmaf(s[n][i], c2, lutw[rel & 127]);
            s[n][i] = ok ? v : NEGV;
          }
      } else {
#pragma unroll
        for (int n = 0; n < 2; ++n)
#pragma unroll
          for (int i = 0; i < 16; ++i) s[n][i] *= c2;
      }
      float mx = s[0][0];
#pragma unroll
      for (int i = 1; i < 16; ++i) mx = fmaxf(mx, s[0][i]);
#pragma unroll
      for (int i = 0; i < 16; ++i) mx = fmaxf(mx, s[1][i]);
      mx = xhalf_max(mx);
      if (__any(mx - m > 8.0f)) {
        const float mnew = fmaxf(m, mx), alpha = __builtin_amdgcn_exp2f(m - mnew);
        m = mnew; l *= alpha;
#pragma unroll
        for (int cb = 0; cb < NCB; ++cb)
#pragma unroll
          for (int r = 0; r < 16; ++r) o[cb][r] *= alpha;
      }
      float ps = 0.f;
#pragma unroll
      for (int n = 0; n < 2; ++n)
#pragma unroll
        for (int i = 0; i < 16; ++i) { const float p = __builtin_amdgcn_exp2f(s[n][i] - m); ps += p; s[n][i] = p; }
      l += ps;
      bf16x8 pb[2][2];
#pragma unroll
      for (int n = 0; n < 2; ++n)
#pragma unroll
        for (int s2 = 0; s2 < 2; ++s2) {
          u32x4 pw = {pk2(s[n][8 * s2 + 0], s[n][8 * s2 + 1]), pk2(s[n][8 * s2 + 2], s[n][8 * s2 + 3]),
                      pk2(s[n][8 * s2 + 4], s[n][8 * s2 + 5]), pk2(s[n][8 * s2 + 6], s[n][8 * s2 + 7])};
          pb[n][s2] = __builtin_bit_cast(bf16x8, pw);
        }
      pv_block<0>(o[0], bufa + vlane, pb);
      if constexpr (NCB > 1) pv_block<1>(o[1], bufa + vlane, pb);
      if constexpr (NCB > 2) pv_block<2>(o[2], bufa + vlane, pb);
      if constexpr (NCB > 3) pv_block<3>(o[3], bufa + vlane, pb);
    }
    asm volatile("s_waitcnt vmcnt(0)" ::: "memory");
    __syncthreads();
  }
  const float inv = 1.f / xhalf_sum(l);
#pragma unroll
  for (int cb = 0; cb < NCB; ++cb)
#pragma unroll
    for (int g = 0; g < 4; ++g) {
      const int dv = 32 * cb + 8 * g + 4 * hi;
      const u32x2 gg = *(const u32x2*)(grow + dv);
      float gv[4] = {bf2f(gg[0] & 0xffffu), bf2f(gg[0] >> 16), bf2f(gg[1] & 0xffffu), bf2f(gg[1] >> 16)};
      float ov[4];
#pragma unroll
      for (int j = 0; j < 4; ++j) {
        const float sg = gv[j] / (1.f + __expf(-gv[j]));
        ov[j] = o[cb][4 * g + j] * inv * sg;
      }
      *(unsigned*)((unsigned char*)yrow + dv) = pk4_fp8(ov[0] * Y_SCALE, ov[1] * Y_SCALE, ov[2] * Y_SCALE, ov[3] * Y_SCALE);
      __builtin_amdgcn_sched_barrier(0);
    }
}

DI unsigned ordkey(float f) { const unsigned b = __float_as_uint(f); return b ^ ((unsigned)((int)b >> 31) | 0x80000000u); }
DI void indexer_phase(const u16* __restrict__ P, unsigned* __restrict__ mask) {
  int tidx = threadIdx.x; asm volatile("" : "+v"(tidx));
  const int lane = tidx & 63, r32 = lane & 31, hi = lane >> 5;
  const int gw = blockIdx.x * 8 + (tidx >> 6), nw = gridDim.x * 8;
  for (int item = gw; item < 8192; item += nw) {
    const int b = item & 7, t0 = (1023 - (item >> 3)) * 2;
    const size_t brow = (size_t)b * SEQ;
    const int g = (r32 >> 2) & 1, head = 4 * (r32 >> 3) + (r32 & 3);
    bf16x8 aq[4];
#pragma unroll
    for (int s = 0; s < 4; ++s) aq[s] = *(const bf16x8*)(P + (brow + t0 + g) * 7808 + 2560 + head * 64 + 16 * s + 8 * hi);
    float wv[16];
    {
      const u32x4 w0 = *(const u32x4*)(P + (brow + t0 + hi) * 7808 + 3648), w1 = *(const u32x4*)(P + (brow + t0 + hi) * 7808 + 3656);
#pragma unroll
      for (int j = 0; j < 4; ++j) { wv[2 * j] = bf2f(w0[j] & 0xffffu); wv[2 * j + 1] = bf2f(w0[j] >> 16); wv[8 + 2 * j] = bf2f(w1[j] & 0xffffu); wv[8 + 2 * j + 1] = bf2f(w1[j] >> 16); }
    }
    const int tme = t0 + hi, kbmax = (t0 + 1) >> 5;
    unsigned sc[64];
#pragma unroll
    for (int kb = 0; kb < 64; ++kb) {
      unsigned u = 0u;
      if (kb <= kbmax) {
        f32x16 a;
#pragma unroll
        for (int r = 0; r < 16; ++r) a[r] = 0.f;
        const u16* kp = P + (brow + 32 * kb + r32) * 7808 + 3584 + 8 * hi;
#pragma unroll
        for (int s = 0; s < 4; ++s) { const bf16x8 bk = *(const bf16x8*)(kp + 16 * s); a = MFMA(aq[s], bk, a); }
        float v = 0.f;
#pragma unroll
        for (int i = 0; i < 16; ++i) v = fmaf(wv[i], fmaxf(a[i], 0.f), v);
        u = (32 * kb + r32 <= tme) ? ordkey(v) : 0u;
      }
      sc[kb] = u;
    }
    const int target = (tme + 1 < 256) ? tme + 1 : 256;
    unsigned T = 0u;
    for (int bit = 31; bit >= 0; --bit) {
      const unsigned Tp = T | (1u << bit);
      int cnt = 0;
#pragma unroll
      for (int kb = 0; kb < 64; ++kb) cnt += (sc[kb] >= Tp) ? 1 : 0;
#pragma unroll
      for (int o = 16; o; o >>= 1) cnt += __shfl_xor(cnt, o);
      if (cnt >= target) T = Tp;
    }
    unsigned w0 = 0u, w1 = 0u;
#pragma unroll
    for (int kb = 0; kb < 64; ++kb) {
      const bool pred = (sc[kb] >= T) && (sc[kb] != 0u);
      const unsigned long long bal = __ballot(pred);
      const unsigned wd = (unsigned)(bal >> (32 * hi));
      if ((kb & 31) == r32) { if (kb < 32) w0 = wd; else w1 = wd; }
    }
    mask[(brow + tme) * 64 + r32] = w0;
    mask[(brow + tme) * 64 + 32 + r32] = w1;
  }
}

DI void gbar(unsigned* cnt, unsigned target) {
  asm volatile("s_waitcnt vmcnt(0)" ::: "memory");
  __syncthreads();
  if (threadIdx.x == 0) {
    __builtin_amdgcn_fence(__ATOMIC_RELEASE, "agent");
    asm volatile("s_waitcnt vmcnt(0)" ::: "memory");
    __hip_atomic_fetch_add(cnt, 1u, __ATOMIC_RELAXED, __HIP_MEMORY_SCOPE_AGENT);
    while (__hip_atomic_load(cnt, __ATOMIC_RELAXED, __HIP_MEMORY_SCOPE_AGENT) < target) __builtin_amdgcn_s_sleep(1);
    __builtin_amdgcn_fence(__ATOMIC_ACQUIRE, "agent");
    asm volatile("s_waitcnt vmcnt(0)" ::: "memory");
  }
  __syncthreads();
}
#define GSYNC() do { ++bar_gen; gbar(BAR, bar_gen * gridDim.x); } while (0)
__global__ void __launch_bounds__(512, 2) mega(Params p) {
  cg::grid_group grid = cg::this_grid();
  extern __shared__ __attribute__((aligned(16))) char smem[];
  volatile int* s_item = (volatile int*)(smem + LDS_ITEM);
  char* ws = p.ws;
  unsigned char* Y8 = (unsigned char*)(ws + OFF_Y);
  unsigned char* H8 = (unsigned char*)(ws + OFF_Y);
  u16* WIN8 = (u16*)(ws + OFF_WIN + 19922944);
  unsigned char* CQ8 = (unsigned char*)(ws + OFF_Y + 67108864);     u16* H = (u16*)(ws + OFF_H); u16* Cb = (u16*)(ws + OFF_Y); u16* Qb = (u16*)(ws + OFF_H);
  u16* KV = (u16*)(ws + OFF_KV); u16* MG = (u16*)(ws + OFF_MG); u16* KR = (u16*)(ws + OFF_KR); u16* Pb = (u16*)(ws + OFF_P);
  u16* WIN = (u16*)(ws + OFF_WIN); u16* WUQ = (u16*)(ws + OFF_WUQ); u16* WUKV = (u16*)(ws + OFF_WUKV); u16* WOUT = (u16*)(ws + OFF_WOUT);
  u16* WMEMALL = (u16*)(ws + OFF_KV); u16* MEMN = (u16*)(ws + OFF_MEMN); u16* MEMKV = (u16*)(ws + OFF_MEMKV);
  unsigned* MASK = (unsigned*)(ws + OFF_MASK); f32x2* ROPE = (f32x2*)(ws + OFF_ROPE); float* LUT = (float*)(ws + OFF_LUT);
  int* CTR = (int*)(ws + OFF_CTR);
  unsigned* BAR = (unsigned*)(ws + OFF_CTR) + 64;
  unsigned bar_gen = 0;
  const int tid = threadIdx.x, lane = tid & 63, wv = __builtin_amdgcn_readfirstlane(tid >> 6), r32 = lane & 31, hi = lane >> 5;
  const int gtid = blockIdx.x * 512 + tid, gthreads = gridDim.x * 512;

  for (int i = gtid; i < 2048 * 32; i += gthreads) {
    const int pos = i >> 5, j = i & 31;
    const float inv = 1.0f / powf(10000.0f, (float)(2 * j) / 64.0f);
    const float ang = (float)pos * inv;
    const float k = rintf(ang * 0.15915494309189535f);
    float r = fmaf(-k, 6.28318548202514648f, ang);
    r = fmaf(-k, -1.74845553e-7f, r);
    f32x2 cs = {__cosf(r), __sinf(r)};
    ROPE[i] = cs;
  }
  for (int i = gtid; i < 129 * 32; i += gthreads) {
    const int rel = i >> 5, h = i & 31;
    int bucket;
    if (rel < 16) bucket = rel;
    else { const int lg = 16 + (int)(logf((float)rel / 16.0f) / 2.0794415416798357f * 16.0f); bucket = lg < 31 ? lg : 31; }
    LUT[i] = p.rel_bias[bucket * 32 + h] * LOG2E;
  }
  rmsnorm_rows<false>(p.mem, p.mem_norm, MEMN, 2048);
#pragma unroll 1
  for (int l = 0; l < 4; ++l) convert_wt<0>(p.w_mem_kv + (size_t)l * 2048 * 2048, 2048, 2048, 2048, WMEMALL + (size_t)l * 2048 * 2048, smem);

#pragma unroll 1
  for (int layer = 0; layer < 4; ++layer) {
    const int kind = layer % 3, j = layer / 3;
    const float* xin = (layer == 0) ? p.x : p.out;
    rmsnorm_rows<false>(xin, p.norm_in + layer * 2048, H, NTOK, (kind == 0) ? nullptr : H8);
    if (kind == 0) {
      convert_wt<1>(p.w_in_a + (size_t)j * 2048 * 6208, 2048, 6208, 6400, WIN, smem);
      convert_wt<2, true>(p.w_uq + (size_t)j * 1536 * 3072, 1536, 3072, 3072, WUQ, smem, WUQ_SCALE);
      convert_wt<0>(p.w_ukv + (size_t)j * 512 * 4096, 512, 4096, 4096, WUKV, smem);
    } else if (kind == 1) {
      convert_wt<0>(p.w_in_b, 2048, 7760, 4864, WIN, smem, 1.f, 4688, 1616, 2048, 3072);
      convert_wt<0, true>(p.w_in_b, 2048, 7760, 3072, WIN8, smem, WIN_SCALE, 3072, 2048, 0, 1616);
    } else {
      convert_wt<0>(p.w_in_c, 2048, 6656, 3584, WIN, smem, 1.f, 3584, 512, 2048, 3072);
      convert_wt<0, true>(p.w_in_c, 2048, 6656, 3072, WIN8, smem, WIN_SCALE, 3072, 2048, 0, 512);
    }
    convert_wt<0, true>(p.w_out + (size_t)layer * 3072 * 2048, 3072, 2048, 2048, WOUT, smem, WOUT_SCALE);
    if (layer == 0) { __builtin_amdgcn_fence(__ATOMIC_RELEASE, "agent"); grid.sync(); __builtin_amdgcn_fence(__ATOMIC_ACQUIRE, "agent"); asm volatile("s_waitcnt vmcnt(0)" ::: "memory"); }
    else GSYNC();

    if (kind == 0) { EpiBf<1> e{Cb, 2048, 6208, MG, KR, ROPE}; run_gemm(H, 2048, WIN, NTOK, 6400, 2048, e, smem); }
    else if (kind == 1) {
      { EpiBf<0> e{Pb, 7808, 4688, nullptr, nullptr, nullptr, 1.f, 1616, 2048, 3072}; run_gemm(H, 2048, WIN, NTOK, 4864, 2048, e, smem); }
      { EpiBf<0> e{Pb, 7808, 3072, nullptr, nullptr, nullptr, 1.f / (H_SCALE * WIN_SCALE), 2048, 0, 1616}; run_gemm<true>((const u16*)H8, 1024, WIN8, NTOK, 3072, 1024, e, smem); }
    } else {
      { EpiBf<0> e{Pb, 6656, 3584, nullptr, nullptr, nullptr, 1.f, 512, 2048, 3072}; run_gemm(H, 2048, WIN, NTOK, 3584, 2048, e, smem); }
      { EpiBf<0> e{Pb, 6656, 3072, nullptr, nullptr, nullptr, 1.f / (H_SCALE * WIN_SCALE), 2048, 0, 512}; run_gemm<true>((const u16*)H8, 1024, WIN8, NTOK, 3072, 1024, e, smem); }
    }
    if (layer == 0) { EpiBf<0> e{MEMKV, 8192, 8192, nullptr, nullptr, nullptr}; run_gemm(MEMN, 2048, WMEMALL, 2048, 8192, 2048, e, smem); }
    GSYNC();

    if (kind == 0) {
      anorm_phase(Cb, p.a_q_norm + j * 1536, p.a_kv_norm + j * 512, CQ8);
      GSYNC();
      { EpiBf<2> e{Qb, 3072, 3072, nullptr, nullptr, ROPE, 1.f / (CQ_SCALE * WUQ_SCALE)}; run_gemm<true>((const u16*)CQ8, 768, WUQ, NTOK, 3072, 768, e, smem); }
      { EpiBf<0> e{KV, 4096, 4096, nullptr, nullptr, nullptr}; run_gemm(Cb + 1536, 2048, WUKV, NTOK, 4096, 512, e, smem); }
      GSYNC();
    } else if (kind == 1) {
      indexer_phase(Pb, MASK);
      GSYNC();
    }

    {
      const int nself = (kind == 0) ? 1024 : 2048, total = nself + 512;
      const u16* mgb = (kind == 0) ? MG : Pb;
      const int ldmg = (kind == 0) ? 4096 : (kind == 1 ? 7808 : 6656);
      const int mqcol = (kind == 0) ? 0 : (kind == 1 ? 3664 : 2560);
      const int gatecol = (kind == 0) ? 1024 : (kind == 1 ? 4688 : 3584);
      const u16* memkv = MEMKV + layer * 2048;
      float* lut_all = (float*)(smem + LDS_LUT);
      if (kind != 0) {
        for (int i = tid; i < 32 * 129; i += 512) { const int h = i / 129, r = i - h * 129; lut_all[h * 132 + r] = LUT[r * 32 + h]; }
      }
      if (tid == 0) s_item[0] = atomicAdd(&CTR[layer], 1);
      __syncthreads();
      for (int par = 0;; par ^= 1) {
        const int item = __builtin_amdgcn_readfirstlane(s_item[par]);
        if (item >= total) break;
        if (tid == 0) s_item[par ^ 1] = atomicAdd(&CTR[layer], 1);
        if (item < nself) {
          if (kind == 0) {
            const int qblk = 7 - item / 128, rem = item % 128, b = rem / 16, head = rem % 16;
            const size_t brow = (size_t)b * SEQ;
            const int tq0 = qblk * 256 + 32 * wv, tq = tq0 + r32;
            attn_core<192, 128, 128, 128, 0>(KV + brow * 4096 + head * 256, 4096, KR + brow * 64, 64, KV + brow * 4096 + head * 256 + 128, 4096,
                                            SEQ, 0, 4 * qblk + 4, Qb + (brow + tq) * 3072 + head * 192, tq, tq0, 0.07216878364870322f * LOG2E, 0,
                                            (u16*)(Y8 + (brow + tq) * 3072 + head * 128), mgb + (brow + tq) * ldmg + gatecol + head * 128,
                                            nullptr, nullptr, 0.f, -1e29f, 0.f, smem);
          } else {
            const int qb = 63 - item / 32, rem = item % 32, b = rem / 4, kvh = rem % 4;
            const size_t brow = (size_t)b * SEQ;
            const int head = kvh * 8 + wv, tq0 = qb * 32, tq = tq0 + r32;
            const float* lutw = lut_all + head * 132;
            if (kind == 1) {
              attn_core<64, 64, 64, 64, 1>(Pb + brow * 7808 + 2048 + kvh * 64, 7808, nullptr, 0, Pb + brow * 7808 + 2304 + kvh * 64, 7808,
                                          SEQ, 0, (tq0 + 31) / 64 + 1, Pb + (brow + tq) * 7808 + head * 64, tq, tq0, 0.125f * LOG2E, 0,
                                          (u16*)(Y8 + (brow + tq) * 3072 + head * 64), Pb + (brow + tq) * 7808 + gatecol + head * 64,
                                          MASK + (brow + tq) * 64, lutw, lutw[128], -1e29f, 0.f, smem);
            } else {
              const float sink = p.c_sinks[j * 32 + head] * LOG2E;
              attn_core<64, 64, 64, 64, 2>(Pb + brow * 6656 + 2048 + kvh * 64, 6656, nullptr, 0, Pb + brow * 6656 + 2304 + kvh * 64, 6656,
                                          SEQ, tq0 - 128, 3, Pb + (brow + tq) * 6656 + head * 64, tq, tq0, 0.125f * LOG2E, 0,
                                          (u16*)(Y8 + (brow + tq) * 3072 + head * 64), Pb + (brow + tq) * 6656 + gatecol + head * 64,
                                          nullptr, lutw, 0.f, sink, hi == 0 ? 1.f : 0.f, smem);
            }
          }
        } else {
          const int it = item - nself, b = it / 64, mh = (it % 64) / 16, qb = it % 16;
          const size_t brow = (size_t)b * SEQ;
          const int tq0 = qb * 128 + 32 * (wv >> 1), tq = tq0 + r32, vh = wv & 1;
          attn_core<256, 256, 128, 256, 3>(memkv + (size_t)b * 256 * 8192 + mh * 256, 8192, nullptr, 0, memkv + (size_t)b * 256 * 8192 + 1024 + mh * 256, 8192,
                                          256, 0, 4, mgb + (brow + tq) * ldmg + mqcol + mh * 256, tq, tq0, 0.0625f * LOG2E, 4 * vh,
                                          (u16*)(Y8 + (brow + tq) * 3072 + 2048 + mh * 256 + 128 * vh), mgb + (brow + tq) * ldmg + gatecol + 2048 + mh * 256 + 128 * vh,
                                          nullptr, nullptr, 0.f, -1e29f, 0.f, smem);
        }
      }
    }
    GSYNC();

    { EpiResid e{xin, p.out, 1.f / (Y_SCALE * WOUT_SCALE)}; run_gemm<true>((const u16*)Y8, 1536, WOUT, NTOK, 2048, 1536, e, smem); }
    GSYNC();
  }
  rmsnorm_rows<true>(p.out, p.final_norm, p.out, NTOK);
}

extern "C" void kernel_launch(void* const* d_in, const int* in_sizes, int n_in, void* d_out, int out_size,
                              void* d_ws, size_t ws_size, hipStream_t stream) {
  static int grid_blocks = 0;
  if (!grid_blocks) {
    int dev = 0, cus = 0, per_cu = 0;
    (void)hipGetDevice(&dev);
    (void)hipDeviceGetAttribute(&cus, hipDeviceAttributeMultiprocessorCount, dev);
    (void)hipFuncSetAttribute((const void*)mega, hipFuncAttributeMaxDynamicSharedMemorySize, LDS_BYTES);
    (void)hipOccupancyMaxActiveBlocksPerMultiprocessor(&per_cu, mega, 512, LDS_BYTES);
    if (per_cu > 1) per_cu = 1;
    grid_blocks = cus * per_cu;
  }
  Params p{};
  p.x = (const float*)d_in[0]; p.mem = (const float*)d_in[1]; p.norm_in = (const float*)d_in[2]; p.final_norm = (const float*)d_in[3];
  p.mem_norm = (const float*)d_in[4]; p.rel_bias = (const float*)d_in[5]; p.w_in_a = (const float*)d_in[6]; p.a_q_norm = (const float*)d_in[7];
  p.w_uq = (const float*)d_in[8]; p.a_kv_norm = (const float*)d_in[9]; p.w_ukv = (const float*)d_in[10]; p.w_in_b = (const float*)d_in[11];
  p.w_in_c = (const float*)d_in[12]; p.c_sinks = (const float*)d_in[13]; p.w_mem_kv = (const float*)d_in[14]; p.w_out = (const float*)d_in[15];
  p.out = (float*)d_out; p.ws = (char*)d_ws;
  (void)hipMemsetAsync((char*)d_ws + OFF_CTR, 0, 1024, stream);
  void* args[] = {&p};
  (void)hipLaunchCooperativeKernel((void*)mega, dim3(grid_blocks), dim3(512), args, LDS_BYTES, stream);
}
```

```cpp
#include <hip/hip_runtime.h>
#include <hip/hip_cooperative_groups.h>
#include <stdint.h>
namespace cg = cooperative_groups;

typedef unsigned short u16;
typedef __attribute__((ext_vector_type(8))) short bf16x8;
typedef __attribute__((ext_vector_type(4))) short s16x4;
typedef __attribute__((ext_vector_type(16))) float f32x16;
typedef __attribute__((ext_vector_type(4))) float f32x4;
typedef __attribute__((ext_vector_type(2))) float f32x2;
typedef __attribute__((ext_vector_type(4))) unsigned u32x4;
typedef __attribute__((ext_vector_type(2))) unsigned u32x2;
typedef __attribute__((ext_vector_type(2))) __bf16 bf16x2_t;
typedef short v4i16_t __attribute__((ext_vector_type(4)));
#define DI __device__ __forceinline__
#define MFMA(a, b, c) __builtin_amdgcn_mfma_f32_32x32x16_bf16((a), (b), (c), 0, 0, 0)

constexpr int SEQ = 2048, NTOK = 16384;
constexpr int LDS_LUT = 133120, LDS_ITEM = LDS_LUT + 32 * 528, LDS_BYTES = LDS_ITEM + 64;
constexpr float LOG2E = 1.4426950408889634f;
constexpr float NEGV = -1e30f;
constexpr float Y_SCALE = 16.f, WOUT_SCALE = 256.f, CQ_SCALE = 16.f, WUQ_SCALE = 256.f, H_SCALE = 16.f, WIN_SCALE = 256.f;

constexpr size_t OFF_Y = 0;
constexpr size_t OFF_H = 100663296;
constexpr size_t OFF_KV = 201326592;
constexpr size_t OFF_MG = 335544320;
constexpr size_t OFF_KR = 469762048;
constexpr size_t OFF_P = 167772160;
constexpr size_t OFF_WIN = 471859200;
constexpr size_t OFF_WUQ = OFF_WIN + 32505856;
constexpr size_t OFF_WUKV = OFF_WUQ + 9437184;
constexpr size_t OFF_WOUT = OFF_WUKV + 4194304;
constexpr size_t OFF_MEMN = OFF_WOUT + 12582912;
constexpr size_t OFF_MEMKV = OFF_MEMN + 8388608;
constexpr size_t OFF_MASK = OFF_MEMKV + 33554432;
constexpr size_t OFF_ROPE = OFF_MASK + 4194304;
constexpr size_t OFF_LUT = OFF_ROPE + 524288;
constexpr size_t OFF_CTR = OFF_LUT + 32768;

struct Params {
  const float *x, *mem, *norm_in, *final_norm, *mem_norm, *rel_bias, *w_in_a, *a_q_norm, *w_uq, *a_kv_norm, *w_ukv,
      *w_in_b, *w_in_c, *c_sinks, *w_mem_kv, *w_out;
  float* out;
  char* ws;
};

DI float bf2f(unsigned b) { return __uint_as_float(b << 16); }
DI unsigned pk2(float a, float b) {
  f32x2 v = {a, b};
  return __builtin_bit_cast(unsigned, __builtin_convertvector(v, bf16x2_t));
}
DI float clamp8(float x) { return fminf(fmaxf(x, -448.f), 448.f); }
DI unsigned pk4_fp8(float a, float b, float c, float d) {
  int w = 0;
  w = __builtin_amdgcn_cvt_pk_fp8_f32(clamp8(a), clamp8(b), w, false);
  w = __builtin_amdgcn_cvt_pk_fp8_f32(clamp8(c), clamp8(d), w, true);
  return (unsigned)w;
}
DI u16 f2bf(float a) { return (u16)(pk2(a, 0.f) & 0xffffu); }
DI float wave_sum(float v) {
#pragma unroll
  for (int o = 32; o; o >>= 1) v += __shfl_xor(v, o);
  return v;
}
DI int crow(int reg, int hi) { return (reg & 3) + 8 * (reg >> 2) + 4 * hi; }
DI float xhalf_max(float m) {
  auto rr = __builtin_amdgcn_permlane32_swap(__float_as_uint(m), __float_as_uint(m), false, false);
  return fmaxf(__uint_as_float(rr[0]), __uint_as_float(rr[1]));
}
DI float xhalf_sum(float m) {
  auto rr = __builtin_amdgcn_permlane32_swap(__float_as_uint(m), __float_as_uint(m), false, false);
  return __uint_as_float(rr[0]) + __uint_as_float(rr[1]);
}
typedef __attribute__((address_space(3))) v4i16_t* lds_v4p;
DI s16x4 vtr(const char* p) {
  return __builtin_bit_cast(s16x4, __builtin_amdgcn_ds_read_tr16_b64_v4i16((lds_v4p)(p)));
}

template <int PERM, bool FP8 = false>
DI void convert_wt(const float* __restrict__ W, int K, int N, int Npad, u16* __restrict__ Wt, char* smem, float wscale = 1.f,
                   int nvalid = -1, int csplit = 0, int coff1 = 0, int coff2 = 0, int rot_n0 = 2048) {
  float* tile = (float*)smem;
  int tid = threadIdx.x; asm volatile("" : "+v"(tid));
  const int ntk = K / 64, ntn = Npad / 64;
  for (int t = blockIdx.x; t < ntk * ntn; t += gridDim.x) {
    const int tk = t % ntk, tn = t / ntk, k0 = tk * 64, n0 = tn * 64;
    __syncthreads();
#pragma unroll
    for (int i = 0; i < 2; ++i) {
      const int id = tid + 512 * i, kr = id >> 4, n4 = (id & 15) * 4;
      f32x4 v = {0.f, 0.f, 0.f, 0.f};
      const int nd = n0 + n4, nsrc = (nvalid < 0) ? nd : (nd < csplit ? nd + coff1 : nd + coff2);
      if (nd < ((nvalid < 0) ? N : nvalid)) v = *(const f32x4*)(W + (size_t)(k0 + kr) * N + nsrc);
      tile[kr * 65 + n4 + 0] = v[0]; tile[kr * 65 + n4 + 1] = v[1]; tile[kr * 65 + n4 + 2] = v[2]; tile[kr * 65 + n4 + 3] = v[3];
    }
    __syncthreads();
    {
      const int n = tid >> 3, c = tid & 7;
      bool rot = false;
      if (PERM == 1) rot = (n0 == rot_n0);
      if (PERM == 2) rot = ((tn % 3) == 2);
      const int ns = rot ? ((n >> 1) + 32 * (n & 1)) : n;
      if (FP8) {
        float f[8];
#pragma unroll
        for (int j = 0; j < 8; ++j) f[j] = tile[(c * 8 + j) * 65 + ns] * wscale;
        u32x2 o = {pk4_fp8(f[0], f[1], f[2], f[3]), pk4_fp8(f[4], f[5], f[6], f[7])};
        *(u32x2*)((unsigned char*)Wt + (size_t)(n0 + n) * K + k0 + c * 8) = o;
      } else {
        u32x4 o;
#pragma unroll
        for (int j = 0; j < 4; ++j) o[j] = pk2(tile[(c * 8 + 2 * j) * 65 + ns], tile[(c * 8 + 2 * j + 1) * 65 + ns]);
        *(u32x4*)(Wt + (size_t)(n0 + n) * K + k0 + c * 8) = o;
      }
    }
  }
}

template <bool F32OUT>
DI void rmsnorm_rows(const float* X, const float* __restrict__ g, void* outp, int nrows, unsigned char* __restrict__ out8 = nullptr) {
  int tidx = threadIdx.x; asm volatile("" : "+v"(tidx));
  const int lane = tidx & 63, gw = blockIdx.x * 8 + (tidx >> 6), nw = gridDim.x * 8;
  for (int row = gw; row < nrows; row += nw) {
    const f32x4* xr = (const f32x4*)(X + (size_t)row * 2048);
    f32x4 v[8];
    float ss = 0.f;
#pragma unroll
    for (int i = 0; i < 8; ++i) { v[i] = xr[lane + 64 * i]; ss += v[i][0] * v[i][0] + v[i][1] * v[i][1] + v[i][2] * v[i][2] + v[i][3] * v[i][3]; }
    ss = wave_sum(ss);
    const float r = rsqrtf(ss * (1.f / 2048.f) + 1e-6f);
#pragma unroll
    for (int i = 0; i < 8; ++i) {
      const f32x4 gg = ((const f32x4*)g)[lane + 64 * i];
      f32x4 o = {v[i][0] * r * gg[0], v[i][1] * r * gg[1], v[i][2] * r * gg[2], v[i][3] * r * gg[3]};
      if (F32OUT) ((f32x4*)((float*)outp + (size_t)row * 2048))[lane + 64 * i] = o;
      else { u32x2 pk = {pk2(o[0], o[1]), pk2(o[2], o[3])}; ((u32x2*)((u16*)outp + (size_t)row * 2048))[lane + 64 * i] = pk; }
      if (!F32OUT && out8) ((unsigned*)(out8 + (size_t)row * 2048))[lane + 64 * i] = pk4_fp8(o[0] * H_SCALE, o[1] * H_SCALE, o[2] * H_SCALE, o[3] * H_SCALE);
    }
  }
}

DI void anorm_phase(u16* C, const float* __restrict__ gq, const float* __restrict__ gkv, unsigned char* __restrict__ cq8) {
  int tidx = threadIdx.x; asm volatile("" : "+v"(tidx));
  const int lane = tidx & 63, gw = blockIdx.x * 8 + (tidx >> 6), nw = gridDim.x * 8;
  for (int row = gw; row < NTOK; row += nw) {
    u32x4* cr = (u32x4*)(C + (size_t)row * 2048);
    u32x4 v[4];
    float sq = 0.f, skv = 0.f;
#pragma unroll
    for (int i = 0; i < 4; ++i) {
      v[i] = cr[lane + 64 * i];
      float s = 0.f;
#pragma unroll
      for (int j = 0; j < 4; ++j) { float a = bf2f(v[i][j] & 0xffffu), b = bf2f(v[i][j] >> 16); s += a * a + b * b; }
      if (i < 3) sq += s; else skv += s;
    }
    sq = wave_sum(sq); skv = wave_sum(skv);
    const float rq = rsqrtf(sq * (1.f / 1536.f) + 1e-6f), rkv = rsqrtf(skv * (1.f / 512.f) + 1e-6f);
#pragma unroll
    for (int i = 0; i < 4; ++i) {
      const int col = (lane + 64 * i) * 8;
      const float* gp = (i < 3) ? (gq + col) : (gkv + col - 1536);
      const float r = (i < 3) ? rq : rkv;
      const f32x4 g0 = *(const f32x4*)gp, g1 = *(const f32x4*)(gp + 4);
      u32x4 o;
      o[0] = pk2(bf2f(v[i][0] & 0xffffu) * r * g0[0], bf2f(v[i][0] >> 16) * r * g0[1]);
      o[1] = pk2(bf2f(v[i][1] & 0xffffu) * r * g0[2], bf2f(v[i][1] >> 16) * r * g0[3]);
      o[2] = pk2(bf2f(v[i][2] & 0xffffu) * r * g1[0], bf2f(v[i][2] >> 16) * r * g1[1]);
      o[3] = pk2(bf2f(v[i][3] & 0xffffu) * r * g1[2], bf2f(v[i][3] >> 16) * r * g1[3]);
      cr[lane + 64 * i] = o;
      if (i < 3) {
        const float q0 = bf2f(v[i][0] & 0xffffu) * r * g0[0] * CQ_SCALE, q1 = bf2f(v[i][0] >> 16) * r * g0[1] * CQ_SCALE;
        const float q2 = bf2f(v[i][1] & 0xffffu) * r * g0[2] * CQ_SCALE, q3 = bf2f(v[i][1] >> 16) * r * g0[3] * CQ_SCALE;
        const float q4 = bf2f(v[i][2] & 0xffffu) * r * g1[0] * CQ_SCALE, q5 = bf2f(v[i][2] >> 16) * r * g1[1] * CQ_SCALE;
        const float q6 = bf2f(v[i][3] & 0xffffu) * r * g1[2] * CQ_SCALE, q7 = bf2f(v[i][3] >> 16) * r * g1[3] * CQ_SCALE;
        u32x2 w8 = {pk4_fp8(q0, q1, q2, q3), pk4_fp8(q4, q5, q6, q7)};
        *(u32x2*)(cq8 + (size_t)row * 1536 + col) = w8;
      }
    }
  }
}

namespace pg8 {
#define PG8_LAS __attribute__((address_space(3)))
constexpr int BM = 256, BK = 64, HALF = 128, HTB = HALF * BK * 2, STAGE_BYTES = 8 * HTB, NXCD = 8, WGM = 8;
DI int lds_byte(int r, int c) { const int st = (r >> 4) * 2 + (c >> 5), rr = r & 15, cc = c & 31, ob = rr * 64 + cc * 2; return st * 1024 + (ob ^ (((ob >> 9) & 1) << 5)); }
DI void stage_rc(int b, int& R, int& C) { const int st = b / 1024, sb = b % 1024, swz = sb ^ (((sb >> 9) & 1) << 5); R = (st >> 1) * 16 + swz / 64; C = (st & 1) * 32 + (swz % 64) / 2; }
DI int perm32(int rho) { const int n = rho >> 4, i = rho & 15; return 8 * (i >> 2) + 4 * n + (i & 3); }
typedef int i32x4v __attribute__((ext_vector_type(4)));
typedef int i32x8 __attribute__((ext_vector_type(8)));
DI i32x8 cat8(bf16x8 a, bf16x8 b) { const i32x4v x = __builtin_bit_cast(i32x4v, a), y = __builtin_bit_cast(i32x4v, b); return __builtin_shufflevector(x, y, 0, 1, 2, 3, 4, 5, 6, 7); }
struct Unit { int pm, pn; };
struct Gemm { const u16* A; const u16* Bt; int M, N, K, lda; };
struct StaticOrder {
  int nM, nN, nwg, G, c;
  DI void init(int M, int N, int G_, int c_) { nM = M / BM; nN = N / BM; nwg = nM * nN; G = G_; c = c_; }
  DI bool next(int i, Unit& u) const {
    const long L = (long)i * G + c; if (L >= nwg) return false;
    int wgid = (int)L; { const int q = nwg / NXCD, r = nwg % NXCD, xcd = wgid % NXCD, off = wgid / NXCD; wgid = (xcd < r ? xcd * (q + 1) : r * (q + 1) + (xcd - r) * q) + off; }
    const int nig = WGM * nN, gid = wgid / nig, fm = gid * WGM, gsz = (nM - fm) < WGM ? (nM - fm) : WGM;
    u.pm = fm + ((wgid % nig) % gsz); u.pn = (wgid % nig) / gsz; return true;
  }
  DI void a_ready(const Unit&) const {}
  DI void done(const Unit&) const {}
};
template <bool FP8, class Epi, class Sched>
__device__ __forceinline__ void gemm_phase(PG8_LAS unsigned char* lds, const Gemm g, const Sched& S, const Epi& E) {
    int tid = threadIdx.x; asm volatile("" : "+v"(tid));
    const int wid = __builtin_amdgcn_readfirstlane(tid >> 6), lane = tid & 63, wr = wid >> 2, wc = wid & 3, fr = lane & 15, fq = lane >> 4;
    const int K = g.K, nt = K / BK;
    unsigned voffA[2], voffB[2];
#pragma unroll
    for (int i = 0; i < 2; ++i) { int R, C; stage_rc(tid * 16 + i * 8192, R, C); const int Rb = Epi::PERM ? ((R & ~31) + perm32(R & 31)) : R;
        voffA[i] = (unsigned)(R * g.lda + C) * 2u; voffB[i] = (unsigned)(Rb * K + C) * 2u; }
    const size_t kstep = (size_t)(BK * 2);
    const size_t hstep = (size_t)HALF * K * 2, hstepA = (size_t)HALF * g.lda * 2;
    const size_t tstep = 2 * hstep, tstepA = 2 * hstepA;
    const unsigned ldsw = (unsigned)wid * 1024u;
    const int aoff = lds_byte(wr * 64 + fr, fq * 8), boff = lds_byte(wc * 32 + fr, fq * 8);
#define PG8_SA(b, h) (((b) * 2 + (h)) * HTB)
#define PG8_SB(b, h) ((4 + (b) * 2 + (h)) * HTB)
#define PG8_STAGE(bufoff, gbase, voff) do { _Pragma("unroll") for (int _i = 0; _i < 2; ++_i) \
        __builtin_amdgcn_global_load_lds((const unsigned*)((const char*)(gbase) + (voff)[_i]), (PG8_LAS unsigned*)(lds + (bufoff) + ldsw + _i * 8192), 16, 0, 0); } while (0)
#define PG8_LDA(dst, b, h) do { _Pragma("unroll") for (int m = 0; m < 4; ++m) _Pragma("unroll") for (int k = 0; k < 2; ++k) dst[m][k] = *(const PG8_LAS bf16x8*)(lds + PG8_SA(b, h) + aoff + m * 2048 + k * 1024); } while (0)
#define PG8_LDB(dst, b, h) do { _Pragma("unroll") for (int n = 0; n < 2; ++n) _Pragma("unroll") for (int k = 0; k < 2; ++k) dst[n][k] = *(const PG8_LAS bf16x8*)(lds + PG8_SB(b, h) + boff + n * 2048 + k * 1024); } while (0)
#define PG8_MMA(ai, bj, At, Bt) do { __builtin_amdgcn_s_setprio(1); _Pragma("unroll") for (int m = 0; m < 4; ++m) _Pragma("unroll") for (int n = 0; n < 2; ++n) { \
        if constexpr (FP8) { const i32x8 bv_ = cat8(Bt[n][0], Bt[n][1]), av_ = cat8(At[m][0], At[m][1]); \
            asm volatile("s_nop 1\n\tv_mfma_scale_f32_16x16x128_f8f6f4 %0, %1, %2, %0, %3, %3 op_sel_hi:[0,0,0]" : "+v"(acc[ai][bj][m][n]) : "v"(bv_), "v"(av_), "v"(sc127)); } \
        else { _Pragma("unroll") for (int k = 0; k < 2; ++k) acc[ai][bj][m][n] = __builtin_amdgcn_mfma_f32_16x16x32_bf16(Bt[n][k], At[m][k], acc[ai][bj][m][n], 0, 0, 0); } } \
        __builtin_amdgcn_s_setprio(0); } while (0)
#define PG8_WAIT_V(n) asm volatile("s_waitcnt vmcnt(" #n ")" ::: "memory")
#define PG8_WAIT_L(n) asm volatile("s_waitcnt lgkmcnt(" #n ")" ::: "memory")
#define PG8_BAR __builtin_amdgcn_s_barrier()
#define PG8_SCHED __builtin_amdgcn_sched_barrier(0)
    Unit cur, nxt; int ui = 0;
    if (!S.next(0, cur)) return;
    f32x4 acc[2][2][4][2];
#pragma unroll
    for (int a = 0; a < 2; ++a)
#pragma unroll
        for (int b = 0; b < 2; ++b)
#pragma unroll
            for (int m = 0; m < 4; ++m)
#pragma unroll
                for (int n = 0; n < 2; ++n) acc[a][b][m][n] = (f32x4){0.f, 0.f, 0.f, 0.f};
    bf16x8 At[4][2], B0[2][2], B1[2][2];
    int sc127 = 0x7F7F7F7F; asm volatile("" : "+v"(sc127));
    const char* cA = (const char*)g.A + (size_t)cur.pm * tstepA; const char* cB = (const char*)g.Bt + (size_t)cur.pn * tstep;
    S.a_ready(cur);
    PG8_STAGE(PG8_SB(0, 0), cB, voffB); PG8_STAGE(PG8_SA(0, 0), cA, voffA); PG8_STAGE(PG8_SB(0, 1), cB + hstep, voffB); PG8_STAGE(PG8_SA(0, 1), cA + hstepA, voffA);
    if (wr == 1) PG8_BAR;
    PG8_WAIT_V(4); PG8_BAR;
    PG8_STAGE(PG8_SB(1, 0), cB + kstep, voffB); PG8_STAGE(PG8_SA(1, 0), cA + kstep, voffA); PG8_STAGE(PG8_SB(1, 1), cB + hstep + kstep, voffB);
    PG8_WAIT_V(6); PG8_BAR;
    for (;;) {
        const bool has_next = S.next(ui + 1, nxt);
        const char* nA = has_next ? (const char*)g.A + (size_t)nxt.pm * tstepA : cA; const char* nB = has_next ? (const char*)g.Bt + (size_t)nxt.pn * tstep : cB;
        for (int t = 0; t < nt; t += 2) {
            const bool last = (t == nt - 2);
            const char* a1 = cA + (size_t)(t + 1) * kstep;
            const char* a2 = last ? nA : cA + (size_t)(t + 2) * kstep; const char* b2 = last ? nB : cB + (size_t)(t + 2) * kstep;
            const char* a3 = a2 + kstep; const char* b3 = b2 + kstep;
            if (last && has_next) S.a_ready(nxt);
            PG8_LDB(B0, 0, 0); PG8_SCHED; PG8_LDA(At, 0, 0); PG8_STAGE(PG8_SA(1, 1), a1 + hstepA, voffA);
            PG8_WAIT_L(8); PG8_BAR; PG8_WAIT_L(0); PG8_MMA(0, 0, At, B0); PG8_BAR; PG8_SCHED;
            PG8_LDB(B1, 0, 1); PG8_STAGE(PG8_SB(0, 0), b2, voffB);
            PG8_BAR; PG8_WAIT_L(0); PG8_MMA(0, 1, At, B1); PG8_BAR;
            PG8_LDA(At, 0, 1); PG8_STAGE(PG8_SA(0, 0), a2, voffA);
            PG8_BAR; PG8_WAIT_L(0); PG8_MMA(1, 0, At, B0); PG8_BAR; PG8_SCHED;
            PG8_STAGE(PG8_SB(0, 1), b2 + hstep, voffB);
            PG8_WAIT_V(6); PG8_BAR; PG8_MMA(1, 1, At, B1); PG8_BAR;
            PG8_LDB(B0, 1, 0); PG8_SCHED; PG8_LDA(At, 1, 0); PG8_STAGE(PG8_SA(0, 1), a2 + hstepA, voffA);
            PG8_WAIT_L(8); PG8_BAR; PG8_WAIT_L(0); PG8_MMA(0, 0, At, B0); PG8_BAR; PG8_SCHED;
            PG8_LDB(B1, 1, 1); PG8_STAGE(PG8_SB(1, 0), b3, voffB);
            PG8_BAR; PG8_WAIT_L(0); PG8_MMA(0, 1, At, B1); PG8_BAR;
            PG8_LDA(At, 1, 1); PG8_STAGE(PG8_SA(1, 0), a3, voffA);
            PG8_BAR; PG8_WAIT_L(0); PG8_MMA(1, 0, At, B0); PG8_BAR; PG8_SCHED;
            PG8_STAGE(PG8_SB(1, 1), b3 + hstep, voffB);
            PG8_WAIT_V(6); PG8_BAR; PG8_MMA(1, 1, At, B1); PG8_BAR;
        }
        if constexpr (FP8) asm volatile("s_nop 15\n\ts_nop 15" ::: "memory");
        if constexpr (!Epi::AFTER_DRAIN) { E(acc, cur, wr, wc, fr, fq); S.done(cur); }
        if (!has_next) break;
#pragma unroll
        for (int a = 0; a < 2; ++a)
#pragma unroll
            for (int b = 0; b < 2; ++b)
#pragma unroll
                for (int m = 0; m < 4; ++m)
#pragma unroll
                    for (int n = 0; n < 2; ++n) acc[a][b][m][n] = (f32x4){0.f, 0.f, 0.f, 0.f};
        cur = nxt; cA = nA; cB = nB; ++ui;
    }
    PG8_WAIT_V(0);
    if (wr == 0) PG8_BAR;
    PG8_BAR;
    if constexpr (Epi::AFTER_DRAIN) { E.fused(acc, cur, wr, wc, fr, fq, lds, wid, lane); S.done(cur); }
#undef PG8_SA
#undef PG8_SB
#undef PG8_STAGE
#undef PG8_LDA
#undef PG8_LDB
#undef PG8_MMA
#undef PG8_WAIT_V
#undef PG8_WAIT_L
#undef PG8_BAR
#undef PG8_SCHED
}

}

struct EpiResid {
  static constexpr bool PERM = false, AFTER_DRAIN = false;
  const float* xin; float* xout; float sc;
  DI void operator()(const f32x4 (&acc)[2][2][4][2], const pg8::Unit& u, int wr, int wc, int fr, int fq) const {
    const int row0 = u.pm * 256 + wr * 64 + fr, col0 = u.pn * 256 + wc * 32 + 4 * fq;
#pragma unroll
    for (int ai = 0; ai < 2; ++ai)
#pragma unroll
      for (int m = 0; m < 4; ++m) {
        const size_t ro = (size_t)(row0 + ai * 128 + m * 16) * 2048 + col0;
#pragma unroll
        for (int bj = 0; bj < 2; ++bj)
#pragma unroll
          for (int n = 0; n < 2; ++n) {
            const size_t o = ro + bj * 128 + n * 16;
            const f32x4 xv = *(const f32x4*)(xin + o);
            *(f32x4*)(xout + o) = xv + acc[ai][bj][m][n] * sc;
          }
        asm volatile("" ::: "memory");
      }
  }
};
template <int MODE>
struct EpiBf {
  static constexpr bool PERM = true, AFTER_DRAIN = false;
  u16* d0; int ld0; int N; u16* d1; u16* d2; const f32x2* rope; float sc = 1.f; int csplit = 0, coff1 = 0, coff2 = 0;
  DI void rot(f32x4& v0, f32x4& v1, int row, int col) const {
    const f32x4* cp = (const f32x4*)(rope + (row & 2047) * 32 + ((col & 63) >> 1));
    const f32x4 c01 = cp[0], c23 = cp[1];
    const f32x4 a = {v0[0] * c01[0] - v0[1] * c01[1], v0[1] * c01[0] + v0[0] * c01[1], v0[2] * c01[2] - v0[3] * c01[3], v0[3] * c01[2] + v0[2] * c01[3]};
    const f32x4 b = {v1[0] * c23[0] - v1[1] * c23[1], v1[1] * c23[0] + v1[0] * c23[1], v1[2] * c23[2] - v1[3] * c23[3], v1[3] * c23[2] + v1[2] * c23[3]};
    v0 = a; v1 = b;
  }
  DI void operator()(const f32x4 (&acc)[2][2][4][2], const pg8::Unit& u, int wr, int wc, int fr, int fq) const {
    const int row0 = u.pm * 256 + wr * 64 + fr, colb = u.pn * 256 + wc * 32 + 8 * fq;
#pragma unroll
    for (int ai = 0; ai < 2; ++ai)
#pragma unroll
      for (int m = 0; m < 4; ++m) {
        const int row = row0 + ai * 128 + m * 16;
#pragma unroll
        for (int bj = 0; bj < 2; ++bj) {
          const int col = colb + bj * 128;
          f32x4 v0 = acc[ai][bj][m][0] * sc, v1 = acc[ai][bj][m][1] * sc;
          u16* dst = nullptr;
          if (MODE == 0) { if (col < N) dst = d0 + (size_t)row * ld0 + (col + coff2 + ((col < csplit) ? (coff1 - coff2) : 0)); }
          else if (MODE == 1) {
            const int oc = col + coff2 + ((col < csplit) ? (coff1 - coff2) : 0);
            if (col < N) {
              if (oc < 2048) dst = d0 + (size_t)row * 2048 + oc;
              else if (oc < 2112) { rot(v0, v1, row, oc); dst = d2 + (size_t)row * 64 + (oc - 2048); }
              else dst = d1 + (size_t)row * 4096 + (oc - 2112);
            }
          } else if (MODE == 3) {
            if (col < N) { const bool lo = col < csplit; u16* bp = lo ? d0 : d1; const int ldd = lo ? 2048 : 4096, oc = lo ? col : col + (coff2 - 2112); dst = bp + (size_t)row * ldd + oc + (lo ? coff1 : 0); }
          } else {
            if (((col >> 6) % 3) == 2) rot(v0, v1, row, col);
            dst = d0 + (size_t)row * 3072 + col;
          }
          if (dst) { u32x4 w = {pk2(v0[0], v0[1]), pk2(v0[2], v0[3]), pk2(v1[0], v1[1]), pk2(v1[2], v1[3])}; *(u32x4*)dst = w; }
        }
        asm volatile("" ::: "memory");
      }
  }
};

template <bool FP8 = false, class Epi>
DI void run_gemm(const u16* A, int lda, const u16* Bt, int M, int N, int K, const Epi& e, char* smem) {
  __syncthreads();
  pg8::Gemm g{A, Bt, M, N, K, lda};
  pg8::StaticOrder S; S.init(M, N, gridDim.x, blockIdx.x);
  pg8::gemm_phase<FP8>(( __attribute__((address_space(3))) unsigned char*)smem, g, S, e);
  __syncthreads();
}

typedef __attribute__((address_space(3))) unsigned* lds_u32p;
template <int OFF> DI void rd4(bf16x8 (&f)[4], unsigned addr) {
  asm volatile("ds_read_b128 %0, %4 offset:%5\n\tds_read_b128 %1, %4 offset:%6\n\tds_read_b128 %2, %4 offset:%7\n\tds_read_b128 %3, %4 offset:%8\n\ts_waitcnt lgkmcnt(0)"
               : "=&v"(f[0]), "=&v"(f[1]), "=&v"(f[2]), "=&v"(f[3]) : "v"(addr), "i"(OFF), "i"(OFF + 32), "i"(OFF + 64), "i"(OFF + 96) : "memory");
}
template <int OFF> DI void rdv8(s16x4 (&v)[8], unsigned addr) {
  asm volatile("ds_read_b64_tr_b16 %0, %8 offset:%9\n\tds_read_b64_tr_b16 %1, %8 offset:%10\n\tds_read_b64_tr_b16 %2, %8 offset:%11\n\tds_read_b64_tr_b16 %3, %8 offset:%12\n\t"
               "ds_read_b64_tr_b16 %4, %8 offset:%13\n\tds_read_b64_tr_b16 %5, %8 offset:%14\n\tds_read_b64_tr_b16 %6, %8 offset:%15\n\tds_read_b64_tr_b16 %7, %8 offset:%16\n\ts_waitcnt lgkmcnt(0)"
               : "=&v"(v[0]), "=&v"(v[1]), "=&v"(v[2]), "=&v"(v[3]), "=&v"(v[4]), "=&v"(v[5]), "=&v"(v[6]), "=&v"(v[7])
               : "v"(addr), "i"(OFF), "i"(OFF + 512), "i"(OFF + 1024), "i"(OFF + 1536), "i"(OFF + 2048), "i"(OFF + 2560), "i"(OFF + 3072), "i"(OFF + 3584) : "memory");
}
template <int KSTR, int ND, int N>
DI f32x16 s_block(unsigned kaddr, const bf16x8* qf) {
  const f32x16 z16 = {0.f, 0.f, 0.f, 0.f, 0.f, 0.f, 0.f, 0.f, 0.f, 0.f, 0.f, 0.f, 0.f, 0.f, 0.f, 0.f};
  bf16x8 f[4];
  rd4<N * 32 * KSTR>(f, kaddr);
  f32x16 a = MFMA(f[0], qf[0], z16); a = MFMA(f[1], qf[1], a); a = MFMA(f[2], qf[2], a); a = MFMA(f[3], qf[3], a);
  if constexpr (ND > 4) { rd4<N * 32 * KSTR + 128>(f, kaddr); a = MFMA(f[0], qf[4], a); a = MFMA(f[1], qf[5], a); a = MFMA(f[2], qf[6], a); a = MFMA(f[3], qf[7], a); }
  if constexpr (ND > 8) { rd4<N * 32 * KSTR + 256>(f, kaddr); a = MFMA(f[0], qf[8], a); a = MFMA(f[1], qf[9], a); a = MFMA(f[2], qf[10], a); a = MFMA(f[3], qf[11], a); }
  if constexpr (ND > 12) { rd4<N * 32 * KSTR + 384>(f, kaddr); a = MFMA(f[0], qf[12], a); a = MFMA(f[1], qf[13], a); a = MFMA(f[2], qf[14], a); a = MFMA(f[3], qf[15], a); }
  return a;
}
template <int CB> DI void pv_block(f32x16& o, unsigned vaddr, const bf16x8 (&pb)[2][2]) {
  s16x4 v[8];
  rdv8<CB * 4096>(v, vaddr);
#pragma unroll
  for (int q = 0; q < 4; ++q) {
    const bf16x8 vf = {v[2 * q][0], v[2 * q][1], v[2 * q][2], v[2 * q][3], v[2 * q + 1][0], v[2 * q + 1][1], v[2 * q + 1][2], v[2 * q + 1][3]};
    o = MFMA(vf, pb[q >> 1][q & 1], o);
  }
}
template <int DQK, int W1, int DV, int VW, int MODE>
DI void attn_core(const u16* __restrict__ k1, int ldk1, const u16* __restrict__ k2, int ldk2, const u16* __restrict__ vsrc, int ldv,
                  int kv_len, int kbase0, int ntiles, const u16* qrow, int tq, int tq0, float c2, int vcb0, u16* yrow,
                  const u16* grow, const unsigned* maskrow, const float* lutw, float bias_far, float m_init, float l_init, char* smem) {
  constexpr int KSTR = DQK * 2 + 16, KCH = DQK / 8;
  constexpr int ND = DQK / 16, NCB = DV / 32, BUF = 64 * KSTR + (VW / 32) * 4096;
  constexpr int NKI = KSTR / 16, NVI = VW / 8;
  static_assert(ND % 4 == 0 && NCB <= 4, "fragment batches");
  int tid0 = threadIdx.x; asm volatile("" : "+v"(tid0));
  const int lane = tid0 & 63, r32 = lane & 31, hi = lane >> 5;
  const int wv = __builtin_amdgcn_readfirstlane(tid0 >> 6);
  const unsigned lds0 = (unsigned)(uintptr_t)smem;
  bf16x8 qf[ND];
#pragma unroll
  for (int d0 = 0; d0 < ND; ++d0) qf[d0] = *(const bf16x8*)(qrow + d0 * 16 + hi * 8);
  f32x16 o[NCB];
#pragma unroll
  for (int cb = 0; cb < NCB; ++cb)
#pragma unroll
    for (int r = 0; r < 16; ++r) o[cb][r] = 0.f;
  float m = m_init, l = (hi == 0) ? l_init : 0.f;
  const unsigned klane = (unsigned)(r32 * KSTR + hi * 16);
  const unsigned vlane = (unsigned)(64 * KSTR + vcb0 * 4096 + ((lane >> 4) & 1) * 32 + (lane & 3) * 8 + (4 * hi + ((lane & 15) >> 2)) * 64);
  unsigned mwn[2] = {0u, 0u};
  auto stage_tile = [&](int kb, int buf) {
    int ln = threadIdx.x & 63; asm volatile("" : "+v"(ln));
    const unsigned bofs = (unsigned)(buf * BUF);
#pragma unroll
    for (int ii = 0; ii < (NKI + 7) / 8; ++ii) {
      const int i = wv + 8 * ii;
      if (i < NKI) {
        const int ob = i * 1024 + ln * 16, row = ob / KSTR;
        int c = (ob - row * KSTR) >> 4; c = (c >= KCH) ? 0 : c;
        int key = kb + row; key = key < 0 ? 0 : (key >= kv_len ? kv_len - 1 : key);
        const u16* src = (c < W1 / 8) ? (k1 + (key * ldk1 + c * 8)) : (k2 + (key * ldk2 + (c - W1 / 8) * 8));
        __builtin_amdgcn_global_load_lds((const unsigned*)src, (lds_u32p)(smem + bofs + i * 1024), 16, 0, 0);
      }
    }
#pragma unroll
    for (int ii = 0; ii < (NVI + 7) / 8; ++ii) {
      const int i = wv + 8 * ii;
      if (i < NVI) {
        const int ob = i * 1024 + ln * 16, cbk = ob >> 12, row = (ob & 4095) >> 6, cw = (ob & 63) >> 4;
        int key = kb + row; key = key < 0 ? 0 : (key >= kv_len ? kv_len - 1 : key);
        __builtin_amdgcn_global_load_lds((const unsigned*)(vsrc + (key * ldv + (cbk * 4 + cw) * 8)), (lds_u32p)(smem + bofs + 64 * KSTR + i * 1024), 16, 0, 0);
      }
    }
    if (MODE == 1) { mwn[0] = maskrow[(kb >> 5)]; mwn[1] = maskrow[(kb >> 5) + 1]; }
  };
  stage_tile(kbase0, 0);
  asm volatile("s_waitcnt vmcnt(0)" ::: "memory");
  __syncthreads();
  for (int t = 0; t < ntiles; ++t) {
    const int kb = kbase0 + t * 64;
    const unsigned bufa = lds0 + (unsigned)((t & 1) * BUF);
    const unsigned mw0 = mwn[0], mw1 = mwn[1];
    if (t + 1 < ntiles) stage_tile(kb + 64, (t + 1) & 1);
    if (!(MODE == 0 && kb > tq0 + 31)) {
      f32x16 s[2];
      s[0] = s_block<KSTR, ND, 0>(bufa + klane, qf);
      s[1] = s_block<KSTR, ND, 1>(bufa + klane, qf);
      if (MODE == 0) {
        const bool diag = kb + 63 > tq0;
#pragma unroll
        for (int n = 0; n < 2; ++n)
#pragma unroll
          for (int i = 0; i < 16; ++i) {
            float v = s[n][i] * c2;
            if (diag) { const int key = kb + 32 * n + crow(i, hi); if (key > tq) v = NEGV; }
            s[n][i] = v;
          }
      } else if (MODE == 1) {
        const bool far = (tq0 - (kb + 63)) >= 128;
#pragma unroll
        for (int n = 0; n < 2; ++n) {
          const unsigned wb = (n ? mw1 : mw0) >> (4 * hi);
          if (far) {
#pragma unroll
            for (int i = 0; i < 16; ++i) {
              const float v = fmaf(s[n][i], c2, bias_far);
              s[n][i] = ((wb >> ((i & 3) + 8 * (i >> 2))) & 1u) ? v : NEGV;
            }
          } else {
#pragma unroll
            for (int i = 0; i < 16; ++i) {
              const int key = kb + 32 * n + crow(i, hi);
              int rel = tq - key; rel = rel < 0 ? 0 : (rel > 128 ? 128 : rel);
              const float v = fmaf(s[n][i], c2, lutw[rel]);
              s[n][i] = ((wb >> ((i & 3) + 8 * (i >> 2))) & 1u) ? v : NEGV;
            }
          }
        }
      } else if (MODE == 2) {
#pragma unroll
        for (int n = 0; n < 2; ++n)
#pragma unroll
          for (int i = 0; i < 16; ++i) {
            const int key = kb + 32 * n + crow(i, hi), rel = tq - key;
            const bool ok = ((unsigned)rel < 128u) && (key >= 0);
            const float v = fmaf(s[n][i], c2, lutw[rel & 127]);
            s[n][i] = ok ? v : NEGV;
          }
      } else {
#pragma unroll
        for (int n = 0; n < 2; ++n)
#pragma unroll
          for (int i = 0; i < 16; ++i) s[n][i] *= c2;
      }
      float mx = s[0][0];
#pragma unroll
      for (int i = 1; i < 16; ++i) mx = fmaxf(mx, s[0][i]);
#pragma unroll
      for (int i = 0; i < 16; ++i) mx = fmaxf(mx, s[1][i]);
      mx = xhalf_max(mx);
      if (__any(mx - m > 8.0f)) {
        const float mnew = fmaxf(m, mx), alpha = __builtin_amdgcn_exp2f(m - mnew);
        m = mnew; l *= alpha;
#pragma unroll
        for (int cb = 0; cb < NCB; ++cb)
#pragma unroll
          for (int r = 0; r < 16; ++r) o[cb][r] *= alpha;
      }
      float ps = 0.f;
#pragma unroll
      for (int n = 0; n < 2; ++n)
#pragma unroll
        for (int i = 0; i < 16; ++i) { const float p = __builtin_amdgcn_exp2f(s[n][i] - m); ps += p; s[n][i] = p; }
      l += ps;
      bf16x8 pb[2][2];
#pragma unroll
      for (int n = 0; n < 2; ++n)
#pragma unroll
        for (int s2 = 0; s2 < 2; ++s2) {
          u32x4 pw = {pk2(s[n][8 * s2 + 0], s[n][8 * s2 + 1]), pk2(s[n][8 * s2 + 2], s[n][8 * s2 + 3]),
                      pk2(s[n][8 * s2 + 4], s[n][8 * s2 + 5]), pk2(s[n][8 * s2 + 6], s[n][8 * s2 + 7])};
          pb[n][s2] = __builtin_bit_cast(bf16x8, pw);
        }
      pv_block<0>(o[0], bufa + vlane, pb);
      if constexpr (NCB > 1) pv_block<1>(o[1], bufa + vlane, pb);
      if constexpr (NCB > 2) pv_block<2>(o[2], bufa + vlane, pb);
      if constexpr (NCB > 3) pv_block<3>(o[3], bufa + vlane, pb);
    }
    asm volatile("s_waitcnt vmcnt(0)" ::: "memory");
    __syncthreads();
  }
  const float inv = 1.f / xhalf_sum(l);
#pragma unroll
  for (int cb = 0; cb < NCB; ++cb)
#pragma unroll
    for (int g = 0; g < 4; ++g) {
      const int dv = 32 * cb + 8 * g + 4 * hi;
      const u32x2 gg = *(const u32x2*)(grow + dv);
      float gv[4] = {bf2f(gg[0] & 0xffffu), bf2f(gg[0] >> 16), bf2f(gg[1] & 0xffffu), bf2f(gg[1] >> 16)};
      float ov[4];
#pragma unroll
      for (int j = 0; j < 4; ++j) {
        const float sg = gv[j] / (1.f + __expf(-gv[j]));
        ov[j] = o[cb][4 * g + j] * inv * sg;
      }
      *(unsigned*)((unsigned char*)yrow + dv) = pk4_fp8(ov[0] * Y_SCALE, ov[1] * Y_SCALE, ov[2] * Y_SCALE, ov[3] * Y_SCALE);
      __builtin_amdgcn_sched_barrier(0);
    }
}

DI unsigned ordkey(float f) { const unsigned b = __float_as_uint(f); return b ^ ((unsigned)((int)b >> 31) | 0x80000000u); }
DI void indexer_phase(const u16* __restrict__ P, unsigned* __restrict__ mask) {
  int tidx = threadIdx.x; asm volatile("" : "+v"(tidx));
  const int lane = tidx & 63, r32 = lane & 31, hi = lane >> 5;
  const int gw = blockIdx.x * 8 + (tidx >> 6), nw = gridDim.x * 8;
  for (int item = gw; item < 8192; item += nw) {
    const int b = item & 7, t0 = (1023 - (item >> 3)) * 2;
    const size_t brow = (size_t)b * SEQ;
    const int g = (r32 >> 2) & 1, head = 4 * (r32 >> 3) + (r32 & 3);
    bf16x8 aq[4];
#pragma unroll
    for (int s = 0; s < 4; ++s) aq[s] = *(const bf16x8*)(P + (brow + t0 + g) * 7808 + 2560 + head * 64 + 16 * s + 8 * hi);
    float wv[16];
    {
      const u32x4 w0 = *(const u32x4*)(P + (brow + t0 + hi) * 7808 + 3648), w1 = *(const u32x4*)(P + (brow + t0 + hi) * 7808 + 3656);
#pragma unroll
      for (int j = 0; j < 4; ++j) { wv[2 * j] = bf2f(w0[j] & 0xffffu); wv[2 * j + 1] = bf2f(w0[j] >> 16); wv[8 + 2 * j] = bf2f(w1[j] & 0xffffu); wv[8 + 2 * j + 1] = bf2f(w1[j] >> 16); }
    }
    const int tme = t0 + hi, kbmax = (t0 + 1) >> 5;
    unsigned sc[64];
#pragma unroll
    for (int kb = 0; kb < 64; ++kb) {
      unsigned u = 0u;
      if (kb <= kbmax) {
        f32x16 a;
#pragma unroll
        for (int r = 0; r < 16; ++r) a[r] = 0.f;
        const u16* kp = P + (brow + 32 * kb + r32) * 7808 + 3584 + 8 * hi;
#pragma unroll
        for (int s = 0; s < 4; ++s) { const bf16x8 bk = *(const bf16x8*)(kp + 16 * s); a = MFMA(aq[s], bk, a); }
        float v = 0.f;
#pragma unroll
        for (int i = 0; i < 16; ++i) v = fmaf(wv[i], fmaxf(a[i], 0.f), v);
        u = (32 * kb + r32 <= tme) ? ordkey(v) : 0u;
      }
      sc[kb] = u;
    }
    const int target = (tme + 1 < 256) ? tme + 1 : 256;
    unsigned T = 0u;
    for (int bit = 31; bit >= 0; --bit) {
      const unsigned Tp = T | (1u << bit);
      int cnt = 0;
#pragma unroll
      for (int kb = 0; kb < 64; ++kb) cnt += (sc[kb] >= Tp) ? 1 : 0;
#pragma unroll
      for (int o = 16; o; o >>= 1) cnt += __shfl_xor(cnt, o);
      if (cnt >= target) T = Tp;
    }
    unsigned w0 = 0u, w1 = 0u;
#pragma unroll
    for (int kb = 0; kb < 64; ++kb) {
      const bool pred = (sc[kb] >= T) && (sc[kb] != 0u);
      const unsigned long long bal = __ballot(pred);
      const unsigned wd = (unsigned)(bal >> (32 * hi));
      if ((kb & 31) == r32) { if (kb < 32) w0 = wd; else w1 = wd; }
    }
    mask[(brow + tme) * 64 + r32] = w0;
    mask[(brow + tme) * 64 + 32 + r32] = w1;
  }
}

DI void gbar(unsigned* cnt, unsigned target) {
  asm volatile("s_waitcnt vmcnt(0)" ::: "memory");
  __syncthreads();
  if (threadIdx.x == 0) {
    __builtin_amdgcn_fence(__ATOMIC_RELEASE, "agent");
    asm volatile("s_waitcnt vmcnt(0)" ::: "memory");
    __hip_atomic_fetch_add(cnt, 1u, __ATOMIC_RELAXED, __HIP_MEMORY_SCOPE_AGENT);
    while (__hip_atomic_load(cnt, __ATOMIC_RELAXED, __HIP_MEMORY_SCOPE_AGENT) < target) __builtin_amdgcn_s_sleep(1);
    __builtin_amdgcn_fence(__ATOMIC_ACQUIRE, "agent");
    asm volatile("s_waitcnt vmcnt(0)" ::: "memory");
  }
  __syncthreads();
}
#define GSYNC() do { ++bar_gen; gbar(BAR, bar_gen * gridDim.x); } while (0)
__global__ void __launch_bounds__(512, 2) mega(Params p) {
  cg::grid_group grid = cg::this_grid();
  extern __shared__ __attribute__((aligned(16))) char smem[];
  volatile int* s_item = (volatile int*)(smem + LDS_ITEM);
  char* ws = p.ws;
  unsigned char* Y8 = (unsigned char*)(ws + OFF_Y);
  u16* WIN8 = (u16*)(ws + OFF_WIN + 19922944);
  unsigned char* CQ8 = (unsigned char*)(ws + OFF_Y + 67108864);     u16* H = (u16*)(ws + OFF_H); u16* Cb = (u16*)(ws + OFF_Y); u16* Qb = (u16*)(ws + OFF_H);
  u16* KV = (u16*)(ws + OFF_KV); u16* MG = (u16*)(ws + OFF_MG); u16* KR = (u16*)(ws + OFF_KR); u16* Pb = (u16*)(ws + OFF_P);
  u16* WIN = (u16*)(ws + OFF_WIN); u16* WUQ = (u16*)(ws + OFF_WUQ); u16* WUKV = (u16*)(ws + OFF_WUKV); u16* WOUT = (u16*)(ws + OFF_WOUT);
  u16* WMEMALL = (u16*)(ws + OFF_KV); u16* MEMN = (u16*)(ws + OFF_MEMN); u16* MEMKV = (u16*)(ws + OFF_MEMKV);
  unsigned* MASK = (unsigned*)(ws + OFF_MASK); f32x2* ROPE = (f32x2*)(ws + OFF_ROPE); float* LUT = (float*)(ws + OFF_LUT);
  int* CTR = (int*)(ws + OFF_CTR);
  unsigned* BAR = (unsigned*)(ws + OFF_CTR) + 64;
  unsigned bar_gen = 0;
  const int tid = threadIdx.x, lane = tid & 63, wv = __builtin_amdgcn_readfirstlane(tid >> 6), r32 = lane & 31, hi = lane >> 5;
  const int gtid = blockIdx.x * 512 + tid, gthreads = gridDim.x * 512;

  for (int i = gtid; i < 2048 * 32; i += gthreads) {
    const int pos = i >> 5, j = i & 31;
    const float inv = 1.0f / powf(10000.0f, (float)(2 * j) / 64.0f);
    const float ang = (float)pos * inv;
    const float k = rintf(ang * 0.15915494309189535f);
    float r = fmaf(-k, 6.28318548202514648f, ang);
    r = fmaf(-k, -1.74845553e-7f, r);
    f32x2 cs = {__cosf(r), __sinf(r)};
    ROPE[i] = cs;
  }
  for (int i = gtid; i < 129 * 32; i += gthreads) {
    const int rel = i >> 5, h = i & 31;
    int bucket;
    if (rel < 16) bucket = rel;
    else { const int lg = 16 + (int)(logf((float)rel / 16.0f) / 2.0794415416798357f * 16.0f); bucket = lg < 31 ? lg : 31; }
    LUT[i] = p.rel_bias[bucket * 32 + h] * LOG2E;
  }
  rmsnorm_rows<false>(p.mem, p.mem_norm, MEMN, 2048);
#pragma unroll 1
  for (int l = 0; l < 4; ++l) convert_wt<0>(p.w_mem_kv + (size_t)l * 2048 * 2048, 2048, 2048, 2048, WMEMALL + (size_t)l * 2048 * 2048, smem);

#pragma unroll 1
  for (int layer = 0; layer < 4; ++layer) {
    const int kind = layer % 3, j = layer / 3;
    const float* xin = (layer == 0) ? p.x : p.out;
    unsigned char* H8 = (unsigned char*)(ws + ((kind == 0) ? OFF_KV + 67108864 : OFF_Y));
    rmsnorm_rows<false>(xin, p.norm_in + layer * 2048, H, NTOK, H8);
    if (kind == 0) {
      convert_wt<1>(p.w_in_a + (size_t)j * 2048 * 6208, 2048, 6208, 3840, WIN, smem, 1.f, 3648, 576, 1536, 2560, 512);
      convert_wt<0, true>(p.w_in_a + (size_t)j * 2048 * 6208, 2048, 6208, 2560, WIN8, smem, WIN_SCALE, 2560, 1536, 0, 576);
      convert_wt<2, true>(p.w_uq + (size_t)j * 1536 * 3072, 1536, 3072, 3072, WUQ, smem, WUQ_SCALE);
      convert_wt<0>(p.w_ukv + (size_t)j * 512 * 4096, 512, 4096, 4096, WUKV, smem);
    } else if (kind == 1) {
      convert_wt<0>(p.w_in_b, 2048, 7760, 4864, WIN, smem, 1.f, 4688, 1616, 2048, 3072);
      convert_wt<0, true>(p.w_in_b, 2048, 7760, 3072, WIN8, smem, WIN_SCALE, 3072, 2048, 0, 1616);
    } else {
      convert_wt<0>(p.w_in_c, 2048, 6656, 3584, WIN, smem, 1.f, 3584, 512, 2048, 3072);
      convert_wt<0, true>(p.w_in_c, 2048, 6656, 3072, WIN8, smem, WIN_SCALE, 3072, 2048, 0, 512);
    }
    convert_wt<0, true>(p.w_out + (size_t)layer * 3072 * 2048, 3072, 2048, 2048, WOUT, smem, WOUT_SCALE);
    if (layer == 0) { __builtin_amdgcn_fence(__ATOMIC_RELEASE, "agent"); grid.sync(); __builtin_amdgcn_fence(__ATOMIC_ACQUIRE, "agent"); asm volatile("s_waitcnt vmcnt(0)" ::: "memory"); }
    else GSYNC();

    if (kind == 0) {
      { EpiBf<1> e{Cb, 2048, 3648, MG, KR, ROPE, 1.f, 576, 1536, 2560}; run_gemm(H, 2048, WIN, NTOK, 3840, 2048, e, smem); }
      { EpiBf<3> e{Cb, 2048, 2560, MG, nullptr, nullptr, 1.f / (H_SCALE * WIN_SCALE), 1536, 0, 576}; run_gemm<true>((const u16*)H8, 1024, WIN8, NTOK, 2560, 1024, e, smem); }
    }
    else if (kind == 1) {
      { EpiBf<0> e{Pb, 7808, 4688, nullptr, nullptr, nullptr, 1.f, 1616, 2048, 3072}; run_gemm(H, 2048, WIN, NTOK, 4864, 2048, e, smem); }
      { EpiBf<0> e{Pb, 7808, 3072, nullptr, nullptr, nullptr, 1.f / (H_SCALE * WIN_SCALE), 2048, 0, 1616}; run_gemm<true>((const u16*)H8, 1024, WIN8, NTOK, 3072, 1024, e, smem); }
    } else {
      { EpiBf<0> e{Pb, 6656, 3584, nullptr, nullptr, nullptr, 1.f, 512, 2048, 3072}; run_gemm(H, 2048, WIN, NTOK, 3584, 2048, e, smem); }
      { EpiBf<0> e{Pb, 6656, 3072, nullptr, nullptr, nullptr, 1.f / (H_SCALE * WIN_SCALE), 2048, 0, 512}; run_gemm<true>((const u16*)H8, 1024, WIN8, NTOK, 3072, 1024, e, smem); }
    }
    if (layer == 0) { EpiBf<0> e{MEMKV, 8192, 8192, nullptr, nullptr, nullptr}; run_gemm(MEMN, 2048, WMEMALL, 2048, 8192, 2048, e, smem); }
    GSYNC();

    if (kind == 0) {
      anorm_phase(Cb, p.a_q_norm + j * 1536, p.a_kv_norm + j * 512, CQ8);
      GSYNC();
      { EpiBf<2> e{Qb, 3072, 3072, nullptr, nullptr, ROPE, 1.f / (CQ_SCALE * WUQ_SCALE)}; run_gemm<true>((const u16*)CQ8, 768, WUQ, NTOK, 3072, 768, e, smem); }
      { EpiBf<0> e{KV, 4096, 4096, nullptr, nullptr, nullptr}; run_gemm(Cb + 1536, 2048, WUKV, NTOK, 4096, 512, e, smem); }
      GSYNC();
    } else if (kind == 1) {
      indexer_phase(Pb, MASK);
      GSYNC();
    }

    {
      const int nself = (kind == 0) ? 1024 : 2048, total = nself + 512;
      const u16* mgb = (kind == 0) ? MG : Pb;
      const int ldmg = (kind == 0) ? 4096 : (kind == 1 ? 7808 : 6656);
      const int mqcol = (kind == 0) ? 0 : (kind == 1 ? 3664 : 2560);
      const int gatecol = (kind == 0) ? 1024 : (kind == 1 ? 4688 : 3584);
      const u16* memkv = MEMKV + layer * 2048;
      float* lut_all = (float*)(smem + LDS_LUT);
      if (kind != 0) {
        for (int i = tid; i < 32 * 129; i += 512) { const int h = i / 129, r = i - h * 129; lut_all[h * 132 + r] = LUT[r * 32 + h]; }
      }
      if (tid == 0) s_item[0] = atomicAdd(&CTR[layer], 1);
      __syncthreads();
      for (int par = 0;; par ^= 1) {
        const int item = __builtin_amdgcn_readfirstlane(s_item[par]);
        if (item >= total) break;
        if (tid == 0) s_item[par ^ 1] = atomicAdd(&CTR[layer], 1);
        if (item < nself) {
          if (kind == 0) {
            const int qblk = 7 - item / 128, rem = item % 128, b = rem / 16, head = rem % 16;
            const size_t brow = (size_t)b * SEQ;
            const int tq0 = qblk * 256 + 32 * wv, tq = tq0 + r32;
            attn_core<192, 128, 128, 128, 0>(KV + brow * 4096 + head * 256, 4096, KR + brow * 64, 64, KV + brow * 4096 + head * 256 + 128, 4096,
                                            SEQ, 0, 4 * qblk + 4, Qb + (brow + tq) * 3072 + head * 192, tq, tq0, 0.07216878364870322f * LOG2E, 0,
                                            (u16*)(Y8 + (brow + tq) * 3072 + head * 128), mgb + (brow + tq) * ldmg + gatecol + head * 128,
                                            nullptr, nullptr, 0.f, -1e29f, 0.f, smem);
          } else {
            const int qb = 63 - item / 32, rem = item % 32, b = rem / 4, kvh = rem % 4;
            const size_t brow = (size_t)b * SEQ;
            const int head = kvh * 8 + wv, tq0 = qb * 32, tq = tq0 + r32;
            const float* lutw = lut_all + head * 132;
            if (kind == 1) {
              attn_core<64, 64, 64, 64, 1>(Pb + brow * 7808 + 2048 + kvh * 64, 7808, nullptr, 0, Pb + brow * 7808 + 2304 + kvh * 64, 7808,
                                          SEQ, 0, (tq0 + 31) / 64 + 1, Pb + (brow + tq) * 7808 + head * 64, tq, tq0, 0.125f * LOG2E, 0,
                                          (u16*)(Y8 + (brow + tq) * 3072 + head * 64), Pb + (brow + tq) * 7808 + gatecol + head * 64,
                                          MASK + (brow + tq) * 64, lutw, lutw[128], -1e29f, 0.f, smem);
            } else {
              const float sink = p.c_sinks[j * 32 + head] * LOG2E;
              attn_core<64, 64, 64, 64, 2>(Pb + brow * 6656 + 2048 + kvh * 64, 6656, nullptr, 0, Pb + brow * 6656 + 2304 + kvh * 64, 6656,
                                          SEQ, tq0 - 128, 3, Pb + (brow + tq) * 6656 + head * 64, tq, tq0, 0.125f * LOG2E, 0,
                                          (u16*)(Y8 + (brow + tq) * 3072 + head * 64), Pb + (brow + tq) * 6656 + gatecol + head * 64,
                                          nullptr, lutw, 0.f, sink, 1.f, smem);
            }
          }
        } else {
          const int it = item - nself, b = it / 64, mh = (it % 64) / 16, qb = it % 16;
          const size_t brow = (size_t)b * SEQ;
          const int tq0 = qb * 128 + 32 * (wv >> 1), tq = tq0 + r32, vh = wv & 1;
          attn_core<256, 256, 128, 256, 3>(memkv + (size_t)b * 256 * 8192 + mh * 256, 8192, nullptr, 0, memkv + (size_t)b * 256 * 8192 + 1024 + mh * 256, 8192,
                                          256, 0, 4, mgb + (brow + tq) * ldmg + mqcol + mh * 256, tq, tq0, 0.0625f * LOG2E, 4 * vh,
                                          (u16*)(Y8 + (brow + tq) * 3072 + 2048 + mh * 256 + 128 * vh), mgb + (brow + tq) * ldmg + gatecol + 2048 + mh * 256 + 128 * vh,
                                          nullptr, nullptr, 0.f, -1e29f, 0.f, smem);
        }
      }
    }
    GSYNC();

    { EpiResid e{xin, p.out, 1.f / (Y_SCALE * WOUT_SCALE)}; run_gemm<true>((const u16*)Y8, 1536, WOUT, NTOK, 2048, 1536, e, smem); }
    GSYNC();
  }
  rmsnorm_rows<true>(p.out, p.final_norm, p.out, NTOK);
}

extern "C" void kernel_launch(void* const* d_in, const int* in_sizes, int n_in, void* d_out, int out_size,
                              void* d_ws, size_t ws_size, hipStream_t stream) {
  static int grid_blocks = 0;
  if (!grid_blocks) {
    int dev = 0, cus = 0, per_cu = 0;
    (void)hipGetDevice(&dev);
    (void)hipDeviceGetAttribute(&cus, hipDeviceAttributeMultiprocessorCount, dev);
    (void)hipFuncSetAttribute((const void*)mega, hipFuncAttributeMaxDynamicSharedMemorySize, LDS_BYTES);
    (void)hipOccupancyMaxActiveBlocksPerMultiprocessor(&per_cu, mega, 512, LDS_BYTES);
    if (per_cu > 1) per_cu = 1;
    grid_blocks = cus * per_cu;
  }
  Params p{};
  p.x = (const float*)d_in[0]; p.mem = (const float*)d_in[1]; p.norm_in = (const float*)d_in[2]; p.final_norm = (const float*)d_in[3];
  p.mem_norm = (const float*)d_in[4]; p.rel_bias = (const float*)d_in[5]; p.w_in_a = (const float*)d_in[6]; p.a_q_norm = (const float*)d_in[7];
  p.w_uq = (const float*)d_in[8]; p.a_kv_norm = (const float*)d_in[9]; p.w_ukv = (const float*)d_in[10]; p.w_in_b = (const float*)d_in[11];
  p.w_in_c = (const float*)d_in[12]; p.c_sinks = (const float*)d_in[13]; p.w_mem_kv = (const float*)d_in[14]; p.w_out = (const float*)d_in[15];
  p.out = (float*)d_out; p.ws = (char*)d_ws;
  (void)hipMemsetAsync((char*)d_ws + OFF_CTR, 0, 1024, stream);
  void* args[] = {&p};
  (void)hipLaunchCooperativeKernel((void*)mega, dim3(grid_blocks), dim3(512), args, LDS_BYTES, stream);
}
```

```cpp
#include <hip/hip_runtime.h>
#include <hip/hip_cooperative_groups.h>
#include <stdint.h>
namespace cg = cooperative_groups;

typedef unsigned short u16;
typedef __attribute__((ext_vector_type(8))) short bf16x8;
typedef __attribute__((ext_vector_type(4))) short s16x4;
typedef __attribute__((ext_vector_type(16))) float f32x16;
typedef __attribute__((ext_vector_type(4))) float f32x4;
typedef __attribute__((ext_vector_type(2))) float f32x2;
typedef __attribute__((ext_vector_type(4))) unsigned u32x4;
typedef __attribute__((ext_vector_type(2))) unsigned u32x2;
typedef __attribute__((ext_vector_type(2))) __bf16 bf16x2_t;
typedef short v4i16_t __attribute__((ext_vector_type(4)));
#define DI __device__ __forceinline__
#define MFMA(a, b, c) __builtin_amdgcn_mfma_f32_32x32x16_bf16((a), (b), (c), 0, 0, 0)

constexpr int SEQ = 2048, NTOK = 16384;
constexpr int LDS_LUT = 133120, LDS_ITEM = LDS_LUT + 32 * 528, LDS_BYTES = LDS_ITEM + 64;
constexpr float LOG2E = 1.4426950408889634f;
constexpr float NEGV = -1e30f;
constexpr float Y_SCALE = 16.f, WOUT_SCALE = 256.f, CQ_SCALE = 16.f, WUQ_SCALE = 256.f, H_SCALE = 16.f, WIN_SCALE = 256.f;

constexpr size_t OFF_Y = 0;
constexpr size_t OFF_H = 100663296;
constexpr size_t OFF_KV = 201326592;
constexpr size_t OFF_MG = 335544320;
constexpr size_t OFF_KR = 469762048;
constexpr size_t OFF_P = 167772160;
constexpr size_t OFF_WIN = 471859200;
constexpr size_t OFF_WUQ = OFF_WIN + 32505856;
constexpr size_t OFF_WUKV = OFF_WUQ + 9437184;
constexpr size_t OFF_WOUT = OFF_WUKV + 4194304;
constexpr size_t OFF_MEMN = OFF_WOUT + 12582912;
constexpr size_t OFF_MEMKV = OFF_MEMN + 8388608;
constexpr size_t OFF_MASK = OFF_MEMKV + 33554432;
constexpr size_t OFF_ROPE = OFF_MASK + 4194304;
constexpr size_t OFF_LUT = OFF_ROPE + 524288;
constexpr size_t OFF_CTR = OFF_LUT + 32768;

struct Params {
  const float *x, *mem, *norm_in, *final_norm, *mem_norm, *rel_bias, *w_in_a, *a_q_norm, *w_uq, *a_kv_norm, *w_ukv,
      *w_in_b, *w_in_c, *c_sinks, *w_mem_kv, *w_out;
  float* out;
  char* ws;
};

DI float bf2f(unsigned b) { return __uint_as_float(b << 16); }
DI unsigned pk2(float a, float b) {
  f32x2 v = {a, b};
  return __builtin_bit_cast(unsigned, __builtin_convertvector(v, bf16x2_t));
}
DI float clamp8(float x) { return fminf(fmaxf(x, -448.f), 448.f); }
DI unsigned pk4_fp8(float a, float b, float c, float d) {
  int w = 0;
  w = __builtin_amdgcn_cvt_pk_fp8_f32(clamp8(a), clamp8(b), w, false);
  w = __builtin_amdgcn_cvt_pk_fp8_f32(clamp8(c), clamp8(d), w, true);
  return (unsigned)w;
}
DI u16 f2bf(float a) { return (u16)(pk2(a, 0.f) & 0xffffu); }
DI float wave_sum(float v) {
#pragma unroll
  for (int o = 32; o; o >>= 1) v += __shfl_xor(v, o);
  return v;
}
DI int crow(int reg, int hi) { return (reg & 3) + 8 * (reg >> 2) + 4 * hi; }
DI float xhalf_max(float m) {
  auto rr = __builtin_amdgcn_permlane32_swap(__float_as_uint(m), __float_as_uint(m), false, false);
  return fmaxf(__uint_as_float(rr[0]), __uint_as_float(rr[1]));
}
DI float xhalf_sum(float m) {
  auto rr = __builtin_amdgcn_permlane32_swap(__float_as_uint(m), __float_as_uint(m), false, false);
  return __uint_as_float(rr[0]) + __uint_as_float(rr[1]);
}
typedef __attribute__((address_space(3))) v4i16_t* lds_v4p;
DI s16x4 vtr(const char* p) {
  return __builtin_bit_cast(s16x4, __builtin_amdgcn_ds_read_tr16_b64_v4i16((lds_v4p)(p)));
}

template <int PERM, bool FP8 = false>
DI void convert_wt(const float* __restrict__ W, int K, int N, int Npad, u16* __restrict__ Wt, char* smem, float wscale = 1.f,
                   int nvalid = -1, int csplit = 0, int coff1 = 0, int coff2 = 0, int rot_n0 = 2048) {
  float* tile = (float*)smem;
  int tid = threadIdx.x; asm volatile("" : "+v"(tid));
  const int ntk = K / 64, ntn = Npad / 64;
  for (int t = blockIdx.x; t < ntk * ntn; t += gridDim.x) {
    const int tk = t % ntk, tn = t / ntk, k0 = tk * 64, n0 = tn * 64;
    __syncthreads();
#pragma unroll
    for (int i = 0; i < 2; ++i) {
      const int id = tid + 512 * i, kr = id >> 4, n4 = (id & 15) * 4;
      f32x4 v = {0.f, 0.f, 0.f, 0.f};
      const int nd = n0 + n4, nsrc = (nvalid < 0) ? nd : (nd < csplit ? nd + coff1 : nd + coff2);
      if (nd < ((nvalid < 0) ? N : nvalid)) v = *(const f32x4*)(W + (size_t)(k0 + kr) * N + nsrc);
      tile[kr * 65 + n4 + 0] = v[0]; tile[kr * 65 + n4 + 1] = v[1]; tile[kr * 65 + n4 + 2] = v[2]; tile[kr * 65 + n4 + 3] = v[3];
    }
    __syncthreads();
    {
      const int n = tid >> 3, c = tid & 7;
      bool rot = false;
      if (PERM == 1) rot = (n0 == rot_n0);
      if (PERM == 2) rot = ((tn % 3) == 2);
      const int ns = rot ? ((n >> 1) + 32 * (n & 1)) : n;
      if (FP8) {
        float f[8];
#pragma unroll
        for (int j = 0; j < 8; ++j) f[j] = tile[(c * 8 + j) * 65 + ns] * wscale;
        u32x2 o = {pk4_fp8(f[0], f[1], f[2], f[3]), pk4_fp8(f[4], f[5], f[6], f[7])};
        *(u32x2*)((unsigned char*)Wt + (size_t)(n0 + n) * K + k0 + c * 8) = o;
      } else {
        u32x4 o;
#pragma unroll
        for (int j = 0; j < 4; ++j) o[j] = pk2(tile[(c * 8 + 2 * j) * 65 + ns], tile[(c * 8 + 2 * j + 1) * 65 + ns]);
        *(u32x4*)(Wt + (size_t)(n0 + n) * K + k0 + c * 8) = o;
      }
    }
  }
}

template <bool F32OUT>
DI void rmsnorm_rows(const float* X, const float* __restrict__ g, void* outp, int nrows, unsigned char* __restrict__ out8 = nullptr) {
  int tidx = threadIdx.x; asm volatile("" : "+v"(tidx));
  const int lane = tidx & 63, gw = blockIdx.x * 8 + (tidx >> 6), nw = gridDim.x * 8;
  for (int row = gw; row < nrows; row += nw) {
    const f32x4* xr = (const f32x4*)(X + (size_t)row * 2048);
    f32x4 v[8];
    float ss = 0.f;
#pragma unroll
    for (int i = 0; i < 8; ++i) { v[i] = xr[lane + 64 * i]; ss += v[i][0] * v[i][0] + v[i][1] * v[i][1] + v[i][2] * v[i][2] + v[i][3] * v[i][3]; }
    ss = wave_sum(ss);
    const float r = rsqrtf(ss * (1.f / 2048.f) + 1e-6f);
#pragma unroll
    for (int i = 0; i < 8; ++i) {
      const f32x4 gg = ((const f32x4*)g)[lane + 64 * i];
      f32x4 o = {v[i][0] * r * gg[0], v[i][1] * r * gg[1], v[i][2] * r * gg[2], v[i][3] * r * gg[3]};
      if (F32OUT) ((f32x4*)((float*)outp + (size_t)row * 2048))[lane + 64 * i] = o;
      else { u32x2 pk = {pk2(o[0], o[1]), pk2(o[2], o[3])}; ((u32x2*)((u16*)outp + (size_t)row * 2048))[lane + 64 * i] = pk; }
      if (!F32OUT && out8) ((unsigned*)(out8 + (size_t)row * 2048))[lane + 64 * i] = pk4_fp8(o[0] * H_SCALE, o[1] * H_SCALE, o[2] * H_SCALE, o[3] * H_SCALE);
    }
  }
}

DI void anorm_phase(u16* C, const float* __restrict__ gq, const float* __restrict__ gkv, unsigned char* __restrict__ cq8) {
  int tidx = threadIdx.x; asm volatile("" : "+v"(tidx));
  const int lane = tidx & 63, gw = blockIdx.x * 8 + (tidx >> 6), nw = gridDim.x * 8;
  for (int row = gw; row < NTOK; row += nw) {
    u32x4* cr = (u32x4*)(C + (size_t)row * 2048);
    u32x4 v[4];
    float sq = 0.f, skv = 0.f;
#pragma unroll
    for (int i = 0; i < 4; ++i) {
      v[i] = cr[lane + 64 * i];
      float s = 0.f;
#pragma unroll
      for (int j = 0; j < 4; ++j) { float a = bf2f(v[i][j] & 0xffffu), b = bf2f(v[i][j] >> 16); s += a * a + b * b; }
      if (i < 3) sq += s; else skv += s;
    }
    sq = wave_sum(sq); skv = wave_sum(skv);
    const float rq = rsqrtf(sq * (1.f / 1536.f) + 1e-6f), rkv = rsqrtf(skv * (1.f / 512.f) + 1e-6f);
#pragma unroll
    for (int i = 0; i < 4; ++i) {
      const int col = (lane + 64 * i) * 8;
      const float* gp = (i < 3) ? (gq + col) : (gkv + col - 1536);
      const float r = (i < 3) ? rq : rkv;
      const f32x4 g0 = *(const f32x4*)gp, g1 = *(const f32x4*)(gp + 4);
      u32x4 o;
      o[0] = pk2(bf2f(v[i][0] & 0xffffu) * r * g0[0], bf2f(v[i][0] >> 16) * r * g0[1]);
      o[1] = pk2(bf2f(v[i][1] & 0xffffu) * r * g0[2], bf2f(v[i][1] >> 16) * r * g0[3]);
      o[2] = pk2(bf2f(v[i][2] & 0xffffu) * r * g1[0], bf2f(v[i][2] >> 16) * r * g1[1]);
      o[3] = pk2(bf2f(v[i][3] & 0xffffu) * r * g1[2], bf2f(v[i][3] >> 16) * r * g1[3]);
      cr[lane + 64 * i] = o;
      if (i < 3) {
        const float q0 = bf2f(v[i][0] & 0xffffu) * r * g0[0] * CQ_SCALE, q1 = bf2f(v[i][0] >> 16) * r * g0[1] * CQ_SCALE;
        const float q2 = bf2f(v[i][1] & 0xffffu) * r * g0[2] * CQ_SCALE, q3 = bf2f(v[i][1] >> 16) * r * g0[3] * CQ_SCALE;
        const float q4 = bf2f(v[i][2] & 0xffffu) * r * g1[0] * CQ_SCALE, q5 = bf2f(v[i][2] >> 16) * r * g1[1] * CQ_SCALE;
        const float q6 = bf2f(v[i][3] & 0xffffu) * r * g1[2] * CQ_SCALE, q7 = bf2f(v[i][3] >> 16) * r * g1[3] * CQ_SCALE;
        u32x2 w8 = {pk4_fp8(q0, q1, q2, q3), pk4_fp8(q4, q5, q6, q7)};
        *(u32x2*)(cq8 + (size_t)row * 1536 + col) = w8;
      }
    }
  }
}

namespace pg8 {
#define PG8_LAS __attribute__((address_space(3)))
constexpr int BM = 256, BK = 64, HALF = 128, HTB = HALF * BK * 2, STAGE_BYTES = 8 * HTB, NXCD = 8, WGM = 8;
DI int lds_byte(int r, int c) { const int st = (r >> 4) * 2 + (c >> 5), rr = r & 15, cc = c & 31, ob = rr * 64 + cc * 2; return st * 1024 + (ob ^ (((ob >> 9) & 1) << 5)); }
DI void stage_rc(int b, int& R, int& C) { const int st = b / 1024, sb = b % 1024, swz = sb ^ (((sb >> 9) & 1) << 5); R = (st >> 1) * 16 + swz / 64; C = (st & 1) * 32 + (swz % 64) / 2; }
DI int perm32(int rho) { const int n = rho >> 4, i = rho & 15; return 8 * (i >> 2) + 4 * n + (i & 3); }
typedef int i32x4v __attribute__((ext_vector_type(4)));
typedef int i32x8 __attribute__((ext_vector_type(8)));
DI i32x8 cat8(bf16x8 a, bf16x8 b) { const i32x4v x = __builtin_bit_cast(i32x4v, a), y = __builtin_bit_cast(i32x4v, b); return __builtin_shufflevector(x, y, 0, 1, 2, 3, 4, 5, 6, 7); }
struct Unit { int pm, pn; };
struct Gemm { const u16* A; const u16* Bt; int M, N, K, lda; };
struct StaticOrder {
  int nM, nN, nwg, G, c;
  DI void init(int M, int N, int G_, int c_) { nM = M / BM; nN = N / BM; nwg = nM * nN; G = G_; c = c_; }
  DI bool next(int i, Unit& u) const {
    const long L = (long)i * G + c; if (L >= nwg) return false;
    int wgid = (int)L; { const int q = nwg / NXCD, r = nwg % NXCD, xcd = wgid % NXCD, off = wgid / NXCD; wgid = (xcd < r ? xcd * (q + 1) : r * (q + 1) + (xcd - r) * q) + off; }
    const int nig = WGM * nN, gid = wgid / nig, fm = gid * WGM, gsz = (nM - fm) < WGM ? (nM - fm) : WGM;
    u.pm = fm + ((wgid % nig) % gsz); u.pn = (wgid % nig) / gsz; return true;
  }
  DI void a_ready(const Unit&) const {}
  DI void done(const Unit&) const {}
};
template <bool FP8, class Epi, class Sched>
__device__ __forceinline__ void gemm_phase(PG8_LAS unsigned char* lds, const Gemm g, const Sched& S, const Epi& E) {
    int tid = threadIdx.x; asm volatile("" : "+v"(tid));
    const int wid = __builtin_amdgcn_readfirstlane(tid >> 6), lane = tid & 63, wr = wid >> 2, wc = wid & 3, fr = lane & 15, fq = lane >> 4;
    const int K = g.K, nt = K / BK;
    unsigned voffA[2], voffB[2];
#pragma unroll
    for (int i = 0; i < 2; ++i) { int R, C; stage_rc(tid * 16 + i * 8192, R, C); const int Rb = Epi::PERM ? ((R & ~31) + perm32(R & 31)) : R;
        voffA[i] = (unsigned)(R * g.lda + C) * 2u; voffB[i] = (unsigned)(Rb * K + C) * 2u; }
    const size_t kstep = (size_t)(BK * 2);
    const size_t hstep = (size_t)HALF * K * 2, hstepA = (size_t)HALF * g.lda * 2;
    const size_t tstep = 2 * hstep, tstepA = 2 * hstepA;
    const unsigned ldsw = (unsigned)wid * 1024u;
    const int aoff = lds_byte(wr * 64 + fr, fq * 8), boff = lds_byte(wc * 32 + fr, fq * 8);
#define PG8_SA(b, h) (((b) * 2 + (h)) * HTB)
#define PG8_SB(b, h) ((4 + (b) * 2 + (h)) * HTB)
#define PG8_STAGE(bufoff, gbase, voff) do { _Pragma("unroll") for (int _i = 0; _i < 2; ++_i) \
        __builtin_amdgcn_global_load_lds((const unsigned*)((const char*)(gbase) + (voff)[_i]), (PG8_LAS unsigned*)(lds + (bufoff) + ldsw + _i * 8192), 16, 0, 0); } while (0)
#define PG8_LDA(dst, b, h) do { _Pragma("unroll") for (int m = 0; m < 4; ++m) _Pragma("unroll") for (int k = 0; k < 2; ++k) dst[m][k] = *(const PG8_LAS bf16x8*)(lds + PG8_SA(b, h) + aoff + m * 2048 + k * 1024); } while (0)
#define PG8_LDB(dst, b, h) do { _Pragma("unroll") for (int n = 0; n < 2; ++n) _Pragma("unroll") for (int k = 0; k < 2; ++k) dst[n][k] = *(const PG8_LAS bf16x8*)(lds + PG8_SB(b, h) + boff + n * 2048 + k * 1024); } while (0)
#define PG8_MMA(ai, bj, At, Bt) do { __builtin_amdgcn_s_setprio(1); _Pragma("unroll") for (int m = 0; m < 4; ++m) _Pragma("unroll") for (int n = 0; n < 2; ++n) { \
        if constexpr (FP8) { const i32x8 bv_ = cat8(Bt[n][0], Bt[n][1]), av_ = cat8(At[m][0], At[m][1]); \
            asm volatile("s_nop 1\n\tv_mfma_scale_f32_16x16x128_f8f6f4 %0, %1, %2, %0, %3, %3 op_sel_hi:[0,0,0]" : "+v"(acc[ai][bj][m][n]) : "v"(bv_), "v"(av_), "v"(sc127)); } \
        else { _Pragma("unroll") for (int k = 0; k < 2; ++k) acc[ai][bj][m][n] = __builtin_amdgcn_mfma_f32_16x16x32_bf16(Bt[n][k], At[m][k], acc[ai][bj][m][n], 0, 0, 0); } } \
        __builtin_amdgcn_s_setprio(0); } while (0)
#define PG8_WAIT_V(n) asm volatile("s_waitcnt vmcnt(" #n ")" ::: "memory")
#define PG8_WAIT_L(n) asm volatile("s_waitcnt lgkmcnt(" #n ")" ::: "memory")
#define PG8_BAR __builtin_amdgcn_s_barrier()
#define PG8_SCHED __builtin_amdgcn_sched_barrier(0)
    Unit cur, nxt; int ui = 0;
    if (!S.next(0, cur)) return;
    f32x4 acc[2][2][4][2];
#pragma unroll
    for (int a = 0; a < 2; ++a)
#pragma unroll
        for (int b = 0; b < 2; ++b)
#pragma unroll
            for (int m = 0; m < 4; ++m)
#pragma unroll
                for (int n = 0; n < 2; ++n) acc[a][b][m][n] = (f32x4){0.f, 0.f, 0.f, 0.f};
    bf16x8 At[4][2], B0[2][2], B1[2][2];
    int sc127 = 0x7F7F7F7F; asm volatile("" : "+v"(sc127));
    const char* cA = (const char*)g.A + (size_t)cur.pm * tstepA; const char* cB = (const char*)g.Bt + (size_t)cur.pn * tstep;
    S.a_ready(cur);
    PG8_STAGE(PG8_SB(0, 0), cB, voffB); PG8_STAGE(PG8_SA(0, 0), cA, voffA); PG8_STAGE(PG8_SB(0, 1), cB + hstep, voffB); PG8_STAGE(PG8_SA(0, 1), cA + hstepA, voffA);
    if (wr == 1) PG8_BAR;
    PG8_WAIT_V(4); PG8_BAR;
    PG8_STAGE(PG8_SB(1, 0), cB + kstep, voffB); PG8_STAGE(PG8_SA(1, 0), cA + kstep, voffA); PG8_STAGE(PG8_SB(1, 1), cB + hstep + kstep, voffB);
    PG8_WAIT_V(6); PG8_BAR;
    for (;;) {
        const bool has_next = S.next(ui + 1, nxt);
        const char* nA = has_next ? (const char*)g.A + (size_t)nxt.pm * tstepA : cA; const char* nB = has_next ? (const char*)g.Bt + (size_t)nxt.pn * tstep : cB;
        for (int t = 0; t < nt; t += 2) {
            const bool last = (t == nt - 2);
            const char* a1 = cA + (size_t)(t + 1) * kstep;
            const char* a2 = last ? nA : cA + (size_t)(t + 2) * kstep; const char* b2 = last ? nB : cB + (size_t)(t + 2) * kstep;
            const char* a3 = a2 + kstep; const char* b3 = b2 + kstep;
            if (last && has_next) S.a_ready(nxt);
            PG8_LDB(B0, 0, 0); PG8_SCHED; PG8_LDA(At, 0, 0); PG8_STAGE(PG8_SA(1, 1), a1 + hstepA, voffA);
            PG8_WAIT_L(8); PG8_BAR; PG8_WAIT_L(0); PG8_MMA(0, 0, At, B0); PG8_BAR; PG8_SCHED;
            PG8_LDB(B1, 0, 1); PG8_STAGE(PG8_SB(0, 0), b2, voffB);
            PG8_BAR; PG8_WAIT_L(0); PG8_MMA(0, 1, At, B1); PG8_BAR;
            PG8_LDA(At, 0, 1); PG8_STAGE(PG8_SA(0, 0), a2, voffA);
            PG8_BAR; PG8_WAIT_L(0); PG8_MMA(1, 0, At, B0); PG8_BAR; PG8_SCHED;
            PG8_STAGE(PG8_SB(0, 1), b2 + hstep, voffB);
            PG8_WAIT_V(6); PG8_BAR; PG8_MMA(1, 1, At, B1); PG8_BAR;
            PG8_LDB(B0, 1, 0); PG8_SCHED; PG8_LDA(At, 1, 0); PG8_STAGE(PG8_SA(0, 1), a2 + hstepA, voffA);
            PG8_WAIT_L(8); PG8_BAR; PG8_WAIT_L(0); PG8_MMA(0, 0, At, B0); PG8_BAR; PG8_SCHED;
            PG8_LDB(B1, 1, 1); PG8_STAGE(PG8_SB(1, 0), b3, voffB);
            PG8_BAR; PG8_WAIT_L(0); PG8_MMA(0, 1, At, B1); PG8_BAR;
            PG8_LDA(At, 1, 1); PG8_STAGE(PG8_SA(1, 0), a3, voffA);
            PG8_BAR; PG8_WAIT_L(0); PG8_MMA(1, 0, At, B0); PG8_BAR; PG8_SCHED;
            PG8_STAGE(PG8_SB(1, 1), b3 + hstep, voffB);
            PG8_WAIT_V(6); PG8_BAR; PG8_MMA(1, 1, At, B1); PG8_BAR;
        }
        if constexpr (FP8) asm volatile("s_nop 15\n\ts_nop 15" ::: "memory");
        if constexpr (!Epi::AFTER_DRAIN) { E(acc, cur, wr, wc, fr, fq); S.done(cur); }
        if (!has_next) break;
#pragma unroll
        for (int a = 0; a < 2; ++a)
#pragma unroll
            for (int b = 0; b < 2; ++b)
#pragma unroll
                for (int m = 0; m < 4; ++m)
#pragma unroll
                    for (int n = 0; n < 2; ++n) acc[a][b][m][n] = (f32x4){0.f, 0.f, 0.f, 0.f};
        cur = nxt; cA = nA; cB = nB; ++ui;
    }
    PG8_WAIT_V(0);
    if (wr == 0) PG8_BAR;
    PG8_BAR;
    if constexpr (Epi::AFTER_DRAIN) { E.fused(acc, cur, wr, wc, fr, fq, lds, wid, lane); S.done(cur); }
#undef PG8_SA
#undef PG8_SB
#undef PG8_STAGE
#undef PG8_LDA
#undef PG8_LDB
#undef PG8_MMA
#undef PG8_WAIT_V
#undef PG8_WAIT_L
#undef PG8_BAR
#undef PG8_SCHED
}

}

struct EpiResid {
  static constexpr bool PERM = false, AFTER_DRAIN = false;
  const float* xin; float* xout; float sc;
  DI void operator()(const f32x4 (&acc)[2][2][4][2], const pg8::Unit& u, int wr, int wc, int fr, int fq) const {
    const int row0 = u.pm * 256 + wr * 64 + fr, col0 = u.pn * 256 + wc * 32 + 4 * fq;
#pragma unroll
    for (int ai = 0; ai < 2; ++ai)
#pragma unroll
      for (int m = 0; m < 4; ++m) {
        const size_t ro = (size_t)(row0 + ai * 128 + m * 16) * 2048 + col0;
#pragma unroll
        for (int bj = 0; bj < 2; ++bj)
#pragma unroll
          for (int n = 0; n < 2; ++n) {
            const size_t o = ro + bj * 128 + n * 16;
            const f32x4 xv = *(const f32x4*)(xin + o);
            *(f32x4*)(xout + o) = xv + acc[ai][bj][m][n] * sc;
          }
        asm volatile("" ::: "memory");
      }
  }
};
template <int MODE>
struct EpiBf {
  static constexpr bool PERM = true, AFTER_DRAIN = false;
  u16* d0; int ld0; int N; u16* d1; u16* d2; const f32x2* rope; float sc = 1.f; int csplit = 0, coff1 = 0, coff2 = 0;
  DI void rot(f32x4& v0, f32x4& v1, int row, int col) const {
    const f32x4* cp = (const f32x4*)(rope + (row & 2047) * 32 + ((col & 63) >> 1));
    const f32x4 c01 = cp[0], c23 = cp[1];
    const f32x4 a = {v0[0] * c01[0] - v0[1] * c01[1], v0[1] * c01[0] + v0[0] * c01[1], v0[2] * c01[2] - v0[3] * c01[3], v0[3] * c01[2] + v0[2] * c01[3]};
    const f32x4 b = {v1[0] * c23[0] - v1[1] * c23[1], v1[1] * c23[0] + v1[0] * c23[1], v1[2] * c23[2] - v1[3] * c23[3], v1[3] * c23[2] + v1[2] * c23[3]};
    v0 = a; v1 = b;
  }
  DI void operator()(const f32x4 (&acc)[2][2][4][2], const pg8::Unit& u, int wr, int wc, int fr, int fq) const {
    const int row0 = u.pm * 256 + wr * 64 + fr, colb = u.pn * 256 + wc * 32 + 8 * fq;
#pragma unroll
    for (int ai = 0; ai < 2; ++ai)
#pragma unroll
      for (int m = 0; m < 4; ++m) {
        const int row = row0 + ai * 128 + m * 16;
#pragma unroll
        for (int bj = 0; bj < 2; ++bj) {
          const int col = colb + bj * 128;
          f32x4 v0 = acc[ai][bj][m][0] * sc, v1 = acc[ai][bj][m][1] * sc;
          u16* dst = nullptr;
          if (MODE == 0) { if (col < N) dst = d0 + (size_t)row * ld0 + (col + coff2 + ((col < csplit) ? (coff1 - coff2) : 0)); }
          else if (MODE == 1) {
            const int oc = col + coff2 + ((col < csplit) ? (coff1 - coff2) : 0);
            if (col < N) {
              if (oc < 2048) dst = d0 + (size_t)row * 2048 + oc;
              else if (oc < 2112) { rot(v0, v1, row, oc); dst = d2 + (size_t)row * 64 + (oc - 2048); }
              else dst = d1 + (size_t)row * 4096 + (oc - 2112);
            }
          } else if (MODE == 3) {
            if (col < N) { const bool lo = col < csplit; u16* bp = lo ? d0 : d1; const int ldd = lo ? 2048 : 4096, oc = lo ? col : col + (coff2 - 2112); dst = bp + (size_t)row * ldd + oc + (lo ? coff1 : 0); }
          } else {
            if (((col >> 6) % 3) == 2) rot(v0, v1, row, col);
            dst = d0 + (size_t)row * 3072 + col;
          }
          if (dst) { u32x4 w = {pk2(v0[0], v0[1]), pk2(v0[2], v0[3]), pk2(v1[0], v1[1]), pk2(v1[2], v1[3])}; *(u32x4*)dst = w; }
        }
        asm volatile("" ::: "memory");
      }
  }
};

template <bool FP8 = false, class Epi>
DI void run_gemm(const u16* A, int lda, const u16* Bt, int M, int N, int K, const Epi& e, char* smem) {
  __syncthreads();
  pg8::Gemm g{A, Bt, M, N, K, lda};
  pg8::StaticOrder S; S.init(M, N, gridDim.x, blockIdx.x);
  pg8::gemm_phase<FP8>(( __attribute__((address_space(3))) unsigned char*)smem, g, S, e);
  __syncthreads();
}

typedef __attribute__((address_space(3))) unsigned* lds_u32p;
template <int OFF> DI void rd4(bf16x8 (&f)[4], unsigned addr) {
  asm volatile("ds_read_b128 %0, %4 offset:%5\n\tds_read_b128 %1, %4 offset:%6\n\tds_read_b128 %2, %4 offset:%7\n\tds_read_b128 %3, %4 offset:%8\n\ts_waitcnt lgkmcnt(0)"
               : "=&v"(f[0]), "=&v"(f[1]), "=&v"(f[2]), "=&v"(f[3]) : "v"(addr), "i"(OFF), "i"(OFF + 32), "i"(OFF + 64), "i"(OFF + 96) : "memory");
}
template <int OFF> DI void rdv8(s16x4 (&v)[8], unsigned addr) {
  asm volatile("ds_read_b64_tr_b16 %0, %8 offset:%9\n\tds_read_b64_tr_b16 %1, %8 offset:%10\n\tds_read_b64_tr_b16 %2, %8 offset:%11\n\tds_read_b64_tr_b16 %3, %8 offset:%12\n\t"
               "ds_read_b64_tr_b16 %4, %8 offset:%13\n\tds_read_b64_tr_b16 %5, %8 offset:%14\n\tds_read_b64_tr_b16 %6, %8 offset:%15\n\tds_read_b64_tr_b16 %7, %8 offset:%16\n\ts_waitcnt lgkmcnt(0)"
               : "=&v"(v[0]), "=&v"(v[1]), "=&v"(v[2]), "=&v"(v[3]), "=&v"(v[4]), "=&v"(v[5]), "=&v"(v[6]), "=&v"(v[7])
               : "v"(addr), "i"(OFF), "i"(OFF + 512), "i"(OFF + 1024), "i"(OFF + 1536), "i"(OFF + 2048), "i"(OFF + 2560), "i"(OFF + 3072), "i"(OFF + 3584) : "memory");
}
template <int KSTR, int ND, int N>
DI f32x16 s_block(unsigned kaddr, const bf16x8* qf) {
  const f32x16 z16 = {0.f, 0.f, 0.f, 0.f, 0.f, 0.f, 0.f, 0.f, 0.f, 0.f, 0.f, 0.f, 0.f, 0.f, 0.f, 0.f};
  bf16x8 f[4];
  rd4<N * 32 * KSTR>(f, kaddr);
  f32x16 a = MFMA(f[0], qf[0], z16); a = MFMA(f[1], qf[1], a); a = MFMA(f[2], qf[2], a); a = MFMA(f[3], qf[3], a);
  if constexpr (ND > 4) { rd4<N * 32 * KSTR + 128>(f, kaddr); a = MFMA(f[0], qf[4], a); a = MFMA(f[1], qf[5], a); a = MFMA(f[2], qf[6], a); a = MFMA(f[3], qf[7], a); }
  if constexpr (ND > 8) { rd4<N * 32 * KSTR + 256>(f, kaddr); a = MFMA(f[0], qf[8], a); a = MFMA(f[1], qf[9], a); a = MFMA(f[2], qf[10], a); a = MFMA(f[3], qf[11], a); }
  if constexpr (ND > 12) { rd4<N * 32 * KSTR + 384>(f, kaddr); a = MFMA(f[0], qf[12], a); a = MFMA(f[1], qf[13], a); a = MFMA(f[2], qf[14], a); a = MFMA(f[3], qf[15], a); }
  return a;
}
template <int CB> DI void pv_block(f32x16& o, unsigned vaddr, const bf16x8 (&pb)[2][2]) {
  s16x4 v[8];
  rdv8<CB * 4096>(v, vaddr);
#pragma unroll
  for (int q = 0; q < 4; ++q) {
    const bf16x8 vf = {v[2 * q][0], v[2 * q][1], v[2 * q][2], v[2 * q][3], v[2 * q + 1][0], v[2 * q + 1][1], v[2 * q + 1][2], v[2 * q + 1][3]};
    o = MFMA(vf, pb[q >> 1][q & 1], o);
  }
}
template <int DQK, int W1, int DV, int VW, int MODE>
DI void attn_core(const u16* __restrict__ k1, int ldk1, const u16* __restrict__ k2, int ldk2, const u16* __restrict__ vsrc, int ldv,
                  int kv_len, int kbase0, int ntiles, const u16* qrow, int tq, int tq0, float c2, int vcb0, u16* yrow,
                  const u16* grow, const unsigned* maskrow, const float* lutw, float bias_far, float m_init, float l_init, char* smem) {
  constexpr int KSTR = DQK * 2 + 16, KCH = DQK / 8;
  constexpr int ND = DQK / 16, NCB = DV / 32, BUF = 64 * KSTR + (VW / 32) * 4096;
  constexpr int NKI = KSTR / 16, NVI = VW / 8;
  static_assert(ND % 4 == 0 && NCB <= 4, "fragment batches");
  int tid0 = threadIdx.x; asm volatile("" : "+v"(tid0));
  const int lane = tid0 & 63, r32 = lane & 31, hi = lane >> 5;
  const int wv = __builtin_amdgcn_readfirstlane(tid0 >> 6);
  const unsigned lds0 = (unsigned)(uintptr_t)smem;
  bf16x8 qf[ND];
#pragma unroll
  for (int d0 = 0; d0 < ND; ++d0) qf[d0] = *(const bf16x8*)(qrow + d0 * 16 + hi * 8);
  f32x16 o[NCB];
#pragma unroll
  for (int cb = 0; cb < NCB; ++cb)
#pragma unroll
    for (int r = 0; r < 16; ++r) o[cb][r] = 0.f;
  float m = m_init, l = (hi == 0) ? l_init : 0.f;
  const unsigned klane = (unsigned)(r32 * KSTR + hi * 16);
  const unsigned vlane = (unsigned)(64 * KSTR + vcb0 * 4096 + ((lane >> 4) & 1) * 32 + (lane & 3) * 8 + (4 * hi + ((lane & 15) >> 2)) * 64);
  unsigned mwn[2] = {0u, 0u};
  auto stage_tile = [&](int kb, int buf) {
    int ln = threadIdx.x & 63; asm volatile("" : "+v"(ln));
    const unsigned bofs = (unsigned)(buf * BUF);
#pragma unroll
    for (int ii = 0; ii < (NKI + 7) / 8; ++ii) {
      const int i = wv + 8 * ii;
      if (i < NKI) {
        const int ob = i * 1024 + ln * 16, row = ob / KSTR;
        int c = (ob - row * KSTR) >> 4; c = (c >= KCH) ? 0 : c;
        int key = kb + row; key = key < 0 ? 0 : (key >= kv_len ? kv_len - 1 : key);
        const u16* src = (c < W1 / 8) ? (k1 + (key * ldk1 + c * 8)) : (k2 + (key * ldk2 + (c - W1 / 8) * 8));
        __builtin_amdgcn_global_load_lds((const unsigned*)src, (lds_u32p)(smem + bofs + i * 1024), 16, 0, 0);
      }
    }
#pragma unroll
    for (int ii = 0; ii < (NVI + 7) / 8; ++ii) {
      const int i = wv + 8 * ii;
      if (i < NVI) {
        const int ob = i * 1024 + ln * 16, cbk = ob >> 12, row = (ob & 4095) >> 6, cw = (ob & 63) >> 4;
        int key = kb + row; key = key < 0 ? 0 : (key >= kv_len ? kv_len - 1 : key);
        __builtin_amdgcn_global_load_lds((const unsigned*)(vsrc + (key * ldv + (cbk * 4 + cw) * 8)), (lds_u32p)(smem + bofs + 64 * KSTR + i * 1024), 16, 0, 0);
      }
    }
    if (MODE == 1) { mwn[0] = maskrow[(kb >> 5)]; mwn[1] = maskrow[(kb >> 5) + 1]; }
  };
  stage_tile(kbase0, 0);
  asm volatile("s_waitcnt vmcnt(0)" ::: "memory");
  __syncthreads();
  for (int t = 0; t < ntiles; ++t) {
    const int kb = kbase0 + t * 64;
    const unsigned bufa = lds0 + (unsigned)((t & 1) * BUF);
    const unsigned mw0 = mwn[0], mw1 = mwn[1];
    if (t + 1 < ntiles) stage_tile(kb + 64, (t + 1) & 1);
    if (!(MODE == 0 && kb > tq0 + 31)) {
      f32x16 s[2];
      s[0] = s_block<KSTR, ND, 0>(bufa + klane, qf);
      s[1] = s_block<KSTR, ND, 1>(bufa + klane, qf);
      if (MODE == 0) {
        const bool diag = kb + 63 > tq0;
#pragma unroll
        for (int n = 0; n < 2; ++n)
#pragma unroll
          for (int i = 0; i < 16; ++i) {
            float v = s[n][i] * c2;
            if (diag) { const int key = kb + 32 * n + crow(i, hi); if (key > tq) v = NEGV; }
            s[n][i] = v;
          }
      } else if (MODE == 1) {
        const bool far = (tq0 - (kb + 63)) >= 128;
#pragma unroll
        for (int n = 0; n < 2; ++n) {
          const unsigned wb = (n ? mw1 : mw0) >> (4 * hi);
          if (far) {
#pragma unroll
            for (int i = 0; i < 16; ++i) {
              const float v = fmaf(s[n][i], c2, bias_far);
              s[n][i] = ((wb >> ((i & 3) + 8 * (i >> 2))) & 1u) ? v : NEGV;
            }
          } else {
#pragma unroll
            for (int i = 0; i < 16; ++i) {
              const int key = kb + 32 * n + crow(i, hi);
              int rel = tq - key; rel = rel < 0 ? 0 : (rel > 128 ? 128 : rel);
              const float v = fmaf(s[n][i], c2, lutw[rel]);
              s[n][i] = ((wb >> ((i & 3) + 8 * (i >> 2))) & 1u) ? v : NEGV;
            }
          }
        }
      } else if (MODE == 2) {
#pragma unroll
        for (int n = 0; n < 2; ++n)
#pragma unroll
          for (int i = 0; i < 16; ++i) {
            const int key = kb + 32 * n + crow(i, hi), rel = tq - key;
            const bool ok = ((unsigned)rel < 128u) && (key >= 0);
            const float v = fmaf(s[n][i], c2, lutw[rel & 127]);
            s[n][i] = ok ? v : NEGV;
          }
      } else {
#pragma unroll
        for (int n = 0; n < 2; ++n)
#pragma unroll
          for (int i = 0; i < 16; ++i) s[n][i] *= c2;
      }
      float mx = s[0][0];
#pragma unroll
      for (int i = 1; i < 16; ++i) mx = fmaxf(mx, s[0][i]);
#pragma unroll
      for (int i = 0; i < 16; ++i) mx = fmaxf(mx, s[1][i]);
      mx = xhalf_max(mx);
      if (__any(mx - m > 8.0f)) {
        const float mnew = fmaxf(m, mx), alpha = __builtin_amdgcn_exp2f(m - mnew);
        m = mnew; l *= alpha;
#pragma unroll
        for (int cb = 0; cb < NCB; ++cb)
#pragma unroll
          for (int r = 0; r < 16; ++r) o[cb][r] *= alpha;
      }
      float ps = 0.f;
#pragma unroll
      for (int n = 0; n < 2; ++n)
#pragma unroll
        for (int i = 0; i < 16; ++i) { const float p = __builtin_amdgcn_exp2f(s[n][i] - m); ps += p; s[n][i] = p; }
      l += ps;
      bf16x8 pb[2][2];
#pragma unroll
      for (int n = 0; n < 2; ++n)
#pragma unroll
        for (int s2 = 0; s2 < 2; ++s2) {
          u32x4 pw = {pk2(s[n][8 * s2 + 0], s[n][8 * s2 + 1]), pk2(s[n][8 * s2 + 2], s[n][8 * s2 + 3]),
                      pk2(s[n][8 * s2 + 4], s[n][8 * s2 + 5]), pk2(s[n][8 * s2 + 6], s[n][8 * s2 + 7])};
          pb[n][s2] = __builtin_bit_cast(bf16x8, pw);
        }
      pv_block<0>(o[0], bufa + vlane, pb);
      if constexpr (NCB > 1) pv_block<1>(o[1], bufa + vlane, pb);
      if constexpr (NCB > 2) pv_block<2>(o[2], bufa + vlane, pb);
      if constexpr (NCB > 3) pv_block<3>(o[3], bufa + vlane, pb);
    }
    asm volatile("s_waitcnt vmcnt(0)" ::: "memory");
    __syncthreads();
  }
  const float inv = 1.f / xhalf_sum(l);
#pragma unroll
  for (int cb = 0; cb < NCB; ++cb)
#pragma unroll
    for (int g = 0; g < 4; ++g) {
      const int dv = 32 * cb + 8 * g + 4 * hi;
      const u32x2 gg = *(const u32x2*)(grow + dv);
      float gv[4] = {bf2f(gg[0] & 0xffffu), bf2f(gg[0] >> 16), bf2f(gg[1] & 0xffffu), bf2f(gg[1] >> 16)};
      float ov[4];
#pragma unroll
      for (int j = 0; j < 4; ++j) {
        const float sg = gv[j] / (1.f + __expf(-gv[j]));
        ov[j] = o[cb][4 * g + j] * inv * sg;
      }
      *(unsigned*)((unsigned char*)yrow + dv) = pk4_fp8(ov[0] * Y_SCALE, ov[1] * Y_SCALE, ov[2] * Y_SCALE, ov[3] * Y_SCALE);
      __builtin_amdgcn_sched_barrier(0);
    }
}

DI unsigned ordkey(float f) { const unsigned b = __float_as_uint(f); return b ^ ((unsigned)((int)b >> 31) | 0x80000000u); }
DI void indexer_phase(const u16* __restrict__ P, unsigned* __restrict__ mask) {
  int tidx = threadIdx.x; asm volatile("" : "+v"(tidx));
  const int lane = tidx & 63, r32 = lane & 31, hi = lane >> 5;
  const int gw = blockIdx.x * 8 + (tidx >> 6), nw = gridDim.x * 8;
  for (int item = gw; item < 8192; item += nw) {
    const int b = item & 7, t0 = (1023 - (item >> 3)) * 2;
    const size_t brow = (size_t)b * SEQ;
    const int g = (r32 >> 2) & 1, head = 4 * (r32 >> 3) + (r32 & 3);
    bf16x8 aq[4];
#pragma unroll
    for (int s = 0; s < 4; ++s) aq[s] = *(const bf16x8*)(P + (brow + t0 + g) * 7808 + 2560 + head * 64 + 16 * s + 8 * hi);
    float wv[16];
    {
      const u32x4 w0 = *(const u32x4*)(P + (brow + t0 + hi) * 7808 + 3648), w1 = *(const u32x4*)(P + (brow + t0 + hi) * 7808 + 3656);
#pragma unroll
      for (int j = 0; j < 4; ++j) { wv[2 * j] = bf2f(w0[j] & 0xffffu); wv[2 * j + 1] = bf2f(w0[j] >> 16); wv[8 + 2 * j] = bf2f(w1[j] & 0xffffu); wv[8 + 2 * j + 1] = bf2f(w1[j] >> 16); }
    }
    const int tme = t0 + hi, kbmax = (t0 + 1) >> 5;
    unsigned sc[64];
#pragma unroll
    for (int kb = 0; kb < 64; ++kb) {
      unsigned u = 0u;
      if (kb <= kbmax) {
        f32x16 a;
#pragma unroll
        for (int r = 0; r < 16; ++r) a[r] = 0.f;
        const u16* kp = P + (brow + 32 * kb + r32) * 7808 + 3584 + 8 * hi;
#pragma unroll
        for (int s = 0; s < 4; ++s) { const bf16x8 bk = *(const bf16x8*)(kp + 16 * s); a = MFMA(aq[s], bk, a); }
        float v = 0.f;
#pragma unroll
        for (int i = 0; i < 16; ++i) v = fmaf(wv[i], fmaxf(a[i], 0.f), v);
        u = (32 * kb + r32 <= tme) ? ordkey(v) : 0u;
      }
      sc[kb] = u;
    }
    const int target = (tme + 1 < 256) ? tme + 1 : 256;
    unsigned T = 0u;
    for (int bit = 31; bit >= 0; --bit) {
      const unsigned Tp = T | (1u << bit);
      int cnt = 0;
#pragma unroll
      for (int kb = 0; kb < 64; ++kb) cnt += (sc[kb] >= Tp) ? 1 : 0;
#pragma unroll
      for (int o = 16; o; o >>= 1) cnt += __shfl_xor(cnt, o);
      if (cnt >= target) T = Tp;
    }
    unsigned w0 = 0u, w1 = 0u;
#pragma unroll
    for (int kb = 0; kb < 64; ++kb) {
      const bool pred = (sc[kb] >= T) && (sc[kb] != 0u);
      const unsigned long long bal = __ballot(pred);
      const unsigned wd = (unsigned)(bal >> (32 * hi));
      if ((kb & 31) == r32) { if (kb < 32) w0 = wd; else w1 = wd; }
    }
    mask[(brow + tme) * 64 + r32] = w0;
    mask[(brow + tme) * 64 + 32 + r32] = w1;
  }
}

DI void gbar(unsigned* cnt, unsigned target) {
  asm volatile("s_waitcnt vmcnt(0)" ::: "memory");
  __syncthreads();
  if (threadIdx.x == 0) {
    __builtin_amdgcn_fence(__ATOMIC_RELEASE, "agent");
    asm volatile("s_waitcnt vmcnt(0)" ::: "memory");
    __hip_atomic_fetch_add(cnt, 1u, __ATOMIC_RELAXED, __HIP_MEMORY_SCOPE_AGENT);
    while (__hip_atomic_load(cnt, __ATOMIC_RELAXED, __HIP_MEMORY_SCOPE_AGENT) < target) __builtin_amdgcn_s_sleep(1);
    __builtin_amdgcn_fence(__ATOMIC_ACQUIRE, "agent");
    asm volatile("s_waitcnt vmcnt(0)" ::: "memory");
  }
  __syncthreads();
}
#define GSYNC() do { ++bar_gen; gbar(BAR, bar_gen * gridDim.x); } while (0)
__global__ void __launch_bounds__(512, 2) mega(Params p) {
  cg::grid_group grid = cg::this_grid();
  extern __shared__ __attribute__((aligned(16))) char smem[];
  volatile int* s_item = (volatile int*)(smem + LDS_ITEM);
  char* ws = p.ws;
  unsigned char* Y8 = (unsigned char*)(ws + OFF_Y);
  u16* WIN8 = (u16*)(ws + OFF_WIN + 19922944);
  unsigned char* CQ8 = (unsigned char*)(ws + OFF_Y + 67108864);     u16* H = (u16*)(ws + OFF_H); u16* Cb = (u16*)(ws + OFF_Y); u16* Qb = (u16*)(ws + OFF_H);
  u16* KV = (u16*)(ws + OFF_KV); u16* MG = (u16*)(ws + OFF_MG); u16* KR = (u16*)(ws + OFF_KR); u16* Pb = (u16*)(ws + OFF_P);
  u16* WIN = (u16*)(ws + OFF_WIN); u16* WUQ = (u16*)(ws + OFF_WUQ); u16* WUKV = (u16*)(ws + OFF_WUKV); u16* WOUT = (u16*)(ws + OFF_WOUT);
  u16* WMEMALL = (u16*)(ws + OFF_KV); u16* MEMN = (u16*)(ws + OFF_MEMN); u16* MEMKV = (u16*)(ws + OFF_MEMKV);
  unsigned* MASK = (unsigned*)(ws + OFF_MASK); f32x2* ROPE = (f32x2*)(ws + OFF_ROPE); float* LUT = (float*)(ws + OFF_LUT);
  int* CTR = (int*)(ws + OFF_CTR);
  unsigned* BAR = (unsigned*)(ws + OFF_CTR) + 64;
  unsigned bar_gen = 0;
  const int tid = threadIdx.x, lane = tid & 63, wv = __builtin_amdgcn_readfirstlane(tid >> 6), r32 = lane & 31, hi = lane >> 5;
  const int gtid = blockIdx.x * 512 + tid, gthreads = gridDim.x * 512;

  for (int i = gtid; i < 2048 * 32; i += gthreads) {
    const int pos = i >> 5, j = i & 31;
    const float inv = 1.0f / powf(10000.0f, (float)(2 * j) / 64.0f);
    const float ang = (float)pos * inv;
    const float k = rintf(ang * 0.15915494309189535f);
    float r = fmaf(-k, 6.28318548202514648f, ang);
    r = fmaf(-k, -1.74845553e-7f, r);
    f32x2 cs = {__cosf(r), __sinf(r)};
    ROPE[i] = cs;
  }
  for (int i = gtid; i < 129 * 32; i += gthreads) {
    const int rel = i >> 5, h = i & 31;
    int bucket;
    if (rel < 16) bucket = rel;
    else { const int lg = 16 + (int)(logf((float)rel / 16.0f) / 2.0794415416798357f * 16.0f); bucket = lg < 31 ? lg : 31; }
    LUT[i] = p.rel_bias[bucket * 32 + h] * LOG2E;
  }
  rmsnorm_rows<false>(p.mem, p.mem_norm, MEMN, 2048);
#pragma unroll 1
  for (int l = 0; l < 4; ++l) convert_wt<0>(p.w_mem_kv + (size_t)l * 2048 * 2048, 2048, 2048, 2048, WMEMALL + (size_t)l * 2048 * 2048, smem);

  auto convert_layer = [&](int L) {
    const int kind = L % 3, j = L / 3;
    if (kind == 0) {
    convert_wt<1>(p.w_in_a + (size_t)j * 2048 * 6208, 2048, 6208, 3840, WIN, smem, 1.f, 3648, 576, 1536, 2560, 512);
    convert_wt<0, true>(p.w_in_a + (size_t)j * 2048 * 6208, 2048, 6208, 2560, WIN8, smem, WIN_SCALE, 2560, 1536, 0, 576);
    convert_wt<2, true>(p.w_uq + (size_t)j * 1536 * 3072, 1536, 3072, 3072, WUQ, smem, WUQ_SCALE);
    convert_wt<0>(p.w_ukv + (size_t)j * 512 * 4096, 512, 4096, 4096, WUKV, smem);
  } else if (kind == 1) {
    convert_wt<0>(p.w_in_b, 2048, 7760, 4864, WIN, smem, 1.f, 4688, 1616, 2048, 3072);
    convert_wt<0, true>(p.w_in_b, 2048, 7760, 3072, WIN8, smem, WIN_SCALE, 3072, 2048, 0, 1616);
  } else {
    convert_wt<0>(p.w_in_c, 2048, 6656, 3584, WIN, smem, 1.f, 3584, 512, 2048, 3072);
    convert_wt<0, true>(p.w_in_c, 2048, 6656, 3072, WIN8, smem, WIN_SCALE, 3072, 2048, 0, 512);
  }
  };
#pragma unroll 1
  for (int layer = 0; layer < 4; ++layer) {
    const int kind = layer % 3, j = layer / 3;
    const float* xin = (layer == 0) ? p.x : p.out;
    unsigned char* H8 = (unsigned char*)(ws + ((kind == 0) ? OFF_KV + 67108864 : OFF_Y));
    rmsnorm_rows<false>(xin, p.norm_in + layer * 2048, H, NTOK, H8);
    if (layer == 0) convert_layer(0);
    convert_wt<0, true>(p.w_out + (size_t)layer * 3072 * 2048, 3072, 2048, 2048, WOUT, smem, WOUT_SCALE);
    if (layer == 0) { __builtin_amdgcn_fence(__ATOMIC_RELEASE, "agent"); grid.sync(); __builtin_amdgcn_fence(__ATOMIC_ACQUIRE, "agent"); asm volatile("s_waitcnt vmcnt(0)" ::: "memory"); }
    else GSYNC();

    if (kind == 0) {
      { EpiBf<1> e{Cb, 2048, 3648, MG, KR, ROPE, 1.f, 576, 1536, 2560}; run_gemm(H, 2048, WIN, NTOK, 3840, 2048, e, smem); }
      { EpiBf<3> e{Cb, 2048, 2560, MG, nullptr, nullptr, 1.f / (H_SCALE * WIN_SCALE), 1536, 0, 576}; run_gemm<true>((const u16*)H8, 1024, WIN8, NTOK, 2560, 1024, e, smem); }
    }
    else if (kind == 1) {
      { EpiBf<0> e{Pb, 7808, 4688, nullptr, nullptr, nullptr, 1.f, 1616, 2048, 3072}; run_gemm(H, 2048, WIN, NTOK, 4864, 2048, e, smem); }
      { EpiBf<0> e{Pb, 7808, 3072, nullptr, nullptr, nullptr, 1.f / (H_SCALE * WIN_SCALE), 2048, 0, 1616}; run_gemm<true>((const u16*)H8, 1024, WIN8, NTOK, 3072, 1024, e, smem); }
    } else {
      { EpiBf<0> e{Pb, 6656, 3584, nullptr, nullptr, nullptr, 1.f, 512, 2048, 3072}; run_gemm(H, 2048, WIN, NTOK, 3584, 2048, e, smem); }
      { EpiBf<0> e{Pb, 6656, 3072, nullptr, nullptr, nullptr, 1.f / (H_SCALE * WIN_SCALE), 2048, 0, 512}; run_gemm<true>((const u16*)H8, 1024, WIN8, NTOK, 3072, 1024, e, smem); }
    }
    if (layer == 0) { EpiBf<0> e{MEMKV, 8192, 8192, nullptr, nullptr, nullptr}; run_gemm(MEMN, 2048, WMEMALL, 2048, 8192, 2048, e, smem); }
    GSYNC();

    if (kind == 0) {
      anorm_phase(Cb, p.a_q_norm + j * 1536, p.a_kv_norm + j * 512, CQ8);
      GSYNC();
      { EpiBf<2> e{Qb, 3072, 3072, nullptr, nullptr, ROPE, 1.f / (CQ_SCALE * WUQ_SCALE)}; run_gemm<true>((const u16*)CQ8, 768, WUQ, NTOK, 3072, 768, e, smem); }
      { EpiBf<0> e{KV, 4096, 4096, nullptr, nullptr, nullptr}; run_gemm(Cb + 1536, 2048, WUKV, NTOK, 4096, 512, e, smem); }
      GSYNC();
    } else if (kind == 1) {
      indexer_phase(Pb, MASK);
      GSYNC();
    }

    {
      const int nself = (kind == 0) ? 1024 : 2048, total = nself + 512;
      const u16* mgb = (kind == 0) ? MG : Pb;
      const int ldmg = (kind == 0) ? 4096 : (kind == 1 ? 7808 : 6656);
      const int mqcol = (kind == 0) ? 0 : (kind == 1 ? 3664 : 2560);
      const int gatecol = (kind == 0) ? 1024 : (kind == 1 ? 4688 : 3584);
      const u16* memkv = MEMKV + layer * 2048;
      float* lut_all = (float*)(smem + LDS_LUT);
      if (kind != 0) {
        for (int i = tid; i < 32 * 129; i += 512) { const int h = i / 129, r = i - h * 129; lut_all[h * 132 + r] = LUT[r * 32 + h]; }
      }
      if (tid == 0) s_item[0] = atomicAdd(&CTR[layer], 1);
      __syncthreads();
      for (int par = 0;; par ^= 1) {
        const int item = __builtin_amdgcn_readfirstlane(s_item[par]);
        if (item >= total) break;
        if (tid == 0) s_item[par ^ 1] = atomicAdd(&CTR[layer], 1);
        if (item < nself) {
          if (kind == 0) {
            const int qblk = 7 - item / 128, rem = item % 128, b = rem / 16, head = rem % 16;
            const size_t brow = (size_t)b * SEQ;
            const int tq0 = qblk * 256 + 32 * wv, tq = tq0 + r32;
            attn_core<192, 128, 128, 128, 0>(KV + brow * 4096 + head * 256, 4096, KR + brow * 64, 64, KV + brow * 4096 + head * 256 + 128, 4096,
                                            SEQ, 0, 4 * qblk + 4, Qb + (brow + tq) * 3072 + head * 192, tq, tq0, 0.07216878364870322f * LOG2E, 0,
                                            (u16*)(Y8 + (brow + tq) * 3072 + head * 128), mgb + (brow + tq) * ldmg + gatecol + head * 128,
                                            nullptr, nullptr, 0.f, -1e29f, 0.f, smem);
          } else {
            const int qb = 63 - item / 32, rem = item % 32, b = rem / 4, kvh = rem % 4;
            const size_t brow = (size_t)b * SEQ;
            const int head = kvh * 8 + wv, tq0 = qb * 32, tq = tq0 + r32;
            const float* lutw = lut_all + head * 132;
            if (kind == 1) {
              attn_core<64, 64, 64, 64, 1>(Pb + brow * 7808 + 2048 + kvh * 64, 7808, nullptr, 0, Pb + brow * 7808 + 2304 + kvh * 64, 7808,
                                          SEQ, 0, (tq0 + 31) / 64 + 1, Pb + (brow + tq) * 7808 + head * 64, tq, tq0, 0.125f * LOG2E, 0,
                                          (u16*)(Y8 + (brow + tq) * 3072 + head * 64), Pb + (brow + tq) * 7808 + gatecol + head * 64,
                                          MASK + (brow + tq) * 64, lutw, lutw[128], -1e29f, 0.f, smem);
            } else {
              const float sink = p.c_sinks[j * 32 + head] * LOG2E;
              attn_core<64, 64, 64, 64, 2>(Pb + brow * 6656 + 2048 + kvh * 64, 6656, nullptr, 0, Pb + brow * 6656 + 2304 + kvh * 64, 6656,
                                          SEQ, tq0 - 128, 3, Pb + (brow + tq) * 6656 + head * 64, tq, tq0, 0.125f * LOG2E, 0,
                                          (u16*)(Y8 + (brow + tq) * 3072 + head * 64), Pb + (brow + tq) * 6656 + gatecol + head * 64,
                                          nullptr, lutw, 0.f, sink, 1.f, smem);
            }
          }
        } else {
          const int it = item - nself, b = it / 64, mh = (it % 64) / 16, qb = it % 16;
          const size_t brow = (size_t)b * SEQ;
          const int tq0 = qb * 128 + 32 * (wv >> 1), tq = tq0 + r32, vh = wv & 1;
          attn_core<256, 256, 128, 256, 3>(memkv + (size_t)b * 256 * 8192 + mh * 256, 8192, nullptr, 0, memkv + (size_t)b * 256 * 8192 + 1024 + mh * 256, 8192,
                                          256, 0, 4, mgb + (brow + tq) * ldmg + mqcol + mh * 256, tq, tq0, 0.0625f * LOG2E, 4 * vh,
                                          (u16*)(Y8 + (brow + tq) * 3072 + 2048 + mh * 256 + 128 * vh), mgb + (brow + tq) * ldmg + gatecol + 2048 + mh * 256 + 128 * vh,
                                          nullptr, nullptr, 0.f, -1e29f, 0.f, smem);
        }
      }
    }
    if (layer + 1 < 4) convert_layer(layer + 1);
    GSYNC();

    { EpiResid e{xin, p.out, 1.f / (Y_SCALE * WOUT_SCALE)}; run_gemm<true>((const u16*)Y8, 1536, WOUT, NTOK, 2048, 1536, e, smem); }
    GSYNC();
  }
  rmsnorm_rows<true>(p.out, p.final_norm, p.out, NTOK);
}

extern "C" void kernel_launch(void* const* d_in, const int* in_sizes, int n_in, void* d_out, int out_size,
                              void* d_ws, size_t ws_size, hipStream_t stream) {
  static int grid_blocks = 0;
  if (!grid_blocks) {
    int dev = 0, cus = 0, per_cu = 0;
    (void)hipGetDevice(&dev);
    (void)hipDeviceGetAttribute(&cus, hipDeviceAttributeMultiprocessorCount, dev);
    (void)hipFuncSetAttribute((const void*)mega, hipFuncAttributeMaxDynamicSharedMemorySize, LDS_BYTES);
    (void)hipOccupancyMaxActiveBlocksPerMultiprocessor(&per_cu, mega, 512, LDS_BYTES);
    if (per_cu > 1) per_cu = 1;
    grid_blocks = cus * per_cu;
  }
  Params p{};
  p.x = (const float*)d_in[0]; p.mem = (const float*)d_in[1]; p.norm_in = (const float*)d_in[2]; p.final_norm = (const float*)d_in[3];
  p.mem_norm = (const float*)d_in[4]; p.rel_bias = (const float*)d_in[5]; p.w_in_a = (const float*)d_in[6]; p.a_q_norm = (const float*)d_in[7];
  p.w_uq = (const float*)d_in[8]; p.a_kv_norm = (const float*)d_in[9]; p.w_ukv = (const float*)d_in[10]; p.w_in_b = (const float*)d_in[11];
  p.w_in_c = (const float*)d_in[12]; p.c_sinks = (const float*)d_in[13]; p.w_mem_kv = (const float*)d_in[14]; p.w_out = (const float*)d_in[15];
  p.out = (float*)d_out; p.ws = (char*)d_ws;
  (void)hipMemsetAsync((char*)d_ws + OFF_CTR, 0, 1024, stream);
  void* args[] = {&p};
  (void)hipLaunchCooperativeKernel((void*)mega, dim3(grid_blocks), dim3(512), args, LDS_BYTES, stream);
}
```

```cpp
#include <hip/hip_runtime.h>
#include <hip/hip_cooperative_groups.h>
#include <stdint.h>
namespace cg = cooperative_groups;

typedef unsigned short u16;
typedef __attribute__((ext_vector_type(8))) short bf16x8;
typedef __attribute__((ext_vector_type(4))) short s16x4;
typedef __attribute__((ext_vector_type(16))) float f32x16;
typedef __attribute__((ext_vector_type(4))) float f32x4;
typedef __attribute__((ext_vector_type(2))) float f32x2;
typedef __attribute__((ext_vector_type(4))) unsigned u32x4;
typedef __attribute__((ext_vector_type(2))) unsigned u32x2;
typedef __attribute__((ext_vector_type(2))) __bf16 bf16x2_t;
typedef short v4i16_t __attribute__((ext_vector_type(4)));
#define DI __device__ __forceinline__
#define MFMA(a, b, c) __builtin_amdgcn_mfma_f32_32x32x16_bf16((a), (b), (c), 0, 0, 0)

constexpr int SEQ = 2048, NTOK = 16384;
constexpr int LDS_LUT = 133120, LDS_ITEM = LDS_LUT + 32 * 528, LDS_BYTES = LDS_ITEM + 64;
constexpr float LOG2E = 1.4426950408889634f;
constexpr float NEGV = -1e30f;
constexpr float Y_SCALE = 16.f, WOUT_SCALE = 256.f, CQ_SCALE = 16.f, WUQ_SCALE = 256.f, H_SCALE = 16.f, WIN_SCALE = 256.f;

constexpr size_t OFF_Y = 0;
constexpr size_t OFF_H = 100663296;
constexpr size_t OFF_KV = 201326592;
constexpr size_t OFF_MG = 335544320;
constexpr size_t OFF_KR = 469762048;
constexpr size_t OFF_P = 167772160;
constexpr size_t OFF_WIN = 471859200;
constexpr size_t OFF_WUQ = OFF_WIN + 32505856;
constexpr size_t OFF_WUKV = OFF_WUQ + 9437184;
constexpr size_t OFF_WOUT = OFF_WUKV + 4194304;
constexpr size_t OFF_MEMN = OFF_WOUT + 12582912;
constexpr size_t OFF_MEMKV = OFF_MEMN + 8388608;
constexpr size_t OFF_MASK = OFF_MEMKV + 33554432;
constexpr size_t OFF_ROPE = OFF_MASK + 4194304;
constexpr size_t OFF_LUT = OFF_ROPE + 524288;
constexpr size_t OFF_CTR = OFF_LUT + 32768;

struct Params {
  const float *x, *mem, *norm_in, *final_norm, *mem_norm, *rel_bias, *w_in_a, *a_q_norm, *w_uq, *a_kv_norm, *w_ukv,
      *w_in_b, *w_in_c, *c_sinks, *w_mem_kv, *w_out;
  float* out;
  char* ws;
};

DI float bf2f(unsigned b) { return __uint_as_float(b << 16); }
DI unsigned pk2(float a, float b) {
  f32x2 v = {a, b};
  return __builtin_bit_cast(unsigned, __builtin_convertvector(v, bf16x2_t));
}
DI float clamp8(float x) { return fminf(fmaxf(x, -448.f), 448.f); }
DI unsigned pk4_fp8(float a, float b, float c, float d) {
  int w = 0;
  w = __builtin_amdgcn_cvt_pk_fp8_f32(clamp8(a), clamp8(b), w, false);
  w = __builtin_amdgcn_cvt_pk_fp8_f32(clamp8(c), clamp8(d), w, true);
  return (unsigned)w;
}
DI u16 f2bf(float a) { return (u16)(pk2(a, 0.f) & 0xffffu); }
DI float wave_sum(float v) {
#pragma unroll
  for (int o = 32; o; o >>= 1) v += __shfl_xor(v, o);
  return v;
}
DI int crow(int reg, int hi) { return (reg & 3) + 8 * (reg >> 2) + 4 * hi; }
DI float xhalf_max(float m) {
  auto rr = __builtin_amdgcn_permlane32_swap(__float_as_uint(m), __float_as_uint(m), false, false);
  return fmaxf(__uint_as_float(rr[0]), __uint_as_float(rr[1]));
}
DI float xhalf_sum(float m) {
  auto rr = __builtin_amdgcn_permlane32_swap(__float_as_uint(m), __float_as_uint(m), false, false);
  return __uint_as_float(rr[0]) + __uint_as_float(rr[1]);
}
typedef __attribute__((address_space(3))) v4i16_t* lds_v4p;
DI s16x4 vtr(const char* p) {
  return __builtin_bit_cast(s16x4, __builtin_amdgcn_ds_read_tr16_b64_v4i16((lds_v4p)(p)));
}

template <int PERM, bool FP8 = false>
DI void convert_wt(const float* __restrict__ W, int K, int N, int Npad, u16* __restrict__ Wt, char* smem, float wscale = 1.f,
                   int nvalid = -1, int csplit = 0, int coff1 = 0, int coff2 = 0, int rot_n0 = 2048) {
  float* tile = (float*)smem;
  int tid = threadIdx.x; asm volatile("" : "+v"(tid));
  const int ntk = K / 64, ntn = Npad / 64;
  for (int t = blockIdx.x; t < ntk * ntn; t += gridDim.x) {
    const int tk = t % ntk, tn = t / ntk, k0 = tk * 64, n0 = tn * 64;
    __syncthreads();
#pragma unroll
    for (int i = 0; i < 2; ++i) {
      const int id = tid + 512 * i, kr = id >> 4, n4 = (id & 15) * 4;
      f32x4 v = {0.f, 0.f, 0.f, 0.f};
      const int nd = n0 + n4, nsrc = (nvalid < 0) ? nd : (nd < csplit ? nd + coff1 : nd + coff2);
      if (nd < ((nvalid < 0) ? N : nvalid)) v = *(const f32x4*)(W + (size_t)(k0 + kr) * N + nsrc);
      tile[kr * 65 + n4 + 0] = v[0]; tile[kr * 65 + n4 + 1] = v[1]; tile[kr * 65 + n4 + 2] = v[2]; tile[kr * 65 + n4 + 3] = v[3];
    }
    __syncthreads();
    {
      const int n = tid >> 3, c = tid & 7;
      bool rot = false;
      if (PERM == 1) rot = (n0 == rot_n0);
      if (PERM == 2) rot = ((tn % 3) == 2);
      const int ns = rot ? ((n >> 1) + 32 * (n & 1)) : n;
      if (FP8) {
        float f[8];
#pragma unroll
        for (int j = 0; j < 8; ++j) f[j] = tile[(c * 8 + j) * 65 + ns] * wscale;
        u32x2 o = {pk4_fp8(f[0], f[1], f[2], f[3]), pk4_fp8(f[4], f[5], f[6], f[7])};
        *(u32x2*)((unsigned char*)Wt + (size_t)(n0 + n) * K + k0 + c * 8) = o;
      } else {
        u32x4 o;
#pragma unroll
        for (int j = 0; j < 4; ++j) o[j] = pk2(tile[(c * 8 + 2 * j) * 65 + ns], tile[(c * 8 + 2 * j + 1) * 65 + ns]);
        *(u32x4*)(Wt + (size_t)(n0 + n) * K + k0 + c * 8) = o;
      }
    }
  }
}

template <bool F32OUT>
DI void rmsnorm_rows(const float* X, const float* __restrict__ g, void* outp, int nrows, unsigned char* __restrict__ out8 = nullptr) {
  int tidx = threadIdx.x; asm volatile("" : "+v"(tidx));
  const int lane = tidx & 63, gw = blockIdx.x * 8 + (tidx >> 6), nw = gridDim.x * 8;
  for (int row = gw; row < nrows; row += nw) {
    const f32x4* xr = (const f32x4*)(X + (size_t)row * 2048);
    f32x4 v[8];
    float ss = 0.f;
#pragma unroll
    for (int i = 0; i < 8; ++i) { v[i] = xr[lane + 64 * i]; ss += v[i][0] * v[i][0] + v[i][1] * v[i][1] + v[i][2] * v[i][2] + v[i][3] * v[i][3]; }
    ss = wave_sum(ss);
    const float r = rsqrtf(ss * (1.f / 2048.f) + 1e-6f);
#pragma unroll
    for (int i = 0; i < 8; ++i) {
      const f32x4 gg = ((const f32x4*)g)[lane + 64 * i];
      f32x4 o = {v[i][0] * r * gg[0], v[i][1] * r * gg[1], v[i][2] * r * gg[2], v[i][3] * r * gg[3]};
      if (F32OUT) ((f32x4*)((float*)outp + (size_t)row * 2048))[lane + 64 * i] = o;
      else { u32x2 pk = {pk2(o[0], o[1]), pk2(o[2], o[3])}; ((u32x2*)((u16*)outp + (size_t)row * 2048))[lane + 64 * i] = pk; }
      if (!F32OUT && out8) ((unsigned*)(out8 + (size_t)row * 2048))[lane + 64 * i] = pk4_fp8(o[0] * H_SCALE, o[1] * H_SCALE, o[2] * H_SCALE, o[3] * H_SCALE);
    }
  }
}

DI void anorm_phase(u16* C, const float* __restrict__ gq, const float* __restrict__ gkv, unsigned char* __restrict__ cq8) {
  int tidx = threadIdx.x; asm volatile("" : "+v"(tidx));
  const int lane = tidx & 63, gw = blockIdx.x * 8 + (tidx >> 6), nw = gridDim.x * 8;
  for (int row = gw; row < NTOK; row += nw) {
    u32x4* cr = (u32x4*)(C + (size_t)row * 2048);
    u32x4 v[4];
    float sq = 0.f, skv = 0.f;
#pragma unroll
    for (int i = 0; i < 4; ++i) {
      v[i] = cr[lane + 64 * i];
      float s = 0.f;
#pragma unroll
      for (int j = 0; j < 4; ++j) { float a = bf2f(v[i][j] & 0xffffu), b = bf2f(v[i][j] >> 16); s += a * a + b * b; }
      if (i < 3) sq += s; else skv += s;
    }
    sq = wave_sum(sq); skv = wave_sum(skv);
    const float rq = rsqrtf(sq * (1.f / 1536.f) + 1e-6f), rkv = rsqrtf(skv * (1.f / 512.f) + 1e-6f);
#pragma unroll
    for (int i = 0; i < 4; ++i) {
      const int col = (lane + 64 * i) * 8;
      const float* gp = (i < 3) ? (gq + col) : (gkv + col - 1536);
      const float r = (i < 3) ? rq : rkv;
      const f32x4 g0 = *(const f32x4*)gp, g1 = *(const f32x4*)(gp + 4);
      u32x4 o;
      o[0] = pk2(bf2f(v[i][0] & 0xffffu) * r * g0[0], bf2f(v[i][0] >> 16) * r * g0[1]);
      o[1] = pk2(bf2f(v[i][1] & 0xffffu) * r * g0[2], bf2f(v[i][1] >> 16) * r * g0[3]);
      o[2] = pk2(bf2f(v[i][2] & 0xffffu) * r * g1[0], bf2f(v[i][2] >> 16) * r * g1[1]);
      o[3] = pk2(bf2f(v[i][3] & 0xffffu) * r * g1[2], bf2f(v[i][3] >> 16) * r * g1[3]);
      cr[lane + 64 * i] = o;
      if (i < 3) {
        const float q0 = bf2f(v[i][0] & 0xffffu) * r * g0[0] * CQ_SCALE, q1 = bf2f(v[i][0] >> 16) * r * g0[1] * CQ_SCALE;
        const float q2 = bf2f(v[i][1] & 0xffffu) * r * g0[2] * CQ_SCALE, q3 = bf2f(v[i][1] >> 16) * r * g0[3] * CQ_SCALE;
        const float q4 = bf2f(v[i][2] & 0xffffu) * r * g1[0] * CQ_SCALE, q5 = bf2f(v[i][2] >> 16) * r * g1[1] * CQ_SCALE;
        const float q6 = bf2f(v[i][3] & 0xffffu) * r * g1[2] * CQ_SCALE, q7 = bf2f(v[i][3] >> 16) * r * g1[3] * CQ_SCALE;
        u32x2 w8 = {pk4_fp8(q0, q1, q2, q3), pk4_fp8(q4, q5, q6, q7)};
        *(u32x2*)(cq8 + (size_t)row * 1536 + col) = w8;
      }
    }
  }
}

namespace pg8 {
#define PG8_LAS __attribute__((address_space(3)))
constexpr int BM = 256, BK = 64, HALF = 128, HTB = HALF * BK * 2, STAGE_BYTES = 8 * HTB, NXCD = 8, WGM = 8;
DI int lds_byte(int r, int c) { const int st = (r >> 4) * 2 + (c >> 5), rr = r & 15, cc = c & 31, ob = rr * 64 + cc * 2; return st * 1024 + (ob ^ (((ob >> 9) & 1) << 5)); }
DI void stage_rc(int b, int& R, int& C) { const int st = b / 1024, sb = b % 1024, swz = sb ^ (((sb >> 9) & 1) << 5); R = (st >> 1) * 16 + swz / 64; C = (st & 1) * 32 + (swz % 64) / 2; }
DI int perm32(int rho) { const int n = rho >> 4, i = rho & 15; return 8 * (i >> 2) + 4 * n + (i & 3); }
typedef int i32x4v __attribute__((ext_vector_type(4)));
typedef int i32x8 __attribute__((ext_vector_type(8)));
DI i32x8 cat8(bf16x8 a, bf16x8 b) { const i32x4v x = __builtin_bit_cast(i32x4v, a), y = __builtin_bit_cast(i32x4v, b); return __builtin_shufflevector(x, y, 0, 1, 2, 3, 4, 5, 6, 7); }
struct Unit { int pm, pn; };
struct Gemm { const u16* A; const u16* Bt; int M, N, K, lda; };
struct StaticOrder {
  int nM, nN, nwg, G, c;
  DI void init(int M, int N, int G_, int c_) { nM = M / BM; nN = N / BM; nwg = nM * nN; G = G_; c = c_; }
  DI bool next(int i, Unit& u) const {
    const long L = (long)i * G + c; if (L >= nwg) return false;
    int wgid = (int)L; { const int q = nwg / NXCD, r = nwg % NXCD, xcd = wgid % NXCD, off = wgid / NXCD; wgid = (xcd < r ? xcd * (q + 1) : r * (q + 1) + (xcd - r) * q) + off; }
    const int nig = WGM * nN, gid = wgid / nig, fm = gid * WGM, gsz = (nM - fm) < WGM ? (nM - fm) : WGM;
    u.pm = fm + ((wgid % nig) % gsz); u.pn = (wgid % nig) / gsz; return true;
  }
  DI void a_ready(const Unit&) const {}
  DI void done(const Unit&) const {}
};
template <bool FP8, class Epi, class Sched>
__device__ __forceinline__ void gemm_phase(PG8_LAS unsigned char* lds, const Gemm g, const Sched& S, const Epi& E) {
    int tid = threadIdx.x; asm volatile("" : "+v"(tid));
    const int wid = __builtin_amdgcn_readfirstlane(tid >> 6), lane = tid & 63, wr = wid >> 2, wc = wid & 3, fr = lane & 15, fq = lane >> 4;
    const int K = g.K, nt = K / BK;
    unsigned voffA[2], voffB[2];
#pragma unroll
    for (int i = 0; i < 2; ++i) { int R, C; stage_rc(tid * 16 + i * 8192, R, C); const int Rb = Epi::PERM ? ((R & ~31) + perm32(R & 31)) : R;
        voffA[i] = (unsigned)(R * g.lda + C) * 2u; voffB[i] = (unsigned)(Rb * K + C) * 2u; }
    const size_t kstep = (size_t)(BK * 2);
    const size_t hstep = (size_t)HALF * K * 2, hstepA = (size_t)HALF * g.lda * 2;
    const size_t tstep = 2 * hstep, tstepA = 2 * hstepA;
    const unsigned ldsw = (unsigned)wid * 1024u;
    const int aoff = lds_byte(wr * 64 + fr, fq * 8), boff = lds_byte(wc * 32 + fr, fq * 8);
#define PG8_SA(b, h) (((b) * 2 + (h)) * HTB)
#define PG8_SB(b, h) ((4 + (b) * 2 + (h)) * HTB)
#define PG8_STAGE(bufoff, gbase, voff) do { _Pragma("unroll") for (int _i = 0; _i < 2; ++_i) \
        __builtin_amdgcn_global_load_lds((const unsigned*)((const char*)(gbase) + (voff)[_i]), (PG8_LAS unsigned*)(lds + (bufoff) + ldsw + _i * 8192), 16, 0, 0); } while (0)
#define PG8_LDA(dst, b, h) do { _Pragma("unroll") for (int m = 0; m < 4; ++m) _Pragma("unroll") for (int k = 0; k < 2; ++k) dst[m][k] = *(const PG8_LAS bf16x8*)(lds + PG8_SA(b, h) + aoff + m * 2048 + k * 1024); } while (0)
#define PG8_LDB(dst, b, h) do { _Pragma("unroll") for (int n = 0; n < 2; ++n) _Pragma("unroll") for (int k = 0; k < 2; ++k) dst[n][k] = *(const PG8_LAS bf16x8*)(lds + PG8_SB(b, h) + boff + n * 2048 + k * 1024); } while (0)
#define PG8_MMA(ai, bj, At, Bt) do { __builtin_amdgcn_s_setprio(1); _Pragma("unroll") for (int m = 0; m < 4; ++m) _Pragma("unroll") for (int n = 0; n < 2; ++n) { \
        if constexpr (FP8) { const i32x8 bv_ = cat8(Bt[n][0], Bt[n][1]), av_ = cat8(At[m][0], At[m][1]); \
            asm volatile("s_nop 1\n\tv_mfma_scale_f32_16x16x128_f8f6f4 %0, %1, %2, %0, %3, %3 op_sel_hi:[0,0,0]" : "+v"(acc[ai][bj][m][n]) : "v"(bv_), "v"(av_), "v"(sc127)); } \
        else { _Pragma("unroll") for (int k = 0; k < 2; ++k) acc[ai][bj][m][n] = __builtin_amdgcn_mfma_f32_16x16x32_bf16(Bt[n][k], At[m][k], acc[ai][bj][m][n], 0, 0, 0); } } \
        __builtin_amdgcn_s_setprio(0); } while (0)
#define PG8_WAIT_V(n) asm volatile("s_waitcnt vmcnt(" #n ")" ::: "memory")
#define PG8_WAIT_L(n) asm volatile("s_waitcnt lgkmcnt(" #n ")" ::: "memory")
#define PG8_BAR __builtin_amdgcn_s_barrier()
#define PG8_SCHED __builtin_amdgcn_sched_barrier(0)
    Unit cur, nxt; int ui = 0;
    if (!S.next(0, cur)) return;
    f32x4 acc[2][2][4][2];
#pragma unroll
    for (int a = 0; a < 2; ++a)
#pragma unroll
        for (int b = 0; b < 2; ++b)
#pragma unroll
            for (int m = 0; m < 4; ++m)
#pragma unroll
                for (int n = 0; n < 2; ++n) acc[a][b][m][n] = (f32x4){0.f, 0.f, 0.f, 0.f};
    bf16x8 At[4][2], B0[2][2], B1[2][2];
    int sc127 = 0x7F7F7F7F; asm volatile("" : "+v"(sc127));
    const char* cA = (const char*)g.A + (size_t)cur.pm * tstepA; const char* cB = (const char*)g.Bt + (size_t)cur.pn * tstep;
    S.a_ready(cur);
    PG8_STAGE(PG8_SB(0, 0), cB, voffB); PG8_STAGE(PG8_SA(0, 0), cA, voffA); PG8_STAGE(PG8_SB(0, 1), cB + hstep, voffB); PG8_STAGE(PG8_SA(0, 1), cA + hstepA, voffA);
    if (wr == 1) PG8_BAR;
    PG8_WAIT_V(4); PG8_BAR;
    PG8_STAGE(PG8_SB(1, 0), cB + kstep, voffB); PG8_STAGE(PG8_SA(1, 0), cA + kstep, voffA); PG8_STAGE(PG8_SB(1, 1), cB + hstep + kstep, voffB);
    PG8_WAIT_V(6); PG8_BAR;
    for (;;) {
        const bool has_next = S.next(ui + 1, nxt);
        const char* nA = has_next ? (const char*)g.A + (size_t)nxt.pm * tstepA : cA; const char* nB = has_next ? (const char*)g.Bt + (size_t)nxt.pn * tstep : cB;
        for (int t = 0; t < nt; t += 2) {
            const bool last = (t == nt - 2);
            const char* a1 = cA + (size_t)(t + 1) * kstep;
            const char* a2 = last ? nA : cA + (size_t)(t + 2) * kstep; const char* b2 = last ? nB : cB + (size_t)(t + 2) * kstep;
            const char* a3 = a2 + kstep; const char* b3 = b2 + kstep;
            if (last && has_next) S.a_ready(nxt);
            PG8_LDB(B0, 0, 0); PG8_SCHED; PG8_LDA(At, 0, 0); PG8_STAGE(PG8_SA(1, 1), a1 + hstepA, voffA);
            PG8_WAIT_L(8); PG8_BAR; PG8_WAIT_L(0); PG8_MMA(0, 0, At, B0); PG8_BAR; PG8_SCHED;
            PG8_LDB(B1, 0, 1); PG8_STAGE(PG8_SB(0, 0), b2, voffB);
            PG8_BAR; PG8_WAIT_L(0); PG8_MMA(0, 1, At, B1); PG8_BAR;
            PG8_LDA(At, 0, 1); PG8_STAGE(PG8_SA(0, 0), a2, voffA);
            PG8_BAR; PG8_WAIT_L(0); PG8_MMA(1, 0, At, B0); PG8_BAR; PG8_SCHED;
            PG8_STAGE(PG8_SB(0, 1), b2 + hstep, voffB);
            PG8_WAIT_V(6); PG8_BAR; PG8_MMA(1, 1, At, B1); PG8_BAR;
            PG8_LDB(B0, 1, 0); PG8_SCHED; PG8_LDA(At, 1, 0); PG8_STAGE(PG8_SA(0, 1), a2 + hstepA, voffA);
            PG8_WAIT_L(8); PG8_BAR; PG8_WAIT_L(0); PG8_MMA(0, 0, At, B0); PG8_BAR; PG8_SCHED;
            PG8_LDB(B1, 1, 1); PG8_STAGE(PG8_SB(1, 0), b3, voffB);
            PG8_BAR; PG8_WAIT_L(0); PG8_MMA(0, 1, At, B1); PG8_BAR;
            PG8_LDA(At, 1, 1); PG8_STAGE(PG8_SA(1, 0), a3, voffA);
            PG8_BAR; PG8_WAIT_L(0); PG8_MMA(1, 0, At, B0); PG8_BAR; PG8_SCHED;
            PG8_STAGE(PG8_SB(1, 1), b3 + hstep, voffB);
            PG8_WAIT_V(6); PG8_BAR; PG8_MMA(1, 1, At, B1); PG8_BAR;
        }
        if constexpr (FP8) asm volatile("s_nop 15\n\ts_nop 15" ::: "memory");
        if constexpr (!Epi::AFTER_DRAIN) { E(acc, cur, wr, wc, fr, fq); S.done(cur); }
        if (!has_next) break;
#pragma unroll
        for (int a = 0; a < 2; ++a)
#pragma unroll
            for (int b = 0; b < 2; ++b)
#pragma unroll
                for (int m = 0; m < 4; ++m)
#pragma unroll
                    for (int n = 0; n < 2; ++n) acc[a][b][m][n] = (f32x4){0.f, 0.f, 0.f, 0.f};
        cur = nxt; cA = nA; cB = nB; ++ui;
    }
    PG8_WAIT_V(0);
    if (wr == 0) PG8_BAR;
    PG8_BAR;
    if constexpr (Epi::AFTER_DRAIN) { E.fused(acc, cur, wr, wc, fr, fq, lds, wid, lane); S.done(cur); }
#undef PG8_SA
#undef PG8_SB
#undef PG8_STAGE
#undef PG8_LDA
#undef PG8_LDB
#undef PG8_MMA
#undef PG8_WAIT_V
#undef PG8_WAIT_L
#undef PG8_BAR
#undef PG8_SCHED
}

}

struct EpiResid {
  static constexpr bool PERM = false, AFTER_DRAIN = false;
  const float* xin; float* xout; float sc;
  DI void operator()(const f32x4 (&acc)[2][2][4][2], const pg8::Unit& u, int wr, int wc, int fr, int fq) const {
    const int row0 = u.pm * 256 + wr * 64 + fr, col0 = u.pn * 256 + wc * 32 + 4 * fq;
#pragma unroll
    for (int ai = 0; ai < 2; ++ai)
#pragma unroll
      for (int m = 0; m < 4; ++m) {
        const size_t ro = (size_t)(row0 + ai * 128 + m * 16) * 2048 + col0;
#pragma unroll
        for (int bj = 0; bj < 2; ++bj)
#pragma unroll
          for (int n = 0; n < 2; ++n) {
            const size_t o = ro + bj * 128 + n * 16;
            const f32x4 xv = *(const f32x4*)(xin + o);
            *(f32x4*)(xout + o) = xv + acc[ai][bj][m][n] * sc;
          }
        asm volatile("" ::: "memory");
      }
  }
};
template <int MODE>
struct EpiBf {
  static constexpr bool PERM = true, AFTER_DRAIN = false;
  u16* d0; int ld0; int N; u16* d1; u16* d2; const f32x2* rope; float sc = 1.f; int csplit = 0, coff1 = 0, coff2 = 0;
  DI void rot(f32x4& v0, f32x4& v1, int row, int col) const {
    const f32x4* cp = (const f32x4*)(rope + (row & 2047) * 32 + ((col & 63) >> 1));
    const f32x4 c01 = cp[0], c23 = cp[1];
    const f32x4 a = {v0[0] * c01[0] - v0[1] * c01[1], v0[1] * c01[0] + v0[0] * c01[1], v0[2] * c01[2] - v0[3] * c01[3], v0[3] * c01[2] + v0[2] * c01[3]};
    const f32x4 b = {v1[0] * c23[0] - v1[1] * c23[1], v1[1] * c23[0] + v1[0] * c23[1], v1[2] * c23[2] - v1[3] * c23[3], v1[3] * c23[2] + v1[2] * c23[3]};
    v0 = a; v1 = b;
  }
  DI void operator()(const f32x4 (&acc)[2][2][4][2], const pg8::Unit& u, int wr, int wc, int fr, int fq) const {
    const int row0 = u.pm * 256 + wr * 64 + fr, colb = u.pn * 256 + wc * 32 + 8 * fq;
#pragma unroll
    for (int ai = 0; ai < 2; ++ai)
#pragma unroll
      for (int m = 0; m < 4; ++m) {
        const int row = row0 + ai * 128 + m * 16;
#pragma unroll
        for (int bj = 0; bj < 2; ++bj) {
          const int col = colb + bj * 128;
          f32x4 v0 = acc[ai][bj][m][0] * sc, v1 = acc[ai][bj][m][1] * sc;
          u16* dst = nullptr;
          if (MODE == 0) { if (col < N) dst = d0 + (size_t)row * ld0 + (col + coff2 + ((col < csplit) ? (coff1 - coff2) : 0)); }
          else if (MODE == 1) {
            const int oc = col + coff2 + ((col < csplit) ? (coff1 - coff2) : 0);
            if (col < N) {
              if (oc < 2048) dst = d0 + (size_t)row * 2048 + oc;
              else if (oc < 2112) { rot(v0, v1, row, oc); dst = d2 + (size_t)row * 64 + (oc - 2048); }
              else dst = d1 + (size_t)row * 4096 + (oc - 2112);
            }
          } else if (MODE == 3) {
            if (col < N) { const bool lo = col < csplit; u16* bp = lo ? d0 : d1; const int ldd = lo ? 2048 : 4096, oc = lo ? col : col + (coff2 - 2112); dst = bp + (size_t)row * ldd + oc + (lo ? coff1 : 0); }
          } else {
            if (((col >> 6) % 3) == 2) rot(v0, v1, row, col);
            dst = d0 + (size_t)row * 3072 + col;
          }
          if (dst) { u32x4 w = {pk2(v0[0], v0[1]), pk2(v0[2], v0[3]), pk2(v1[0], v1[1]), pk2(v1[2], v1[3])}; *(u32x4*)dst = w; }
        }
        asm volatile("" ::: "memory");
      }
  }
};

template <bool FP8 = false, class Epi>
DI void run_gemm(const u16* A, int lda, const u16* Bt, int M, int N, int K, const Epi& e, char* smem) {
  __syncthreads();
  pg8::Gemm g{A, Bt, M, N, K, lda};
  pg8::StaticOrder S; S.init(M, N, gridDim.x, blockIdx.x);
  pg8::gemm_phase<FP8>(( __attribute__((address_space(3))) unsigned char*)smem, g, S, e);
  __syncthreads();
}

typedef __attribute__((address_space(3))) unsigned* lds_u32p;
template <int OFF> DI void rd4(bf16x8 (&f)[4], unsigned addr) {
  asm volatile("ds_read_b128 %0, %4 offset:%5\n\tds_read_b128 %1, %4 offset:%6\n\tds_read_b128 %2, %4 offset:%7\n\tds_read_b128 %3, %4 offset:%8\n\ts_waitcnt lgkmcnt(0)"
               : "=&v"(f[0]), "=&v"(f[1]), "=&v"(f[2]), "=&v"(f[3]) : "v"(addr), "i"(OFF), "i"(OFF + 32), "i"(OFF + 64), "i"(OFF + 96) : "memory");
}
template <int OFF> DI void rdv8(s16x4 (&v)[8], unsigned addr) {
  asm volatile("ds_read_b64_tr_b16 %0, %8 offset:%9\n\tds_read_b64_tr_b16 %1, %8 offset:%10\n\tds_read_b64_tr_b16 %2, %8 offset:%11\n\tds_read_b64_tr_b16 %3, %8 offset:%12\n\t"
               "ds_read_b64_tr_b16 %4, %8 offset:%13\n\tds_read_b64_tr_b16 %5, %8 offset:%14\n\tds_read_b64_tr_b16 %6, %8 offset:%15\n\tds_read_b64_tr_b16 %7, %8 offset:%16\n\ts_waitcnt lgkmcnt(0)"
               : "=&v"(v[0]), "=&v"(v[1]), "=&v"(v[2]), "=&v"(v[3]), "=&v"(v[4]), "=&v"(v[5]), "=&v"(v[6]), "=&v"(v[7])
               : "v"(addr), "i"(OFF), "i"(OFF + 512), "i"(OFF + 1024), "i"(OFF + 1536), "i"(OFF + 2048), "i"(OFF + 2560), "i"(OFF + 3072), "i"(OFF + 3584) : "memory");
}
template <int KSTR, int ND, int N>
DI f32x16 s_block(unsigned kaddr, const bf16x8* qf) {
  const f32x16 z16 = {0.f, 0.f, 0.f, 0.f, 0.f, 0.f, 0.f, 0.f, 0.f, 0.f, 0.f, 0.f, 0.f, 0.f, 0.f, 0.f};
  bf16x8 f[4];
  rd4<N * 32 * KSTR>(f, kaddr);
  f32x16 a = MFMA(f[0], qf[0], z16); a = MFMA(f[1], qf[1], a); a = MFMA(f[2], qf[2], a); a = MFMA(f[3], qf[3], a);
  if constexpr (ND > 4) { rd4<N * 32 * KSTR + 128>(f, kaddr); a = MFMA(f[0], qf[4], a); a = MFMA(f[1], qf[5], a); a = MFMA(f[2], qf[6], a); a = MFMA(f[3], qf[7], a); }
  if constexpr (ND > 8) { rd4<N * 32 * KSTR + 256>(f, kaddr); a = MFMA(f[0], qf[8], a); a = MFMA(f[1], qf[9], a); a = MFMA(f[2], qf[10], a); a = MFMA(f[3], qf[11], a); }
  if constexpr (ND > 12) { rd4<N * 32 * KSTR + 384>(f, kaddr); a = MFMA(f[0], qf[12], a); a = MFMA(f[1], qf[13], a); a = MFMA(f[2], qf[14], a); a = MFMA(f[3], qf[15], a); }
  return a;
}
template <int CB> DI void pv_block(f32x16& o, unsigned vaddr, const bf16x8 (&pb)[2][2]) {
  s16x4 v[8];
  rdv8<CB * 4096>(v, vaddr);
#pragma unroll
  for (int q = 0; q < 4; ++q) {
    const bf16x8 vf = {v[2 * q][0], v[2 * q][1], v[2 * q][2], v[2 * q][3], v[2 * q + 1][0], v[2 * q + 1][1], v[2 * q + 1][2], v[2 * q + 1][3]};
    o = MFMA(vf, pb[q >> 1][q & 1], o);
  }
}
template <int DQK, int W1, int DV, int VW, int MODE>
DI void attn_core(const u16* __restrict__ k1, int ldk1, const u16* __restrict__ k2, int ldk2, const u16* __restrict__ vsrc, int ldv,
                  int kv_len, int kbase0, int ntiles, const u16* qrow, int tq, int tq0, float c2, int vcb0, u16* yrow,
                  const u16* grow, const unsigned* maskrow, const float* lutw, float bias_far, float m_init, float l_init, char* smem) {
  constexpr int KSTR = DQK * 2 + 16, KCH = DQK / 8;
  constexpr int ND = DQK / 16, NCB = DV / 32, BUF = 64 * KSTR + (VW / 32) * 4096;
  constexpr int NKI = KSTR / 16, NVI = VW / 8;
  static_assert(ND % 4 == 0 && NCB <= 4, "fragment batches");
  int tid0 = threadIdx.x; asm volatile("" : "+v"(tid0));
  const int lane = tid0 & 63, r32 = lane & 31, hi = lane >> 5;
  const int wv = __builtin_amdgcn_readfirstlane(tid0 >> 6);
  const unsigned lds0 = (unsigned)(uintptr_t)smem;
  bf16x8 qf[ND];
#pragma unroll
  for (int d0 = 0; d0 < ND; ++d0) qf[d0] = *(const bf16x8*)(qrow + d0 * 16 + hi * 8);
  f32x16 o[NCB];
#pragma unroll
  for (int cb = 0; cb < NCB; ++cb)
#pragma unroll
    for (int r = 0; r < 16; ++r) o[cb][r] = 0.f;
  float m = m_init, l = (hi == 0) ? l_init : 0.f;
  const unsigned klane = (unsigned)(r32 * KSTR + hi * 16);
  const unsigned vlane = (unsigned)(64 * KSTR + vcb0 * 4096 + ((lane >> 4) & 1) * 32 + (lane & 3) * 8 + (4 * hi + ((lane & 15) >> 2)) * 64);
  unsigned mwn[2] = {0u, 0u};
  constexpr int NKS = (NKI + 7) / 8, NVS = (NVI + 7) / 8;
  const u16* kptr[NKS]; int kstr[NKS]; const u16* vptr[NVS];
  if (MODE != 2) {
    int ln = threadIdx.x & 63; asm volatile("" : "+v"(ln));
#pragma unroll
    for (int ii = 0; ii < NKS; ++ii) {
      const int i = wv + 8 * ii, ob = i * 1024 + ln * 16, row = ob / KSTR;
      int c = (ob - row * KSTR) >> 4; c = (c >= KCH) ? 0 : c;
      const bool seg1 = c < W1 / 8;
      kptr[ii] = seg1 ? (k1 + ((kbase0 + row) * ldk1 + c * 8)) : (k2 + ((kbase0 + row) * ldk2 + (c - W1 / 8) * 8));
      kstr[ii] = seg1 ? 64 * ldk1 : 64 * ldk2;
    }
#pragma unroll
    for (int ii = 0; ii < NVS; ++ii) {
      const int i = wv + 8 * ii, ob = i * 1024 + ln * 16, cbk = ob >> 12, row = (ob & 4095) >> 6, cw = (ob & 63) >> 4;
      vptr[ii] = vsrc + ((kbase0 + row) * ldv + (cbk * 4 + cw) * 8);
    }
  }
  auto stage_tile = [&](int kb, int buf) {
    const unsigned bofs = (unsigned)(buf * BUF);
    if (MODE != 2) {
#pragma unroll
      for (int ii = 0; ii < NKS; ++ii) {
        const int i = wv + 8 * ii;
        if (i < NKI) { __builtin_amdgcn_global_load_lds((const unsigned*)kptr[ii], (lds_u32p)(smem + bofs + i * 1024), 16, 0, 0); kptr[ii] += kstr[ii]; }
      }
#pragma unroll
      for (int ii = 0; ii < NVS; ++ii) {
        const int i = wv + 8 * ii;
        if (i < NVI) { __builtin_amdgcn_global_load_lds((const unsigned*)vptr[ii], (lds_u32p)(smem + bofs + 64 * KSTR + i * 1024), 16, 0, 0); vptr[ii] += 64 * ldv; }
      }
    } else {
      int ln = threadIdx.x & 63; asm volatile("" : "+v"(ln));
#pragma unroll
      for (int ii = 0; ii < NKS; ++ii) {
        const int i = wv + 8 * ii;
        if (i < NKI) {
          const int ob = i * 1024 + ln * 16, row = ob / KSTR;
          int c = (ob - row * KSTR) >> 4; c = (c >= KCH) ? 0 : c;
          int key = kb + row; key = key < 0 ? 0 : (key >= kv_len ? kv_len - 1 : key);
          const u16* src = (c < W1 / 8) ? (k1 + (key * ldk1 + c * 8)) : (k2 + (key * ldk2 + (c - W1 / 8) * 8));
          __builtin_amdgcn_global_load_lds((const unsigned*)src, (lds_u32p)(smem + bofs + i * 1024), 16, 0, 0);
        }
      }
#pragma unroll
      for (int ii = 0; ii < NVS; ++ii) {
        const int i = wv + 8 * ii;
        if (i < NVI) {
          const int ob = i * 1024 + ln * 16, cbk = ob >> 12, row = (ob & 4095) >> 6, cw = (ob & 63) >> 4;
          int key = kb + row; key = key < 0 ? 0 : (key >= kv_len ? kv_len - 1 : key);
          __builtin_amdgcn_global_load_lds((const unsigned*)(vsrc + (key * ldv + (cbk * 4 + cw) * 8)), (lds_u32p)(smem + bofs + 64 * KSTR + i * 1024), 16, 0, 0);
        }
      }
    }
    if (MODE == 1) { mwn[0] = maskrow[(kb >> 5)]; mwn[1] = maskrow[(kb >> 5) + 1]; }
  };
  stage_tile(kbase0, 0);
  asm volatile("s_waitcnt vmcnt(0)" ::: "memory");
  __syncthreads();
  for (int t = 0; t < ntiles; ++t) {
    const int kb = kbase0 + t * 64;
    const unsigned bufa = lds0 + (unsigned)((t & 1) * BUF);
    const unsigned mw0 = mwn[0], mw1 = mwn[1];
    if (t + 1 < ntiles) stage_tile(kb + 64, (t + 1) & 1);
    if (!(MODE == 0 && kb > tq0 + 31)) {
      f32x16 s[2];
      s[0] = s_block<KSTR, ND, 0>(bufa + klane, qf);
      s[1] = s_block<KSTR, ND, 1>(bufa + klane, qf);
      if (MODE == 0) {
        const bool diag = kb + 63 > tq0;
#pragma unroll
        for (int n = 0; n < 2; ++n)
#pragma unroll
          for (int i = 0; i < 16; ++i) {
            float v = s[n][i] * c2;
            if (diag) { const int key = kb + 32 * n + crow(i, hi); if (key > tq) v = NEGV; }
            s[n][i] = v;
          }
      } else if (MODE == 1) {
        const bool far = (tq0 - (kb + 63)) >= 128;
#pragma unroll
        for (int n = 0; n < 2; ++n) {
          const unsigned wb = (n ? mw1 : mw0) >> (4 * hi);
          if (far) {
#pragma unroll
            for (int i = 0; i < 16; ++i) {
              const float v = fmaf(s[n][i], c2, bias_far);
              s[n][i] = ((wb >> ((i & 3) + 8 * (i >> 2))) & 1u) ? v : NEGV;
            }
          } else {
#pragma unroll
            for (int i = 0; i < 16; ++i) {
              const int key = kb + 32 * n + crow(i, hi);
              int rel = tq - key; rel = rel < 0 ? 0 : (rel > 128 ? 128 : rel);
              const float v = fmaf(s[n][i], c2, lutw[rel]);
              s[n][i] = ((wb >> ((i & 3) + 8 * (i >> 2))) & 1u) ? v : NEGV;
            }
          }
        }
      } else if (MODE == 2) {
#pragma unroll
        for (int n = 0; n < 2; ++n)
#pragma unroll
          for (int i = 0; i < 16; ++i) {
            const int key = kb + 32 * n + crow(i, hi), rel = tq - key;
            const bool ok = ((unsigned)rel < 128u) && (key >= 0);
            const float v = fmaf(s[n][i], c2, lutw[rel & 127]);
            s[n][i] = ok ? v : NEGV;
          }
      } else {
#pragma unroll
        for (int n = 0; n < 2; ++n)
#pragma unroll
          for (int i = 0; i < 16; ++i) s[n][i] *= c2;
      }
      float mx = s[0][0];
#pragma unroll
      for (int i = 1; i < 16; ++i) mx = fmaxf(mx, s[0][i]);
#pragma unroll
      for (int i = 0; i < 16; ++i) mx = fmaxf(mx, s[1][i]);
      mx = xhalf_max(mx);
      if (__any(mx - m > 8.0f)) {
        const float mnew = fmaxf(m, mx), alpha = __builtin_amdgcn_exp2f(m - mnew);
        m = mnew; l *= alpha;
#pragma unroll
        for (int cb = 0; cb < NCB; ++cb)
#pragma unroll
          for (int r = 0; r < 16; ++r) o[cb][r] *= alpha;
      }
      float ps = 0.f;
#pragma unroll
      for (int n = 0; n < 2; ++n)
#pragma unroll
        for (int i = 0; i < 16; ++i) { const float p = __builtin_amdgcn_exp2f(s[n][i] - m); ps += p; s[n][i] = p; }
      l += ps;
      bf16x8 pb[2][2];
#pragma unroll
      for (int n = 0; n < 2; ++n)
#pragma unroll
        for (int s2 = 0; s2 < 2; ++s2) {
          u32x4 pw = {pk2(s[n][8 * s2 + 0], s[n][8 * s2 + 1]), pk2(s[n][8 * s2 + 2], s[n][8 * s2 + 3]),
                      pk2(s[n][8 * s2 + 4], s[n][8 * s2 + 5]), pk2(s[n][8 * s2 + 6], s[n][8 * s2 + 7])};
          pb[n][s2] = __builtin_bit_cast(bf16x8, pw);
        }
      pv_block<0>(o[0], bufa + vlane, pb);
      if constexpr (NCB > 1) pv_block<1>(o[1], bufa + vlane, pb);
      if constexpr (NCB > 2) pv_block<2>(o[2], bufa + vlane, pb);
      if constexpr (NCB > 3) pv_block<3>(o[3], bufa + vlane, pb);
    }
    asm volatile("s_waitcnt vmcnt(0)" ::: "memory");
    __syncthreads();
  }
  const float inv = 1.f / xhalf_sum(l);
#pragma unroll
  for (int cb = 0; cb < NCB; ++cb)
#pragma unroll
    for (int g = 0; g < 4; ++g) {
      const int dv = 32 * cb + 8 * g + 4 * hi;
      const u32x2 gg = *(const u32x2*)(grow + dv);
      float gv[4] = {bf2f(gg[0] & 0xffffu), bf2f(gg[0] >> 16), bf2f(gg[1] & 0xffffu), bf2f(gg[1] >> 16)};
      float ov[4];
#pragma unroll
      for (int j = 0; j < 4; ++j) {
        const float sg = gv[j] / (1.f + __expf(-gv[j]));
        ov[j] = o[cb][4 * g + j] * inv * sg;
      }
      *(unsigned*)((unsigned char*)yrow + dv) = pk4_fp8(ov[0] * Y_SCALE, ov[1] * Y_SCALE, ov[2] * Y_SCALE, ov[3] * Y_SCALE);
      __builtin_amdgcn_sched_barrier(0);
    }
}

DI unsigned ordkey(float f) { const unsigned b = __float_as_uint(f); return b ^ ((unsigned)((int)b >> 31) | 0x80000000u); }
DI void indexer_phase(const u16* __restrict__ P, unsigned* __restrict__ mask) {
  int tidx = threadIdx.x; asm volatile("" : "+v"(tidx));
  const int lane = tidx & 63, r32 = lane & 31, hi = lane >> 5;
  const int gw = blockIdx.x * 8 + (tidx >> 6), nw = gridDim.x * 8;
  for (int item = gw; item < 8192; item += nw) {
    const int b = item & 7, t0 = (1023 - (item >> 3)) * 2;
    const size_t brow = (size_t)b * SEQ;
    const int g = (r32 >> 2) & 1, head = 4 * (r32 >> 3) + (r32 & 3);
    bf16x8 aq[4];
#pragma unroll
    for (int s = 0; s < 4; ++s) aq[s] = *(const bf16x8*)(P + (brow + t0 + g) * 7808 + 2560 + head * 64 + 16 * s + 8 * hi);
    float wv[16];
    {
      const u32x4 w0 = *(const u32x4*)(P + (brow + t0 + hi) * 7808 + 3648), w1 = *(const u32x4*)(P + (brow + t0 + hi) * 7808 + 3656);
#pragma unroll
      for (int j = 0; j < 4; ++j) { wv[2 * j] = bf2f(w0[j] & 0xffffu); wv[2 * j + 1] = bf2f(w0[j] >> 16); wv[8 + 2 * j] = bf2f(w1[j] & 0xffffu); wv[8 + 2 * j + 1] = bf2f(w1[j] >> 16); }
    }
    const int tme = t0 + hi, kbmax = (t0 + 1) >> 5;
    unsigned sc[64];
#pragma unroll
    for (int kb = 0; kb < 64; ++kb) {
      unsigned u = 0u;
      if (kb <= kbmax) {
        f32x16 a;
#pragma unroll
        for (int r = 0; r < 16; ++r) a[r] = 0.f;
        const u16* kp = P + (brow + 32 * kb + r32) * 7808 + 3584 + 8 * hi;
#pragma unroll
        for (int s = 0; s < 4; ++s) { const bf16x8 bk = *(const bf16x8*)(kp + 16 * s); a = MFMA(aq[s], bk, a); }
        float v = 0.f;
#pragma unroll
        for (int i = 0; i < 16; ++i) v = fmaf(wv[i], fmaxf(a[i], 0.f), v);
        u = (32 * kb + r32 <= tme) ? ordkey(v) : 0u;
      }
      sc[kb] = u;
    }
    const int target = (tme + 1 < 256) ? tme + 1 : 256;
    unsigned T = 0u;
    for (int bit = 31; bit >= 0; --bit) {
      const unsigned Tp = T | (1u << bit);
      int cnt = 0;
#pragma unroll
      for (int kb = 0; kb < 64; ++kb) cnt += (sc[kb] >= Tp) ? 1 : 0;
#pragma unroll
      for (int o = 16; o; o >>= 1) cnt += __shfl_xor(cnt, o);
      if (cnt >= target) T = Tp;
    }
    unsigned w0 = 0u, w1 = 0u;
#pragma unroll
    for (int kb = 0; kb < 64; ++kb) {
      const bool pred = (sc[kb] >= T) && (sc[kb] != 0u);
      const unsigned long long bal = __ballot(pred);
      const unsigned wd = (unsigned)(bal >> (32 * hi));
      if ((kb & 31) == r32) { if (kb < 32) w0 = wd; else w1 = wd; }
    }
    mask[(brow + tme) * 64 + r32] = w0;
    mask[(brow + tme) * 64 + 32 + r32] = w1;
  }
}

DI void gbar(unsigned* cnt, unsigned target) {
  asm volatile("s_waitcnt vmcnt(0)" ::: "memory");
  __syncthreads();
  if (threadIdx.x == 0) {
    __builtin_amdgcn_fence(__ATOMIC_RELEASE, "agent");
    asm volatile("s_waitcnt vmcnt(0)" ::: "memory");
    __hip_atomic_fetch_add(cnt, 1u, __ATOMIC_RELAXED, __HIP_MEMORY_SCOPE_AGENT);
    while (__hip_atomic_load(cnt, __ATOMIC_RELAXED, __HIP_MEMORY_SCOPE_AGENT) < target) __builtin_amdgcn_s_sleep(1);
    __builtin_amdgcn_fence(__ATOMIC_ACQUIRE, "agent");
    asm volatile("s_waitcnt vmcnt(0)" ::: "memory");
  }
  __syncthreads();
}
#define GSYNC() do { ++bar_gen; gbar(BAR, bar_gen * gridDim.x); } while (0)
__global__ void __launch_bounds__(512, 2) mega(Params p) {
  cg::grid_group grid = cg::this_grid();
  extern __shared__ __attribute__((aligned(16))) char smem[];
  volatile int* s_item = (volatile int*)(smem + LDS_ITEM);
  char* ws = p.ws;
  unsigned char* Y8 = (unsigned char*)(ws + OFF_Y);
  u16* WIN8 = (u16*)(ws + OFF_WIN + 19922944);
  unsigned char* CQ8 = (unsigned char*)(ws + OFF_Y + 67108864);     u16* H = (u16*)(ws + OFF_H); u16* Cb = (u16*)(ws + OFF_Y); u16* Qb = (u16*)(ws + OFF_H);
  u16* KV = (u16*)(ws + OFF_KV); u16* MG = (u16*)(ws + OFF_MG); u16* KR = (u16*)(ws + OFF_KR); u16* Pb = (u16*)(ws + OFF_P);
  u16* WIN = (u16*)(ws + OFF_WIN); u16* WUQ = (u16*)(ws + OFF_WUQ); u16* WUKV = (u16*)(ws + OFF_WUKV); u16* WOUT = (u16*)(ws + OFF_WOUT);
  u16* WMEMALL = (u16*)(ws + OFF_KV); u16* MEMN = (u16*)(ws + OFF_MEMN); u16* MEMKV = (u16*)(ws + OFF_MEMKV);
  unsigned* MASK = (unsigned*)(ws + OFF_MASK); f32x2* ROPE = (f32x2*)(ws + OFF_ROPE); float* LUT = (float*)(ws + OFF_LUT);
  int* CTR = (int*)(ws + OFF_CTR);
  unsigned* BAR = (unsigned*)(ws + OFF_CTR) + 64;
  unsigned bar_gen = 0;
  const int tid = threadIdx.x, lane = tid & 63, wv = __builtin_amdgcn_readfirstlane(tid >> 6), r32 = lane & 31, hi = lane >> 5;
  const int gtid = blockIdx.x * 512 + tid, gthreads = gridDim.x * 512;

  for (int i = gtid; i < 2048 * 32; i += gthreads) {
    const int pos = i >> 5, j = i & 31;
    const float inv = 1.0f / powf(10000.0f, (float)(2 * j) / 64.0f);
    const float ang = (float)pos * inv;
    const float k = rintf(ang * 0.15915494309189535f);
    float r = fmaf(-k, 6.28318548202514648f, ang);
    r = fmaf(-k, -1.74845553e-7f, r);
    f32x2 cs = {__cosf(r), __sinf(r)};
    ROPE[i] = cs;
  }
  for (int i = gtid; i < 129 * 32; i += gthreads) {
    const int rel = i >> 5, h = i & 31;
    int bucket;
    if (rel < 16) bucket = rel;
    else { const int lg = 16 + (int)(logf((float)rel / 16.0f) / 2.0794415416798357f * 16.0f); bucket = lg < 31 ? lg : 31; }
    LUT[i] = p.rel_bias[bucket * 32 + h] * LOG2E;
  }
  rmsnorm_rows<false>(p.mem, p.mem_norm, MEMN, 2048);
#pragma unroll 1
  for (int l = 0; l < 4; ++l) convert_wt<0>(p.w_mem_kv + (size_t)l * 2048 * 2048, 2048, 2048, 2048, WMEMALL + (size_t)l * 2048 * 2048, smem);

  auto convert_layer = [&](int L) {
    const int kind = L % 3, j = L / 3;
    if (kind == 0) {
    convert_wt<1>(p.w_in_a + (size_t)j * 2048 * 6208, 2048, 6208, 3840, WIN, smem, 1.f, 3648, 576, 1536, 2560, 512);
    convert_wt<0, true>(p.w_in_a + (size_t)j * 2048 * 6208, 2048, 6208, 2560, WIN8, smem, WIN_SCALE, 2560, 1536, 0, 576);
    convert_wt<2, true>(p.w_uq + (size_t)j * 1536 * 3072, 1536, 3072, 3072, WUQ, smem, WUQ_SCALE);
    convert_wt<0>(p.w_ukv + (size_t)j * 512 * 4096, 512, 4096, 4096, WUKV, smem);
  } else if (kind == 1) {
    convert_wt<0>(p.w_in_b, 2048, 7760, 4864, WIN, smem, 1.f, 4688, 1616, 2048, 3072);
    convert_wt<0, true>(p.w_in_b, 2048, 7760, 3072, WIN8, smem, WIN_SCALE, 3072, 2048, 0, 1616);
  } else {
    convert_wt<0>(p.w_in_c, 2048, 6656, 3584, WIN, smem, 1.f, 3584, 512, 2048, 3072);
    convert_wt<0, true>(p.w_in_c, 2048, 6656, 3072, WIN8, smem, WIN_SCALE, 3072, 2048, 0, 512);
  }
  };
#pragma unroll 1
  for (int layer = 0; layer < 4; ++layer) {
    const int kind = layer % 3, j = layer / 3;
    const float* xin = (layer == 0) ? p.x : p.out;
    unsigned char* H8 = (unsigned char*)(ws + ((kind == 0) ? OFF_KV + 67108864 : OFF_Y));
    rmsnorm_rows<false>(xin, p.norm_in + layer * 2048, H, NTOK, H8);
    if (layer == 0) convert_layer(0);
    convert_wt<0, true>(p.w_out + (size_t)layer * 3072 * 2048, 3072, 2048, 2048, WOUT, smem, WOUT_SCALE);
    if (layer == 0) { __builtin_amdgcn_fence(__ATOMIC_RELEASE, "agent"); grid.sync(); __builtin_amdgcn_fence(__ATOMIC_ACQUIRE, "agent"); asm volatile("s_waitcnt vmcnt(0)" ::: "memory"); }
    else GSYNC();

    if (kind == 0) {
      { EpiBf<1> e{Cb, 2048, 3648, MG, KR, ROPE, 1.f, 576, 1536, 2560}; run_gemm(H, 2048, WIN, NTOK, 3840, 2048, e, smem); }
      { EpiBf<3> e{Cb, 2048, 2560, MG, nullptr, nullptr, 1.f / (H_SCALE * WIN_SCALE), 1536, 0, 576}; run_gemm<true>((const u16*)H8, 1024, WIN8, NTOK, 2560, 1024, e, smem); }
    }
    else if (kind == 1) {
      { EpiBf<0> e{Pb, 7808, 4688, nullptr, nullptr, nullptr, 1.f, 1616, 2048, 3072}; run_gemm(H, 2048, WIN, NTOK, 4864, 2048, e, smem); }
      { EpiBf<0> e{Pb, 7808, 3072, nullptr, nullptr, nullptr, 1.f / (H_SCALE * WIN_SCALE), 2048, 0, 1616}; run_gemm<true>((const u16*)H8, 1024, WIN8, NTOK, 3072, 1024, e, smem); }
    } else {
      { EpiBf<0> e{Pb, 6656, 3584, nullptr, nullptr, nullptr, 1.f, 512, 2048, 3072}; run_gemm(H, 2048, WIN, NTOK, 3584, 2048, e, smem); }
      { EpiBf<0> e{Pb, 6656, 3072, nullptr, nullptr, nullptr, 1.f / (H_SCALE * WIN_SCALE), 2048, 0, 512}; run_gemm<true>((const u16*)H8, 1024, WIN8, NTOK, 3072, 1024, e, smem); }
    }
    if (layer == 0) { EpiBf<0> e{MEMKV, 8192, 8192, nullptr, nullptr, nullptr}; run_gemm(MEMN, 2048, WMEMALL, 2048, 8192, 2048, e, smem); }
    GSYNC();

    if (kind == 0) {
      anorm_phase(Cb, p.a_q_norm + j * 1536, p.a_kv_norm + j * 512, CQ8);
      GSYNC();
      { EpiBf<2> e{Qb, 3072, 3072, nullptr, nullptr, ROPE, 1.f / (CQ_SCALE * WUQ_SCALE)}; run_gemm<true>((const u16*)CQ8, 768, WUQ, NTOK, 3072, 768, e, smem); }
      { EpiBf<0> e{KV, 4096, 4096, nullptr, nullptr, nullptr}; run_gemm(Cb + 1536, 2048, WUKV, NTOK, 4096, 512, e, smem); }
      GSYNC();
    } else if (kind == 1) {
      indexer_phase(Pb, MASK);
      GSYNC();
    }

    {
      const int nself = (kind == 0) ? 1024 : 2048, total = nself + 512;
      const u16* mgb = (kind == 0) ? MG : Pb;
      const int ldmg = (kind == 0) ? 4096 : (kind == 1 ? 7808 : 6656);
      const int mqcol = (kind == 0) ? 0 : (kind == 1 ? 3664 : 2560);
      const int gatecol = (kind == 0) ? 1024 : (kind == 1 ? 4688 : 3584);
      const u16* memkv = MEMKV + layer * 2048;
      float* lut_all = (float*)(smem + LDS_LUT);
      if (kind != 0) {
        for (int i = tid; i < 32 * 129; i += 512) { const int h = i / 129, r = i - h * 129; lut_all[h * 132 + r] = LUT[r * 32 + h]; }
      }
      if (tid == 0) s_item[0] = atomicAdd(&CTR[layer], 1);
      __syncthreads();
      for (int par = 0;; par ^= 1) {
        const int item = __builtin_amdgcn_readfirstlane(s_item[par]);
        if (item >= total) break;
        if (tid == 0) s_item[par ^ 1] = atomicAdd(&CTR[layer], 1);
        if (item < nself) {
          if (kind == 0) {
            const int qblk = 7 - item / 128, rem = item % 128, b = rem / 16, head = rem % 16;
            const size_t brow = (size_t)b * SEQ;
            const int tq0 = qblk * 256 + 32 * wv, tq = tq0 + r32;
            attn_core<192, 128, 128, 128, 0>(KV + brow * 4096 + head * 256, 4096, KR + brow * 64, 64, KV + brow * 4096 + head * 256 + 128, 4096,
                                            SEQ, 0, 4 * qblk + 4, Qb + (brow + tq) * 3072 + head * 192, tq, tq0, 0.07216878364870322f * LOG2E, 0,
                                            (u16*)(Y8 + (brow + tq) * 3072 + head * 128), mgb + (brow + tq) * ldmg + gatecol + head * 128,
                                            nullptr, nullptr, 0.f, -1e29f, 0.f, smem);
          } else {
            const int qb = 63 - item / 32, rem = item % 32, b = rem / 4, kvh = rem % 4;
            const size_t brow = (size_t)b * SEQ;
            const int head = kvh * 8 + wv, tq0 = qb * 32, tq = tq0 + r32;
            const float* lutw = lut_all + head * 132;
            if (kind == 1) {
              attn_core<64, 64, 64, 64, 1>(Pb + brow * 7808 + 2048 + kvh * 64, 7808, nullptr, 0, Pb + brow * 7808 + 2304 + kvh * 64, 7808,
                                          SEQ, 0, (tq0 + 31) / 64 + 1, Pb + (brow + tq) * 7808 + head * 64, tq, tq0, 0.125f * LOG2E, 0,
                                          (u16*)(Y8 + (brow + tq) * 3072 + head * 64), Pb + (brow + tq) * 7808 + gatecol + head * 64,
                                          MASK + (brow + tq) * 64, lutw, lutw[128], -1e29f, 0.f, smem);
            } else {
              const float sink = p.c_sinks[j * 32 + head] * LOG2E;
              attn_core<64, 64, 64, 64, 2>(Pb + brow * 6656 + 2048 + kvh * 64, 6656, nullptr, 0, Pb + brow * 6656 + 2304 + kvh * 64, 6656,
                                          SEQ, tq0 - 128, 3, Pb + (brow + tq) * 6656 + head * 64, tq, tq0, 0.125f * LOG2E, 0,
                                          (u16*)(Y8 + (brow + tq) * 3072 + head * 64), Pb + (brow + tq) * 6656 + gatecol + head * 64,
                                          nullptr, lutw, 0.f, sink, 1.f, smem);
            }
          }
        } else {
          const int it = item - nself, b = it / 64, mh = (it % 64) / 16, qb = it % 16;
          const size_t brow = (size_t)b * SEQ;
          const int tq0 = qb * 128 + 32 * (wv >> 1), tq = tq0 + r32, vh = wv & 1;
          attn_core<256, 256, 128, 256, 3>(memkv + (size_t)b * 256 * 8192 + mh * 256, 8192, nullptr, 0, memkv + (size_t)b * 256 * 8192 + 1024 + mh * 256, 8192,
                                          256, 0, 4, mgb + (brow + tq) * ldmg + mqcol + mh * 256, tq, tq0, 0.0625f * LOG2E, 4 * vh,
                                          (u16*)(Y8 + (brow + tq) * 3072 + 2048 + mh * 256 + 128 * vh), mgb + (brow + tq) * ldmg + gatecol + 2048 + mh * 256 + 128 * vh,
                                          nullptr, nullptr, 0.f, -1e29f, 0.f, smem);
        }
      }
    }
    if (layer + 1 < 4) convert_layer(layer + 1);
    GSYNC();

    { EpiResid e{xin, p.out, 1.f / (Y_SCALE * WOUT_SCALE)}; run_gemm<true>((const u16*)Y8, 1536, WOUT, NTOK, 2048, 1536, e, smem); }
    GSYNC();
  }
  rmsnorm_rows<true>(p.out, p.final_norm, p.out, NTOK);
}

extern "C" void kernel_launch(void* const* d_in, const int* in_sizes, int n_in, void* d_out, int out_size,
                              void* d_ws, size_t ws_size, hipStream_t stream) {
  static int grid_blocks = 0;
  if (!grid_blocks) {
    int dev = 0, cus = 0, per_cu = 0;
    (void)hipGetDevice(&dev);
    (void)hipDeviceGetAttribute(&cus, hipDeviceAttributeMultiprocessorCount, dev);
    (void)hipFuncSetAttribute((const void*)mega, hipFuncAttributeMaxDynamicSharedMemorySize, LDS_BYTES);
    (void)hipOccupancyMaxActiveBlocksPerMultiprocessor(&per_cu, mega, 512, LDS_BYTES);
    if (per_cu > 1) per_cu = 1;
    grid_blocks = cus * per_cu;
  }
  Params p{};
  p.x = (const float*)d_in[0]; p.mem = (const float*)d_in[1]; p.norm_in = (const float*)d_in[2]; p.final_norm = (const float*)d_in[3];
  p.mem_norm = (const float*)d_in[4]; p.rel_bias = (const float*)d_in[5]; p.w_in_a = (const float*)d_in[6]; p.a_q_norm = (const float*)d_in[7];
  p.w_uq = (const float*)d_in[8]; p.a_kv_norm = (const float*)d_in[9]; p.w_ukv = (const float*)d_in[10]; p.w_in_b = (const float*)d_in[11];
  p.w_in_c = (const float*)d_in[12]; p.c_sinks = (const float*)d_in[13]; p.w_mem_kv = (const float*)d_in[14]; p.w_out = (const float*)d_in[15];
  p.out = (float*)d_out; p.ws = (char*)d_ws;
  (void)hipMemsetAsync((char*)d_ws + OFF_CTR, 0, 1024, stream);
  void* args[] = {&p};
  (void)hipLaunchCooperativeKernel((void*)mega, dim3(grid_blocks), dim3(512), args, LDS_BYTES, stream);
}
```

```cpp
#include <hip/hip_runtime.h>
#include <hip/hip_cooperative_groups.h>
#include <stdint.h>
namespace cg = cooperative_groups;

typedef unsigned short u16;
typedef __attribute__((ext_vector_type(8))) short bf16x8;
typedef __attribute__((ext_vector_type(4))) short s16x4;
typedef __attribute__((ext_vector_type(16))) float f32x16;
typedef __attribute__((ext_vector_type(4))) float f32x4;
typedef __attribute__((ext_vector_type(2))) float f32x2;
typedef __attribute__((ext_vector_type(4))) unsigned u32x4;
typedef __attribute__((ext_vector_type(2))) unsigned u32x2;
typedef __attribute__((ext_vector_type(2))) __bf16 bf16x2_t;
typedef short v4i16_t __attribute__((ext_vector_type(4)));
#define DI __device__ __forceinline__
#define MFMA(a, b, c) __builtin_amdgcn_mfma_f32_32x32x16_bf16((a), (b), (c), 0, 0, 0)

constexpr int SEQ = 2048, NTOK = 16384;
constexpr int LDS_LUT = 133120, LDS_ITEM = LDS_LUT + 32 * 528, LDS_BYTES = LDS_ITEM + 64;
constexpr float LOG2E = 1.4426950408889634f;
constexpr float NEGV = -1e30f;
constexpr float Y_SCALE = 16.f, WOUT_SCALE = 256.f, CQ_SCALE = 16.f, WUQ_SCALE = 256.f, H_SCALE = 16.f, WIN_SCALE = 256.f;

constexpr size_t OFF_Y = 0;
constexpr size_t OFF_H = 100663296;
constexpr size_t OFF_KV = 201326592;
constexpr size_t OFF_MG = 335544320;
constexpr size_t OFF_KR = 469762048;
constexpr size_t OFF_P = 167772160;
constexpr size_t OFF_WIN = 471859200;
constexpr size_t OFF_WUQ = OFF_WIN + 32505856;
constexpr size_t OFF_WUKV = OFF_WUQ + 9437184;
constexpr size_t OFF_WOUT = OFF_WUKV + 4194304;
constexpr size_t OFF_MEMN = OFF_WOUT + 12582912;
constexpr size_t OFF_MEMKV = OFF_MEMN + 8388608;
constexpr size_t OFF_MASK = OFF_MEMKV + 33554432;
constexpr size_t OFF_ROPE = OFF_MASK + 4194304;
constexpr size_t OFF_LUT = OFF_ROPE + 524288;
constexpr size_t OFF_CTR = OFF_LUT + 32768;

struct Params {
  const float *x, *mem, *norm_in, *final_norm, *mem_norm, *rel_bias, *w_in_a, *a_q_norm, *w_uq, *a_kv_norm, *w_ukv,
      *w_in_b, *w_in_c, *c_sinks, *w_mem_kv, *w_out;
  float* out;
  char* ws;
};

DI float bf2f(unsigned b) { return __uint_as_float(b << 16); }
DI unsigned pk2(float a, float b) {
  f32x2 v = {a, b};
  return __builtin_bit_cast(unsigned, __builtin_convertvector(v, bf16x2_t));
}
DI float clamp8(float x) { return fminf(fmaxf(x, -448.f), 448.f); }
DI unsigned pk4_fp8(float a, float b, float c, float d) {
  int w = 0;
  w = __builtin_amdgcn_cvt_pk_fp8_f32(clamp8(a), clamp8(b), w, false);
  w = __builtin_amdgcn_cvt_pk_fp8_f32(clamp8(c), clamp8(d), w, true);
  return (unsigned)w;
}
DI u16 f2bf(float a) { return (u16)(pk2(a, 0.f) & 0xffffu); }
DI float wave_sum(float v) {
#pragma unroll
  for (int o = 32; o; o >>= 1) v += __shfl_xor(v, o);
  return v;
}
DI int crow(int reg, int hi) { return (reg & 3) + 8 * (reg >> 2) + 4 * hi; }
DI float xhalf_max(float m) {
  auto rr = __builtin_amdgcn_permlane32_swap(__float_as_uint(m), __float_as_uint(m), false, false);
  return fmaxf(__uint_as_float(rr[0]), __uint_as_float(rr[1]));
}
DI float xhalf_sum(float m) {
  auto rr = __builtin_amdgcn_permlane32_swap(__float_as_uint(m), __float_as_uint(m), false, false);
  return __uint_as_float(rr[0]) + __uint_as_float(rr[1]);
}
typedef __attribute__((address_space(3))) v4i16_t* lds_v4p;
DI s16x4 vtr(const char* p) {
  return __builtin_bit_cast(s16x4, __builtin_amdgcn_ds_read_tr16_b64_v4i16((lds_v4p)(p)));
}

template <int PERM, bool FP8 = false>
DI void convert_wt(const float* __restrict__ W, int K, int N, int Npad, u16* __restrict__ Wt, char* smem, float wscale = 1.f,
                   int nvalid = -1, int csplit = 0, int coff1 = 0, int coff2 = 0, int rot_n0 = 2048) {
  float* tile = (float*)smem;
  int tid = threadIdx.x; asm volatile("" : "+v"(tid));
  const int ntk = K / 64, ntn = Npad / 64;
  for (int t = blockIdx.x; t < ntk * ntn; t += gridDim.x) {
    const int tk = t % ntk, tn = t / ntk, k0 = tk * 64, n0 = tn * 64;
    __syncthreads();
#pragma unroll
    for (int i = 0; i < 2; ++i) {
      const int id = tid + 512 * i, kr = id >> 4, n4 = (id & 15) * 4;
      f32x4 v = {0.f, 0.f, 0.f, 0.f};
      const int nd = n0 + n4, nsrc = (nvalid < 0) ? nd : (nd < csplit ? nd + coff1 : nd + coff2);
      if (nd < ((nvalid < 0) ? N : nvalid)) v = *(const f32x4*)(W + (size_t)(k0 + kr) * N + nsrc);
      tile[kr * 65 + n4 + 0] = v[0]; tile[kr * 65 + n4 + 1] = v[1]; tile[kr * 65 + n4 + 2] = v[2]; tile[kr * 65 + n4 + 3] = v[3];
    }
    __syncthreads();
    {
      const int n = tid >> 3, c = tid & 7;
      bool rot = false;
      if (PERM == 1) rot = (n0 == rot_n0);
      if (PERM == 2) rot = ((tn % 3) == 2);
      const int ns = rot ? ((n >> 1) + 32 * (n & 1)) : n;
      if (FP8) {
        float f[8];
#pragma unroll
        for (int j = 0; j < 8; ++j) f[j] = tile[(c * 8 + j) * 65 + ns] * wscale;
        u32x2 o = {pk4_fp8(f[0], f[1], f[2], f[3]), pk4_fp8(f[4], f[5], f[6], f[7])};
        *(u32x2*)((unsigned char*)Wt + (size_t)(n0 + n) * K + k0 + c * 8) = o;
      } else {
        u32x4 o;
#pragma unroll
        for (int j = 0; j < 4; ++j) o[j] = pk2(tile[(c * 8 + 2 * j) * 65 + ns], tile[(c * 8 + 2 * j + 1) * 65 + ns]);
        *(u32x4*)(Wt + (size_t)(n0 + n) * K + k0 + c * 8) = o;
      }
    }
  }
}

template <bool F32OUT>
DI void rmsnorm_rows(const float* X, const float* __restrict__ g, void* outp, int nrows, unsigned char* __restrict__ out8 = nullptr) {
  int tidx = threadIdx.x; asm volatile("" : "+v"(tidx));
  const int lane = tidx & 63, gw = blockIdx.x * 8 + (tidx >> 6), nw = gridDim.x * 8;
  for (int row = gw; row < nrows; row += nw) {
    const f32x4* xr = (const f32x4*)(X + (size_t)row * 2048);
    f32x4 v[8];
    float ss = 0.f;
#pragma unroll
    for (int i = 0; i < 8; ++i) { v[i] = xr[lane + 64 * i]; ss += v[i][0] * v[i][0] + v[i][1] * v[i][1] + v[i][2] * v[i][2] + v[i][3] * v[i][3]; }
    ss = wave_sum(ss);
    const float r = rsqrtf(ss * (1.f / 2048.f) + 1e-6f);
#pragma unroll
    for (int i = 0; i < 8; ++i) {
      const f32x4 gg = ((const f32x4*)g)[lane + 64 * i];
      f32x4 o = {v[i][0] * r * gg[0], v[i][1] * r * gg[1], v[i][2] * r * gg[2], v[i][3] * r * gg[3]};
      if (F32OUT) ((f32x4*)((float*)outp + (size_t)row * 2048))[lane + 64 * i] = o;
      else { u32x2 pk = {pk2(o[0], o[1]), pk2(o[2], o[3])}; ((u32x2*)((u16*)outp + (size_t)row * 2048))[lane + 64 * i] = pk; }
      if (!F32OUT && out8) ((unsigned*)(out8 + (size_t)row * 2048))[lane + 64 * i] = pk4_fp8(o[0] * H_SCALE, o[1] * H_SCALE, o[2] * H_SCALE, o[3] * H_SCALE);
    }
  }
}

DI void anorm_phase(u16* C, const float* __restrict__ gq, const float* __restrict__ gkv, unsigned char* __restrict__ cq8) {
  int tidx = threadIdx.x; asm volatile("" : "+v"(tidx));
  const int lane = tidx & 63, gw = blockIdx.x * 8 + (tidx >> 6), nw = gridDim.x * 8;
  for (int row = gw; row < NTOK; row += nw) {
    u32x4* cr = (u32x4*)(C + (size_t)row * 2048);
    u32x4 v[4];
    float sq = 0.f, skv = 0.f;
#pragma unroll
    for (int i = 0; i < 4; ++i) {
      v[i] = cr[lane + 64 * i];
      float s = 0.f;
#pragma unroll
      for (int j = 0; j < 4; ++j) { float a = bf2f(v[i][j] & 0xffffu), b = bf2f(v[i][j] >> 16); s += a * a + b * b; }
      if (i < 3) sq += s; else skv += s;
    }
    sq = wave_sum(sq); skv = wave_sum(skv);
    const float rq = rsqrtf(sq * (1.f / 1536.f) + 1e-6f), rkv = rsqrtf(skv * (1.f / 512.f) + 1e-6f);
#pragma unroll
    for (int i = 0; i < 4; ++i) {
      const int col = (lane + 64 * i) * 8;
      const float* gp = (i < 3) ? (gq + col) : (gkv + col - 1536);
      const float r = (i < 3) ? rq : rkv;
      const f32x4 g0 = *(const f32x4*)gp, g1 = *(const f32x4*)(gp + 4);
      u32x4 o;
      o[0] = pk2(bf2f(v[i][0] & 0xffffu) * r * g0[0], bf2f(v[i][0] >> 16) * r * g0[1]);
      o[1] = pk2(bf2f(v[i][1] & 0xffffu) * r * g0[2], bf2f(v[i][1] >> 16) * r * g0[3]);
      o[2] = pk2(bf2f(v[i][2] & 0xffffu) * r * g1[0], bf2f(v[i][2] >> 16) * r * g1[1]);
      o[3] = pk2(bf2f(v[i][3] & 0xffffu) * r * g1[2], bf2f(v[i][3] >> 16) * r * g1[3]);
      cr[lane + 64 * i] = o;
      if (i < 3) {
        const float q0 = bf2f(v[i][0] & 0xffffu) * r * g0[0] * CQ_SCALE, q1 = bf2f(v[i][0] >> 16) * r * g0[1] * CQ_SCALE;
        const float q2 = bf2f(v[i][1] & 0xffffu) * r * g0[2] * CQ_SCALE, q3 = bf2f(v[i][1] >> 16) * r * g0[3] * CQ_SCALE;
        const float q4 = bf2f(v[i][2] & 0xffffu) * r * g1[0] * CQ_SCALE, q5 = bf2f(v[i][2] >> 16) * r * g1[1] * CQ_SCALE;
        const float q6 = bf2f(v[i][3] & 0xffffu) * r * g1[2] * CQ_SCALE, q7 = bf2f(v[i][3] >> 16) * r * g1[3] * CQ_SCALE;
        u32x2 w8 = {pk4_fp8(q0, q1, q2, q3), pk4_fp8(q4, q5, q6, q7)};
        *(u32x2*)(cq8 + (size_t)row * 1536 + col) = w8;
      }
    }
  }
}

namespace pg8 {
#define PG8_LAS __attribute__((address_space(3)))
constexpr int BM = 256, BK = 64, HALF = 128, HTB = HALF * BK * 2, STAGE_BYTES = 8 * HTB, NXCD = 8, WGM = 8;
DI int lds_byte(int r, int c) { const int st = (r >> 4) * 2 + (c >> 5), rr = r & 15, cc = c & 31, ob = rr * 64 + cc * 2; return st * 1024 + (ob ^ (((ob >> 9) & 1) << 5)); }
DI void stage_rc(int b, int& R, int& C) { const int st = b / 1024, sb = b % 1024, swz = sb ^ (((sb >> 9) & 1) << 5); R = (st >> 1) * 16 + swz / 64; C = (st & 1) * 32 + (swz % 64) / 2; }
DI int perm32(int rho) { const int n = rho >> 4, i = rho & 15; return 8 * (i >> 2) + 4 * n + (i & 3); }
typedef int i32x4v __attribute__((ext_vector_type(4)));
typedef int i32x8 __attribute__((ext_vector_type(8)));
DI i32x8 cat8(bf16x8 a, bf16x8 b) { const i32x4v x = __builtin_bit_cast(i32x4v, a), y = __builtin_bit_cast(i32x4v, b); return __builtin_shufflevector(x, y, 0, 1, 2, 3, 4, 5, 6, 7); }
struct Unit { int pm, pn; };
struct Gemm { const u16* A; const u16* Bt; int M, N, K, lda; };
struct StaticOrder {
  int nM, nN, nwg, G, c;
  DI void init(int M, int N, int G_, int c_) { nM = M / BM; nN = N / BM; nwg = nM * nN; G = G_; c = c_; }
  DI bool next(int i, Unit& u) const {
    const long L = (long)i * G + c; if (L >= nwg) return false;
    int wgid = (int)L; { const int q = nwg / NXCD, r = nwg % NXCD, xcd = wgid % NXCD, off = wgid / NXCD; wgid = (xcd < r ? xcd * (q + 1) : r * (q + 1) + (xcd - r) * q) + off; }
    const int nig = WGM * nN, gid = wgid / nig, fm = gid * WGM, gsz = (nM - fm) < WGM ? (nM - fm) : WGM;
    u.pm = fm + ((wgid % nig) % gsz); u.pn = (wgid % nig) / gsz; return true;
  }
  DI void a_ready(const Unit&) const {}
  DI void done(const Unit&) const {}
};
template <bool FP8, class Epi, class Sched>
__device__ __forceinline__ void gemm_phase(PG8_LAS unsigned char* lds, const Gemm g, const Sched& S, const Epi& E) {
    int tid = threadIdx.x; asm volatile("" : "+v"(tid));
    const int wid = __builtin_amdgcn_readfirstlane(tid >> 6), lane = tid & 63, wr = wid >> 2, wc = wid & 3, fr = lane & 15, fq = lane >> 4;
    const int K = g.K, nt = K / BK;
    unsigned voffA[2], voffB[2];
#pragma unroll
    for (int i = 0; i < 2; ++i) { int R, C; stage_rc(tid * 16 + i * 8192, R, C); const int Rb = Epi::PERM ? ((R & ~31) + perm32(R & 31)) : R;
        voffA[i] = (unsigned)(R * g.lda + C) * 2u; voffB[i] = (unsigned)(Rb * K + C) * 2u; }
    const size_t kstep = (size_t)(BK * 2);
    const size_t hstep = (size_t)HALF * K * 2, hstepA = (size_t)HALF * g.lda * 2;
    const size_t tstep = 2 * hstep, tstepA = 2 * hstepA;
    const unsigned ldsw = (unsigned)wid * 1024u;
    const int aoff = lds_byte(wr * 64 + fr, fq * 8), boff = lds_byte(wc * 32 + fr, fq * 8);
#define PG8_SA(b, h) (((b) * 2 + (h)) * HTB)
#define PG8_SB(b, h) ((4 + (b) * 2 + (h)) * HTB)
#define PG8_STAGE(bufoff, gbase, voff) do { _Pragma("unroll") for (int _i = 0; _i < 2; ++_i) \
        __builtin_amdgcn_global_load_lds((const unsigned*)((const char*)(gbase) + (voff)[_i]), (PG8_LAS unsigned*)(lds + (bufoff) + ldsw + _i * 8192), 16, 0, 0); } while (0)
#define PG8_LDA(dst, b, h) do { _Pragma("unroll") for (int m = 0; m < 4; ++m) _Pragma("unroll") for (int k = 0; k < 2; ++k) dst[m][k] = *(const PG8_LAS bf16x8*)(lds + PG8_SA(b, h) + aoff + m * 2048 + k * 1024); } while (0)
#define PG8_LDB(dst, b, h) do { _Pragma("unroll") for (int n = 0; n < 2; ++n) _Pragma("unroll") for (int k = 0; k < 2; ++k) dst[n][k] = *(const PG8_LAS bf16x8*)(lds + PG8_SB(b, h) + boff + n * 2048 + k * 1024); } while (0)
#define PG8_MMA(ai, bj, At, Bt) do { __builtin_amdgcn_s_setprio(1); _Pragma("unroll") for (int m = 0; m < 4; ++m) _Pragma("unroll") for (int n = 0; n < 2; ++n) { \
        if constexpr (FP8) { const i32x8 bv_ = cat8(Bt[n][0], Bt[n][1]), av_ = cat8(At[m][0], At[m][1]); \
            asm volatile("s_nop 1\n\tv_mfma_scale_f32_16x16x128_f8f6f4 %0, %1, %2, %0, %3, %3 op_sel_hi:[0,0,0]" : "+v"(acc[ai][bj][m][n]) : "v"(bv_), "v"(av_), "v"(sc127)); } \
        else { _Pragma("unroll") for (int k = 0; k < 2; ++k) acc[ai][bj][m][n] = __builtin_amdgcn_mfma_f32_16x16x32_bf16(Bt[n][k], At[m][k], acc[ai][bj][m][n], 0, 0, 0); } } \
        __builtin_amdgcn_s_setprio(0); } while (0)
#define PG8_WAIT_V(n) asm volatile("s_waitcnt vmcnt(" #n ")" ::: "memory")
#define PG8_WAIT_L(n) asm volatile("s_waitcnt lgkmcnt(" #n ")" ::: "memory")
#define PG8_BAR __builtin_amdgcn_s_barrier()
#define PG8_SCHED __builtin_amdgcn_sched_barrier(0)
    Unit cur, nxt; int ui = 0;
    if (!S.next(0, cur)) return;
    f32x4 acc[2][2][4][2];
#pragma unroll
    for (int a = 0; a < 2; ++a)
#pragma unroll
        for (int b = 0; b < 2; ++b)
#pragma unroll
            for (int m = 0; m < 4; ++m)
#pragma unroll
                for (int n = 0; n < 2; ++n) acc[a][b][m][n] = (f32x4){0.f, 0.f, 0.f, 0.f};
    bf16x8 At[4][2], B0[2][2], B1[2][2];
    int sc127 = 0x7F7F7F7F; asm volatile("" : "+v"(sc127));
    const char* cA = (const char*)g.A + (size_t)cur.pm * tstepA; const char* cB = (const char*)g.Bt + (size_t)cur.pn * tstep;
    S.a_ready(cur);
    PG8_STAGE(PG8_SB(0, 0), cB, voffB); PG8_STAGE(PG8_SA(0, 0), cA, voffA); PG8_STAGE(PG8_SB(0, 1), cB + hstep, voffB); PG8_STAGE(PG8_SA(0, 1), cA + hstepA, voffA);
    if (wr == 1) PG8_BAR;
    PG8_WAIT_V(4); PG8_BAR;
    PG8_STAGE(PG8_SB(1, 0), cB + kstep, voffB); PG8_STAGE(PG8_SA(1, 0), cA + kstep, voffA); PG8_STAGE(PG8_SB(1, 1), cB + hstep + kstep, voffB);
    PG8_WAIT_V(6); PG8_BAR;
    for (;;) {
        const bool has_next = S.next(ui + 1, nxt);
        const char* nA = has_next ? (const char*)g.A + (size_t)nxt.pm * tstepA : cA; const char* nB = has_next ? (const char*)g.Bt + (size_t)nxt.pn * tstep : cB;
        for (int t = 0; t < nt; t += 2) {
            const bool last = (t == nt - 2);
            const char* a1 = cA + (size_t)(t + 1) * kstep;
            const char* a2 = last ? nA : cA + (size_t)(t + 2) * kstep; const char* b2 = last ? nB : cB + (size_t)(t + 2) * kstep;
            const char* a3 = a2 + kstep; const char* b3 = b2 + kstep;
            if (last && has_next) S.a_ready(nxt);
            PG8_LDB(B0, 0, 0); PG8_SCHED; PG8_LDA(At, 0, 0); PG8_STAGE(PG8_SA(1, 1), a1 + hstepA, voffA);
            PG8_WAIT_L(8); PG8_BAR; PG8_WAIT_L(0); PG8_MMA(0, 0, At, B0); PG8_BAR; PG8_SCHED;
            PG8_LDB(B1, 0, 1); PG8_STAGE(PG8_SB(0, 0), b2, voffB);
            PG8_BAR; PG8_WAIT_L(0); PG8_MMA(0, 1, At, B1); PG8_BAR;
            PG8_LDA(At, 0, 1); PG8_STAGE(PG8_SA(0, 0), a2, voffA);
            PG8_BAR; PG8_WAIT_L(0); PG8_MMA(1, 0, At, B0); PG8_BAR; PG8_SCHED;
            PG8_STAGE(PG8_SB(0, 1), b2 + hstep, voffB);
            PG8_WAIT_V(6); PG8_BAR; PG8_MMA(1, 1, At, B1); PG8_BAR;
            PG8_LDB(B0, 1, 0); PG8_SCHED; PG8_LDA(At, 1, 0); PG8_STAGE(PG8_SA(0, 1), a2 + hstepA, voffA);
            PG8_WAIT_L(8); PG8_BAR; PG8_WAIT_L(0); PG8_MMA(0, 0, At, B0); PG8_BAR; PG8_SCHED;
            PG8_LDB(B1, 1, 1); PG8_STAGE(PG8_SB(1, 0), b3, voffB);
            PG8_BAR; PG8_WAIT_L(0); PG8_MMA(0, 1, At, B1); PG8_BAR;
            PG8_LDA(At, 1, 1); PG8_STAGE(PG8_SA(1, 0), a3, voffA);
            PG8_BAR; PG8_WAIT_L(0); PG8_MMA(1, 0, At, B0); PG8_BAR; PG8_SCHED;
            PG8_STAGE(PG8_SB(1, 1), b3 + hstep, voffB);
            PG8_WAIT_V(6); PG8_BAR; PG8_MMA(1, 1, At, B1); PG8_BAR;
        }
        if constexpr (FP8) asm volatile("s_nop 15\n\ts_nop 15" ::: "memory");
        if constexpr (!Epi::AFTER_DRAIN) { E(acc, cur, wr, wc, fr, fq); S.done(cur); }
        if (!has_next) break;
#pragma unroll
        for (int a = 0; a < 2; ++a)
#pragma unroll
            for (int b = 0; b < 2; ++b)
#pragma unroll
                for (int m = 0; m < 4; ++m)
#pragma unroll
                    for (int n = 0; n < 2; ++n) acc[a][b][m][n] = (f32x4){0.f, 0.f, 0.f, 0.f};
        cur = nxt; cA = nA; cB = nB; ++ui;
    }
    PG8_WAIT_V(0);
    if (wr == 0) PG8_BAR;
    PG8_BAR;
    if constexpr (Epi::AFTER_DRAIN) { E.fused(acc, cur, wr, wc, fr, fq, lds, wid, lane); S.done(cur); }
#undef PG8_SA
#undef PG8_SB
#undef PG8_STAGE
#undef PG8_LDA
#undef PG8_LDB
#undef PG8_MMA
#undef PG8_WAIT_V
#undef PG8_WAIT_L
#undef PG8_BAR
#undef PG8_SCHED
}

}

struct EpiResid {
  static constexpr bool PERM = false, AFTER_DRAIN = false;
  const float* xin; float* xout; float sc;
  DI void operator()(const f32x4 (&acc)[2][2][4][2], const pg8::Unit& u, int wr, int wc, int fr, int fq) const {
    const int row0 = u.pm * 256 + wr * 64 + fr, col0 = u.pn * 256 + wc * 32 + 4 * fq;
#pragma unroll
    for (int ai = 0; ai < 2; ++ai)
#pragma unroll
      for (int m = 0; m < 4; ++m) {
        const size_t ro = (size_t)(row0 + ai * 128 + m * 16) * 2048 + col0;
#pragma unroll
        for (int bj = 0; bj < 2; ++bj)
#pragma unroll
          for (int n = 0; n < 2; ++n) {
            const size_t o = ro + bj * 128 + n * 16;
            const f32x4 xv = *(const f32x4*)(xin + o);
            *(f32x4*)(xout + o) = xv + acc[ai][bj][m][n] * sc;
          }
        asm volatile("" ::: "memory");
      }
  }
};
template <int MODE>
struct EpiBf {
  static constexpr bool PERM = true, AFTER_DRAIN = false;
  u16* d0; int ld0; int N; u16* d1; u16* d2; const f32x2* rope; float sc = 1.f; int csplit = 0, coff1 = 0, coff2 = 0;
  DI void rot(f32x4& v0, f32x4& v1, int row, int col) const {
    const f32x4* cp = (const f32x4*)(rope + (row & 2047) * 32 + ((col & 63) >> 1));
    const f32x4 c01 = cp[0], c23 = cp[1];
    const f32x4 a = {v0[0] * c01[0] - v0[1] * c01[1], v0[1] * c01[0] + v0[0] * c01[1], v0[2] * c01[2] - v0[3] * c01[3], v0[3] * c01[2] + v0[2] * c01[3]};
    const f32x4 b = {v1[0] * c23[0] - v1[1] * c23[1], v1[1] * c23[0] + v1[0] * c23[1], v1[2] * c23[2] - v1[3] * c23[3], v1[3] * c23[2] + v1[2] * c23[3]};
    v0 = a; v1 = b;
  }
  DI void operator()(const f32x4 (&acc)[2][2][4][2], const pg8::Unit& u, int wr, int wc, int fr, int fq) const {
    const int row0 = u.pm * 256 + wr * 64 + fr, colb = u.pn * 256 + wc * 32 + 8 * fq;
#pragma unroll
    for (int ai = 0; ai < 2; ++ai)
#pragma unroll
      for (int m = 0; m < 4; ++m) {
        const int row = row0 + ai * 128 + m * 16;
#pragma unroll
        for (int bj = 0; bj < 2; ++bj) {
          const int col = colb + bj * 128;
          f32x4 v0 = acc[ai][bj][m][0] * sc, v1 = acc[ai][bj][m][1] * sc;
          u16* dst = nullptr;
          if (MODE == 0) { if (col < N) dst = d0 + (size_t)row * ld0 + (col + coff2 + ((col < csplit) ? (coff1 - coff2) : 0)); }
          else if (MODE == 1) {
            const int oc = col + coff2 + ((col < csplit) ? (coff1 - coff2) : 0);
            if (col < N) {
              if (oc < 2048) dst = d0 + (size_t)row * 2048 + oc;
              else if (oc < 2112) { rot(v0, v1, row, oc); dst = d2 + (size_t)row * 64 + (oc - 2048); }
              else dst = d1 + (size_t)row * 4096 + (oc - 2112);
            }
          } else if (MODE == 3) {
            if (col < N) { const bool lo = col < csplit; u16* bp = lo ? d0 : d1; const int ldd = lo ? 2048 : 4096, oc = lo ? col : col + (coff2 - 2112); dst = bp + (size_t)row * ldd + oc + (lo ? coff1 : 0); }
          } else {
            if (((col >> 6) % 3) == 2) rot(v0, v1, row, col);
            dst = d0 + (size_t)row * 3072 + col;
          }
          if (dst) { u32x4 w = {pk2(v0[0], v0[1]), pk2(v0[2], v0[3]), pk2(v1[0], v1[1]), pk2(v1[2], v1[3])}; *(u32x4*)dst = w; }
        }
        asm volatile("" ::: "memory");
      }
  }
};

template <bool FP8 = false, class Epi>
DI void run_gemm(const u16* A, int lda, const u16* Bt, int M, int N, int K, const Epi& e, char* smem) {
  __syncthreads();
  pg8::Gemm g{A, Bt, M, N, K, lda};
  pg8::StaticOrder S; S.init(M, N, gridDim.x, blockIdx.x);
  pg8::gemm_phase<FP8>(( __attribute__((address_space(3))) unsigned char*)smem, g, S, e);
  __syncthreads();
}

typedef __attribute__((address_space(3))) unsigned* lds_u32p;
template <int OFF> DI void rd4(bf16x8 (&f)[4], unsigned addr) {
  asm volatile("ds_read_b128 %0, %4 offset:%5\n\tds_read_b128 %1, %4 offset:%6\n\tds_read_b128 %2, %4 offset:%7\n\tds_read_b128 %3, %4 offset:%8\n\ts_waitcnt lgkmcnt(0)"
               : "=&v"(f[0]), "=&v"(f[1]), "=&v"(f[2]), "=&v"(f[3]) : "v"(addr), "i"(OFF), "i"(OFF + 32), "i"(OFF + 64), "i"(OFF + 96) : "memory");
}
template <int OFF> DI void rdv8(s16x4 (&v)[8], unsigned addr) {
  asm volatile("ds_read_b64_tr_b16 %0, %8 offset:%9\n\tds_read_b64_tr_b16 %1, %8 offset:%10\n\tds_read_b64_tr_b16 %2, %8 offset:%11\n\tds_read_b64_tr_b16 %3, %8 offset:%12\n\t"
               "ds_read_b64_tr_b16 %4, %8 offset:%13\n\tds_read_b64_tr_b16 %5, %8 offset:%14\n\tds_read_b64_tr_b16 %6, %8 offset:%15\n\tds_read_b64_tr_b16 %7, %8 offset:%16\n\ts_waitcnt lgkmcnt(0)"
               : "=&v"(v[0]), "=&v"(v[1]), "=&v"(v[2]), "=&v"(v[3]), "=&v"(v[4]), "=&v"(v[5]), "=&v"(v[6]), "=&v"(v[7])
               : "v"(addr), "i"(OFF), "i"(OFF + 512), "i"(OFF + 1024), "i"(OFF + 1536), "i"(OFF + 2048), "i"(OFF + 2560), "i"(OFF + 3072), "i"(OFF + 3584) : "memory");
}
template <int KSTR, int ND, int N>
DI f32x16 s_block(unsigned kaddr, const bf16x8* qf) {
  const f32x16 z16 = {0.f, 0.f, 0.f, 0.f, 0.f, 0.f, 0.f, 0.f, 0.f, 0.f, 0.f, 0.f, 0.f, 0.f, 0.f, 0.f};
  bf16x8 f[4];
  rd4<N * 32 * KSTR>(f, kaddr);
  f32x16 a = MFMA(f[0], qf[0], z16); a = MFMA(f[1], qf[1], a); a = MFMA(f[2], qf[2], a); a = MFMA(f[3], qf[3], a);
  if constexpr (ND > 4) { rd4<N * 32 * KSTR + 128>(f, kaddr); a = MFMA(f[0], qf[4], a); a = MFMA(f[1], qf[5], a); a = MFMA(f[2], qf[6], a); a = MFMA(f[3], qf[7], a); }
  if constexpr (ND > 8) { rd4<N * 32 * KSTR + 256>(f, kaddr); a = MFMA(f[0], qf[8], a); a = MFMA(f[1], qf[9], a); a = MFMA(f[2], qf[10], a); a = MFMA(f[3], qf[11], a); }
  if constexpr (ND > 12) { rd4<N * 32 * KSTR + 384>(f, kaddr); a = MFMA(f[0], qf[12], a); a = MFMA(f[1], qf[13], a); a = MFMA(f[2], qf[14], a); a = MFMA(f[3], qf[15], a); }
  return a;
}
template <int CB> DI void pv_block(f32x16& o, unsigned vaddr, const bf16x8 (&pb)[2][2]) {
  s16x4 v[8];
  rdv8<CB * 4096>(v, vaddr);
#pragma unroll
  for (int q = 0; q < 4; ++q) {
    const bf16x8 vf = {v[2 * q][0], v[2 * q][1], v[2 * q][2], v[2 * q][3], v[2 * q + 1][0], v[2 * q + 1][1], v[2 * q + 1][2], v[2 * q + 1][3]};
    o = MFMA(vf, pb[q >> 1][q & 1], o);
  }
}
template <int DQK, int W1, int DV, int VW, int MODE>
DI void attn_core(const u16* __restrict__ k1, int ldk1, const u16* __restrict__ k2, int ldk2, const u16* __restrict__ vsrc, int ldv,
                  int kv_len, int kbase0, int ntiles, const u16* qrow, int tq, int tq0, float c2, int vcb0, u16* yrow,
                  const u16* grow, const unsigned* maskrow, const float* lutw, float bias_far, float m_init, float l_init, char* smem) {
  constexpr int KSTR = DQK * 2 + 16, KCH = DQK / 8;
  constexpr int ND = DQK / 16, NCB = DV / 32, BUF = 64 * KSTR + (VW / 32) * 4096;
  constexpr int NKI = KSTR / 16, NVI = VW / 8;
  static_assert(ND % 4 == 0 && NCB <= 4, "fragment batches");
  int tid0 = threadIdx.x; asm volatile("" : "+v"(tid0));
  const int lane = tid0 & 63, r32 = lane & 31, hi = lane >> 5;
  const int wv = __builtin_amdgcn_readfirstlane(tid0 >> 6);
  const unsigned lds0 = (unsigned)(uintptr_t)smem;
  bf16x8 qf[ND];
#pragma unroll
  for (int d0 = 0; d0 < ND; ++d0) qf[d0] = *(const bf16x8*)(qrow + d0 * 16 + hi * 8);
  f32x16 o[NCB];
#pragma unroll
  for (int cb = 0; cb < NCB; ++cb)
#pragma unroll
    for (int r = 0; r < 16; ++r) o[cb][r] = 0.f;
  float m = m_init, l = (hi == 0) ? l_init : 0.f;
  const unsigned klane = (unsigned)(r32 * KSTR + hi * 16);
  const unsigned vlane = (unsigned)(64 * KSTR + vcb0 * 4096 + ((lane >> 4) & 1) * 32 + (lane & 3) * 8 + (4 * hi + ((lane & 15) >> 2)) * 64);
  unsigned mwn[2] = {0u, 0u};
  constexpr int NKS = (NKI + 7) / 8, NVS = (NVI + 7) / 8;
  const u16* kptr[NKS]; int kstr[NKS]; const u16* vptr[NVS];
  if (MODE != 2) {
    int ln = threadIdx.x & 63; asm volatile("" : "+v"(ln));
#pragma unroll
    for (int ii = 0; ii < NKS; ++ii) {
      const int i = wv + 8 * ii, ob = i * 1024 + ln * 16, row = ob / KSTR;
      int c = (ob - row * KSTR) >> 4; c = (c >= KCH) ? 0 : c;
      const bool seg1 = c < W1 / 8;
      kptr[ii] = seg1 ? (k1 + ((kbase0 + row) * ldk1 + c * 8)) : (k2 + ((kbase0 + row) * ldk2 + (c - W1 / 8) * 8));
      kstr[ii] = seg1 ? 64 * ldk1 : 64 * ldk2;
    }
#pragma unroll
    for (int ii = 0; ii < NVS; ++ii) {
      const int i = wv + 8 * ii, ob = i * 1024 + ln * 16, cbk = ob >> 12, row = (ob & 4095) >> 6, cw = (ob & 63) >> 4;
      vptr[ii] = vsrc + ((kbase0 + row) * ldv + (cbk * 4 + cw) * 8);
    }
  }
  auto stage_tile = [&](int kb, int buf) {
    const unsigned bofs = (unsigned)(buf * BUF);
    if (MODE != 2) {
#pragma unroll
      for (int ii = 0; ii < NKS; ++ii) {
        const int i = wv + 8 * ii;
        if (i < NKI) { __builtin_amdgcn_global_load_lds((const unsigned*)kptr[ii], (lds_u32p)(smem + bofs + i * 1024), 16, 0, 0); kptr[ii] += kstr[ii]; }
      }
#pragma unroll
      for (int ii = 0; ii < NVS; ++ii) {
        const int i = wv + 8 * ii;
        if (i < NVI) { __builtin_amdgcn_global_load_lds((const unsigned*)vptr[ii], (lds_u32p)(smem + bofs + 64 * KSTR + i * 1024), 16, 0, 0); vptr[ii] += 64 * ldv; }
      }
    } else {
      int ln = threadIdx.x & 63; asm volatile("" : "+v"(ln));
#pragma unroll
      for (int ii = 0; ii < NKS; ++ii) {
        const int i = wv + 8 * ii;
        if (i < NKI) {
          const int ob = i * 1024 + ln * 16, row = ob / KSTR;
          int c = (ob - row * KSTR) >> 4; c = (c >= KCH) ? 0 : c;
          int key = kb + row; key = key < 0 ? 0 : (key >= kv_len ? kv_len - 1 : key);
          const u16* src = (c < W1 / 8) ? (k1 + (key * ldk1 + c * 8)) : (k2 + (key * ldk2 + (c - W1 / 8) * 8));
          __builtin_amdgcn_global_load_lds((const unsigned*)src, (lds_u32p)(smem + bofs + i * 1024), 16, 0, 0);
        }
      }
#pragma unroll
      for (int ii = 0; ii < NVS; ++ii) {
        const int i = wv + 8 * ii;
        if (i < NVI) {
          const int ob = i * 1024 + ln * 16, cbk = ob >> 12, row = (ob & 4095) >> 6, cw = (ob & 63) >> 4;
          int key = kb + row; key = key < 0 ? 0 : (key >= kv_len ? kv_len - 1 : key);
          __builtin_amdgcn_global_load_lds((const unsigned*)(vsrc + (key * ldv + (cbk * 4 + cw) * 8)), (lds_u32p)(smem + bofs + 64 * KSTR + i * 1024), 16, 0, 0);
        }
      }
    }
    if (MODE == 1) { mwn[0] = maskrow[(kb >> 5)]; mwn[1] = maskrow[(kb >> 5) + 1]; }
  };
  stage_tile(kbase0, 0);
  asm volatile("s_waitcnt vmcnt(0)" ::: "memory");
  __syncthreads();
  for (int t = 0; t < ntiles; ++t) {
    const int kb = kbase0 + t * 64;
    const unsigned bufa = lds0 + (unsigned)((t & 1) * BUF);
    const unsigned mw0 = mwn[0], mw1 = mwn[1];
    if (t + 1 < ntiles) stage_tile(kb + 64, (t + 1) & 1);
    if (!(MODE == 0 && kb > tq0 + 31)) {
      f32x16 s[2];
      s[0] = s_block<KSTR, ND, 0>(bufa + klane, qf);
      s[1] = s_block<KSTR, ND, 1>(bufa + klane, qf);
      if (MODE == 0) {
        s[0] = s[0] * c2; s[1] = s[1] * c2;
        if (__builtin_amdgcn_readfirstlane((int)(kb + 63 > tq0))) {
#pragma unroll
          for (int n = 0; n < 2; ++n)
#pragma unroll
            for (int i = 0; i < 16; ++i) { const int key = kb + 32 * n + crow(i, hi); if (key > tq) s[n][i] = NEGV; }
        }
      } else if (MODE == 1) {
        const bool far = (tq0 - (kb + 63)) >= 128;
#pragma unroll
        for (int n = 0; n < 2; ++n) {
          const unsigned wb = (n ? mw1 : mw0) >> (4 * hi);
          if (far) {
#pragma unroll
            for (int i = 0; i < 16; ++i) {
              const float v = fmaf(s[n][i], c2, bias_far);
              s[n][i] = ((wb >> ((i & 3) + 8 * (i >> 2))) & 1u) ? v : NEGV;
            }
          } else {
#pragma unroll
            for (int i = 0; i < 16; ++i) {
              const int key = kb + 32 * n + crow(i, hi);
              int rel = tq - key; rel = rel < 0 ? 0 : (rel > 128 ? 128 : rel);
              const float v = fmaf(s[n][i], c2, lutw[rel]);
              s[n][i] = ((wb >> ((i & 3) + 8 * (i >> 2))) & 1u) ? v : NEGV;
            }
          }
        }
      } else if (MODE == 2) {
#pragma unroll
        for (int n = 0; n < 2; ++n)
#pragma unroll
          for (int i = 0; i < 16; ++i) {
            const int key = kb + 32 * n + crow(i, hi), rel = tq - key;
            const bool ok = ((unsigned)rel < 128u) && (key >= 0);
            const float v = fmaf(s[n][i], c2, lutw[rel & 127]);
            s[n][i] = ok ? v : NEGV;
          }
      } else {
#pragma unroll
        for (int n = 0; n < 2; ++n)
#pragma unroll
          for (int i = 0; i < 16; ++i) s[n][i] *= c2;
      }
      float mx = s[0][0];
#pragma unroll
      for (int i = 1; i < 16; ++i) mx = fmaxf(mx, s[0][i]);
#pragma unroll
      for (int i = 0; i < 16; ++i) mx = fmaxf(mx, s[1][i]);
      mx = xhalf_max(mx);
      if (__any(mx - m > 8.0f)) {
        const float mnew = fmaxf(m, mx), alpha = __builtin_amdgcn_exp2f(m - mnew);
        m = mnew; l *= alpha;
#pragma unroll
        for (int cb = 0; cb < NCB; ++cb)
#pragma unroll
          for (int r = 0; r < 16; ++r) o[cb][r] *= alpha;
      }
      {
        const float nm = -m;
        f32x16 e0 = s[0] + nm, e1 = s[1] + nm;
#pragma unroll
        for (int i = 0; i < 16; ++i) { e0[i] = __builtin_amdgcn_exp2f(e0[i]); e1[i] = __builtin_amdgcn_exp2f(e1[i]); }
        s[0] = e0; s[1] = e1;
        const f32x16 sm = e0 + e1;
        typedef __attribute__((ext_vector_type(8))) float f32x8;
        const f32x8 h8 = sm.lo + sm.hi;
        const f32x4 h4 = h8.lo + h8.hi;
        const f32x2 h2 = h4.lo + h4.hi;
        l += h2[0] + h2[1];
      }
      bf16x8 pb[2][2];
#pragma unroll
      for (int n = 0; n < 2; ++n)
#pragma unroll
        for (int s2 = 0; s2 < 2; ++s2) {
          u32x4 pw = {pk2(s[n][8 * s2 + 0], s[n][8 * s2 + 1]), pk2(s[n][8 * s2 + 2], s[n][8 * s2 + 3]),
                      pk2(s[n][8 * s2 + 4], s[n][8 * s2 + 5]), pk2(s[n][8 * s2 + 6], s[n][8 * s2 + 7])};
          pb[n][s2] = __builtin_bit_cast(bf16x8, pw);
        }
      pv_block<0>(o[0], bufa + vlane, pb);
      if constexpr (NCB > 1) pv_block<1>(o[1], bufa + vlane, pb);
      if constexpr (NCB > 2) pv_block<2>(o[2], bufa + vlane, pb);
      if constexpr (NCB > 3) pv_block<3>(o[3], bufa + vlane, pb);
    }
    asm volatile("s_waitcnt vmcnt(0)" ::: "memory");
    __syncthreads();
  }
  const float inv = 1.f / xhalf_sum(l);
#pragma unroll
  for (int cb = 0; cb < NCB; ++cb)
#pragma unroll
    for (int g = 0; g < 4; ++g) {
      const int dv = 32 * cb + 8 * g + 4 * hi;
      const u32x2 gg = *(const u32x2*)(grow + dv);
      float gv[4] = {bf2f(gg[0] & 0xffffu), bf2f(gg[0] >> 16), bf2f(gg[1] & 0xffffu), bf2f(gg[1] >> 16)};
      float ov[4];
#pragma unroll
      for (int j = 0; j < 4; ++j) {
        const float sg = gv[j] / (1.f + __expf(-gv[j]));
        ov[j] = o[cb][4 * g + j] * inv * sg;
      }
      *(unsigned*)((unsigned char*)yrow + dv) = pk4_fp8(ov[0] * Y_SCALE, ov[1] * Y_SCALE, ov[2] * Y_SCALE, ov[3] * Y_SCALE);
      __builtin_amdgcn_sched_barrier(0);
    }
}

DI unsigned ordkey(float f) { const unsigned b = __float_as_uint(f); return b ^ ((unsigned)((int)b >> 31) | 0x80000000u); }
DI void indexer_phase(const u16* __restrict__ P, unsigned* __restrict__ mask) {
  int tidx = threadIdx.x; asm volatile("" : "+v"(tidx));
  const int lane = tidx & 63, r32 = lane & 31, hi = lane >> 5;
  const int gw = blockIdx.x * 8 + (tidx >> 6), nw = gridDim.x * 8;
  for (int item = gw; item < 8192; item += nw) {
    const int b = item & 7, t0 = (1023 - (item >> 3)) * 2;
    const size_t brow = (size_t)b * SEQ;
    const int g = (r32 >> 2) & 1, head = 4 * (r32 >> 3) + (r32 & 3);
    bf16x8 aq[4];
#pragma unroll
    for (int s = 0; s < 4; ++s) aq[s] = *(const bf16x8*)(P + (brow + t0 + g) * 7808 + 2560 + head * 64 + 16 * s + 8 * hi);
    float wv[16];
    {
      const u32x4 w0 = *(const u32x4*)(P + (brow + t0 + hi) * 7808 + 3648), w1 = *(const u32x4*)(P + (brow + t0 + hi) * 7808 + 3656);
#pragma unroll
      for (int j = 0; j < 4; ++j) { wv[2 * j] = bf2f(w0[j] & 0xffffu); wv[2 * j + 1] = bf2f(w0[j] >> 16); wv[8 + 2 * j] = bf2f(w1[j] & 0xffffu); wv[8 + 2 * j + 1] = bf2f(w1[j] >> 16); }
    }
    const int tme = t0 + hi, kbmax = (t0 + 1) >> 5;
    unsigned sc[64];
#pragma unroll
    for (int kb = 0; kb < 64; ++kb) {
      unsigned u = 0u;
      if (kb <= kbmax) {
        f32x16 a;
#pragma unroll
        for (int r = 0; r < 16; ++r) a[r] = 0.f;
        const u16* kp = P + (brow + 32 * kb + r32) * 7808 + 3584 + 8 * hi;
#pragma unroll
        for (int s = 0; s < 4; ++s) { const bf16x8 bk = *(const bf16x8*)(kp + 16 * s); a = MFMA(aq[s], bk, a); }
        float v = 0.f;
#pragma unroll
        for (int i = 0; i < 16; ++i) v = fmaf(wv[i], fmaxf(a[i], 0.f), v);
        u = (32 * kb + r32 <= tme) ? ordkey(v) : 0u;
      }
      sc[kb] = u;
    }
    const int target = (tme + 1 < 256) ? tme + 1 : 256;
    unsigned T = 0u;
    for (int bit = 31; bit >= 0; --bit) {
      const unsigned Tp = T | (1u << bit);
      int cnt = 0;
#pragma unroll
      for (int kb = 0; kb < 64; ++kb) cnt += (sc[kb] >= Tp) ? 1 : 0;
#pragma unroll
      for (int o = 16; o; o >>= 1) cnt += __shfl_xor(cnt, o);
      if (cnt >= target) T = Tp;
    }
    unsigned w0 = 0u, w1 = 0u;
#pragma unroll
    for (int kb = 0; kb < 64; ++kb) {
      const bool pred = (sc[kb] >= T) && (sc[kb] != 0u);
      const unsigned long long bal = __ballot(pred);
      const unsigned wd = (unsigned)(bal >> (32 * hi));
      if ((kb & 31) == r32) { if (kb < 32) w0 = wd; else w1 = wd; }
    }
    mask[(brow + tme) * 64 + r32] = w0;
    mask[(brow + tme) * 64 + 32 + r32] = w1;
  }
}

DI void gbar(unsigned* cnt, unsigned target) {
  asm volatile("s_waitcnt vmcnt(0)" ::: "memory");
  __syncthreads();
  if (threadIdx.x == 0) {
    __builtin_amdgcn_fence(__ATOMIC_RELEASE, "agent");
    asm volatile("s_waitcnt vmcnt(0)" ::: "memory");
    __hip_atomic_fetch_add(cnt, 1u, __ATOMIC_RELAXED, __HIP_MEMORY_SCOPE_AGENT);
    while (__hip_atomic_load(cnt, __ATOMIC_RELAXED, __HIP_MEMORY_SCOPE_AGENT) < target) __builtin_amdgcn_s_sleep(1);
    __builtin_amdgcn_fence(__ATOMIC_ACQUIRE, "agent");
    asm volatile("s_waitcnt vmcnt(0)" ::: "memory");
  }
  __syncthreads();
}
#define GSYNC() do { ++bar_gen; gbar(BAR, bar_gen * gridDim.x); } while (0)
__global__ void __launch_bounds__(512, 2) mega(Params p) {
  cg::grid_group grid = cg::this_grid();
  extern __shared__ __attribute__((aligned(16))) char smem[];
  volatile int* s_item = (volatile int*)(smem + LDS_ITEM);
  char* ws = p.ws;
  unsigned char* Y8 = (unsigned char*)(ws + OFF_Y);
  u16* WIN8 = (u16*)(ws + OFF_WIN + 19922944);
  unsigned char* CQ8 = (unsigned char*)(ws + OFF_Y + 67108864);     u16* H = (u16*)(ws + OFF_H); u16* Cb = (u16*)(ws + OFF_Y); u16* Qb = (u16*)(ws + OFF_H);
  u16* KV = (u16*)(ws + OFF_KV); u16* MG = (u16*)(ws + OFF_MG); u16* KR = (u16*)(ws + OFF_KR); u16* Pb = (u16*)(ws + OFF_P);
  u16* WIN = (u16*)(ws + OFF_WIN); u16* WUQ = (u16*)(ws + OFF_WUQ); u16* WUKV = (u16*)(ws + OFF_WUKV); u16* WOUT = (u16*)(ws + OFF_WOUT);
  u16* WMEMALL = (u16*)(ws + OFF_KV); u16* MEMN = (u16*)(ws + OFF_MEMN); u16* MEMKV = (u16*)(ws + OFF_MEMKV);
  unsigned* MASK = (unsigned*)(ws + OFF_MASK); f32x2* ROPE = (f32x2*)(ws + OFF_ROPE); float* LUT = (float*)(ws + OFF_LUT);
  int* CTR = (int*)(ws + OFF_CTR);
  unsigned* BAR = (unsigned*)(ws + OFF_CTR) + 64;
  unsigned bar_gen = 0;
  const int tid = threadIdx.x, lane = tid & 63, wv = __builtin_amdgcn_readfirstlane(tid >> 6), r32 = lane & 31, hi = lane >> 5;
  const int gtid = blockIdx.x * 512 + tid, gthreads = gridDim.x * 512;

  for (int i = gtid; i < 2048 * 32; i += gthreads) {
    const int pos = i >> 5, j = i & 31;
    const float inv = 1.0f / powf(10000.0f, (float)(2 * j) / 64.0f);
    const float ang = (float)pos * inv;
    const float k = rintf(ang * 0.15915494309189535f);
    float r = fmaf(-k, 6.28318548202514648f, ang);
    r = fmaf(-k, -1.74845553e-7f, r);
    f32x2 cs = {__cosf(r), __sinf(r)};
    ROPE[i] = cs;
  }
  for (int i = gtid; i < 129 * 32; i += gthreads) {
    const int rel = i >> 5, h = i & 31;
    int bucket;
    if (rel < 16) bucket = rel;
    else { const int lg = 16 + (int)(logf((float)rel / 16.0f) / 2.0794415416798357f * 16.0f); bucket = lg < 31 ? lg : 31; }
    LUT[i] = p.rel_bias[bucket * 32 + h] * LOG2E;
  }
  rmsnorm_rows<false>(p.mem, p.mem_norm, MEMN, 2048);
#pragma unroll 1
  for (int l = 0; l < 4; ++l) convert_wt<0>(p.w_mem_kv + (size_t)l * 2048 * 2048, 2048, 2048, 2048, WMEMALL + (size_t)l * 2048 * 2048, smem);

  auto convert_layer = [&](int L) {
    const int kind = L % 3, j = L / 3;
    if (kind == 0) {
    convert_wt<1>(p.w_in_a + (size_t)j * 2048 * 6208, 2048, 6208, 3840, WIN, smem, 1.f, 3648, 576, 1536, 2560, 512);
    convert_wt<0, true>(p.w_in_a + (size_t)j * 2048 * 6208, 2048, 6208, 2560, WIN8, smem, WIN_SCALE, 2560, 1536, 0, 576);
    convert_wt<2, true>(p.w_uq + (size_t)j * 1536 * 3072, 1536, 3072, 3072, WUQ, smem, WUQ_SCALE);
    convert_wt<0>(p.w_ukv + (size_t)j * 512 * 4096, 512, 4096, 4096, WUKV, smem);
  } else if (kind == 1) {
    convert_wt<0>(p.w_in_b, 2048, 7760, 4864, WIN, smem, 1.f, 4688, 1616, 2048, 3072);
    convert_wt<0, true>(p.w_in_b, 2048, 7760, 3072, WIN8, smem, WIN_SCALE, 3072, 2048, 0, 1616);
  } else {
    convert_wt<0>(p.w_in_c, 2048, 6656, 3584, WIN, smem, 1.f, 3584, 512, 2048, 3072);
    convert_wt<0, true>(p.w_in_c, 2048, 6656, 3072, WIN8, smem, WIN_SCALE, 3072, 2048, 0, 512);
  }
  };
#pragma unroll 1
  for (int layer = 0; layer < 4; ++layer) {
    const int kind = layer % 3, j = layer / 3;
    const float* xin = (layer == 0) ? p.x : p.out;
    unsigned char* H8 = (unsigned char*)(ws + ((kind == 0) ? OFF_KV + 67108864 : OFF_Y));
    rmsnorm_rows<false>(xin, p.norm_in + layer * 2048, H, NTOK, H8);
    if (layer == 0) convert_layer(0);
    convert_wt<0, true>(p.w_out + (size_t)layer * 3072 * 2048, 3072, 2048, 2048, WOUT, smem, WOUT_SCALE);
    if (layer == 0) { __builtin_amdgcn_fence(__ATOMIC_RELEASE, "agent"); grid.sync(); __builtin_amdgcn_fence(__ATOMIC_ACQUIRE, "agent"); asm volatile("s_waitcnt vmcnt(0)" ::: "memory"); }
    else GSYNC();

    if (kind == 0) {
      { EpiBf<1> e{Cb, 2048, 3648, MG, KR, ROPE, 1.f, 576, 1536, 2560}; run_gemm(H, 2048, WIN, NTOK, 3840, 2048, e, smem); }
      { EpiBf<3> e{Cb, 2048, 2560, MG, nullptr, nullptr, 1.f / (H_SCALE * WIN_SCALE), 1536, 0, 576}; run_gemm<true>((const u16*)H8, 1024, WIN8, NTOK, 2560, 1024, e, smem); }
    }
    else if (kind == 1) {
      { EpiBf<0> e{Pb, 7808, 4688, nullptr, nullptr, nullptr, 1.f, 1616, 2048, 3072}; run_gemm(H, 2048, WIN, NTOK, 4864, 2048, e, smem); }
      { EpiBf<0> e{Pb, 7808, 3072, nullptr, nullptr, nullptr, 1.f / (H_SCALE * WIN_SCALE), 2048, 0, 1616}; run_gemm<true>((const u16*)H8, 1024, WIN8, NTOK, 3072, 1024, e, smem); }
    } else {
      { EpiBf<0> e{Pb, 6656, 3584, nullptr, nullptr, nullptr, 1.f, 512, 2048, 3072}; run_gemm(H, 2048, WIN, NTOK, 3584, 2048, e, smem); }
      { EpiBf<0> e{Pb, 6656, 3072, nullptr, nullptr, nullptr, 1.f / (H_SCALE * WIN_SCALE), 2048, 0, 512}; run_gemm<true>((const u16*)H8, 1024, WIN8, NTOK, 3072, 1024, e, smem); }
    }
    if (layer == 0) { EpiBf<0> e{MEMKV, 8192, 8192, nullptr, nullptr, nullptr}; run_gemm(MEMN, 2048, WMEMALL, 2048, 8192, 2048, e, smem); }
    GSYNC();

    if (kind == 0) {
      anorm_phase(Cb, p.a_q_norm + j * 1536, p.a_kv_norm + j * 512, CQ8);
      GSYNC();
      { EpiBf<2> e{Qb, 3072, 3072, nullptr, nullptr, ROPE, 1.f / (CQ_SCALE * WUQ_SCALE)}; run_gemm<true>((const u16*)CQ8, 768, WUQ, NTOK, 3072, 768, e, smem); }
      { EpiBf<0> e{KV, 4096, 4096, nullptr, nullptr, nullptr}; run_gemm(Cb + 1536, 2048, WUKV, NTOK, 4096, 512, e, smem); }
      GSYNC();
    } else if (kind == 1) {
      indexer_phase(Pb, MASK);
      GSYNC();
    }

    {
      const int nself = (kind == 0) ? 1024 : 2048, total = nself + 512;
      const u16* mgb = (kind == 0) ? MG : Pb;
      const int ldmg = (kind == 0) ? 4096 : (kind == 1 ? 7808 : 6656);
      const int mqcol = (kind == 0) ? 0 : (kind == 1 ? 3664 : 2560);
      const int gatecol = (kind == 0) ? 1024 : (kind == 1 ? 4688 : 3584);
      const u16* memkv = MEMKV + layer * 2048;
      float* lut_all = (float*)(smem + LDS_LUT);
      if (kind != 0) {
        for (int i = tid; i < 32 * 129; i += 512) { const int h = i / 129, r = i - h * 129; lut_all[h * 132 + r] = LUT[r * 32 + h]; }
      }
      if (tid == 0) s_item[0] = atomicAdd(&CTR[layer], 1);
      __syncthreads();
      for (int par = 0;; par ^= 1) {
        const int item = __builtin_amdgcn_readfirstlane(s_item[par]);
        if (item >= total) break;
        if (tid == 0) s_item[par ^ 1] = atomicAdd(&CTR[layer], 1);
        if (item < nself) {
          if (kind == 0) {
            const int qblk = 7 - item / 128, rem = item % 128, b = rem / 16, head = rem % 16;
            const size_t brow = (size_t)b * SEQ;
            const int tq0 = qblk * 256 + 32 * wv, tq = tq0 + r32;
            attn_core<192, 128, 128, 128, 0>(KV + brow * 4096 + head * 256, 4096, KR + brow * 64, 64, KV + brow * 4096 + head * 256 + 128, 4096,
                                            SEQ, 0, 4 * qblk + 4, Qb + (brow + tq) * 3072 + head * 192, tq, tq0, 0.07216878364870322f * LOG2E, 0,
                                            (u16*)(Y8 + (brow + tq) * 3072 + head * 128), mgb + (brow + tq) * ldmg + gatecol + head * 128,
                                            nullptr, nullptr, 0.f, -1e29f, 0.f, smem);
          } else {
            const int qb = 63 - item / 32, rem = item % 32, b = rem / 4, kvh = rem % 4;
            const size_t brow = (size_t)b * SEQ;
            const int head = kvh * 8 + wv, tq0 = qb * 32, tq = tq0 + r32;
            const float* lutw = lut_all + head * 132;
            if (kind == 1) {
              attn_core<64, 64, 64, 64, 1>(Pb + brow * 7808 + 2048 + kvh * 64, 7808, nullptr, 0, Pb + brow * 7808 + 2304 + kvh * 64, 7808,
                                          SEQ, 0, (tq0 + 31) / 64 + 1, Pb + (brow + tq) * 7808 + head * 64, tq, tq0, 0.125f * LOG2E, 0,
                                          (u16*)(Y8 + (brow + tq) * 3072 + head * 64), Pb + (brow + tq) * 7808 + gatecol + head * 64,
                                          MASK + (brow + tq) * 64, lutw, lutw[128], -1e29f, 0.f, smem);
            } else {
              const float sink = p.c_sinks[j * 32 + head] * LOG2E;
              attn_core<64, 64, 64, 64, 2>(Pb + brow * 6656 + 2048 + kvh * 64, 6656, nullptr, 0, Pb + brow * 6656 + 2304 + kvh * 64, 6656,
                                          SEQ, tq0 - 128, 3, Pb + (brow + tq) * 6656 + head * 64, tq, tq0, 0.125f * LOG2E, 0,
                                          (u16*)(Y8 + (brow + tq) * 3072 + head * 64), Pb + (brow + tq) * 6656 + gatecol + head * 64,
                                          nullptr, lutw, 0.f, sink, 1.f, smem);
            }
          }
        } else {
          const int it = item - nself, b = it / 64, mh = (it % 64) / 16, qb = it % 16;
          const size_t brow = (size_t)b * SEQ;
          const int tq0 = qb * 128 + 32 * (wv >> 1), tq = tq0 + r32, vh = wv & 1;
          attn_core<256, 256, 128, 256, 3>(memkv + (size_t)b * 256 * 8192 + mh * 256, 8192, nullptr, 0, memkv + (size_t)b * 256 * 8192 + 1024 + mh * 256, 8192,
                                          256, 0, 4, mgb + (brow + tq) * ldmg + mqcol + mh * 256, tq, tq0, 0.0625f * LOG2E, 4 * vh,
                                          (u16*)(Y8 + (brow + tq) * 3072 + 2048 + mh * 256 + 128 * vh), mgb + (brow + tq) * ldmg + gatecol + 2048 + mh * 256 + 128 * vh,
                                          nullptr, nullptr, 0.f, -1e29f, 0.f, smem);
        }
      }
    }
    if (layer + 1 < 4) convert_layer(layer + 1);
    GSYNC();

    { EpiResid e{xin, p.out, 1.f / (Y_SCALE * WOUT_SCALE)}; run_gemm<true>((const u16*)Y8, 1536, WOUT, NTOK, 2048, 1536, e, smem); }
    GSYNC();
  }
  rmsnorm_rows<true>(p.out, p.final_norm, p.out, NTOK);
}

extern "C" void kernel_launch(void* const* d_in, const int* in_sizes, int n_in, void* d_out, int out_size,
                              void* d_ws, size_t ws_size, hipStream_t stream) {
  static int grid_blocks = 0;
  if (!grid_blocks) {
    int dev = 0, cus = 0, per_cu = 0;
    (void)hipGetDevice(&dev);
    (void)hipDeviceGetAttribute(&cus, hipDeviceAttributeMultiprocessorCount, dev);
    (void)hipFuncSetAttribute((const void*)mega, hipFuncAttributeMaxDynamicSharedMemorySize, LDS_BYTES);
    (void)hipOccupancyMaxActiveBlocksPerMultiprocessor(&per_cu, mega, 512, LDS_BYTES);
    if (per_cu > 1) per_cu = 1;
    grid_blocks = cus * per_cu;
  }
  Params p{};
  p.x = (const float*)d_in[0]; p.mem = (const float*)d_in[1]; p.norm_in = (const float*)d_in[2]; p.final_norm = (const float*)d_in[3];
  p.mem_norm = (const float*)d_in[4]; p.rel_bias = (const float*)d_in[5]; p.w_in_a = (const float*)d_in[6]; p.a_q_norm = (const float*)d_in[7];
  p.w_uq = (const float*)d_in[8]; p.a_kv_norm = (const float*)d_in[9]; p.w_ukv = (const float*)d_in[10]; p.w_in_b = (const float*)d_in[11];
  p.w_in_c = (const float*)d_in[12]; p.c_sinks = (const float*)d_in[13]; p.w_mem_kv = (const float*)d_in[14]; p.w_out = (const float*)d_in[15];
  p.out = (float*)d_out; p.ws = (char*)d_ws;
  (void)hipMemsetAsync((char*)d_ws + OFF_CTR, 0, 1024, stream);
  void* args[] = {&p};
  (void)hipLaunchCooperativeKernel((void*)mega, dim3(grid_blocks), dim3(512), args, LDS_BYTES, stream);
}
```

```cpp
#include <hip/hip_runtime.h>
#include <hip/hip_cooperative_groups.h>
#include <stdint.h>
namespace cg = cooperative_groups;

typedef unsigned short u16;
typedef __attribute__((ext_vector_type(8))) short bf16x8;
typedef __attribute__((ext_vector_type(4))) short s16x4;
typedef __attribute__((ext_vector_type(16))) float f32x16;
typedef __attribute__((ext_vector_type(4))) float f32x4;
typedef __attribute__((ext_vector_type(2))) float f32x2;
typedef __attribute__((ext_vector_type(4))) unsigned u32x4;
typedef __attribute__((ext_vector_type(2))) unsigned u32x2;
typedef __attribute__((ext_vector_type(2))) __bf16 bf16x2_t;
typedef short v4i16_t __attribute__((ext_vector_type(4)));
#define DI __device__ __forceinline__
#define MFMA(a, b, c) __builtin_amdgcn_mfma_f32_32x32x16_bf16((a), (b), (c), 0, 0, 0)

constexpr int SEQ = 2048, NTOK = 16384;
constexpr int LDS_LUT = 133120, LDS_ITEM = LDS_LUT + 32 * 528, LDS_BYTES = LDS_ITEM + 64;
constexpr float LOG2E = 1.4426950408889634f;
constexpr float NEGV = -1e30f;
constexpr float Y_SCALE = 16.f, WOUT_SCALE = 256.f, CQ_SCALE = 16.f, WUQ_SCALE = 256.f, H_SCALE = 16.f, WIN_SCALE = 256.f;

constexpr size_t OFF_Y = 0;
constexpr size_t OFF_H = 100663296;
constexpr size_t OFF_KV = 201326592;
constexpr size_t OFF_MG = 335544320;
constexpr size_t OFF_KR = 469762048;
constexpr size_t OFF_P = 167772160;
constexpr size_t OFF_WIN = 471859200;
constexpr size_t OFF_WUQ = OFF_WIN + 32505856;
constexpr size_t OFF_WUKV = OFF_WUQ + 9437184;
constexpr size_t OFF_WOUT = OFF_WUKV + 4194304;
constexpr size_t OFF_MEMN = OFF_WOUT + 12582912;
constexpr size_t OFF_MEMKV = OFF_MEMN + 8388608;
constexpr size_t OFF_MASK = OFF_MEMKV + 33554432;
constexpr size_t OFF_ROPE = OFF_MASK + 4194304;
constexpr size_t OFF_LUT = OFF_ROPE + 524288;
constexpr size_t OFF_CTR = OFF_LUT + 32768;

struct Params {
  const float *x, *mem, *norm_in, *final_norm, *mem_norm, *rel_bias, *w_in_a, *a_q_norm, *w_uq, *a_kv_norm, *w_ukv,
      *w_in_b, *w_in_c, *c_sinks, *w_mem_kv, *w_out;
  float* out;
  char* ws;
};

DI float bf2f(unsigned b) { return __uint_as_float(b << 16); }
DI unsigned pk2(float a, float b) {
  f32x2 v = {a, b};
  return __builtin_bit_cast(unsigned, __builtin_convertvector(v, bf16x2_t));
}
DI float clamp8(float x) { return fminf(fmaxf(x, -448.f), 448.f); }
DI unsigned pk4_fp8(float a, float b, float c, float d) {
  int w = 0;
  w = __builtin_amdgcn_cvt_pk_fp8_f32(clamp8(a), clamp8(b), w, false);
  w = __builtin_amdgcn_cvt_pk_fp8_f32(clamp8(c), clamp8(d), w, true);
  return (unsigned)w;
}
DI u16 f2bf(float a) { return (u16)(pk2(a, 0.f) & 0xffffu); }
DI float wave_sum(float v) {
#pragma unroll
  for (int o = 32; o; o >>= 1) v += __shfl_xor(v, o);
  return v;
}
DI int crow(int reg, int hi) { return (reg & 3) + 8 * (reg >> 2) + 4 * hi; }
DI float xhalf_max(float m) {
  auto rr = __builtin_amdgcn_permlane32_swap(__float_as_uint(m), __float_as_uint(m), false, false);
  return fmaxf(__uint_as_float(rr[0]), __uint_as_float(rr[1]));
}
DI float xhalf_sum(float m) {
  auto rr = __builtin_amdgcn_permlane32_swap(__float_as_uint(m), __float_as_uint(m), false, false);
  return __uint_as_float(rr[0]) + __uint_as_float(rr[1]);
}
typedef __attribute__((address_space(3))) v4i16_t* lds_v4p;
DI s16x4 vtr(const char* p) {
  return __builtin_bit_cast(s16x4, __builtin_amdgcn_ds_read_tr16_b64_v4i16((lds_v4p)(p)));
}

template <int PERM, bool FP8 = false>
DI void convert_wt(const float* __restrict__ W, int K, int N, int Npad, u16* __restrict__ Wt, char* smem, float wscale = 1.f,
                   int nvalid = -1, int csplit = 0, int coff1 = 0, int coff2 = 0, int rot_n0 = 2048) {
  float* tile = (float*)smem;
  int tid = threadIdx.x; asm volatile("" : "+v"(tid));
  const int ntk = K / 64, ntn = Npad / 64;
  for (int t = blockIdx.x; t < ntk * ntn; t += gridDim.x) {
    const int tk = t % ntk, tn = t / ntk, k0 = tk * 64, n0 = tn * 64;
    __syncthreads();
#pragma unroll
    for (int i = 0; i < 2; ++i) {
      const int id = tid + 512 * i, kr = id >> 4, n4 = (id & 15) * 4;
      f32x4 v = {0.f, 0.f, 0.f, 0.f};
      const int nd = n0 + n4, nsrc = (nvalid < 0) ? nd : (nd < csplit ? nd + coff1 : nd + coff2);
      if (nd < ((nvalid < 0) ? N : nvalid)) v = *(const f32x4*)(W + (size_t)(k0 + kr) * N + nsrc);
      tile[kr * 65 + n4 + 0] = v[0]; tile[kr * 65 + n4 + 1] = v[1]; tile[kr * 65 + n4 + 2] = v[2]; tile[kr * 65 + n4 + 3] = v[3];
    }
    __syncthreads();
    {
      const int n = tid >> 3, c = tid & 7;
      bool rot = false;
      if (PERM == 1) rot = (n0 == rot_n0);
      if (PERM == 2) rot = ((tn % 3) == 2);
      const int ns = rot ? ((n >> 1) + 32 * (n & 1)) : n;
      if (FP8) {
        float f[8];
#pragma unroll
        for (int j = 0; j < 8; ++j) f[j] = tile[(c * 8 + j) * 65 + ns] * wscale;
        u32x2 o = {pk4_fp8(f[0], f[1], f[2], f[3]), pk4_fp8(f[4], f[5], f[6], f[7])};
        *(u32x2*)((unsigned char*)Wt + (size_t)(n0 + n) * K + k0 + c * 8) = o;
      } else {
        u32x4 o;
#pragma unroll
        for (int j = 0; j < 4; ++j) o[j] = pk2(tile[(c * 8 + 2 * j) * 65 + ns], tile[(c * 8 + 2 * j + 1) * 65 + ns]);
        *(u32x4*)(Wt + (size_t)(n0 + n) * K + k0 + c * 8) = o;
      }
    }
  }
}

template <bool F32OUT>
DI void rmsnorm_rows(const float* X, const float* __restrict__ g, void* outp, int nrows, unsigned char* __restrict__ out8 = nullptr) {
  int tidx = threadIdx.x; asm volatile("" : "+v"(tidx));
  const int lane = tidx & 63, gw = blockIdx.x * 8 + (tidx >> 6), nw = gridDim.x * 8;
  for (int row = gw; row < nrows; row += nw) {
    const f32x4* xr = (const f32x4*)(X + (size_t)row * 2048);
    f32x4 v[8];
    float ss = 0.f;
#pragma unroll
    for (int i = 0; i < 8; ++i) { v[i] = xr[lane + 64 * i]; ss += v[i][0] * v[i][0] + v[i][1] * v[i][1] + v[i][2] * v[i][2] + v[i][3] * v[i][3]; }
    ss = wave_sum(ss);
    const float r = rsqrtf(ss * (1.f / 2048.f) + 1e-6f);
#pragma unroll
    for (int i = 0; i < 8; ++i) {
      const f32x4 gg = ((const f32x4*)g)[lane + 64 * i];
      f32x4 o = {v[i][0] * r * gg[0], v[i][1] * r * gg[1], v[i][2] * r * gg[2], v[i][3] * r * gg[3]};
      if (F32OUT) ((f32x4*)((float*)outp + (size_t)row * 2048))[lane + 64 * i] = o;
      else { u32x2 pk = {pk2(o[0], o[1]), pk2(o[2], o[3])}; ((u32x2*)((u16*)outp + (size_t)row * 2048))[lane + 64 * i] = pk; }
      if (!F32OUT && out8) ((unsigned*)(out8 + (size_t)row * 2048))[lane + 64 * i] = pk4_fp8(o[0] * H_SCALE, o[1] * H_SCALE, o[2] * H_SCALE, o[3] * H_SCALE);
    }
  }
}

DI void anorm_phase(u16* C, const float* __restrict__ gq, const float* __restrict__ gkv, unsigned char* __restrict__ cq8) {
  int tidx = threadIdx.x; asm volatile("" : "+v"(tidx));
  const int lane = tidx & 63, gw = blockIdx.x * 8 + (tidx >> 6), nw = gridDim.x * 8;
  for (int row = gw; row < NTOK; row += nw) {
    u32x4* cr = (u32x4*)(C + (size_t)row * 2048);
    u32x4 v[4];
    float sq = 0.f, skv = 0.f;
#pragma unroll
    for (int i = 0; i < 4; ++i) {
      v[i] = cr[lane + 64 * i];
      float s = 0.f;
#pragma unroll
      for (int j = 0; j < 4; ++j) { float a = bf2f(v[i][j] & 0xffffu), b = bf2f(v[i][j] >> 16); s += a * a + b * b; }
      if (i < 3) sq += s; else skv += s;
    }
    sq = wave_sum(sq); skv = wave_sum(skv);
    const float rq = rsqrtf(sq * (1.f / 1536.f) + 1e-6f), rkv = rsqrtf(skv * (1.f / 512.f) + 1e-6f);
#pragma unroll
    for (int i = 0; i < 4; ++i) {
      const int col = (lane + 64 * i) * 8;
      const float* gp = (i < 3) ? (gq + col) : (gkv + col - 1536);
      const float r = (i < 3) ? rq : rkv;
      const f32x4 g0 = *(const f32x4*)gp, g1 = *(const f32x4*)(gp + 4);
      u32x4 o;
      o[0] = pk2(bf2f(v[i][0] & 0xffffu) * r * g0[0], bf2f(v[i][0] >> 16) * r * g0[1]);
      o[1] = pk2(bf2f(v[i][1] & 0xffffu) * r * g0[2], bf2f(v[i][1] >> 16) * r * g0[3]);
      o[2] = pk2(bf2f(v[i][2] & 0xffffu) * r * g1[0], bf2f(v[i][2] >> 16) * r * g1[1]);
      o[3] = pk2(bf2f(v[i][3] & 0xffffu) * r * g1[2], bf2f(v[i][3] >> 16) * r * g1[3]);
      cr[lane + 64 * i] = o;
      if (i < 3) {
        const float q0 = bf2f(v[i][0] & 0xffffu) * r * g0[0] * CQ_SCALE, q1 = bf2f(v[i][0] >> 16) * r * g0[1] * CQ_SCALE;
        const float q2 = bf2f(v[i][1] & 0xffffu) * r * g0[2] * CQ_SCALE, q3 = bf2f(v[i][1] >> 16) * r * g0[3] * CQ_SCALE;
        const float q4 = bf2f(v[i][2] & 0xffffu) * r * g1[0] * CQ_SCALE, q5 = bf2f(v[i][2] >> 16) * r * g1[1] * CQ_SCALE;
        const float q6 = bf2f(v[i][3] & 0xffffu) * r * g1[2] * CQ_SCALE, q7 = bf2f(v[i][3] >> 16) * r * g1[3] * CQ_SCALE;
        u32x2 w8 = {pk4_fp8(q0, q1, q2, q3), pk4_fp8(q4, q5, q6, q7)};
        *(u32x2*)(cq8 + (size_t)row * 1536 + col) = w8;
      }
    }
  }
}

namespace pg8 {
#define PG8_LAS __attribute__((address_space(3)))
constexpr int BM = 256, BK = 64, HALF = 128, HTB = HALF * BK * 2, STAGE_BYTES = 8 * HTB, NXCD = 8, WGM = 8;
DI int lds_byte(int r, int c) { const int st = (r >> 4) * 2 + (c >> 5), rr = r & 15, cc = c & 31, ob = rr * 64 + cc * 2; return st * 1024 + (ob ^ (((ob >> 9) & 1) << 5)); }
DI void stage_rc(int b, int& R, int& C) { const int st = b / 1024, sb = b % 1024, swz = sb ^ (((sb >> 9) & 1) << 5); R = (st >> 1) * 16 + swz / 64; C = (st & 1) * 32 + (swz % 64) / 2; }
DI int perm32(int rho) { const int n = rho >> 4, i = rho & 15; return 8 * (i >> 2) + 4 * n + (i & 3); }
typedef int i32x4v __attribute__((ext_vector_type(4)));
typedef int i32x8 __attribute__((ext_vector_type(8)));
DI i32x8 cat8(bf16x8 a, bf16x8 b) { const i32x4v x = __builtin_bit_cast(i32x4v, a), y = __builtin_bit_cast(i32x4v, b); return __builtin_shufflevector(x, y, 0, 1, 2, 3, 4, 5, 6, 7); }
struct Unit { int pm, pn; };
struct Gemm { const u16* A; const u16* Bt; int M, N, K, lda; };
struct StaticOrder {
  int nM, nN, nwg, G, c;
  int nA = 0, uA = 0, uB = 0;
  DI void init(int M, int N, int G_, int c_) { nM = M / BM; nN = N / BM; nwg = nM * nN; G = G_; c = c_; }
  DI bool next(int i, Unit& u) const {
    long L;
    if (nA == 0) L = (long)i * G + c;
    else if (c < nA) { if (i >= uA) return false; L = (long)i * nA + c; }
    else { if (i >= uB) return false; L = (long)nA * uA + (long)i * (G - nA) + (c - nA); }
    if (L >= nwg) return false;
    int wgid = (int)L; { const int q = nwg / NXCD, r = nwg % NXCD, xcd = wgid % NXCD, off = wgid / NXCD; wgid = (xcd < r ? xcd * (q + 1) : r * (q + 1) + (xcd - r) * q) + off; }
    const int nig = WGM * nN, gid = wgid / nig, fm = gid * WGM, gsz = (nM - fm) < WGM ? (nM - fm) : WGM;
    u.pm = fm + ((wgid % nig) % gsz); u.pn = (wgid % nig) / gsz; return true;
  }
  DI void a_ready(const Unit&) const {}
  DI void done(const Unit&) const {}
};
template <bool FP8, class Epi, class Sched>
__device__ __forceinline__ void gemm_phase(PG8_LAS unsigned char* lds, const Gemm g, const Sched& S, const Epi& E) {
    int tid = threadIdx.x; asm volatile("" : "+v"(tid));
    const int wid = __builtin_amdgcn_readfirstlane(tid >> 6), lane = tid & 63, wr = wid >> 2, wc = wid & 3, fr = lane & 15, fq = lane >> 4;
    const int K = g.K, nt = K / BK;
    unsigned voffA[2], voffB[2];
#pragma unroll
    for (int i = 0; i < 2; ++i) { int R, C; stage_rc(tid * 16 + i * 8192, R, C); const int Rb = Epi::PERM ? ((R & ~31) + perm32(R & 31)) : R;
        voffA[i] = (unsigned)(R * g.lda + C) * 2u; voffB[i] = (unsigned)(Rb * K + C) * 2u; }
    const size_t kstep = (size_t)(BK * 2);
    const size_t hstep = (size_t)HALF * K * 2, hstepA = (size_t)HALF * g.lda * 2;
    const size_t tstep = 2 * hstep, tstepA = 2 * hstepA;
    const unsigned ldsw = (unsigned)wid * 1024u;
    const int aoff = lds_byte(wr * 64 + fr, fq * 8), boff = lds_byte(wc * 32 + fr, fq * 8);
#define PG8_SA(b, h) (((b) * 2 + (h)) * HTB)
#define PG8_SB(b, h) ((4 + (b) * 2 + (h)) * HTB)
#define PG8_STAGE(bufoff, gbase, voff) do { _Pragma("unroll") for (int _i = 0; _i < 2; ++_i) \
        __builtin_amdgcn_global_load_lds((const unsigned*)((const char*)(gbase) + (voff)[_i]), (PG8_LAS unsigned*)(lds + (bufoff) + ldsw + _i * 8192), 16, 0, 0); } while (0)
#define PG8_LDA(dst, b, h) do { _Pragma("unroll") for (int m = 0; m < 4; ++m) _Pragma("unroll") for (int k = 0; k < 2; ++k) dst[m][k] = *(const PG8_LAS bf16x8*)(lds + PG8_SA(b, h) + aoff + m * 2048 + k * 1024); } while (0)
#define PG8_LDB(dst, b, h) do { _Pragma("unroll") for (int n = 0; n < 2; ++n) _Pragma("unroll") for (int k = 0; k < 2; ++k) dst[n][k] = *(const PG8_LAS bf16x8*)(lds + PG8_SB(b, h) + boff + n * 2048 + k * 1024); } while (0)
#define PG8_MMA(ai, bj, At, Bt) do { __builtin_amdgcn_s_setprio(1); _Pragma("unroll") for (int m = 0; m < 4; ++m) _Pragma("unroll") for (int n = 0; n < 2; ++n) { \
        if constexpr (FP8) { const i32x8 bv_ = cat8(Bt[n][0], Bt[n][1]), av_ = cat8(At[m][0], At[m][1]); \
            asm volatile("s_nop 1\n\tv_mfma_scale_f32_16x16x128_f8f6f4 %0, %1, %2, %0, %3, %3 op_sel_hi:[0,0,0]" : "+v"(acc[ai][bj][m][n]) : "v"(bv_), "v"(av_), "v"(sc127)); } \
        else { _Pragma("unroll") for (int k = 0; k < 2; ++k) acc[ai][bj][m][n] = __builtin_amdgcn_mfma_f32_16x16x32_bf16(Bt[n][k], At[m][k], acc[ai][bj][m][n], 0, 0, 0); } } \
        __builtin_amdgcn_s_setprio(0); } while (0)
#define PG8_WAIT_V(n) asm volatile("s_waitcnt vmcnt(" #n ")" ::: "memory")
#define PG8_WAIT_L(n) asm volatile("s_waitcnt lgkmcnt(" #n ")" ::: "memory")
#define PG8_BAR __builtin_amdgcn_s_barrier()
#define PG8_SCHED __builtin_amdgcn_sched_barrier(0)
    Unit cur, nxt; int ui = 0;
    if (!S.next(0, cur)) return;
    f32x4 acc[2][2][4][2];
#pragma unroll
    for (int a = 0; a < 2; ++a)
#pragma unroll
        for (int b = 0; b < 2; ++b)
#pragma unroll
            for (int m = 0; m < 4; ++m)
#pragma unroll
                for (int n = 0; n < 2; ++n) acc[a][b][m][n] = (f32x4){0.f, 0.f, 0.f, 0.f};
    bf16x8 At[4][2], B0[2][2], B1[2][2];
    int sc127 = 0x7F7F7F7F; asm volatile("" : "+v"(sc127));
    const char* cA = (const char*)g.A + (size_t)cur.pm * tstepA; const char* cB = (const char*)g.Bt + (size_t)cur.pn * tstep;
    S.a_ready(cur);
    PG8_STAGE(PG8_SB(0, 0), cB, voffB); PG8_STAGE(PG8_SA(0, 0), cA, voffA); PG8_STAGE(PG8_SB(0, 1), cB + hstep, voffB); PG8_STAGE(PG8_SA(0, 1), cA + hstepA, voffA);
    if (wr == 1) PG8_BAR;
    PG8_WAIT_V(4); PG8_BAR;
    PG8_STAGE(PG8_SB(1, 0), cB + kstep, voffB); PG8_STAGE(PG8_SA(1, 0), cA + kstep, voffA); PG8_STAGE(PG8_SB(1, 1), cB + hstep + kstep, voffB);
    PG8_WAIT_V(6); PG8_BAR;
    for (;;) {
        const bool has_next = S.next(ui + 1, nxt);
        const char* nA = has_next ? (const char*)g.A + (size_t)nxt.pm * tstepA : cA; const char* nB = has_next ? (const char*)g.Bt + (size_t)nxt.pn * tstep : cB;
        for (int t = 0; t < nt; t += 2) {
            const bool last = (t == nt - 2);
            const char* a1 = cA + (size_t)(t + 1) * kstep;
            const char* a2 = last ? nA : cA + (size_t)(t + 2) * kstep; const char* b2 = last ? nB : cB + (size_t)(t + 2) * kstep;
            const char* a3 = a2 + kstep; const char* b3 = b2 + kstep;
            if (last && has_next) S.a_ready(nxt);
            PG8_LDB(B0, 0, 0); PG8_SCHED; PG8_LDA(At, 0, 0); PG8_STAGE(PG8_SA(1, 1), a1 + hstepA, voffA);
            PG8_WAIT_L(8); PG8_BAR; PG8_WAIT_L(0); PG8_MMA(0, 0, At, B0); PG8_BAR; PG8_SCHED;
            PG8_LDB(B1, 0, 1); PG8_STAGE(PG8_SB(0, 0), b2, voffB);
            PG8_BAR; PG8_WAIT_L(0); PG8_MMA(0, 1, At, B1); PG8_BAR;
            PG8_LDA(At, 0, 1); PG8_STAGE(PG8_SA(0, 0), a2, voffA);
            PG8_BAR; PG8_WAIT_L(0); PG8_MMA(1, 0, At, B0); PG8_BAR; PG8_SCHED;
            PG8_STAGE(PG8_SB(0, 1), b2 + hstep, voffB);
            PG8_WAIT_V(6); PG8_BAR; PG8_MMA(1, 1, At, B1); PG8_BAR;
            PG8_LDB(B0, 1, 0); PG8_SCHED; PG8_LDA(At, 1, 0); PG8_STAGE(PG8_SA(0, 1), a2 + hstepA, voffA);
            PG8_WAIT_L(8); PG8_BAR; PG8_WAIT_L(0); PG8_MMA(0, 0, At, B0); PG8_BAR; PG8_SCHED;
            PG8_LDB(B1, 1, 1); PG8_STAGE(PG8_SB(1, 0), b3, voffB);
            PG8_BAR; PG8_WAIT_L(0); PG8_MMA(0, 1, At, B1); PG8_BAR;
            PG8_LDA(At, 1, 1); PG8_STAGE(PG8_SA(1, 0), a3, voffA);
            PG8_BAR; PG8_WAIT_L(0); PG8_MMA(1, 0, At, B0); PG8_BAR; PG8_SCHED;
            PG8_STAGE(PG8_SB(1, 1), b3 + hstep, voffB);
            PG8_WAIT_V(6); PG8_BAR; PG8_MMA(1, 1, At, B1); PG8_BAR;
        }
        if constexpr (FP8) asm volatile("s_nop 15\n\ts_nop 15" ::: "memory");
        if constexpr (!Epi::AFTER_DRAIN) { E(acc, cur, wr, wc, fr, fq); S.done(cur); }
        if (!has_next) break;
#pragma unroll
        for (int a = 0; a < 2; ++a)
#pragma unroll
            for (int b = 0; b < 2; ++b)
#pragma unroll
                for (int m = 0; m < 4; ++m)
#pragma unroll
                    for (int n = 0; n < 2; ++n) acc[a][b][m][n] = (f32x4){0.f, 0.f, 0.f, 0.f};
        cur = nxt; cA = nA; cB = nB; ++ui;
    }
    PG8_WAIT_V(0);
    if (wr == 0) PG8_BAR;
    PG8_BAR;
    if constexpr (Epi::AFTER_DRAIN) { E.fused(acc, cur, wr, wc, fr, fq, lds, wid, lane); S.done(cur); }
#undef PG8_SA
#undef PG8_SB
#undef PG8_STAGE
#undef PG8_LDA
#undef PG8_LDB
#undef PG8_MMA
#undef PG8_WAIT_V
#undef PG8_WAIT_L
#undef PG8_BAR
#undef PG8_SCHED
}

}

struct EpiResid {
  static constexpr bool PERM = false, AFTER_DRAIN = false;
  const float* xin; float* xout; float sc;
  DI void operator()(const f32x4 (&acc)[2][2][4][2], const pg8::Unit& u, int wr, int wc, int fr, int fq) const {
    const int row0 = u.pm * 256 + wr * 64 + fr, col0 = u.pn * 256 + wc * 32 + 4 * fq;
#pragma unroll
    for (int ai = 0; ai < 2; ++ai)
#pragma unroll
      for (int m = 0; m < 4; ++m) {
        const size_t ro = (size_t)(row0 + ai * 128 + m * 16) * 2048 + col0;
#pragma unroll
        for (int bj = 0; bj < 2; ++bj)
#pragma unroll
          for (int n = 0; n < 2; ++n) {
            const size_t o = ro + bj * 128 + n * 16;
            const f32x4 xv = *(const f32x4*)(xin + o);
            *(f32x4*)(xout + o) = xv + acc[ai][bj][m][n] * sc;
          }
        asm volatile("" ::: "memory");
      }
  }
};
template <int MODE>
struct EpiBf {
  static constexpr bool PERM = true, AFTER_DRAIN = false;
  u16* d0; int ld0; int N; u16* d1; u16* d2; const f32x2* rope; float sc = 1.f; int csplit = 0, coff1 = 0, coff2 = 0;
  DI void rot(f32x4& v0, f32x4& v1, int row, int col) const {
    const f32x4* cp = (const f32x4*)(rope + (row & 2047) * 32 + ((col & 63) >> 1));
    const f32x4 c01 = cp[0], c23 = cp[1];
    const f32x4 a = {v0[0] * c01[0] - v0[1] * c01[1], v0[1] * c01[0] + v0[0] * c01[1], v0[2] * c01[2] - v0[3] * c01[3], v0[3] * c01[2] + v0[2] * c01[3]};
    const f32x4 b = {v1[0] * c23[0] - v1[1] * c23[1], v1[1] * c23[0] + v1[0] * c23[1], v1[2] * c23[2] - v1[3] * c23[3], v1[3] * c23[2] + v1[2] * c23[3]};
    v0 = a; v1 = b;
  }
  DI void operator()(const f32x4 (&acc)[2][2][4][2], const pg8::Unit& u, int wr, int wc, int fr, int fq) const {
    const int row0 = u.pm * 256 + wr * 64 + fr, colb = u.pn * 256 + wc * 32 + 8 * fq;
#pragma unroll
    for (int ai = 0; ai < 2; ++ai)
#pragma unroll
      for (int m = 0; m < 4; ++m) {
        const int row = row0 + ai * 128 + m * 16;
#pragma unroll
        for (int bj = 0; bj < 2; ++bj) {
          const int col = colb + bj * 128;
          f32x4 v0 = acc[ai][bj][m][0] * sc, v1 = acc[ai][bj][m][1] * sc;
          u16* dst = nullptr;
          if (MODE == 0) { if (col < N) dst = d0 + (size_t)row * ld0 + (col + coff2 + ((col < csplit) ? (coff1 - coff2) : 0)); }
          else if (MODE == 1) {
            const int oc = col + coff2 + ((col < csplit) ? (coff1 - coff2) : 0);
            if (col < N) {
              if (oc < 2048) dst = d0 + (size_t)row * 2048 + oc;
              else if (oc < 2112) { rot(v0, v1, row, oc); dst = d2 + (size_t)row * 64 + (oc - 2048); }
              else dst = d1 + (size_t)row * 4096 + (oc - 2112);
            }
          } else if (MODE == 3) {
            if (col < N) { const bool lo = col < csplit; u16* bp = lo ? d0 : d1; const int ldd = lo ? 2048 : 4096, oc = lo ? col : col + (coff2 - 2112); dst = bp + (size_t)row * ldd + oc + (lo ? coff1 : 0); }
          } else {
            if (((col >> 6) % 3) == 2) rot(v0, v1, row, col);
            dst = d0 + (size_t)row * 3072 + col;
          }
          if (dst) { u32x4 w = {pk2(v0[0], v0[1]), pk2(v0[2], v0[3]), pk2(v1[0], v1[1]), pk2(v1[2], v1[3])}; *(u32x4*)dst = w; }
        }
        asm volatile("" ::: "memory");
      }
  }
};

template <bool FP8 = false, class Epi>
DI void run_gemm(const u16* A, int lda, const u16* Bt, int M, int N, int K, const Epi& e, char* smem, int nA = 0, int uA = 0, int uB = 0) {
  __syncthreads();
  pg8::Gemm g{A, Bt, M, N, K, lda};
  pg8::StaticOrder S; S.init(M, N, gridDim.x, blockIdx.x);
  if (nA > 0 && (int)gridDim.x > nA && nA * uA + ((int)gridDim.x - nA) * uB == S.nwg) { S.nA = nA; S.uA = uA; S.uB = uB; }
  pg8::gemm_phase<FP8>(( __attribute__((address_space(3))) unsigned char*)smem, g, S, e);
  __syncthreads();
}

typedef __attribute__((address_space(3))) unsigned* lds_u32p;
template <int OFF> DI void rd4(bf16x8 (&f)[4], unsigned addr) {
  asm volatile("ds_read_b128 %0, %4 offset:%5\n\tds_read_b128 %1, %4 offset:%6\n\tds_read_b128 %2, %4 offset:%7\n\tds_read_b128 %3, %4 offset:%8\n\ts_waitcnt lgkmcnt(0)"
               : "=&v"(f[0]), "=&v"(f[1]), "=&v"(f[2]), "=&v"(f[3]) : "v"(addr), "i"(OFF), "i"(OFF + 32), "i"(OFF + 64), "i"(OFF + 96) : "memory");
}
template <int OFF> DI void rdv8(s16x4 (&v)[8], unsigned addr) {
  asm volatile("ds_read_b64_tr_b16 %0, %8 offset:%9\n\tds_read_b64_tr_b16 %1, %8 offset:%10\n\tds_read_b64_tr_b16 %2, %8 offset:%11\n\tds_read_b64_tr_b16 %3, %8 offset:%12\n\t"
               "ds_read_b64_tr_b16 %4, %8 offset:%13\n\tds_read_b64_tr_b16 %5, %8 offset:%14\n\tds_read_b64_tr_b16 %6, %8 offset:%15\n\tds_read_b64_tr_b16 %7, %8 offset:%16\n\ts_waitcnt lgkmcnt(0)"
               : "=&v"(v[0]), "=&v"(v[1]), "=&v"(v[2]), "=&v"(v[3]), "=&v"(v[4]), "=&v"(v[5]), "=&v"(v[6]), "=&v"(v[7])
               : "v"(addr), "i"(OFF), "i"(OFF + 512), "i"(OFF + 1024), "i"(OFF + 1536), "i"(OFF + 2048), "i"(OFF + 2560), "i"(OFF + 3072), "i"(OFF + 3584) : "memory");
}
template <int KSTR, int ND, int N>
DI f32x16 s_block(unsigned kaddr, const bf16x8* qf) {
  const f32x16 z16 = {0.f, 0.f, 0.f, 0.f, 0.f, 0.f, 0.f, 0.f, 0.f, 0.f, 0.f, 0.f, 0.f, 0.f, 0.f, 0.f};
  bf16x8 f[4];
  rd4<N * 32 * KSTR>(f, kaddr);
  f32x16 a = MFMA(f[0], qf[0], z16); a = MFMA(f[1], qf[1], a); a = MFMA(f[2], qf[2], a); a = MFMA(f[3], qf[3], a);
  if constexpr (ND > 4) { rd4<N * 32 * KSTR + 128>(f, kaddr); a = MFMA(f[0], qf[4], a); a = MFMA(f[1], qf[5], a); a = MFMA(f[2], qf[6], a); a = MFMA(f[3], qf[7], a); }
  if constexpr (ND > 8) { rd4<N * 32 * KSTR + 256>(f, kaddr); a = MFMA(f[0], qf[8], a); a = MFMA(f[1], qf[9], a); a = MFMA(f[2], qf[10], a); a = MFMA(f[3], qf[11], a); }
  if constexpr (ND > 12) { rd4<N * 32 * KSTR + 384>(f, kaddr); a = MFMA(f[0], qf[12], a); a = MFMA(f[1], qf[13], a); a = MFMA(f[2], qf[14], a); a = MFMA(f[3], qf[15], a); }
  return a;
}
template <int CB> DI void pv_block(f32x16& o, unsigned vaddr, const bf16x8 (&pb)[2][2]) {
  s16x4 v[8];
  rdv8<CB * 4096>(v, vaddr);
#pragma unroll
  for (int q = 0; q < 4; ++q) {
    const bf16x8 vf = {v[2 * q][0], v[2 * q][1], v[2 * q][2], v[2 * q][3], v[2 * q + 1][0], v[2 * q + 1][1], v[2 * q + 1][2], v[2 * q + 1][3]};
    o = MFMA(vf, pb[q >> 1][q & 1], o);
  }
}
template <int DQK, int W1, int DV, int VW, int MODE>
DI void attn_core(const u16* __restrict__ k1, int ldk1, const u16* __restrict__ k2, int ldk2, const u16* __restrict__ vsrc, int ldv,
                  int kv_len, int kbase0, int ntiles, const u16* qrow, int tq, int tq0, float c2, int vcb0, u16* yrow,
                  const u16* grow, const unsigned* maskrow, const float* lutw, float bias_far, float m_init, float l_init, char* smem) {
  constexpr int KSTR = DQK * 2 + 16, KCH = DQK / 8;
  constexpr int ND = DQK / 16, NCB = DV / 32, BUF = 64 * KSTR + (VW / 32) * 4096;
  constexpr int NKI = KSTR / 16, NVI = VW / 8;
  static_assert(ND % 4 == 0 && NCB <= 4, "fragment batches");
  int tid0 = threadIdx.x; asm volatile("" : "+v"(tid0));
  const int lane = tid0 & 63, r32 = lane & 31, hi = lane >> 5;
  const int wv = __builtin_amdgcn_readfirstlane(tid0 >> 6);
  const unsigned lds0 = (unsigned)(uintptr_t)smem;
  bf16x8 qf[ND];
#pragma unroll
  for (int d0 = 0; d0 < ND; ++d0) qf[d0] = *(const bf16x8*)(qrow + d0 * 16 + hi * 8);
  f32x16 o[NCB];
#pragma unroll
  for (int cb = 0; cb < NCB; ++cb)
#pragma unroll
    for (int r = 0; r < 16; ++r) o[cb][r] = 0.f;
  float m = m_init, l = (hi == 0) ? l_init : 0.f;
  const unsigned klane = (unsigned)(r32 * KSTR + hi * 16);
  const unsigned vlane = (unsigned)(64 * KSTR + vcb0 * 4096 + ((lane >> 4) & 1) * 32 + (lane & 3) * 8 + (4 * hi + ((lane & 15) >> 2)) * 64);
  unsigned mwn[2] = {0u, 0u};
  constexpr int NKS = (NKI + 7) / 8, NVS = (NVI + 7) / 8;
  const u16* kptr[NKS]; int kstr[NKS]; const u16* vptr[NVS];
  if (MODE != 2) {
    int ln = threadIdx.x & 63; asm volatile("" : "+v"(ln));
#pragma unroll
    for (int ii = 0; ii < NKS; ++ii) {
      const int i = wv + 8 * ii, ob = i * 1024 + ln * 16, row = ob / KSTR;
      int c = (ob - row * KSTR) >> 4; c = (c >= KCH) ? 0 : c;
      const bool seg1 = c < W1 / 8;
      kptr[ii] = seg1 ? (k1 + ((kbase0 + row) * ldk1 + c * 8)) : (k2 + ((kbase0 + row) * ldk2 + (c - W1 / 8) * 8));
      kstr[ii] = seg1 ? 64 * ldk1 : 64 * ldk2;
    }
#pragma unroll
    for (int ii = 0; ii < NVS; ++ii) {
      const int i = wv + 8 * ii, ob = i * 1024 + ln * 16, cbk = ob >> 12, row = (ob & 4095) >> 6, cw = (ob & 63) >> 4;
      vptr[ii] = vsrc + ((kbase0 + row) * ldv + (cbk * 4 + cw) * 8);
    }
  }
  auto stage_tile = [&](int kb, int buf) {
    const unsigned bofs = (unsigned)(buf * BUF);
    if (MODE != 2) {
#pragma unroll
      for (int ii = 0; ii < NKS; ++ii) {
        const int i = wv + 8 * ii;
        if (i < NKI) { __builtin_amdgcn_global_load_lds((const unsigned*)kptr[ii], (lds_u32p)(smem + bofs + i * 1024), 16, 0, 0); kptr[ii] += kstr[ii]; }
      }
#pragma unroll
      for (int ii = 0; ii < NVS; ++ii) {
        const int i = wv + 8 * ii;
        if (i < NVI) { __builtin_amdgcn_global_load_lds((const unsigned*)vptr[ii], (lds_u32p)(smem + bofs + 64 * KSTR + i * 1024), 16, 0, 0); vptr[ii] += 64 * ldv; }
      }
    } else {
      int ln = threadIdx.x & 63; asm volatile("" : "+v"(ln));
#pragma unroll
      for (int ii = 0; ii < NKS; ++ii) {
        const int i = wv + 8 * ii;
        if (i < NKI) {
          const int ob = i * 1024 + ln * 16, row = ob / KSTR;
          int c = (ob - row * KSTR) >> 4; c = (c >= KCH) ? 0 : c;
          int key = kb + row; key = key < 0 ? 0 : (key >= kv_len ? kv_len - 1 : key);
          const u16* src = (c < W1 / 8) ? (k1 + (key * ldk1 + c * 8)) : (k2 + (key * ldk2 + (c - W1 / 8) * 8));
          __builtin_amdgcn_global_load_lds((const unsigned*)src, (lds_u32p)(smem + bofs + i * 1024), 16, 0, 0);
        }
      }
#pragma unroll
      for (int ii = 0; ii < NVS; ++ii) {
        const int i = wv + 8 * ii;
        if (i < NVI) {
          const int ob = i * 1024 + ln * 16, cbk = ob >> 12, row = (ob & 4095) >> 6, cw = (ob & 63) >> 4;
          int key = kb + row; key = key < 0 ? 0 : (key >= kv_len ? kv_len - 1 : key);
          __builtin_amdgcn_global_load_lds((const unsigned*)(vsrc + (key * ldv + (cbk * 4 + cw) * 8)), (lds_u32p)(smem + bofs + 64 * KSTR + i * 1024), 16, 0, 0);
        }
      }
    }
    if (MODE == 1) { mwn[0] = maskrow[(kb >> 5)]; mwn[1] = maskrow[(kb >> 5) + 1]; }
  };
  stage_tile(kbase0, 0);
  asm volatile("s_waitcnt vmcnt(0)" ::: "memory");
  __syncthreads();
  for (int t = 0; t < ntiles; ++t) {
    const int kb = kbase0 + t * 64;
    const unsigned bufa = lds0 + (unsigned)((t & 1) * BUF);
    const unsigned mw0 = mwn[0], mw1 = mwn[1];
    if (t + 1 < ntiles) stage_tile(kb + 64, (t + 1) & 1);
    if (!(MODE == 0 && kb > tq0 + 31)) {
      f32x16 s[2];
      s[0] = s_block<KSTR, ND, 0>(bufa + klane, qf);
      s[1] = s_block<KSTR, ND, 1>(bufa + klane, qf);
      if (MODE == 0) {
        s[0] = s[0] * c2; s[1] = s[1] * c2;
        if (__builtin_amdgcn_readfirstlane((int)(kb + 63 > tq0))) {
#pragma unroll
          for (int n = 0; n < 2; ++n)
#pragma unroll
            for (int i = 0; i < 16; ++i) { const int key = kb + 32 * n + crow(i, hi); if (key > tq) s[n][i] = NEGV; }
        }
      } else if (MODE == 1) {
        const bool far = (tq0 - (kb + 63)) >= 128;
#pragma unroll
        for (int n = 0; n < 2; ++n) {
          const unsigned wb = (n ? mw1 : mw0) >> (4 * hi);
          if (far) {
#pragma unroll
            for (int i = 0; i < 16; ++i) {
              const float v = fmaf(s[n][i], c2, bias_far);
              s[n][i] = ((wb >> ((i & 3) + 8 * (i >> 2))) & 1u) ? v : NEGV;
            }
          } else {
#pragma unroll
            for (int i = 0; i < 16; ++i) {
              const int key = kb + 32 * n + crow(i, hi);
              int rel = tq - key; rel = rel < 0 ? 0 : (rel > 128 ? 128 : rel);
              const float v = fmaf(s[n][i], c2, lutw[rel]);
              s[n][i] = ((wb >> ((i & 3) + 8 * (i >> 2))) & 1u) ? v : NEGV;
            }
          }
        }
      } else if (MODE == 2) {
#pragma unroll
        for (int n = 0; n < 2; ++n)
#pragma unroll
          for (int i = 0; i < 16; ++i) {
            const int key = kb + 32 * n + crow(i, hi), rel = tq - key;
            const bool ok = ((unsigned)rel < 128u) && (key >= 0);
            const float v = fmaf(s[n][i], c2, lutw[rel & 127]);
            s[n][i] = ok ? v : NEGV;
          }
      } else {
#pragma unroll
        for (int n = 0; n < 2; ++n)
#pragma unroll
          for (int i = 0; i < 16; ++i) s[n][i] *= c2;
      }
      float mx = s[0][0];
#pragma unroll
      for (int i = 1; i < 16; ++i) mx = fmaxf(mx, s[0][i]);
#pragma unroll
      for (int i = 0; i < 16; ++i) mx = fmaxf(mx, s[1][i]);
      mx = xhalf_max(mx);
      if (__any(mx - m > 8.0f)) {
        const float mnew = fmaxf(m, mx), alpha = __builtin_amdgcn_exp2f(m - mnew);
        m = mnew; l *= alpha;
#pragma unroll
        for (int cb = 0; cb < NCB; ++cb)
#pragma unroll
          for (int r = 0; r < 16; ++r) o[cb][r] *= alpha;
      }
      {
        const float nm = -m;
        f32x16 e0 = s[0] + nm, e1 = s[1] + nm;
#pragma unroll
        for (int i = 0; i < 16; ++i) { e0[i] = __builtin_amdgcn_exp2f(e0[i]); e1[i] = __builtin_amdgcn_exp2f(e1[i]); }
        s[0] = e0; s[1] = e1;
        const f32x16 sm = e0 + e1;
        typedef __attribute__((ext_vector_type(8))) float f32x8;
        const f32x8 h8 = sm.lo + sm.hi;
        const f32x4 h4 = h8.lo + h8.hi;
        const f32x2 h2 = h4.lo + h4.hi;
        l += h2[0] + h2[1];
      }
      bf16x8 pb[2][2];
#pragma unroll
      for (int n = 0; n < 2; ++n)
#pragma unroll
        for (int s2 = 0; s2 < 2; ++s2) {
          u32x4 pw = {pk2(s[n][8 * s2 + 0], s[n][8 * s2 + 1]), pk2(s[n][8 * s2 + 2], s[n][8 * s2 + 3]),
                      pk2(s[n][8 * s2 + 4], s[n][8 * s2 + 5]), pk2(s[n][8 * s2 + 6], s[n][8 * s2 + 7])};
          pb[n][s2] = __builtin_bit_cast(bf16x8, pw);
        }
      pv_block<0>(o[0], bufa + vlane, pb);
      if constexpr (NCB > 1) pv_block<1>(o[1], bufa + vlane, pb);
      if constexpr (NCB > 2) pv_block<2>(o[2], bufa + vlane, pb);
      if constexpr (NCB > 3) pv_block<3>(o[3], bufa + vlane, pb);
    }
    asm volatile("s_waitcnt vmcnt(0)" ::: "memory");
    __syncthreads();
  }
  const float inv = __builtin_amdgcn_rcpf(xhalf_sum(l));
#pragma unroll
  for (int cb = 0; cb < NCB; ++cb)
#pragma unroll
    for (int g = 0; g < 4; ++g) {
      const int dv = 32 * cb + 8 * g + 4 * hi;
      const u32x2 gg = *(const u32x2*)(grow + dv);
      float gv[4] = {bf2f(gg[0] & 0xffffu), bf2f(gg[0] >> 16), bf2f(gg[1] & 0xffffu), bf2f(gg[1] >> 16)};
      float ov[4];
#pragma unroll
      for (int j = 0; j < 4; ++j) {
        const float sg = gv[j] * __builtin_amdgcn_rcpf(1.f + __builtin_amdgcn_exp2f(-LOG2E * gv[j]));
        ov[j] = o[cb][4 * g + j] * inv * sg;
      }
      *(unsigned*)((unsigned char*)yrow + dv) = pk4_fp8(ov[0] * Y_SCALE, ov[1] * Y_SCALE, ov[2] * Y_SCALE, ov[3] * Y_SCALE);
      __builtin_amdgcn_sched_barrier(0);
    }
}

DI unsigned ordkey(float f) { const unsigned b = __float_as_uint(f); return b ^ ((unsigned)((int)b >> 31) | 0x80000000u); }
DI void indexer_phase(const u16* __restrict__ P, unsigned* __restrict__ mask) {
  int tidx = threadIdx.x; asm volatile("" : "+v"(tidx));
  const int lane = tidx & 63, r32 = lane & 31, hi = lane >> 5;
  const int gw = blockIdx.x * 8 + (tidx >> 6), nw = gridDim.x * 8;
  for (int item = gw; item < 8192; item += nw) {
    const int b = item & 7, t0 = (1023 - (item >> 3)) * 2;
    const size_t brow = (size_t)b * SEQ;
    const int g = (r32 >> 2) & 1, head = 4 * (r32 >> 3) + (r32 & 3);
    bf16x8 aq[4];
#pragma unroll
    for (int s = 0; s < 4; ++s) aq[s] = *(const bf16x8*)(P + (brow + t0 + g) * 7808 + 2560 + head * 64 + 16 * s + 8 * hi);
    float wv[16];
    {
      const u32x4 w0 = *(const u32x4*)(P + (brow + t0 + hi) * 7808 + 3648), w1 = *(const u32x4*)(P + (brow + t0 + hi) * 7808 + 3656);
#pragma unroll
      for (int j = 0; j < 4; ++j) { wv[2 * j] = bf2f(w0[j] & 0xffffu); wv[2 * j + 1] = bf2f(w0[j] >> 16); wv[8 + 2 * j] = bf2f(w1[j] & 0xffffu); wv[8 + 2 * j + 1] = bf2f(w1[j] >> 16); }
    }
    const int tme = t0 + hi, kbmax = (t0 + 1) >> 5;
    unsigned sc[64];
#pragma unroll
    for (int kb = 0; kb < 64; ++kb) {
      unsigned u = 0u;
      if (kb <= kbmax) {
        f32x16 a;
#pragma unroll
        for (int r = 0; r < 16; ++r) a[r] = 0.f;
        const u16* kp = P + (brow + 32 * kb + r32) * 7808 + 3584 + 8 * hi;
#pragma unroll
        for (int s = 0; s < 4; ++s) { const bf16x8 bk = *(const bf16x8*)(kp + 16 * s); a = MFMA(aq[s], bk, a); }
        float v = 0.f;
#pragma unroll
        for (int i = 0; i < 16; ++i) v = fmaf(wv[i], fmaxf(a[i], 0.f), v);
        u = (32 * kb + r32 <= tme) ? ordkey(v) : 0u;
      }
      sc[kb] = u;
    }
    const int target = (tme + 1 < 256) ? tme + 1 : 256;
    unsigned T = 0u;
    for (int bit = 31; bit >= 0; --bit) {
      const unsigned Tp = T | (1u << bit);
      int cnt = 0;
#pragma unroll
      for (int kb = 0; kb < 64; ++kb) cnt += (sc[kb] >= Tp) ? 1 : 0;
#pragma unroll
      for (int o = 16; o; o >>= 1) cnt += __shfl_xor(cnt, o);
      if (cnt >= target) T = Tp;
    }
    unsigned w0 = 0u, w1 = 0u;
#pragma unroll
    for (int kb = 0; kb < 64; ++kb) {
      const bool pred = (sc[kb] >= T) && (sc[kb] != 0u);
      const unsigned long long bal = __ballot(pred);
      const unsigned wd = (unsigned)(bal >> (32 * hi));
      if ((kb & 31) == r32) { if (kb < 32) w0 = wd; else w1 = wd; }
    }
    mask[(brow + tme) * 64 + r32] = w0;
    mask[(brow + tme) * 64 + 32 + r32] = w1;
  }
}

DI void gbar(unsigned* cnt, unsigned target) {
  asm volatile("s_waitcnt vmcnt(0)" ::: "memory");
  __syncthreads();
  if (threadIdx.x == 0) {
    __builtin_amdgcn_fence(__ATOMIC_RELEASE, "agent");
    asm volatile("s_waitcnt vmcnt(0)" ::: "memory");
    __hip_atomic_fetch_add(cnt, 1u, __ATOMIC_RELAXED, __HIP_MEMORY_SCOPE_AGENT);
    while (__hip_atomic_load(cnt, __ATOMIC_RELAXED, __HIP_MEMORY_SCOPE_AGENT) < target) __builtin_amdgcn_s_sleep(1);
    __builtin_amdgcn_fence(__ATOMIC_ACQUIRE, "agent");
    asm volatile("s_waitcnt vmcnt(0)" ::: "memory");
  }
  __syncthreads();
}
#define GSYNC() do { ++bar_gen; gbar(BAR, bar_gen * gridDim.x); } while (0)
__global__ void __launch_bounds__(512, 2) mega(Params p) {
  cg::grid_group grid = cg::this_grid();
  extern __shared__ __attribute__((aligned(16))) char smem[];
  volatile int* s_item = (volatile int*)(smem + LDS_ITEM);
  char* ws = p.ws;
  unsigned char* Y8 = (unsigned char*)(ws + OFF_Y);
  u16* WIN8 = (u16*)(ws + OFF_WIN + 19922944);
  unsigned char* CQ8 = (unsigned char*)(ws + OFF_Y + 67108864);     u16* H = (u16*)(ws + OFF_H); u16* Cb = (u16*)(ws + OFF_Y); u16* Qb = (u16*)(ws + OFF_H);
  u16* KV = (u16*)(ws + OFF_KV); u16* MG = (u16*)(ws + OFF_MG); u16* KR = (u16*)(ws + OFF_KR); u16* Pb = (u16*)(ws + OFF_P);
  u16* WIN = (u16*)(ws + OFF_WIN); u16* WUQ = (u16*)(ws + OFF_WUQ); u16* WUKV = (u16*)(ws + OFF_WUKV); u16* WOUT = (u16*)(ws + OFF_WOUT);
  u16* WMEMALL = (u16*)(ws + OFF_KV); u16* MEMN = (u16*)(ws + OFF_MEMN); u16* MEMKV = (u16*)(ws + OFF_MEMKV);
  unsigned* MASK = (unsigned*)(ws + OFF_MASK); f32x2* ROPE = (f32x2*)(ws + OFF_ROPE); float* LUT = (float*)(ws + OFF_LUT);
  int* CTR = (int*)(ws + OFF_CTR);
  unsigned* BAR = (unsigned*)(ws + OFF_CTR) + 64;
  unsigned bar_gen = 0;
  const int tid = threadIdx.x, lane = tid & 63, wv = __builtin_amdgcn_readfirstlane(tid >> 6), r32 = lane & 31, hi = lane >> 5;
  const int gtid = blockIdx.x * 512 + tid, gthreads = gridDim.x * 512;

  for (int i = gtid; i < 2048 * 32; i += gthreads) {
    const int pos = i >> 5, j = i & 31;
    const float inv = 1.0f / powf(10000.0f, (float)(2 * j) / 64.0f);
    const float ang = (float)pos * inv;
    const float k = rintf(ang * 0.15915494309189535f);
    float r = fmaf(-k, 6.28318548202514648f, ang);
    r = fmaf(-k, -1.74845553e-7f, r);
    f32x2 cs = {__cosf(r), __sinf(r)};
    ROPE[i] = cs;
  }
  for (int i = gtid; i < 129 * 32; i += gthreads) {
    const int rel = i >> 5, h = i & 31;
    int bucket;
    if (rel < 16) bucket = rel;
    else { const int lg = 16 + (int)(logf((float)rel / 16.0f) / 2.0794415416798357f * 16.0f); bucket = lg < 31 ? lg : 31; }
    LUT[i] = p.rel_bias[bucket * 32 + h] * LOG2E;
  }
  rmsnorm_rows<false>(p.mem, p.mem_norm, MEMN, 2048);
#pragma unroll 1
  for (int l = 0; l < 4; ++l) convert_wt<0>(p.w_mem_kv + (size_t)l * 2048 * 2048, 2048, 2048, 2048, WMEMALL + (size_t)l * 2048 * 2048, smem);

  auto convert_layer = [&](int L) {
    const int kind = L % 3, j = L / 3;
    if (kind == 0) {
    convert_wt<1>(p.w_in_a + (size_t)j * 2048 * 6208, 2048, 6208, 3840, WIN, smem, 1.f, 3648, 576, 1536, 2560, 512);
    convert_wt<0, true>(p.w_in_a + (size_t)j * 2048 * 6208, 2048, 6208, 2560, WIN8, smem, WIN_SCALE, 2560, 1536, 0, 576);
    convert_wt<2, true>(p.w_uq + (size_t)j * 1536 * 3072, 1536, 3072, 3072, WUQ, smem, WUQ_SCALE);
    convert_wt<0>(p.w_ukv + (size_t)j * 512 * 4096, 512, 4096, 4096, WUKV, smem);
  } else if (kind == 1) {
    convert_wt<0>(p.w_in_b, 2048, 7760, 4864, WIN, smem, 1.f, 4688, 1616, 2048, 3072);
    convert_wt<0, true>(p.w_in_b, 2048, 7760, 3072, WIN8, smem, WIN_SCALE, 3072, 2048, 0, 1616);
  } else {
    convert_wt<0>(p.w_in_c, 2048, 6656, 3584, WIN, smem, 1.f, 3584, 512, 2048, 3072);
    convert_wt<0, true>(p.w_in_c, 2048, 6656, 3072, WIN8, smem, WIN_SCALE, 3072, 2048, 0, 512);
  }
  };
#pragma unroll 1
  for (int layer = 0; layer < 4; ++layer) {
    const int kind = layer % 3, j = layer / 3;
    const float* xin = (layer == 0) ? p.x : p.out;
    unsigned char* H8 = (unsigned char*)(ws + ((kind == 0) ? OFF_KV + 67108864 : OFF_Y));
    rmsnorm_rows<false>(xin, p.norm_in + layer * 2048, H, NTOK, H8);
    if (layer == 0) convert_layer(0);
    convert_wt<0, true>(p.w_out + (size_t)layer * 3072 * 2048, 3072, 2048, 2048, WOUT, smem, WOUT_SCALE);
    if (layer == 0) { __builtin_amdgcn_fence(__ATOMIC_RELEASE, "agent"); grid.sync(); __builtin_amdgcn_fence(__ATOMIC_ACQUIRE, "agent"); asm volatile("s_waitcnt vmcnt(0)" ::: "memory"); }
    else GSYNC();

    if (kind == 0) {
      { EpiBf<1> e{Cb, 2048, 3648, MG, KR, ROPE, 1.f, 576, 1536, 2560}; run_gemm(H, 2048, WIN, NTOK, 3840, 2048, e, smem); }
      { EpiBf<3> e{Cb, 2048, 2560, MG, nullptr, nullptr, 1.f / (H_SCALE * WIN_SCALE), 1536, 0, 576}; run_gemm<true>((const u16*)H8, 1024, WIN8, NTOK, 2560, 1024, e, smem, 192, 2, 4); }
    }
    else if (kind == 1) {
      { EpiBf<0> e{Pb, 7808, 4688, nullptr, nullptr, nullptr, 1.f, 1616, 2048, 3072}; run_gemm(H, 2048, WIN, NTOK, 4864, 2048, e, smem); }
      { EpiBf<0> e{Pb, 7808, 3072, nullptr, nullptr, nullptr, 1.f / (H_SCALE * WIN_SCALE), 2048, 0, 1616}; run_gemm<true>((const u16*)H8, 1024, WIN8, NTOK, 3072, 1024, e, smem); }
    } else {
      { EpiBf<0> e{Pb, 6656, 3584, nullptr, nullptr, nullptr, 1.f, 512, 2048, 3072}; run_gemm(H, 2048, WIN, NTOK, 3584, 2048, e, smem); }
      { EpiBf<0> e{Pb, 6656, 3072, nullptr, nullptr, nullptr, 1.f / (H_SCALE * WIN_SCALE), 2048, 0, 512}; run_gemm<true>((const u16*)H8, 1024, WIN8, NTOK, 3072, 1024, e, smem, 128, 2, 4); }
    }
    if (layer == 0) { EpiBf<0> e{MEMKV, 8192, 8192, nullptr, nullptr, nullptr}; run_gemm(MEMN, 2048, WMEMALL, 2048, 8192, 2048, e, smem); }
    GSYNC();

    if (kind == 0) {
      anorm_phase(Cb, p.a_q_norm + j * 1536, p.a_kv_norm + j * 512, CQ8);
      GSYNC();
      { EpiBf<2> e{Qb, 3072, 3072, nullptr, nullptr, ROPE, 1.f / (CQ_SCALE * WUQ_SCALE)}; run_gemm<true>((const u16*)CQ8, 768, WUQ, NTOK, 3072, 768, e, smem); }
      { EpiBf<0> e{KV, 4096, 4096, nullptr, nullptr, nullptr}; run_gemm(Cb + 1536, 2048, WUKV, NTOK, 4096, 512, e, smem); }
      GSYNC();
    } else if (kind == 1) {
      indexer_phase(Pb, MASK);
      GSYNC();
    }

    {
      const int nself = (kind == 0) ? 1024 : 2048, total = nself + 512;
      const u16* mgb = (kind == 0) ? MG : Pb;
      const int ldmg = (kind == 0) ? 4096 : (kind == 1 ? 7808 : 6656);
      const int mqcol = (kind == 0) ? 0 : (kind == 1 ? 3664 : 2560);
      const int gatecol = (kind == 0) ? 1024 : (kind == 1 ? 4688 : 3584);
      const u16* memkv = MEMKV + layer * 2048;
      float* lut_all = (float*)(smem + LDS_LUT);
      if (kind != 0) {
        for (int i = tid; i < 32 * 129; i += 512) { const int h = i / 129, r = i - h * 129; lut_all[h * 132 + r] = LUT[r * 32 + h]; }
      }
      if (tid == 0) s_item[0] = atomicAdd(&CTR[layer], 1);
      __syncthreads();
      for (int par = 0;; par ^= 1) {
        const int item = __builtin_amdgcn_readfirstlane(s_item[par]);
        if (item >= total) break;
        if (tid == 0) s_item[par ^ 1] = atomicAdd(&CTR[layer], 1);
        if (item < nself) {
          if (kind == 0) {
            const int qblk = 7 - item / 128, rem = item % 128, b = rem / 16, head = rem % 16;
            const size_t brow = (size_t)b * SEQ;
            const int tq0 = qblk * 256 + 32 * wv, tq = tq0 + r32;
            attn_core<192, 128, 128, 128, 0>(KV + brow * 4096 + head * 256, 4096, KR + brow * 64, 64, KV + brow * 4096 + head * 256 + 128, 4096,
                                            SEQ, 0, 4 * qblk + 4, Qb + (brow + tq) * 3072 + head * 192, tq, tq0, 0.07216878364870322f * LOG2E, 0,
                                            (u16*)(Y8 + (brow + tq) * 3072 + head * 128), mgb + (brow + tq) * ldmg + gatecol + head * 128,
                                            nullptr, nullptr, 0.f, -1e29f, 0.f, smem);
          } else {
            const int qb = 63 - item / 32, rem = item % 32, b = rem / 4, kvh = rem % 4;
            const size_t brow = (size_t)b * SEQ;
            const int head = kvh * 8 + wv, tq0 = qb * 32, tq = tq0 + r32;
            const float* lutw = lut_all + head * 132;
            if (kind == 1) {
              attn_core<64, 64, 64, 64, 1>(Pb + brow * 7808 + 2048 + kvh * 64, 7808, nullptr, 0, Pb + brow * 7808 + 2304 + kvh * 64, 7808,
                                          SEQ, 0, (tq0 + 31) / 64 + 1, Pb + (brow + tq) * 7808 + head * 64, tq, tq0, 0.125f * LOG2E, 0,
                                          (u16*)(Y8 + (brow + tq) * 3072 + head * 64), Pb + (brow + tq) * 7808 + gatecol + head * 64,
                                          MASK + (brow + tq) * 64, lutw, lutw[128], -1e29f, 0.f, smem);
            } else {
              const float sink = p.c_sinks[j * 32 + head] * LOG2E;
              attn_core<64, 64, 64, 64, 2>(Pb + brow * 6656 + 2048 + kvh * 64, 6656, nullptr, 0, Pb + brow * 6656 + 2304 + kvh * 64, 6656,
                                          SEQ, tq0 - 128, 3, Pb + (brow + tq) * 6656 + head * 64, tq, tq0, 0.125f * LOG2E, 0,
                                          (u16*)(Y8 + (brow + tq) * 3072 + head * 64), Pb + (brow + tq) * 6656 + gatecol + head * 64,
                                          nullptr, lutw, 0.f, sink, 1.f, smem);
            }
          }
        } else {
          const int it = item - nself, b = it / 64, mh = (it % 64) / 16, qb = it % 16;
          const size_t brow = (size_t)b * SEQ;
          const int tq0 = qb * 128 + 32 * (wv >> 1), tq = tq0 + r32, vh = wv & 1;
          attn_core<256, 256, 128, 256, 3>(memkv + (size_t)b * 256 * 8192 + mh * 256, 8192, nullptr, 0, memkv + (size_t)b * 256 * 8192 + 1024 + mh * 256, 8192,
                                          256, 0, 4, mgb + (brow + tq) * ldmg + mqcol + mh * 256, tq, tq0, 0.0625f * LOG2E, 4 * vh,
                                          (u16*)(Y8 + (brow + tq) * 3072 + 2048 + mh * 256 + 128 * vh), mgb + (brow + tq) * ldmg + gatecol + 2048 + mh * 256 + 128 * vh,
                                          nullptr, nullptr, 0.f, -1e29f, 0.f, smem);
        }
      }
    }
    if (layer + 1 < 4) convert_layer(layer + 1);
    GSYNC();

    { EpiResid e{xin, p.out, 1.f / (Y_SCALE * WOUT_SCALE)}; run_gemm<true>((const u16*)Y8, 1536, WOUT, NTOK, 2048, 1536, e, smem); }
    GSYNC();
  }
  rmsnorm_rows<true>(p.out, p.final_norm, p.out, NTOK);
}

extern "C" void kernel_launch(void* const* d_in, const int* in_sizes, int n_in, void* d_out, int out_size,
                              void* d_ws, size_t ws_size, hipStream_t stream) {
  static int grid_blocks = 0;
  if (!grid_blocks) {
    int dev = 0, cus = 0, per_cu = 0;
    (void)hipGetDevice(&dev);
    (void)hipDeviceGetAttribute(&cus, hipDeviceAttributeMultiprocessorCount, dev);
    (void)hipFuncSetAttribute((const void*)mega, hipFuncAttributeMaxDynamicSharedMemorySize, LDS_BYTES);
    (void)hipOccupancyMaxActiveBlocksPerMultiprocessor(&per_cu, mega, 512, LDS_BYTES);
    if (per_cu > 1) per_cu = 1;
    grid_blocks = cus * per_cu;
  }
  Params p{};
  p.x = (const float*)d_in[0]; p.mem = (const float*)d_in[1]; p.norm_in = (const float*)d_in[2]; p.final_norm = (const float*)d_in[3];
  p.mem_norm = (const float*)d_in[4]; p.rel_bias = (const float*)d_in[5]; p.w_in_a = (const float*)d_in[6]; p.a_q_norm = (const float*)d_in[7];
  p.w_uq = (const float*)d_in[8]; p.a_kv_norm = (const float*)d_in[9]; p.w_ukv = (const float*)d_in[10]; p.w_in_b = (const float*)d_in[11];
  p.w_in_c = (const float*)d_in[12]; p.c_sinks = (const float*)d_in[13]; p.w_mem_kv = (const float*)d_in[14]; p.w_out = (const float*)d_in[15];
  p.out = (float*)d_out; p.ws = (char*)d_ws;
  (void)hipMemsetAsync((char*)d_ws + OFF_CTR, 0, 1024, stream);
  void* args[] = {&p};
  (void)hipLaunchCooperativeKernel((void*)mega, dim3(grid_blocks), dim3(512), args, LDS_BYTES, stream);
}
```

```cpp
#include <hip/hip_runtime.h>
#include <hip/hip_cooperative_groups.h>
#include <stdint.h>
namespace cg = cooperative_groups;

typedef unsigned short u16;
typedef __attribute__((ext_vector_type(8))) short bf16x8;
typedef __attribute__((ext_vector_type(4))) short s16x4;
typedef __attribute__((ext_vector_type(16))) float f32x16;
typedef __attribute__((ext_vector_type(4))) float f32x4;
typedef __attribute__((ext_vector_type(2))) float f32x2;
typedef __attribute__((ext_vector_type(4))) unsigned u32x4;
typedef __attribute__((ext_vector_type(2))) unsigned u32x2;
typedef __attribute__((ext_vector_type(2))) __bf16 bf16x2_t;
typedef short v4i16_t __attribute__((ext_vector_type(4)));
#define DI __device__ __forceinline__
#define MFMA(a, b, c) __builtin_amdgcn_mfma_f32_32x32x16_bf16((a), (b), (c), 0, 0, 0)

constexpr int SEQ = 2048, NTOK = 16384;
constexpr int LDS_LUT = 133120, LDS_ITEM = LDS_LUT + 32 * 528, LDS_BYTES = LDS_ITEM + 64;
constexpr float LOG2E = 1.4426950408889634f;
constexpr float NEGV = -1e30f;
constexpr float Y_SCALE = 16.f, WOUT_SCALE = 256.f, CQ_SCALE = 16.f, WUQ_SCALE = 256.f, H_SCALE = 16.f, WIN_SCALE = 256.f;

constexpr size_t OFF_Y = 0;
constexpr size_t OFF_H = 100663296;
constexpr size_t OFF_KV = 201326592;
constexpr size_t OFF_MG = 335544320;
constexpr size_t OFF_KR = 469762048;
constexpr size_t OFF_P = 167772160;
constexpr size_t OFF_WIN = 471859200;
constexpr size_t OFF_WUQ = OFF_WIN + 32505856;
constexpr size_t OFF_WUKV = OFF_WUQ + 9437184;
constexpr size_t OFF_WOUT = OFF_WUKV + 4194304;
constexpr size_t OFF_MEMN = OFF_WOUT + 12582912;
constexpr size_t OFF_MEMKV = OFF_MEMN + 8388608;
constexpr size_t OFF_MASK = OFF_MEMKV + 33554432;
constexpr size_t OFF_ROPE = OFF_MASK + 4194304;
constexpr size_t OFF_LUT = OFF_ROPE + 524288;
constexpr size_t OFF_CTR = OFF_LUT + 32768;

struct Params {
  const float *x, *mem, *norm_in, *final_norm, *mem_norm, *rel_bias, *w_in_a, *a_q_norm, *w_uq, *a_kv_norm, *w_ukv,
      *w_in_b, *w_in_c, *c_sinks, *w_mem_kv, *w_out;
  float* out;
  char* ws;
};

DI float bf2f(unsigned b) { return __uint_as_float(b << 16); }
DI unsigned pk2(float a, float b) {
  f32x2 v = {a, b};
  return __builtin_bit_cast(unsigned, __builtin_convertvector(v, bf16x2_t));
}
DI float clamp8(float x) { return fminf(fmaxf(x, -448.f), 448.f); }
DI unsigned pk4_fp8(float a, float b, float c, float d) {
  int w = 0;
  w = __builtin_amdgcn_cvt_pk_fp8_f32(clamp8(a), clamp8(b), w, false);
  w = __builtin_amdgcn_cvt_pk_fp8_f32(clamp8(c), clamp8(d), w, true);
  return (unsigned)w;
}
DI u16 f2bf(float a) { return (u16)(pk2(a, 0.f) & 0xffffu); }
DI float wave_sum(float v) {
#pragma unroll
  for (int o = 32; o; o >>= 1) v += __shfl_xor(v, o);
  return v;
}
DI int crow(int reg, int hi) { return (reg & 3) + 8 * (reg >> 2) + 4 * hi; }
DI float xhalf_max(float m) {
  auto rr = __builtin_amdgcn_permlane32_swap(__float_as_uint(m), __float_as_uint(m), false, false);
  return fmaxf(__uint_as_float(rr[0]), __uint_as_float(rr[1]));
}
DI float xhalf_sum(float m) {
  auto rr = __builtin_amdgcn_permlane32_swap(__float_as_uint(m), __float_as_uint(m), false, false);
  return __uint_as_float(rr[0]) + __uint_as_float(rr[1]);
}
typedef __attribute__((address_space(3))) v4i16_t* lds_v4p;
DI s16x4 vtr(const char* p) {
  return __builtin_bit_cast(s16x4, __builtin_amdgcn_ds_read_tr16_b64_v4i16((lds_v4p)(p)));
}

template <int PERM, bool FP8 = false>
DI void convert_wt(const float* __restrict__ W, int K, int N, int Npad, u16* __restrict__ Wt, char* smem, float wscale = 1.f,
                   int nvalid = -1, int csplit = 0, int coff1 = 0, int coff2 = 0, int rot_n0 = 2048) {
  float* tile = (float*)smem;
  int tid = threadIdx.x; asm volatile("" : "+v"(tid));
  const int ntk = K / 64, ntn = Npad / 64;
  for (int t = blockIdx.x; t < ntk * ntn; t += gridDim.x) {
    const int tk = t % ntk, tn = t / ntk, k0 = tk * 64, n0 = tn * 64;
    __syncthreads();
#pragma unroll
    for (int i = 0; i < 2; ++i) {
      const int id = tid + 512 * i, kr = id >> 4, n4 = (id & 15) * 4;
      f32x4 v = {0.f, 0.f, 0.f, 0.f};
      const int nd = n0 + n4, nsrc = (nvalid < 0) ? nd : (nd < csplit ? nd + coff1 : nd + coff2);
      if (nd < ((nvalid < 0) ? N : nvalid)) v = *(const f32x4*)(W + (size_t)(k0 + kr) * N + nsrc);
      tile[kr * 65 + n4 + 0] = v[0]; tile[kr * 65 + n4 + 1] = v[1]; tile[kr * 65 + n4 + 2] = v[2]; tile[kr * 65 + n4 + 3] = v[3];
    }
    __syncthreads();
    {
      const int n = tid >> 3, c = tid & 7;
      bool rot = false;
      if (PERM == 1) rot = (n0 == rot_n0);
      if (PERM == 2) rot = ((tn % 3) == 2);
      const int ns = rot ? ((n >> 1) + 32 * (n & 1)) : n;
      if (FP8) {
        float f[8];
#pragma unroll
        for (int j = 0; j < 8; ++j) f[j] = tile[(c * 8 + j) * 65 + ns] * wscale;
        u32x2 o = {pk4_fp8(f[0], f[1], f[2], f[3]), pk4_fp8(f[4], f[5], f[6], f[7])};
        *(u32x2*)((unsigned char*)Wt + (size_t)(n0 + n) * K + k0 + c * 8) = o;
      } else {
        u32x4 o;
#pragma unroll
        for (int j = 0; j < 4; ++j) o[j] = pk2(tile[(c * 8 + 2 * j) * 65 + ns], tile[(c * 8 + 2 * j + 1) * 65 + ns]);
        *(u32x4*)(Wt + (size_t)(n0 + n) * K + k0 + c * 8) = o;
      }
    }
  }
}

template <bool F32OUT>
DI void rmsnorm_rows(const float* X, const float* __restrict__ g, void* outp, int nrows, unsigned char* __restrict__ out8 = nullptr) {
  int tidx = threadIdx.x; asm volatile("" : "+v"(tidx));
  const int lane = tidx & 63, gw = blockIdx.x * 8 + (tidx >> 6), nw = gridDim.x * 8;
  for (int row = gw; row < nrows; row += nw) {
    const f32x4* xr = (const f32x4*)(X + (size_t)row * 2048);
    f32x4 v[8];
    float ss = 0.f;
#pragma unroll
    for (int i = 0; i < 8; ++i) { v[i] = xr[lane + 64 * i]; ss += v[i][0] * v[i][0] + v[i][1] * v[i][1] + v[i][2] * v[i][2] + v[i][3] * v[i][3]; }
    ss = wave_sum(ss);
    const float r = rsqrtf(ss * (1.f / 2048.f) + 1e-6f);
#pragma unroll
    for (int i = 0; i < 8; ++i) {
      const f32x4 gg = ((const f32x4*)g)[lane + 64 * i];
      f32x4 o = {v[i][0] * r * gg[0], v[i][1] * r * gg[1], v[i][2] * r * gg[2], v[i][3] * r * gg[3]};
      if (F32OUT) ((f32x4*)((float*)outp + (size_t)row * 2048))[lane + 64 * i] = o;
      else { u32x2 pk = {pk2(o[0], o[1]), pk2(o[2], o[3])}; ((u32x2*)((u16*)outp + (size_t)row * 2048))[lane + 64 * i] = pk; }
      if (!F32OUT && out8) ((unsigned*)(out8 + (size_t)row * 2048))[lane + 64 * i] = pk4_fp8(o[0] * H_SCALE, o[1] * H_SCALE, o[2] * H_SCALE, o[3] * H_SCALE);
    }
  }
}

DI void anorm_phase(u16* C, const float* __restrict__ gq, const float* __restrict__ gkv, unsigned char* __restrict__ cq8) {
  int tidx = threadIdx.x; asm volatile("" : "+v"(tidx));
  const int lane = tidx & 63, gw = blockIdx.x * 8 + (tidx >> 6), nw = gridDim.x * 8;
  for (int row = gw; row < NTOK; row += nw) {
    u32x4* cr = (u32x4*)(C + (size_t)row * 2048);
    u32x4 v[4];
    float sq = 0.f, skv = 0.f;
#pragma unroll
    for (int i = 0; i < 4; ++i) {
      v[i] = cr[lane + 64 * i];
      float s = 0.f;
#pragma unroll
      for (int j = 0; j < 4; ++j) { float a = bf2f(v[i][j] & 0xffffu), b = bf2f(v[i][j] >> 16); s += a * a + b * b; }
      if (i < 3) sq += s; else skv += s;
    }
    sq = wave_sum(sq); skv = wave_sum(skv);
    const float rq = rsqrtf(sq * (1.f / 1536.f) + 1e-6f), rkv = rsqrtf(skv * (1.f / 512.f) + 1e-6f);
#pragma unroll
    for (int i = 0; i < 4; ++i) {
      const int col = (lane + 64 * i) * 8;
      const float* gp = (i < 3) ? (gq + col) : (gkv + col - 1536);
      const float r = (i < 3) ? rq : rkv;
      const f32x4 g0 = *(const f32x4*)gp, g1 = *(const f32x4*)(gp + 4);
      u32x4 o;
      o[0] = pk2(bf2f(v[i][0] & 0xffffu) * r * g0[0], bf2f(v[i][0] >> 16) * r * g0[1]);
      o[1] = pk2(bf2f(v[i][1] & 0xffffu) * r * g0[2], bf2f(v[i][1] >> 16) * r * g0[3]);
      o[2] = pk2(bf2f(v[i][2] & 0xffffu) * r * g1[0], bf2f(v[i][2] >> 16) * r * g1[1]);
      o[3] = pk2(bf2f(v[i][3] & 0xffffu) * r * g1[2], bf2f(v[i][3] >> 16) * r * g1[3]);
      cr[lane + 64 * i] = o;
      if (i < 3) {
        const float q0 = bf2f(v[i][0] & 0xffffu) * r * g0[0] * CQ_SCALE, q1 = bf2f(v[i][0] >> 16) * r * g0[1] * CQ_SCALE;
        const float q2 = bf2f(v[i][1] & 0xffffu) * r * g0[2] * CQ_SCALE, q3 = bf2f(v[i][1] >> 16) * r * g0[3] * CQ_SCALE;
        const float q4 = bf2f(v[i][2] & 0xffffu) * r * g1[0] * CQ_SCALE, q5 = bf2f(v[i][2] >> 16) * r * g1[1] * CQ_SCALE;
        const float q6 = bf2f(v[i][3] & 0xffffu) * r * g1[2] * CQ_SCALE, q7 = bf2f(v[i][3] >> 16) * r * g1[3] * CQ_SCALE;
        u32x2 w8 = {pk4_fp8(q0, q1, q2, q3), pk4_fp8(q4, q5, q6, q7)};
        *(u32x2*)(cq8 + (size_t)row * 1536 + col) = w8;
      }
    }
  }
}

namespace pg8 {
#define PG8_LAS __attribute__((address_space(3)))
constexpr int BM = 256, BK = 64, HALF = 128, HTB = HALF * BK * 2, STAGE_BYTES = 8 * HTB, NXCD = 8, WGM = 8;
DI int lds_byte(int r, int c) { const int st = (r >> 4) * 2 + (c >> 5), rr = r & 15, cc = c & 31, ob = rr * 64 + cc * 2; return st * 1024 + (ob ^ (((ob >> 9) & 1) << 5)); }
DI void stage_rc(int b, int& R, int& C) { const int st = b / 1024, sb = b % 1024, swz = sb ^ (((sb >> 9) & 1) << 5); R = (st >> 1) * 16 + swz / 64; C = (st & 1) * 32 + (swz % 64) / 2; }
DI int perm32(int rho) { const int n = rho >> 4, i = rho & 15; return 8 * (i >> 2) + 4 * n + (i & 3); }
typedef int i32x4v __attribute__((ext_vector_type(4)));
typedef int i32x8 __attribute__((ext_vector_type(8)));
DI i32x8 cat8(bf16x8 a, bf16x8 b) { const i32x4v x = __builtin_bit_cast(i32x4v, a), y = __builtin_bit_cast(i32x4v, b); return __builtin_shufflevector(x, y, 0, 1, 2, 3, 4, 5, 6, 7); }
struct Unit { int pm, pn; };
struct Gemm { const u16* A; const u16* Bt; int M, N, K, lda; };
struct StaticOrder {
  int nM, nN, nwg, G, c;
  int nA = 0, uA = 0, uB = 0;
  DI void init(int M, int N, int G_, int c_) { nM = M / BM; nN = N / BM; nwg = nM * nN; G = G_; c = c_; }
  DI bool next(int i, Unit& u) const {
    long L;
    if (nA == 0) L = (long)i * G + c;
    else if (c < nA) { if (i >= uA) return false; L = (long)i * nA + c; }
    else { if (i >= uB) return false; L = (long)nA * uA + (long)i * (G - nA) + (c - nA); }
    if (L >= nwg) return false;
    int wgid = (int)L; { const int q = nwg / NXCD, r = nwg % NXCD, xcd = wgid % NXCD, off = wgid / NXCD; wgid = (xcd < r ? xcd * (q + 1) : r * (q + 1) + (xcd - r) * q) + off; }
    const int nig = WGM * nN, gid = wgid / nig, fm = gid * WGM, gsz = (nM - fm) < WGM ? (nM - fm) : WGM;
    u.pm = fm + ((wgid % nig) % gsz); u.pn = (wgid % nig) / gsz; return true;
  }
  DI void a_ready(const Unit&) const {}
  DI void done(const Unit&) const {}
};
template <bool FP8, class Epi, class Sched>
__device__ __forceinline__ void gemm_phase(PG8_LAS unsigned char* lds, const Gemm g, const Sched& S, const Epi& E) {
    int tid = threadIdx.x; asm volatile("" : "+v"(tid));
    const int wid = __builtin_amdgcn_readfirstlane(tid >> 6), lane = tid & 63, wr = wid >> 2, wc = wid & 3, fr = lane & 15, fq = lane >> 4;
    const int K = g.K, nt = K / BK;
    unsigned voffA[2], voffB[2];
#pragma unroll
    for (int i = 0; i < 2; ++i) { int R, C; stage_rc(tid * 16 + i * 8192, R, C); const int Rb = Epi::PERM ? ((R & ~31) + perm32(R & 31)) : R;
        voffA[i] = (unsigned)(R * g.lda + C) * 2u; voffB[i] = (unsigned)(Rb * K + C) * 2u; }
    const size_t kstep = (size_t)(BK * 2);
    const size_t hstep = (size_t)HALF * K * 2, hstepA = (size_t)HALF * g.lda * 2;
    const size_t tstep = 2 * hstep, tstepA = 2 * hstepA;
    const unsigned ldsw = (unsigned)wid * 1024u;
    const int aoff = lds_byte(wr * 64 + fr, fq * 8), boff = lds_byte(wc * 32 + fr, fq * 8);
#define PG8_SA(b, h) (((b) * 2 + (h)) * HTB)
#define PG8_SB(b, h) ((4 + (b) * 2 + (h)) * HTB)
#define PG8_STAGE(bufoff, gbase, voff) do { _Pragma("unroll") for (int _i = 0; _i < 2; ++_i) \
        __builtin_amdgcn_global_load_lds((const unsigned*)((const char*)(gbase) + (voff)[_i]), (PG8_LAS unsigned*)(lds + (bufoff) + ldsw + _i * 8192), 16, 0, 0); } while (0)
#define PG8_LDA(dst, b, h) do { _Pragma("unroll") for (int m = 0; m < 4; ++m) _Pragma("unroll") for (int k = 0; k < 2; ++k) dst[m][k] = *(const PG8_LAS bf16x8*)(lds + PG8_SA(b, h) + aoff + m * 2048 + k * 1024); } while (0)
#define PG8_LDB(dst, b, h) do { _Pragma("unroll") for (int n = 0; n < 2; ++n) _Pragma("unroll") for (int k = 0; k < 2; ++k) dst[n][k] = *(const PG8_LAS bf16x8*)(lds + PG8_SB(b, h) + boff + n * 2048 + k * 1024); } while (0)
#define PG8_MMA(ai, bj, At, Bt) do { __builtin_amdgcn_s_setprio(1); _Pragma("unroll") for (int m = 0; m < 4; ++m) _Pragma("unroll") for (int n = 0; n < 2; ++n) { \
        if constexpr (FP8) { const i32x8 bv_ = cat8(Bt[n][0], Bt[n][1]), av_ = cat8(At[m][0], At[m][1]); \
            asm volatile("s_nop 1\n\tv_mfma_scale_f32_16x16x128_f8f6f4 %0, %1, %2, %0, %3, %3 op_sel_hi:[0,0,0]" : "+v"(acc[ai][bj][m][n]) : "v"(bv_), "v"(av_), "v"(sc127)); } \
        else { _Pragma("unroll") for (int k = 0; k < 2; ++k) acc[ai][bj][m][n] = __builtin_amdgcn_mfma_f32_16x16x32_bf16(Bt[n][k], At[m][k], acc[ai][bj][m][n], 0, 0, 0); } } \
        __builtin_amdgcn_s_setprio(0); } while (0)
#define PG8_WAIT_V(n) asm volatile("s_waitcnt vmcnt(" #n ")" ::: "memory")
#define PG8_WAIT_L(n) asm volatile("s_waitcnt lgkmcnt(" #n ")" ::: "memory")
#define PG8_BAR __builtin_amdgcn_s_barrier()
#define PG8_SCHED __builtin_amdgcn_sched_barrier(0)
    Unit cur, nxt; int ui = 0;
    if (!S.next(0, cur)) return;
    f32x4 acc[2][2][4][2];
#pragma unroll
    for (int a = 0; a < 2; ++a)
#pragma unroll
        for (int b = 0; b < 2; ++b)
#pragma unroll
            for (int m = 0; m < 4; ++m)
#pragma unroll
                for (int n = 0; n < 2; ++n) acc[a][b][m][n] = (f32x4){0.f, 0.f, 0.f, 0.f};
    bf16x8 At[4][2], B0[2][2], B1[2][2];
    int sc127 = 0x7F7F7F7F; asm volatile("" : "+v"(sc127));
    const char* cA = (const char*)g.A + (size_t)cur.pm * tstepA; const char* cB = (const char*)g.Bt + (size_t)cur.pn * tstep;
    S.a_ready(cur);
    PG8_STAGE(PG8_SB(0, 0), cB, voffB); PG8_STAGE(PG8_SA(0, 0), cA, voffA); PG8_STAGE(PG8_SB(0, 1), cB + hstep, voffB); PG8_STAGE(PG8_SA(0, 1), cA + hstepA, voffA);
    if (wr == 1) PG8_BAR;
    PG8_WAIT_V(4); PG8_BAR;
    PG8_STAGE(PG8_SB(1, 0), cB + kstep, voffB); PG8_STAGE(PG8_SA(1, 0), cA + kstep, voffA); PG8_STAGE(PG8_SB(1, 1), cB + hstep + kstep, voffB);
    PG8_WAIT_V(6); PG8_BAR;
    for (;;) {
        const bool has_next = S.next(ui + 1, nxt);
        const char* nA = has_next ? (const char*)g.A + (size_t)nxt.pm * tstepA : cA; const char* nB = has_next ? (const char*)g.Bt + (size_t)nxt.pn * tstep : cB;
        for (int t = 0; t < nt; t += 2) {
            const bool last = (t == nt - 2);
            const char* a1 = cA + (size_t)(t + 1) * kstep;
            const char* a2 = last ? nA : cA + (size_t)(t + 2) * kstep; const char* b2 = last ? nB : cB + (size_t)(t + 2) * kstep;
            const char* a3 = a2 + kstep; const char* b3 = b2 + kstep;
            if (last && has_next) S.a_ready(nxt);
            PG8_LDB(B0, 0, 0); PG8_SCHED; PG8_LDA(At, 0, 0); PG8_STAGE(PG8_SA(1, 1), a1 + hstepA, voffA);
            PG8_WAIT_L(8); PG8_BAR; PG8_WAIT_L(0); PG8_MMA(0, 0, At, B0); PG8_BAR; PG8_SCHED;
            PG8_LDB(B1, 0, 1); PG8_STAGE(PG8_SB(0, 0), b2, voffB);
            PG8_BAR; PG8_WAIT_L(0); PG8_MMA(0, 1, At, B1); PG8_BAR;
            PG8_LDA(At, 0, 1); PG8_STAGE(PG8_SA(0, 0), a2, voffA);
            PG8_BAR; PG8_WAIT_L(0); PG8_MMA(1, 0, At, B0); PG8_BAR; PG8_SCHED;
            PG8_STAGE(PG8_SB(0, 1), b2 + hstep, voffB);
            PG8_WAIT_V(6); PG8_BAR; PG8_MMA(1, 1, At, B1); PG8_BAR;
            PG8_LDB(B0, 1, 0); PG8_SCHED; PG8_LDA(At, 1, 0); PG8_STAGE(PG8_SA(0, 1), a2 + hstepA, voffA);
            PG8_WAIT_L(8); PG8_BAR; PG8_WAIT_L(0); PG8_MMA(0, 0, At, B0); PG8_BAR; PG8_SCHED;
            PG8_LDB(B1, 1, 1); PG8_STAGE(PG8_SB(1, 0), b3, voffB);
            PG8_BAR; PG8_WAIT_L(0); PG8_MMA(0, 1, At, B1); PG8_BAR;
            PG8_LDA(At, 1, 1); PG8_STAGE(PG8_SA(1, 0), a3, voffA);
            PG8_BAR; PG8_WAIT_L(0); PG8_MMA(1, 0, At, B0); PG8_BAR; PG8_SCHED;
            PG8_STAGE(PG8_SB(1, 1), b3 + hstep, voffB);
            PG8_WAIT_V(6); PG8_BAR; PG8_MMA(1, 1, At, B1); PG8_BAR;
        }
        if constexpr (FP8) asm volatile("s_nop 15\n\ts_nop 15" ::: "memory");
        if constexpr (!Epi::AFTER_DRAIN) { E(acc, cur, wr, wc, fr, fq); S.done(cur); }
        if (!has_next) break;
#pragma unroll
        for (int a = 0; a < 2; ++a)
#pragma unroll
            for (int b = 0; b < 2; ++b)
#pragma unroll
                for (int m = 0; m < 4; ++m)
#pragma unroll
                    for (int n = 0; n < 2; ++n) acc[a][b][m][n] = (f32x4){0.f, 0.f, 0.f, 0.f};
        cur = nxt; cA = nA; cB = nB; ++ui;
    }
    PG8_WAIT_V(0);
    if (wr == 0) PG8_BAR;
    PG8_BAR;
    if constexpr (Epi::AFTER_DRAIN) { E.fused(acc, cur, wr, wc, fr, fq, lds, wid, lane); S.done(cur); }
#undef PG8_SA
#undef PG8_SB
#undef PG8_STAGE
#undef PG8_LDA
#undef PG8_LDB
#undef PG8_MMA
#undef PG8_WAIT_V
#undef PG8_WAIT_L
#undef PG8_BAR
#undef PG8_SCHED
}

}

struct EpiResid {
  static constexpr bool PERM = false, AFTER_DRAIN = false;
  const float* xin; float* xout; float sc;
  DI void operator()(const f32x4 (&acc)[2][2][4][2], const pg8::Unit& u, int wr, int wc, int fr, int fq) const {
    const int row0 = u.pm * 256 + wr * 64 + fr, col0 = u.pn * 256 + wc * 32 + 4 * fq;
#pragma unroll
    for (int ai = 0; ai < 2; ++ai)
#pragma unroll
      for (int m = 0; m < 4; ++m) {
        const size_t ro = (size_t)(row0 + ai * 128 + m * 16) * 2048 + col0;
#pragma unroll
        for (int bj = 0; bj < 2; ++bj)
#pragma unroll
          for (int n = 0; n < 2; ++n) {
            const size_t o = ro + bj * 128 + n * 16;
            const f32x4 xv = *(const f32x4*)(xin + o);
            *(f32x4*)(xout + o) = xv + acc[ai][bj][m][n] * sc;
          }
        asm volatile("" ::: "memory");
      }
  }
};
template <int MODE>
struct EpiBf {
  static constexpr bool PERM = true, AFTER_DRAIN = false;
  u16* d0; int ld0; int N; u16* d1; u16* d2; const f32x2* rope; float sc = 1.f; int csplit = 0, coff1 = 0, coff2 = 0;
  DI void rot(f32x4& v0, f32x4& v1, int row, int col) const {
    const f32x4* cp = (const f32x4*)(rope + (row & 2047) * 32 + ((col & 63) >> 1));
    const f32x4 c01 = cp[0], c23 = cp[1];
    const f32x4 a = {v0[0] * c01[0] - v0[1] * c01[1], v0[1] * c01[0] + v0[0] * c01[1], v0[2] * c01[2] - v0[3] * c01[3], v0[3] * c01[2] + v0[2] * c01[3]};
    const f32x4 b = {v1[0] * c23[0] - v1[1] * c23[1], v1[1] * c23[0] + v1[0] * c23[1], v1[2] * c23[2] - v1[3] * c23[3], v1[3] * c23[2] + v1[2] * c23[3]};
    v0 = a; v1 = b;
  }
  DI void operator()(const f32x4 (&acc)[2][2][4][2], const pg8::Unit& u, int wr, int wc, int fr, int fq) const {
    const int row0 = u.pm * 256 + wr * 64 + fr, colb = u.pn * 256 + wc * 32 + 8 * fq;
#pragma unroll
    for (int ai = 0; ai < 2; ++ai)
#pragma unroll
      for (int m = 0; m < 4; ++m) {
        const int row = row0 + ai * 128 + m * 16;
#pragma unroll
        for (int bj = 0; bj < 2; ++bj) {
          const int col = colb + bj * 128;
          f32x4 v0 = acc[ai][bj][m][0] * sc, v1 = acc[ai][bj][m][1] * sc;
          u16* dst = nullptr;
          if (MODE == 0) { if (col < N) dst = d0 + (size_t)row * ld0 + (col + coff2 + ((col < csplit) ? (coff1 - coff2) : 0)); }
          else if (MODE == 1) {
            const int oc = col + coff2 + ((col < csplit) ? (coff1 - coff2) : 0);
            if (col < N) {
              if (oc < 2048) dst = d0 + (size_t)row * 2048 + oc;
              else if (oc < 2112) { rot(v0, v1, row, oc); dst = d2 + (size_t)row * 64 + (oc - 2048); }
              else dst = d1 + (size_t)row * 4096 + (oc - 2112);
            }
          } else if (MODE == 3) {
            if (col < N) { const bool lo = col < csplit; u16* bp = lo ? d0 : d1; const int ldd = lo ? 2048 : 4096, oc = lo ? col : col + (coff2 - 2112); dst = bp + (size_t)row * ldd + oc + (lo ? coff1 : 0); }
          } else {
            if (((col >> 6) % 3) == 2) rot(v0, v1, row, col);
            dst = d0 + (size_t)row * 3072 + col;
          }
          if (dst) { u32x4 w = {pk2(v0[0], v0[1]), pk2(v0[2], v0[3]), pk2(v1[0], v1[1]), pk2(v1[2], v1[3])}; *(u32x4*)dst = w; }
        }
        asm volatile("" ::: "memory");
      }
  }
};

template <bool FP8 = false, class Epi>
DI void run_gemm(const u16* A, int lda, const u16* Bt, int M, int N, int K, const Epi& e, char* smem, int nA = 0, int uA = 0, int uB = 0) {
  __syncthreads();
  pg8::Gemm g{A, Bt, M, N, K, lda};
  pg8::StaticOrder S; S.init(M, N, gridDim.x, blockIdx.x);
  if (nA > 0 && (int)gridDim.x > nA && nA * uA + ((int)gridDim.x - nA) * uB == S.nwg) { S.nA = nA; S.uA = uA; S.uB = uB; }
  pg8::gemm_phase<FP8>(( __attribute__((address_space(3))) unsigned char*)smem, g, S, e);
  __syncthreads();
}

typedef __attribute__((address_space(3))) unsigned* lds_u32p;
template <int OFF> DI void rd4(bf16x8 (&f)[4], unsigned addr) {
  asm volatile("ds_read_b128 %0, %4 offset:%5\n\tds_read_b128 %1, %4 offset:%6\n\tds_read_b128 %2, %4 offset:%7\n\tds_read_b128 %3, %4 offset:%8\n\ts_waitcnt lgkmcnt(0)"
               : "=&v"(f[0]), "=&v"(f[1]), "=&v"(f[2]), "=&v"(f[3]) : "v"(addr), "i"(OFF), "i"(OFF + 32), "i"(OFF + 64), "i"(OFF + 96) : "memory");
}
template <int OFF> DI void rdv8(s16x4 (&v)[8], unsigned addr) {
  asm volatile("ds_read_b64_tr_b16 %0, %8 offset:%9\n\tds_read_b64_tr_b16 %1, %8 offset:%10\n\tds_read_b64_tr_b16 %2, %8 offset:%11\n\tds_read_b64_tr_b16 %3, %8 offset:%12\n\t"
               "ds_read_b64_tr_b16 %4, %8 offset:%13\n\tds_read_b64_tr_b16 %5, %8 offset:%14\n\tds_read_b64_tr_b16 %6, %8 offset:%15\n\tds_read_b64_tr_b16 %7, %8 offset:%16\n\ts_waitcnt lgkmcnt(0)"
               : "=&v"(v[0]), "=&v"(v[1]), "=&v"(v[2]), "=&v"(v[3]), "=&v"(v[4]), "=&v"(v[5]), "=&v"(v[6]), "=&v"(v[7])
               : "v"(addr), "i"(OFF), "i"(OFF + 512), "i"(OFF + 1024), "i"(OFF + 1536), "i"(OFF + 2048), "i"(OFF + 2560), "i"(OFF + 3072), "i"(OFF + 3584) : "memory");
}
template <int KSTR, int ND, int N>
DI f32x16 s_block(unsigned kaddr, const bf16x8* qf) {
  const f32x16 z16 = {0.f, 0.f, 0.f, 0.f, 0.f, 0.f, 0.f, 0.f, 0.f, 0.f, 0.f, 0.f, 0.f, 0.f, 0.f, 0.f};
  bf16x8 f[4];
  rd4<N * 32 * KSTR>(f, kaddr);
  f32x16 a = MFMA(f[0], qf[0], z16); a = MFMA(f[1], qf[1], a); a = MFMA(f[2], qf[2], a); a = MFMA(f[3], qf[3], a);
  if constexpr (ND > 4) { rd4<N * 32 * KSTR + 128>(f, kaddr); a = MFMA(f[0], qf[4], a); a = MFMA(f[1], qf[5], a); a = MFMA(f[2], qf[6], a); a = MFMA(f[3], qf[7], a); }
  if constexpr (ND > 8) { rd4<N * 32 * KSTR + 256>(f, kaddr); a = MFMA(f[0], qf[8], a); a = MFMA(f[1], qf[9], a); a = MFMA(f[2], qf[10], a); a = MFMA(f[3], qf[11], a); }
  if constexpr (ND > 12) { rd4<N * 32 * KSTR + 384>(f, kaddr); a = MFMA(f[0], qf[12], a); a = MFMA(f[1], qf[13], a); a = MFMA(f[2], qf[14], a); a = MFMA(f[3], qf[15], a); }
  return a;
}
template <int CB> DI void pv_block(f32x16& o, unsigned vaddr, const bf16x8 (&pb)[2][2]) {
  s16x4 v[8];
  rdv8<CB * 4096>(v, vaddr);
#pragma unroll
  for (int q = 0; q < 4; ++q) {
    const bf16x8 vf = {v[2 * q][0], v[2 * q][1], v[2 * q][2], v[2 * q][3], v[2 * q + 1][0], v[2 * q + 1][1], v[2 * q + 1][2], v[2 * q + 1][3]};
    o = MFMA(vf, pb[q >> 1][q & 1], o);
  }
}
template <int DQK, int W1, int DV, int VW, int MODE>
DI void attn_core(const u16* __restrict__ k1, int ldk1, const u16* __restrict__ k2, int ldk2, const u16* __restrict__ vsrc, int ldv,
                  int kv_len, int kbase0, int ntiles, const u16* qrow, int tq, int tq0, float c2, int vcb0, u16* yrow,
                  const u16* grow, const unsigned* maskrow, const float* lutw, float bias_far, float m_init, float l_init, char* smem) {
  constexpr int KSTR = DQK * 2 + 16, KCH = DQK / 8;
  constexpr int ND = DQK / 16, NCB = DV / 32, BUF = 64 * KSTR + (VW / 32) * 4096;
  constexpr int NKI = KSTR / 16, NVI = VW / 8;
  static_assert(ND % 4 == 0 && NCB <= 4, "fragment batches");
  int tid0 = threadIdx.x; asm volatile("" : "+v"(tid0));
  const int lane = tid0 & 63, r32 = lane & 31, hi = lane >> 5;
  const int wv = __builtin_amdgcn_readfirstlane(tid0 >> 6);
  const unsigned lds0 = (unsigned)(uintptr_t)smem;
  bf16x8 qf[ND];
#pragma unroll
  for (int d0 = 0; d0 < ND; ++d0) qf[d0] = *(const bf16x8*)(qrow + d0 * 16 + hi * 8);
  f32x16 o[NCB];
#pragma unroll
  for (int cb = 0; cb < NCB; ++cb)
#pragma unroll
    for (int r = 0; r < 16; ++r) o[cb][r] = 0.f;
  float m = m_init, l = (hi == 0) ? l_init : 0.f;
  const unsigned klane = (unsigned)(r32 * KSTR + hi * 16);
  const unsigned vlane = (unsigned)(64 * KSTR + vcb0 * 4096 + ((lane >> 4) & 1) * 32 + (lane & 3) * 8 + (4 * hi + ((lane & 15) >> 2)) * 64);
  unsigned mwn[2] = {0u, 0u};
  constexpr int NKS = (NKI + 7) / 8, NVS = (NVI + 7) / 8;
  const u16* kptr[NKS]; int kstr[NKS]; const u16* vptr[NVS];
  if (MODE != 2) {
    int ln = threadIdx.x & 63; asm volatile("" : "+v"(ln));
#pragma unroll
    for (int ii = 0; ii < NKS; ++ii) {
      const int i = wv + 8 * ii, ob = i * 1024 + ln * 16, row = ob / KSTR;
      int c = (ob - row * KSTR) >> 4; c = (c >= KCH) ? 0 : c;
      const bool seg1 = c < W1 / 8;
      kptr[ii] = seg1 ? (k1 + ((kbase0 + row) * ldk1 + c * 8)) : (k2 + ((kbase0 + row) * ldk2 + (c - W1 / 8) * 8));
      kstr[ii] = seg1 ? 64 * ldk1 : 64 * ldk2;
    }
#pragma unroll
    for (int ii = 0; ii < NVS; ++ii) {
      const int i = wv + 8 * ii, ob = i * 1024 + ln * 16, cbk = ob >> 12, row = (ob & 4095) >> 6, cw = (ob & 63) >> 4;
      vptr[ii] = vsrc + ((kbase0 + row) * ldv + (cbk * 4 + cw) * 8);
    }
  }
  auto stage_tile = [&](int kb, int buf) {
    const unsigned bofs = (unsigned)(buf * BUF);
    if (MODE != 2) {
#pragma unroll
      for (int ii = 0; ii < NKS; ++ii) {
        const int i = wv + 8 * ii;
        if (i < NKI) { __builtin_amdgcn_global_load_lds((const unsigned*)kptr[ii], (lds_u32p)(smem + bofs + i * 1024), 16, 0, 0); kptr[ii] += kstr[ii]; }
      }
#pragma unroll
      for (int ii = 0; ii < NVS; ++ii) {
        const int i = wv + 8 * ii;
        if (i < NVI) { __builtin_amdgcn_global_load_lds((const unsigned*)vptr[ii], (lds_u32p)(smem + bofs + 64 * KSTR + i * 1024), 16, 0, 0); vptr[ii] += 64 * ldv; }
      }
    } else {
      int ln = threadIdx.x & 63; asm volatile("" : "+v"(ln));
#pragma unroll
      for (int ii = 0; ii < NKS; ++ii) {
        const int i = wv + 8 * ii;
        if (i < NKI) {
          const int ob = i * 1024 + ln * 16, row = ob / KSTR;
          int c = (ob - row * KSTR) >> 4; c = (c >= KCH) ? 0 : c;
          int key = kb + row; key = key < 0 ? 0 : (key >= kv_len ? kv_len - 1 : key);
          const u16* src = (c < W1 / 8) ? (k1 + (key * ldk1 + c * 8)) : (k2 + (key * ldk2 + (c - W1 / 8) * 8));
          __builtin_amdgcn_global_load_lds((const unsigned*)src, (lds_u32p)(smem + bofs + i * 1024), 16, 0, 0);
        }
      }
#pragma unroll
      for (int ii = 0; ii < NVS; ++ii) {
        const int i = wv + 8 * ii;
        if (i < NVI) {
          const int ob = i * 1024 + ln * 16, cbk = ob >> 12, row = (ob & 4095) >> 6, cw = (ob & 63) >> 4;
          int key = kb + row; key = key < 0 ? 0 : (key >= kv_len ? kv_len - 1 : key);
          __builtin_amdgcn_global_load_lds((const unsigned*)(vsrc + (key * ldv + (cbk * 4 + cw) * 8)), (lds_u32p)(smem + bofs + 64 * KSTR + i * 1024), 16, 0, 0);
        }
      }
    }
    if (MODE == 1) { mwn[0] = maskrow[(kb >> 5)]; mwn[1] = maskrow[(kb >> 5) + 1]; }
  };
  stage_tile(kbase0, 0);
  asm volatile("s_waitcnt vmcnt(0)" ::: "memory");
  __syncthreads();
  for (int t = 0; t < ntiles; ++t) {
    const int kb = kbase0 + t * 64;
    const unsigned bufa = lds0 + (unsigned)((t & 1) * BUF);
    const unsigned mw0 = mwn[0], mw1 = mwn[1];
    if (t + 1 < ntiles) stage_tile(kb + 64, (t + 1) & 1);
    if (!(MODE == 0 && kb > tq0 + 31)) {
      f32x16 s[2];
      s[0] = s_block<KSTR, ND, 0>(bufa + klane, qf);
      s[1] = s_block<KSTR, ND, 1>(bufa + klane, qf);
      if (MODE == 0) {
        s[0] = s[0] * c2; s[1] = s[1] * c2;
        if (__builtin_amdgcn_readfirstlane((int)(kb + 63 > tq0))) {
#pragma unroll
          for (int n = 0; n < 2; ++n)
#pragma unroll
            for (int i = 0; i < 16; ++i) { const int key = kb + 32 * n + crow(i, hi); if (key > tq) s[n][i] = NEGV; }
        }
      } else if (MODE == 1) {
        const bool far = (tq0 - (kb + 63)) >= 128;
#pragma unroll
        for (int n = 0; n < 2; ++n) {
          const unsigned wb = (n ? mw1 : mw0) >> (4 * hi);
          if (far) {
#pragma unroll
            for (int i = 0; i < 16; ++i) {
              const float v = fmaf(s[n][i], c2, bias_far);
              s[n][i] = ((wb >> ((i & 3) + 8 * (i >> 2))) & 1u) ? v : NEGV;
            }
          } else {
#pragma unroll
            for (int i = 0; i < 16; ++i) {
              const int key = kb + 32 * n + crow(i, hi);
              int rel = tq - key; rel = rel < 0 ? 0 : (rel > 128 ? 128 : rel);
              const float v = fmaf(s[n][i], c2, lutw[rel]);
              s[n][i] = ((wb >> ((i & 3) + 8 * (i >> 2))) & 1u) ? v : NEGV;
            }
          }
        }
      } else if (MODE == 2) {
#pragma unroll
        for (int n = 0; n < 2; ++n)
#pragma unroll
          for (int i = 0; i < 16; ++i) {
            const int key = kb + 32 * n + crow(i, hi), rel = tq - key;
            const bool ok = ((unsigned)rel < 128u) && (key >= 0);
            const float v = fmaf(s[n][i], c2, lutw[rel & 127]);
            s[n][i] = ok ? v : NEGV;
          }
      } else {
#pragma unroll
        for (int n = 0; n < 2; ++n)
#pragma unroll
          for (int i = 0; i < 16; ++i) s[n][i] *= c2;
      }
      float mx = s[0][0];
#pragma unroll
      for (int i = 1; i < 16; ++i) mx = fmaxf(mx, s[0][i]);
#pragma unroll
      for (int i = 0; i < 16; ++i) mx = fmaxf(mx, s[1][i]);
      mx = xhalf_max(mx);
      if (__any(mx - m > 8.0f)) {
        const float mnew = fmaxf(m, mx), alpha = __builtin_amdgcn_exp2f(m - mnew);
        m = mnew; l *= alpha;
#pragma unroll
        for (int cb = 0; cb < NCB; ++cb)
#pragma unroll
          for (int r = 0; r < 16; ++r) o[cb][r] *= alpha;
      }
      {
        const float nm = -m;
        f32x16 e0 = s[0] + nm, e1 = s[1] + nm;
#pragma unroll
        for (int i = 0; i < 16; ++i) { e0[i] = __builtin_amdgcn_exp2f(e0[i]); e1[i] = __builtin_amdgcn_exp2f(e1[i]); }
        s[0] = e0; s[1] = e1;
        const f32x16 sm = e0 + e1;
        typedef __attribute__((ext_vector_type(8))) float f32x8;
        const f32x8 h8 = sm.lo + sm.hi;
        const f32x4 h4 = h8.lo + h8.hi;
        const f32x2 h2 = h4.lo + h4.hi;
        l += h2[0] + h2[1];
      }
      bf16x8 pb[2][2];
#pragma unroll
      for (int n = 0; n < 2; ++n)
#pragma unroll
        for (int s2 = 0; s2 < 2; ++s2) {
          u32x4 pw = {pk2(s[n][8 * s2 + 0], s[n][8 * s2 + 1]), pk2(s[n][8 * s2 + 2], s[n][8 * s2 + 3]),
                      pk2(s[n][8 * s2 + 4], s[n][8 * s2 + 5]), pk2(s[n][8 * s2 + 6], s[n][8 * s2 + 7])};
          pb[n][s2] = __builtin_bit_cast(bf16x8, pw);
        }
      pv_block<0>(o[0], bufa + vlane, pb);
      if constexpr (NCB > 1) pv_block<1>(o[1], bufa + vlane, pb);
      if constexpr (NCB > 2) pv_block<2>(o[2], bufa + vlane, pb);
      if constexpr (NCB > 3) pv_block<3>(o[3], bufa + vlane, pb);
    }
    asm volatile("s_waitcnt vmcnt(0)" ::: "memory");
    __syncthreads();
  }
  const float inv = __builtin_amdgcn_rcpf(xhalf_sum(l));
#pragma unroll
  for (int cb = 0; cb < NCB; ++cb)
#pragma unroll
    for (int g = 0; g < 4; ++g) {
      const int dv = 32 * cb + 8 * g + 4 * hi;
      const u32x2 gg = *(const u32x2*)(grow + dv);
      float gv[4] = {bf2f(gg[0] & 0xffffu), bf2f(gg[0] >> 16), bf2f(gg[1] & 0xffffu), bf2f(gg[1] >> 16)};
      float ov[4];
#pragma unroll
      for (int j = 0; j < 4; ++j) {
        const float sg = gv[j] * __builtin_amdgcn_rcpf(1.f + __builtin_amdgcn_exp2f(-LOG2E * gv[j]));
        ov[j] = o[cb][4 * g + j] * inv * sg;
      }
      *(unsigned*)((unsigned char*)yrow + dv) = pk4_fp8(ov[0] * Y_SCALE, ov[1] * Y_SCALE, ov[2] * Y_SCALE, ov[3] * Y_SCALE);
      __builtin_amdgcn_sched_barrier(0);
    }
}

DI unsigned ordkey(float f) { const unsigned b = __float_as_uint(f); return b ^ ((unsigned)((int)b >> 31) | 0x80000000u); }
DI void indexer_phase(const u16* __restrict__ P, unsigned* __restrict__ mask) {
  int tidx = threadIdx.x; asm volatile("" : "+v"(tidx));
  const int lane = tidx & 63, r32 = lane & 31, hi = lane >> 5;
  const int gw = blockIdx.x * 8 + (tidx >> 6), nw = gridDim.x * 8;
  for (int base = 0, pass = 0; base < 8192; base += nw, ++pass) {
    const int item = (pass & 1) ? base + (nw - 1 - gw) : base + gw;
    if (item >= 8192) continue;
    const int b = item & 7, t0 = (1023 - (item >> 3)) * 2;
    const size_t brow = (size_t)b * SEQ;
    const int g = (r32 >> 2) & 1, head = 4 * (r32 >> 3) + (r32 & 3);
    bf16x8 aq[4];
#pragma unroll
    for (int s = 0; s < 4; ++s) aq[s] = *(const bf16x8*)(P + (brow + t0 + g) * 7808 + 2560 + head * 64 + 16 * s + 8 * hi);
    float wv[16];
    {
      const u32x4 w0 = *(const u32x4*)(P + (brow + t0 + hi) * 7808 + 3648), w1 = *(const u32x4*)(P + (brow + t0 + hi) * 7808 + 3656);
#pragma unroll
      for (int j = 0; j < 4; ++j) { wv[2 * j] = bf2f(w0[j] & 0xffffu); wv[2 * j + 1] = bf2f(w0[j] >> 16); wv[8 + 2 * j] = bf2f(w1[j] & 0xffffu); wv[8 + 2 * j + 1] = bf2f(w1[j] >> 16); }
    }
    const int tme = t0 + hi, kbmax = (t0 + 1) >> 5;
    unsigned sc[64];
#pragma unroll
    for (int kb = 0; kb < 64; ++kb) {
      unsigned u = 0u;
      if (kb <= kbmax) {
        f32x16 a;
#pragma unroll
        for (int r = 0; r < 16; ++r) a[r] = 0.f;
        const u16* kp = P + (brow + 32 * kb + r32) * 7808 + 3584 + 8 * hi;
#pragma unroll
        for (int s = 0; s < 4; ++s) { const bf16x8 bk = *(const bf16x8*)(kp + 16 * s); a = MFMA(aq[s], bk, a); }
        float v = 0.f;
#pragma unroll
        for (int i = 0; i < 16; ++i) v = fmaf(wv[i], fmaxf(a[i], 0.f), v);
        u = (32 * kb + r32 <= tme) ? ordkey(v) : 0u;
      }
      sc[kb] = u;
    }
    const int target = (tme + 1 < 256) ? tme + 1 : 256;
    unsigned T = 0u;
    for (int bit = 31; bit >= 0; --bit) {
      const unsigned Tp = T | (1u << bit);
      int cnt = 0;
#pragma unroll
      for (int kb = 0; kb < 64; ++kb) cnt += (sc[kb] >= Tp) ? 1 : 0;
#pragma unroll
      for (int o = 16; o; o >>= 1) cnt += __shfl_xor(cnt, o);
      if (cnt >= target) T = Tp;
    }
    unsigned w0 = 0u, w1 = 0u;
#pragma unroll
    for (int kb = 0; kb < 64; ++kb) {
      const bool pred = (sc[kb] >= T) && (sc[kb] != 0u);
      const unsigned long long bal = __ballot(pred);
      const unsigned wd = (unsigned)(bal >> (32 * hi));
      if ((kb & 31) == r32) { if (kb < 32) w0 = wd; else w1 = wd; }
    }
    mask[(brow + tme) * 64 + r32] = w0;
    mask[(brow + tme) * 64 + 32 + r32] = w1;
  }
}

DI void gbar(unsigned* cnt, unsigned target) {
  asm volatile("s_waitcnt vmcnt(0)" ::: "memory");
  __syncthreads();
  if (threadIdx.x == 0) {
    __builtin_amdgcn_fence(__ATOMIC_RELEASE, "agent");
    asm volatile("s_waitcnt vmcnt(0)" ::: "memory");
    __hip_atomic_fetch_add(cnt, 1u, __ATOMIC_RELAXED, __HIP_MEMORY_SCOPE_AGENT);
    while (__hip_atomic_load(cnt, __ATOMIC_RELAXED, __HIP_MEMORY_SCOPE_AGENT) < target) __builtin_amdgcn_s_sleep(1);
    __builtin_amdgcn_fence(__ATOMIC_ACQUIRE, "agent");
    asm volatile("s_waitcnt vmcnt(0)" ::: "memory");
  }
  __syncthreads();
}
#define GSYNC() do { ++bar_gen; gbar(BAR, bar_gen * gridDim.x); } while (0)
__global__ void __launch_bounds__(512, 2) mega(Params p) {
  cg::grid_group grid = cg::this_grid();
  extern __shared__ __attribute__((aligned(16))) char smem[];
  volatile int* s_item = (volatile int*)(smem + LDS_ITEM);
  char* ws = p.ws;
  unsigned char* Y8 = (unsigned char*)(ws + OFF_Y);
  u16* WIN8 = (u16*)(ws + OFF_WIN + 19922944);
  unsigned char* CQ8 = (unsigned char*)(ws + OFF_Y + 67108864);     u16* H = (u16*)(ws + OFF_H); u16* Cb = (u16*)(ws + OFF_Y); u16* Qb = (u16*)(ws + OFF_H);
  u16* KV = (u16*)(ws + OFF_KV); u16* MG = (u16*)(ws + OFF_MG); u16* KR = (u16*)(ws + OFF_KR); u16* Pb = (u16*)(ws + OFF_P);
  u16* WIN = (u16*)(ws + OFF_WIN); u16* WUQ = (u16*)(ws + OFF_WUQ); u16* WUKV = (u16*)(ws + OFF_WUKV); u16* WOUT = (u16*)(ws + OFF_WOUT);
  u16* WMEMALL = (u16*)(ws + OFF_KV); u16* MEMN = (u16*)(ws + OFF_MEMN); u16* MEMKV = (u16*)(ws + OFF_MEMKV);
  unsigned* MASK = (unsigned*)(ws + OFF_MASK); f32x2* ROPE = (f32x2*)(ws + OFF_ROPE); float* LUT = (float*)(ws + OFF_LUT);
  int* CTR = (int*)(ws + OFF_CTR);
  unsigned* BAR = (unsigned*)(ws + OFF_CTR) + 64;
  unsigned bar_gen = 0;
  const int tid = threadIdx.x, lane = tid & 63, wv = __builtin_amdgcn_readfirstlane(tid >> 6), r32 = lane & 31, hi = lane >> 5;
  const int gtid = blockIdx.x * 512 + tid, gthreads = gridDim.x * 512;

  for (int i = gtid; i < 2048 * 32; i += gthreads) {
    const int pos = i >> 5, j = i & 31;
    const float inv = 1.0f / powf(10000.0f, (float)(2 * j) / 64.0f);
    const float ang = (float)pos * inv;
    const float k = rintf(ang * 0.15915494309189535f);
    float r = fmaf(-k, 6.28318548202514648f, ang);
    r = fmaf(-k, -1.74845553e-7f, r);
    f32x2 cs = {__cosf(r), __sinf(r)};
    ROPE[i] = cs;
  }
  for (int i = gtid; i < 129 * 32; i += gthreads) {
    const int rel = i >> 5, h = i & 31;
    int bucket;
    if (rel < 16) bucket = rel;
    else { const int lg = 16 + (int)(logf((float)rel / 16.0f) / 2.0794415416798357f * 16.0f); bucket = lg < 31 ? lg : 31; }
    LUT[i] = p.rel_bias[bucket * 32 + h] * LOG2E;
  }
  rmsnorm_rows<false>(p.mem, p.mem_norm, MEMN, 2048);
#pragma unroll 1
  for (int l = 0; l < 4; ++l) convert_wt<0>(p.w_mem_kv + (size_t)l * 2048 * 2048, 2048, 2048, 2048, WMEMALL + (size_t)l * 2048 * 2048, smem);

  auto convert_layer = [&](int L) {
    const int kind = L % 3, j = L / 3;
    if (kind == 0) {
    convert_wt<1>(p.w_in_a + (size_t)j * 2048 * 6208, 2048, 6208, 3840, WIN, smem, 1.f, 3648, 576, 1536, 2560, 512);
    convert_wt<0, true>(p.w_in_a + (size_t)j * 2048 * 6208, 2048, 6208, 2560, WIN8, smem, WIN_SCALE, 2560, 1536, 0, 576);
    convert_wt<2, true>(p.w_uq + (size_t)j * 1536 * 3072, 1536, 3072, 3072, WUQ, smem, WUQ_SCALE);
    convert_wt<0>(p.w_ukv + (size_t)j * 512 * 4096, 512, 4096, 4096, WUKV, smem);
  } else if (kind == 1) {
    convert_wt<0>(p.w_in_b, 2048, 7760, 4864, WIN, smem, 1.f, 4688, 1616, 2048, 3072);
    convert_wt<0, true>(p.w_in_b, 2048, 7760, 3072, WIN8, smem, WIN_SCALE, 3072, 2048, 0, 1616);
  } else {
    convert_wt<0>(p.w_in_c, 2048, 6656, 3584, WIN, smem, 1.f, 3584, 512, 2048, 3072);
    convert_wt<0, true>(p.w_in_c, 2048, 6656, 3072, WIN8, smem, WIN_SCALE, 3072, 2048, 0, 512);
  }
  };
#pragma unroll 1
  for (int layer = 0; layer < 4; ++layer) {
    const int kind = layer % 3, j = layer / 3;
    const float* xin = (layer == 0) ? p.x : p.out;
    unsigned char* H8 = (unsigned char*)(ws + ((kind == 0) ? OFF_KV + 67108864 : OFF_Y));
    rmsnorm_rows<false>(xin, p.norm_in + layer * 2048, H, NTOK, H8);
    if (layer == 0) convert_layer(0);
    convert_wt<0, true>(p.w_out + (size_t)layer * 3072 * 2048, 3072, 2048, 2048, WOUT, smem, WOUT_SCALE);
    if (layer == 0) { __builtin_amdgcn_fence(__ATOMIC_RELEASE, "agent"); grid.sync(); __builtin_amdgcn_fence(__ATOMIC_ACQUIRE, "agent"); asm volatile("s_waitcnt vmcnt(0)" ::: "memory"); }
    else GSYNC();

    if (kind == 0) {
      { EpiBf<1> e{Cb, 2048, 3648, MG, KR, ROPE, 1.f, 576, 1536, 2560}; run_gemm(H, 2048, WIN, NTOK, 3840, 2048, e, smem); }
      { EpiBf<3> e{Cb, 2048, 2560, MG, nullptr, nullptr, 1.f / (H_SCALE * WIN_SCALE), 1536, 0, 576}; run_gemm<true>((const u16*)H8, 1024, WIN8, NTOK, 2560, 1024, e, smem, 192, 2, 4); }
    }
    else if (kind == 1) {
      { EpiBf<0> e{Pb, 7808, 4688, nullptr, nullptr, nullptr, 1.f, 1616, 2048, 3072}; run_gemm(H, 2048, WIN, NTOK, 4864, 2048, e, smem); }
      { EpiBf<0> e{Pb, 7808, 3072, nullptr, nullptr, nullptr, 1.f / (H_SCALE * WIN_SCALE), 2048, 0, 1616}; run_gemm<true>((const u16*)H8, 1024, WIN8, NTOK, 3072, 1024, e, smem); }
    } else {
      { EpiBf<0> e{Pb, 6656, 3584, nullptr, nullptr, nullptr, 1.f, 512, 2048, 3072}; run_gemm(H, 2048, WIN, NTOK, 3584, 2048, e, smem); }
      { EpiBf<0> e{Pb, 6656, 3072, nullptr, nullptr, nullptr, 1.f / (H_SCALE * WIN_SCALE), 2048, 0, 512}; run_gemm<true>((const u16*)H8, 1024, WIN8, NTOK, 3072, 1024, e, smem, 128, 2, 4); }
    }
    if (layer == 0) { EpiBf<0> e{MEMKV, 8192, 8192, nullptr, nullptr, nullptr}; run_gemm(MEMN, 2048, WMEMALL, 2048, 8192, 2048, e, smem); }
    GSYNC();

    if (kind == 0) {
      anorm_phase(Cb, p.a_q_norm + j * 1536, p.a_kv_norm + j * 512, CQ8);
      GSYNC();
      { EpiBf<2> e{Qb, 3072, 3072, nullptr, nullptr, ROPE, 1.f / (CQ_SCALE * WUQ_SCALE)}; run_gemm<true>((const u16*)CQ8, 768, WUQ, NTOK, 3072, 768, e, smem); }
      { EpiBf<0> e{KV, 4096, 4096, nullptr, nullptr, nullptr}; run_gemm(Cb + 1536, 2048, WUKV, NTOK, 4096, 512, e, smem); }
      GSYNC();
    } else if (kind == 1) {
      indexer_phase(Pb, MASK);
      GSYNC();
    }

    {
      const int nself = (kind == 0) ? 1024 : 2048, total = nself + 512;
      const u16* mgb = (kind == 0) ? MG : Pb;
      const int ldmg = (kind == 0) ? 4096 : (kind == 1 ? 7808 : 6656);
      const int mqcol = (kind == 0) ? 0 : (kind == 1 ? 3664 : 2560);
      const int gatecol = (kind == 0) ? 1024 : (kind == 1 ? 4688 : 3584);
      const u16* memkv = MEMKV + layer * 2048;
      float* lut_all = (float*)(smem + LDS_LUT);
      if (kind != 0) {
        for (int i = tid; i < 32 * 129; i += 512) { const int h = i / 129, r = i - h * 129; lut_all[h * 132 + r] = LUT[r * 32 + h]; }
      }
      if (tid == 0) s_item[0] = atomicAdd(&CTR[layer], 1);
      __syncthreads();
      for (int par = 0;; par ^= 1) {
        const int item = __builtin_amdgcn_readfirstlane(s_item[par]);
        if (item >= total) break;
        if (tid == 0) s_item[par ^ 1] = atomicAdd(&CTR[layer], 1);
        if (item < nself) {
          if (kind == 0) {
            const int qblk = 7 - item / 128, rem = item % 128, b = rem / 16, head = rem % 16;
            const size_t brow = (size_t)b * SEQ;
            const int tq0 = qblk * 256 + 32 * wv, tq = tq0 + r32;
            attn_core<192, 128, 128, 128, 0>(KV + brow * 4096 + head * 256, 4096, KR + brow * 64, 64, KV + brow * 4096 + head * 256 + 128, 4096,
                                            SEQ, 0, 4 * qblk + 4, Qb + (brow + tq) * 3072 + head * 192, tq, tq0, 0.07216878364870322f * LOG2E, 0,
                                            (u16*)(Y8 + (brow + tq) * 3072 + head * 128), mgb + (brow + tq) * ldmg + gatecol + head * 128,
                                            nullptr, nullptr, 0.f, -1e29f, 0.f, smem);
          } else {
            const int qb = 63 - item / 32, rem = item % 32, b = rem / 4, kvh = rem % 4;
            const size_t brow = (size_t)b * SEQ;
            const int head = kvh * 8 + wv, tq0 = qb * 32, tq = tq0 + r32;
            const float* lutw = lut_all + head * 132;
            if (kind == 1) {
              attn_core<64, 64, 64, 64, 1>(Pb + brow * 7808 + 2048 + kvh * 64, 7808, nullptr, 0, Pb + brow * 7808 + 2304 + kvh * 64, 7808,
                                          SEQ, 0, (tq0 + 31) / 64 + 1, Pb + (brow + tq) * 7808 + head * 64, tq, tq0, 0.125f * LOG2E, 0,
                                          (u16*)(Y8 + (brow + tq) * 3072 + head * 64), Pb + (brow + tq) * 7808 + gatecol + head * 64,
                                          MASK + (brow + tq) * 64, lutw, lutw[128], -1e29f, 0.f, smem);
            } else {
              const float sink = p.c_sinks[j * 32 + head] * LOG2E;
              attn_core<64, 64, 64, 64, 2>(Pb + brow * 6656 + 2048 + kvh * 64, 6656, nullptr, 0, Pb + brow * 6656 + 2304 + kvh * 64, 6656,
                                          SEQ, tq0 - 128, 3, Pb + (brow + tq) * 6656 + head * 64, tq, tq0, 0.125f * LOG2E, 0,
                                          (u16*)(Y8 + (brow + tq) * 3072 + head * 64), Pb + (brow + tq) * 6656 + gatecol + head * 64,
                                          nullptr, lutw, 0.f, sink, 1.f, smem);
            }
          }
        } else {
          const int it = item - nself, b = it / 64, mh = (it % 64) / 16, qb = it % 16;
          const size_t brow = (size_t)b * SEQ;
          const int tq0 = qb * 128 + 32 * (wv >> 1), tq = tq0 + r32, vh = wv & 1;
          attn_core<256, 256, 128, 256, 3>(memkv + (size_t)b * 256 * 8192 + mh * 256, 8192, nullptr, 0, memkv + (size_t)b * 256 * 8192 + 1024 + mh * 256, 8192,
                                          256, 0, 4, mgb + (brow + tq) * ldmg + mqcol + mh * 256, tq, tq0, 0.0625f * LOG2E, 4 * vh,
                                          (u16*)(Y8 + (brow + tq) * 3072 + 2048 + mh * 256 + 128 * vh), mgb + (brow + tq) * ldmg + gatecol + 2048 + mh * 256 + 128 * vh,
                                          nullptr, nullptr, 0.f, -1e29f, 0.f, smem);
        }
      }
    }
    if (layer + 1 < 4) convert_layer(layer + 1);
    GSYNC();

    { EpiResid e{xin, p.out, 1.f / (Y_SCALE * WOUT_SCALE)}; run_gemm<true>((const u16*)Y8, 1536, WOUT, NTOK, 2048, 1536, e, smem); }
    GSYNC();
  }
  rmsnorm_rows<true>(p.out, p.final_norm, p.out, NTOK);
}

extern "C" void kernel_launch(void* const* d_in, const int* in_sizes, int n_in, void* d_out, int out_size,
                              void* d_ws, size_t ws_size, hipStream_t stream) {
  static int grid_blocks = 0;
  if (!grid_blocks) {
    int dev = 0, cus = 0, per_cu = 0;
    (void)hipGetDevice(&dev);
    (void)hipDeviceGetAttribute(&cus, hipDeviceAttributeMultiprocessorCount, dev);
    (void)hipFuncSetAttribute((const void*)mega, hipFuncAttributeMaxDynamicSharedMemorySize, LDS_BYTES);
    (void)hipOccupancyMaxActiveBlocksPerMultiprocessor(&per_cu, mega, 512, LDS_BYTES);
    if (per_cu > 1) per_cu = 1;
    grid_blocks = cus * per_cu;
  }
  Params p{};
  p.x = (const float*)d_in[0]; p.mem = (const float*)d_in[1]; p.norm_in = (const float*)d_in[2]; p.final_norm = (const float*)d_in[3];
  p.mem_norm = (const float*)d_in[4]; p.rel_bias = (const float*)d_in[5]; p.w_in_a = (const float*)d_in[6]; p.a_q_norm = (const float*)d_in[7];
  p.w_uq = (const float*)d_in[8]; p.a_kv_norm = (const float*)d_in[9]; p.w_ukv = (const float*)d_in[10]; p.w_in_b = (const float*)d_in[11];
  p.w_in_c = (const float*)d_in[12]; p.c_sinks = (const float*)d_in[13]; p.w_mem_kv = (const float*)d_in[14]; p.w_out = (const float*)d_in[15];
  p.out = (float*)d_out; p.ws = (char*)d_ws;
  (void)hipMemsetAsync((char*)d_ws + OFF_CTR, 0, 1024, stream);
  void* args[] = {&p};
  (void)hipLaunchCooperativeKernel((void*)mega, dim3(grid_blocks), dim3(512), args, LDS_BYTES, stream);
}
```

```cpp
#include <hip/hip_runtime.h>
#include <hip/hip_cooperative_groups.h>
#include <stdint.h>
namespace cg = cooperative_groups;

typedef unsigned short u16;
typedef __attribute__((ext_vector_type(8))) short bf16x8;
typedef __attribute__((ext_vector_type(4))) short s16x4;
typedef __attribute__((ext_vector_type(16))) float f32x16;
typedef __attribute__((ext_vector_type(4))) float f32x4;
typedef __attribute__((ext_vector_type(2))) float f32x2;
typedef __attribute__((ext_vector_type(4))) unsigned u32x4;
typedef __attribute__((ext_vector_type(2))) unsigned u32x2;
typedef __attribute__((ext_vector_type(2))) __bf16 bf16x2_t;
typedef short v4i16_t __attribute__((ext_vector_type(4)));
#define DI __device__ __forceinline__
#define MFMA(a, b, c) __builtin_amdgcn_mfma_f32_32x32x16_bf16((a), (b), (c), 0, 0, 0)

constexpr int SEQ = 2048, NTOK = 16384;
constexpr int LDS_LUT = 133120, LDS_ITEM = LDS_LUT + 32 * 528, LDS_BYTES = LDS_ITEM + 64;
constexpr float LOG2E = 1.4426950408889634f;
constexpr float NEGV = -1e30f;
constexpr float Y_SCALE = 16.f, WOUT_SCALE = 256.f, CQ_SCALE = 16.f, WUQ_SCALE = 256.f, H_SCALE = 16.f, WIN_SCALE = 256.f;

constexpr size_t OFF_Y = 0;
constexpr size_t OFF_H = 100663296;
constexpr size_t OFF_KV = 201326592;
constexpr size_t OFF_MG = 335544320;
constexpr size_t OFF_KR = 469762048;
constexpr size_t OFF_P = 167772160;
constexpr size_t OFF_WIN = 471859200;
constexpr size_t OFF_WUQ = OFF_WIN + 32505856;
constexpr size_t OFF_WUKV = OFF_WUQ + 9437184;
constexpr size_t OFF_WOUT = OFF_WUKV + 4194304;
constexpr size_t OFF_MEMN = OFF_WOUT + 12582912;
constexpr size_t OFF_MEMKV = OFF_MEMN + 8388608;
constexpr size_t OFF_MASK = OFF_MEMKV + 33554432;
constexpr size_t OFF_ROPE = OFF_MASK + 4194304;
constexpr size_t OFF_LUT = OFF_ROPE + 524288;
constexpr size_t OFF_CTR = OFF_LUT + 32768;

struct Params {
  const float *x, *mem, *norm_in, *final_norm, *mem_norm, *rel_bias, *w_in_a, *a_q_norm, *w_uq, *a_kv_norm, *w_ukv,
      *w_in_b, *w_in_c, *c_sinks, *w_mem_kv, *w_out;
  float* out;
  char* ws;
};

DI float bf2f(unsigned b) { return __uint_as_float(b << 16); }
DI unsigned pk2(float a, float b) {
  f32x2 v = {a, b};
  return __builtin_bit_cast(unsigned, __builtin_convertvector(v, bf16x2_t));
}
DI float clamp8(float x) { return fminf(fmaxf(x, -448.f), 448.f); }
DI unsigned pk4_fp8(float a, float b, float c, float d) {
  int w = 0;
  w = __builtin_amdgcn_cvt_pk_fp8_f32(clamp8(a), clamp8(b), w, false);
  w = __builtin_amdgcn_cvt_pk_fp8_f32(clamp8(c), clamp8(d), w, true);
  return (unsigned)w;
}
DI u16 f2bf(float a) { return (u16)(pk2(a, 0.f) & 0xffffu); }
DI float wave_sum(float v) {
#pragma unroll
  for (int o = 32; o; o >>= 1) v += __shfl_xor(v, o);
  return v;
}
DI int crow(int reg, int hi) { return (reg & 3) + 8 * (reg >> 2) + 4 * hi; }
DI float xhalf_max(float m) {
  auto rr = __builtin_amdgcn_permlane32_swap(__float_as_uint(m), __float_as_uint(m), false, false);
  return fmaxf(__uint_as_float(rr[0]), __uint_as_float(rr[1]));
}
DI float xhalf_sum(float m) {
  auto rr = __builtin_amdgcn_permlane32_swap(__float_as_uint(m), __float_as_uint(m), false, false);
  return __uint_as_float(rr[0]) + __uint_as_float(rr[1]);
}
typedef __attribute__((address_space(3))) v4i16_t* lds_v4p;
DI s16x4 vtr(const char* p) {
  return __builtin_bit_cast(s16x4, __builtin_amdgcn_ds_read_tr16_b64_v4i16((lds_v4p)(p)));
}

template <int PERM, bool FP8 = false>
DI void convert_wt(const float* __restrict__ W, int K, int N, int Npad, u16* __restrict__ Wt, char* smem, float wscale = 1.f,
                   int nvalid = -1, int csplit = 0, int coff1 = 0, int coff2 = 0, int rot_n0 = 2048) {
  float* tile = (float*)smem;
  int tid = threadIdx.x; asm volatile("" : "+v"(tid));
  const int ntk = K / 64, ntn = Npad / 64;
  for (int t = blockIdx.x; t < ntk * ntn; t += gridDim.x) {
    const int tk = t % ntk, tn = t / ntk, k0 = tk * 64, n0 = tn * 64;
    __syncthreads();
#pragma unroll
    for (int i = 0; i < 2; ++i) {
      const int id = tid + 512 * i, kr = id >> 4, n4 = (id & 15) * 4;
      f32x4 v = {0.f, 0.f, 0.f, 0.f};
      const int nd = n0 + n4, nsrc = (nvalid < 0) ? nd : (nd < csplit ? nd + coff1 : nd + coff2);
      if (nd < ((nvalid < 0) ? N : nvalid)) v = *(const f32x4*)(W + (size_t)(k0 + kr) * N + nsrc);
      tile[kr * 65 + n4 + 0] = v[0]; tile[kr * 65 + n4 + 1] = v[1]; tile[kr * 65 + n4 + 2] = v[2]; tile[kr * 65 + n4 + 3] = v[3];
    }
    __syncthreads();
    {
      const int n = tid >> 3, c = tid & 7;
      bool rot = false;
      if (PERM == 1) rot = (n0 == rot_n0);
      if (PERM == 2) rot = ((tn % 3) == 2);
      const int ns = rot ? ((n >> 1) + 32 * (n & 1)) : n;
      if (FP8) {
        float f[8];
#pragma unroll
        for (int j = 0; j < 8; ++j) f[j] = tile[(c * 8 + j) * 65 + ns] * wscale;
        u32x2 o = {pk4_fp8(f[0], f[1], f[2], f[3]), pk4_fp8(f[4], f[5], f[6], f[7])};
        *(u32x2*)((unsigned char*)Wt + (size_t)(n0 + n) * K + k0 + c * 8) = o;
      } else {
        u32x4 o;
#pragma unroll
        for (int j = 0; j < 4; ++j) o[j] = pk2(tile[(c * 8 + 2 * j) * 65 + ns], tile[(c * 8 + 2 * j + 1) * 65 + ns]);
        *(u32x4*)(Wt + (size_t)(n0 + n) * K + k0 + c * 8) = o;
      }
    }
  }
}

template <bool F32OUT>
DI void rmsnorm_rows(const float* X, const float* __restrict__ g, void* outp, int nrows, unsigned char* __restrict__ out8 = nullptr) {
  int tidx = threadIdx.x; asm volatile("" : "+v"(tidx));
  const int lane = tidx & 63, gw = blockIdx.x * 8 + (tidx >> 6), nw = gridDim.x * 8;
  for (int row = gw; row < nrows; row += nw) {
    const f32x4* xr = (const f32x4*)(X + (size_t)row * 2048);
    f32x4 v[8];
    float ss = 0.f;
#pragma unroll
    for (int i = 0; i < 8; ++i) { v[i] = xr[lane + 64 * i]; ss += v[i][0] * v[i][0] + v[i][1] * v[i][1] + v[i][2] * v[i][2] + v[i][3] * v[i][3]; }
    ss = wave_sum(ss);
    const float r = rsqrtf(ss * (1.f / 2048.f) + 1e-6f);
#pragma unroll
    for (int i = 0; i < 8; ++i) {
      const f32x4 gg = ((const f32x4*)g)[lane + 64 * i];
      f32x4 o = {v[i][0] * r * gg[0], v[i][1] * r * gg[1], v[i][2] * r * gg[2], v[i][3] * r * gg[3]};
      if (F32OUT) ((f32x4*)((float*)outp + (size_t)row * 2048))[lane + 64 * i] = o;
      else { u32x2 pk = {pk2(o[0], o[1]), pk2(o[2], o[3])}; ((u32x2*)((u16*)outp + (size_t)row * 2048))[lane + 64 * i] = pk; }
      if (!F32OUT && out8) ((unsigned*)(out8 + (size_t)row * 2048))[lane + 64 * i] = pk4_fp8(o[0] * H_SCALE, o[1] * H_SCALE, o[2] * H_SCALE, o[3] * H_SCALE);
    }
  }
}

DI void anorm_phase(u16* C, const float* __restrict__ gq, const float* __restrict__ gkv, unsigned char* __restrict__ cq8) {
  int tidx = threadIdx.x; asm volatile("" : "+v"(tidx));
  const int lane = tidx & 63, gw = blockIdx.x * 8 + (tidx >> 6), nw = gridDim.x * 8;
  for (int row = gw; row < NTOK; row += nw) {
    u32x4* cr = (u32x4*)(C + (size_t)row * 2048);
    u32x4 v[4];
    float sq = 0.f, skv = 0.f;
#pragma unroll
    for (int i = 0; i < 4; ++i) {
      v[i] = cr[lane + 64 * i];
      float s = 0.f;
#pragma unroll
      for (int j = 0; j < 4; ++j) { float a = bf2f(v[i][j] & 0xffffu), b = bf2f(v[i][j] >> 16); s += a * a + b * b; }
      if (i < 3) sq += s; else skv += s;
    }
    sq = wave_sum(sq); skv = wave_sum(skv);
    const float rq = rsqrtf(sq * (1.f / 1536.f) + 1e-6f), rkv = rsqrtf(skv * (1.f / 512.f) + 1e-6f);
#pragma unroll
    for (int i = 0; i < 4; ++i) {
      const int col = (lane + 64 * i) * 8;
      const float* gp = (i < 3) ? (gq + col) : (gkv + col - 1536);
      const float r = (i < 3) ? rq : rkv;
      const f32x4 g0 = *(const f32x4*)gp, g1 = *(const f32x4*)(gp + 4);
      u32x4 o;
      o[0] = pk2(bf2f(v[i][0] & 0xffffu) * r * g0[0], bf2f(v[i][0] >> 16) * r * g0[1]);
      o[1] = pk2(bf2f(v[i][1] & 0xffffu) * r * g0[2], bf2f(v[i][1] >> 16) * r * g0[3]);
      o[2] = pk2(bf2f(v[i][2] & 0xffffu) * r * g1[0], bf2f(v[i][2] >> 16) * r * g1[1]);
      o[3] = pk2(bf2f(v[i][3] & 0xffffu) * r * g1[2], bf2f(v[i][3] >> 16) * r * g1[3]);
      cr[lane + 64 * i] = o;
      if (i < 3) {
        const float q0 = bf2f(v[i][0] & 0xffffu) * r * g0[0] * CQ_SCALE, q1 = bf2f(v[i][0] >> 16) * r * g0[1] * CQ_SCALE;
        const float q2 = bf2f(v[i][1] & 0xffffu) * r * g0[2] * CQ_SCALE, q3 = bf2f(v[i][1] >> 16) * r * g0[3] * CQ_SCALE;
        const float q4 = bf2f(v[i][2] & 0xffffu) * r * g1[0] * CQ_SCALE, q5 = bf2f(v[i][2] >> 16) * r * g1[1] * CQ_SCALE;
        const float q6 = bf2f(v[i][3] & 0xffffu) * r * g1[2] * CQ_SCALE, q7 = bf2f(v[i][3] >> 16) * r * g1[3] * CQ_SCALE;
        u32x2 w8 = {pk4_fp8(q0, q1, q2, q3), pk4_fp8(q4, q5, q6, q7)};
        *(u32x2*)(cq8 + (size_t)row * 1536 + col) = w8;
      }
    }
  }
}

namespace pg8 {
#define PG8_LAS __attribute__((address_space(3)))
constexpr int BM = 256, BK = 64, HALF = 128, HTB = HALF * BK * 2, STAGE_BYTES = 8 * HTB, NXCD = 8, WGM = 8;
DI int lds_byte(int r, int c) { const int st = (r >> 4) * 2 + (c >> 5), rr = r & 15, cc = c & 31, ob = rr * 64 + cc * 2; return st * 1024 + (ob ^ (((ob >> 9) & 1) << 5)); }
DI void stage_rc(int b, int& R, int& C) { const int st = b / 1024, sb = b % 1024, swz = sb ^ (((sb >> 9) & 1) << 5); R = (st >> 1) * 16 + swz / 64; C = (st & 1) * 32 + (swz % 64) / 2; }
DI int perm32(int rho) { const int n = rho >> 4, i = rho & 15; return 8 * (i >> 2) + 4 * n + (i & 3); }
typedef int i32x4v __attribute__((ext_vector_type(4)));
typedef int i32x8 __attribute__((ext_vector_type(8)));
DI i32x8 cat8(bf16x8 a, bf16x8 b) { const i32x4v x = __builtin_bit_cast(i32x4v, a), y = __builtin_bit_cast(i32x4v, b); return __builtin_shufflevector(x, y, 0, 1, 2, 3, 4, 5, 6, 7); }
struct Unit { int pm, pn; };
struct Gemm { const u16* A; const u16* Bt; int M, N, K, lda; };
struct StaticOrder {
  int nM, nN, nwg, G, c;
  int nA = 0, uA = 0, uB = 0;
  DI void init(int M, int N, int G_, int c_) { nM = M / BM; nN = N / BM; nwg = nM * nN; G = G_; c = c_; }
  DI bool next(int i, Unit& u) const {
    long L;
    if (nA == 0) L = (long)i * G + c;
    else if (c < nA) { if (i >= uA) return false; L = (long)i * nA + c; }
    else { if (i >= uB) return false; L = (long)nA * uA + (long)i * (G - nA) + (c - nA); }
    if (L >= nwg) return false;
    int wgid = (int)L; { const int q = nwg / NXCD, r = nwg % NXCD, xcd = wgid % NXCD, off = wgid / NXCD; wgid = (xcd < r ? xcd * (q + 1) : r * (q + 1) + (xcd - r) * q) + off; }
    const int nig = WGM * nN, gid = wgid / nig, fm = gid * WGM, gsz = (nM - fm) < WGM ? (nM - fm) : WGM;
    u.pm = fm + ((wgid % nig) % gsz); u.pn = (wgid % nig) / gsz; return true;
  }
  DI void a_ready(const Unit&) const {}
  DI void done(const Unit&) const {}
};
template <bool FP8, class Epi, class Sched>
__device__ __forceinline__ void gemm_phase(PG8_LAS unsigned char* lds, const Gemm g, const Sched& S, const Epi& E) {
    int tid = threadIdx.x; asm volatile("" : "+v"(tid));
    const int wid = __builtin_amdgcn_readfirstlane(tid >> 6), lane = tid & 63, wr = wid >> 2, wc = wid & 3, fr = lane & 15, fq = lane >> 4;
    const int K = g.K, nt = K / BK;
    unsigned voffA[2], voffB[2];
#pragma unroll
    for (int i = 0; i < 2; ++i) { int R, C; stage_rc(tid * 16 + i * 8192, R, C); const int Rb = Epi::PERM ? ((R & ~31) + perm32(R & 31)) : R;
        voffA[i] = (unsigned)(R * g.lda + C) * 2u; voffB[i] = (unsigned)(Rb * K + C) * 2u; }
    const size_t kstep = (size_t)(BK * 2);
    const size_t hstep = (size_t)HALF * K * 2, hstepA = (size_t)HALF * g.lda * 2;
    const size_t tstep = 2 * hstep, tstepA = 2 * hstepA;
    const unsigned ldsw = (unsigned)wid * 1024u;
    const int aoff = lds_byte(wr * 64 + fr, fq * 8), boff = lds_byte(wc * 32 + fr, fq * 8);
#define PG8_SA(b, h) (((b) * 2 + (h)) * HTB)
#define PG8_SB(b, h) ((4 + (b) * 2 + (h)) * HTB)
#define PG8_STAGE(bufoff, gbase, voff) do { _Pragma("unroll") for (int _i = 0; _i < 2; ++_i) \
        __builtin_amdgcn_global_load_lds((const unsigned*)((const char*)(gbase) + (voff)[_i]), (PG8_LAS unsigned*)(lds + (bufoff) + ldsw + _i * 8192), 16, 0, 0); } while (0)
#define PG8_LDA(dst, b, h) do { _Pragma("unroll") for (int m = 0; m < 4; ++m) _Pragma("unroll") for (int k = 0; k < 2; ++k) dst[m][k] = *(const PG8_LAS bf16x8*)(lds + PG8_SA(b, h) + aoff + m * 2048 + k * 1024); } while (0)
#define PG8_LDB(dst, b, h) do { _Pragma("unroll") for (int n = 0; n < 2; ++n) _Pragma("unroll") for (int k = 0; k < 2; ++k) dst[n][k] = *(const PG8_LAS bf16x8*)(lds + PG8_SB(b, h) + boff + n * 2048 + k * 1024); } while (0)
#define PG8_MMA(ai, bj, At, Bt) do { __builtin_amdgcn_s_setprio(1); _Pragma("unroll") for (int m = 0; m < 4; ++m) _Pragma("unroll") for (int n = 0; n < 2; ++n) { \
        if constexpr (FP8) { const i32x8 bv_ = cat8(Bt[n][0], Bt[n][1]), av_ = cat8(At[m][0], At[m][1]); \
            asm volatile("s_nop 1\n\tv_mfma_scale_f32_16x16x128_f8f6f4 %0, %1, %2, %0, %3, %3 op_sel_hi:[0,0,0]" : "+v"(acc[ai][bj][m][n]) : "v"(bv_), "v"(av_), "v"(sc127)); } \
        else { _Pragma("unroll") for (int k = 0; k < 2; ++k) acc[ai][bj][m][n] = __builtin_amdgcn_mfma_f32_16x16x32_bf16(Bt[n][k], At[m][k], acc[ai][bj][m][n], 0, 0, 0); } } \
        __builtin_amdgcn_s_setprio(0); } while (0)
#define PG8_WAIT_V(n) asm volatile("s_waitcnt vmcnt(" #n ")" ::: "memory")
#define PG8_WAIT_L(n) asm volatile("s_waitcnt lgkmcnt(" #n ")" ::: "memory")
#define PG8_BAR __builtin_amdgcn_s_barrier()
#define PG8_SCHED __builtin_amdgcn_sched_barrier(0)
    Unit cur, nxt; int ui = 0;
    if (!S.next(0, cur)) return;
    f32x4 acc[2][2][4][2];
#pragma unroll
    for (int a = 0; a < 2; ++a)
#pragma unroll
        for (int b = 0; b < 2; ++b)
#pragma unroll
            for (int m = 0; m < 4; ++m)
#pragma unroll
                for (int n = 0; n < 2; ++n) acc[a][b][m][n] = (f32x4){0.f, 0.f, 0.f, 0.f};
    bf16x8 At[4][2], B0[2][2], B1[2][2];
    int sc127 = 0x7F7F7F7F; asm volatile("" : "+v"(sc127));
    const char* cA = (const char*)g.A + (size_t)cur.pm * tstepA; const char* cB = (const char*)g.Bt + (size_t)cur.pn * tstep;
    S.a_ready(cur);
    PG8_STAGE(PG8_SB(0, 0), cB, voffB); PG8_STAGE(PG8_SA(0, 0), cA, voffA); PG8_STAGE(PG8_SB(0, 1), cB + hstep, voffB); PG8_STAGE(PG8_SA(0, 1), cA + hstepA, voffA);
    if (wr == 1) PG8_BAR;
    PG8_WAIT_V(4); PG8_BAR;
    PG8_STAGE(PG8_SB(1, 0), cB + kstep, voffB); PG8_STAGE(PG8_SA(1, 0), cA + kstep, voffA); PG8_STAGE(PG8_SB(1, 1), cB + hstep + kstep, voffB);
    PG8_WAIT_V(6); PG8_BAR;
    for (;;) {
        const bool has_next = S.next(ui + 1, nxt);
        const char* nA = has_next ? (const char*)g.A + (size_t)nxt.pm * tstepA : cA; const char* nB = has_next ? (const char*)g.Bt + (size_t)nxt.pn * tstep : cB;
        for (int t = 0; t < nt; t += 2) {
            const bool last = (t == nt - 2);
            const char* a1 = cA + (size_t)(t + 1) * kstep;
            const char* a2 = last ? nA : cA + (size_t)(t + 2) * kstep; const char* b2 = last ? nB : cB + (size_t)(t + 2) * kstep;
            const char* a3 = a2 + kstep; const char* b3 = b2 + kstep;
            if (last && has_next) S.a_ready(nxt);
            PG8_LDB(B0, 0, 0); PG8_SCHED; PG8_LDA(At, 0, 0); PG8_STAGE(PG8_SA(1, 1), a1 + hstepA, voffA);
            PG8_WAIT_L(8); PG8_BAR; PG8_WAIT_L(0); PG8_MMA(0, 0, At, B0); PG8_BAR; PG8_SCHED;
            PG8_LDB(B1, 0, 1); PG8_STAGE(PG8_SB(0, 0), b2, voffB);
            PG8_BAR; PG8_WAIT_L(0); PG8_MMA(0, 1, At, B1); PG8_BAR;
            PG8_LDA(At, 0, 1); PG8_STAGE(PG8_SA(0, 0), a2, voffA);
            PG8_BAR; PG8_WAIT_L(0); PG8_MMA(1, 0, At, B0); PG8_BAR; PG8_SCHED;
            PG8_STAGE(PG8_SB(0, 1), b2 + hstep, voffB);
            PG8_WAIT_V(6); PG8_BAR; PG8_MMA(1, 1, At, B1); PG8_BAR;
            PG8_LDB(B0, 1, 0); PG8_SCHED; PG8_LDA(At, 1, 0); PG8_STAGE(PG8_SA(0, 1), a2 + hstepA, voffA);
            PG8_WAIT_L(8); PG8_BAR; PG8_WAIT_L(0); PG8_MMA(0, 0, At, B0); PG8_BAR; PG8_SCHED;
            PG8_LDB(B1, 1, 1); PG8_STAGE(PG8_SB(1, 0), b3, voffB);
            PG8_BAR; PG8_WAIT_L(0); PG8_MMA(0, 1, At, B1); PG8_BAR;
            PG8_LDA(At, 1, 1); PG8_STAGE(PG8_SA(1, 0), a3, voffA);
            PG8_BAR; PG8_WAIT_L(0); PG8_MMA(1, 0, At, B0); PG8_BAR; PG8_SCHED;
            PG8_STAGE(PG8_SB(1, 1), b3 + hstep, voffB);
            PG8_WAIT_V(6); PG8_BAR; PG8_MMA(1, 1, At, B1); PG8_BAR;
        }
        if constexpr (FP8) asm volatile("s_nop 15\n\ts_nop 15" ::: "memory");
        if constexpr (!Epi::AFTER_DRAIN) { E(acc, cur, wr, wc, fr, fq); S.done(cur); }
        if (!has_next) break;
#pragma unroll
        for (int a = 0; a < 2; ++a)
#pragma unroll
            for (int b = 0; b < 2; ++b)
#pragma unroll
                for (int m = 0; m < 4; ++m)
#pragma unroll
                    for (int n = 0; n < 2; ++n) acc[a][b][m][n] = (f32x4){0.f, 0.f, 0.f, 0.f};
        cur = nxt; cA = nA; cB = nB; ++ui;
    }
    PG8_WAIT_V(0);
    if (wr == 0) PG8_BAR;
    PG8_BAR;
    if constexpr (Epi::AFTER_DRAIN) { E.fused(acc, cur, wr, wc, fr, fq, lds, wid, lane); S.done(cur); }
#undef PG8_SA
#undef PG8_SB
#undef PG8_STAGE
#undef PG8_LDA
#undef PG8_LDB
#undef PG8_MMA
#undef PG8_WAIT_V
#undef PG8_WAIT_L
#undef PG8_BAR
#undef PG8_SCHED
}

}

struct EpiResid {
  static constexpr bool PERM = false, AFTER_DRAIN = false;
  const float* xin; float* xout; float sc;
  DI void operator()(const f32x4 (&acc)[2][2][4][2], const pg8::Unit& u, int wr, int wc, int fr, int fq) const {
    const int row0 = u.pm * 256 + wr * 64 + fr, col0 = u.pn * 256 + wc * 32 + 4 * fq;
#pragma unroll
    for (int ai = 0; ai < 2; ++ai)
#pragma unroll
      for (int m = 0; m < 4; ++m) {
        const size_t ro = (size_t)(row0 + ai * 128 + m * 16) * 2048 + col0;
#pragma unroll
        for (int bj = 0; bj < 2; ++bj)
#pragma unroll
          for (int n = 0; n < 2; ++n) {
            const size_t o = ro + bj * 128 + n * 16;
            const f32x4 xv = *(const f32x4*)(xin + o);
            *(f32x4*)(xout + o) = xv + acc[ai][bj][m][n] * sc;
          }
        asm volatile("" ::: "memory");
      }
  }
};
template <int MODE>
struct EpiBf {
  static constexpr bool PERM = true, AFTER_DRAIN = false;
  u16* d0; int ld0; int N; u16* d1; u16* d2; const f32x2* rope; float sc = 1.f; int csplit = 0, coff1 = 0, coff2 = 0;
  DI void rot(f32x4& v0, f32x4& v1, int row, int col) const {
    const f32x4* cp = (const f32x4*)(rope + (row & 2047) * 32 + ((col & 63) >> 1));
    const f32x4 c01 = cp[0], c23 = cp[1];
    const f32x4 a = {v0[0] * c01[0] - v0[1] * c01[1], v0[1] * c01[0] + v0[0] * c01[1], v0[2] * c01[2] - v0[3] * c01[3], v0[3] * c01[2] + v0[2] * c01[3]};
    const f32x4 b = {v1[0] * c23[0] - v1[1] * c23[1], v1[1] * c23[0] + v1[0] * c23[1], v1[2] * c23[2] - v1[3] * c23[3], v1[3] * c23[2] + v1[2] * c23[3]};
    v0 = a; v1 = b;
  }
  DI void operator()(const f32x4 (&acc)[2][2][4][2], const pg8::Unit& u, int wr, int wc, int fr, int fq) const {
    const int row0 = u.pm * 256 + wr * 64 + fr, colb = u.pn * 256 + wc * 32 + 8 * fq;
#pragma unroll
    for (int ai = 0; ai < 2; ++ai)
#pragma unroll
      for (int m = 0; m < 4; ++m) {
        const int row = row0 + ai * 128 + m * 16;
#pragma unroll
        for (int bj = 0; bj < 2; ++bj) {
          const int col = colb + bj * 128;
          f32x4 v0 = acc[ai][bj][m][0] * sc, v1 = acc[ai][bj][m][1] * sc;
          u16* dst = nullptr;
          if (MODE == 0) { if (col < N) dst = d0 + (size_t)row * ld0 + (col + coff2 + ((col < csplit) ? (coff1 - coff2) : 0)); }
          else if (MODE == 1) {
            const int oc = col + coff2 + ((col < csplit) ? (coff1 - coff2) : 0);
            if (col < N) {
              if (oc < 2048) dst = d0 + (size_t)row * 2048 + oc;
              else if (oc < 2112) { rot(v0, v1, row, oc); dst = d2 + (size_t)row * 64 + (oc - 2048); }
              else dst = d1 + (size_t)row * 4096 + (oc - 2112);
            }
          } else if (MODE == 3) {
            if (col < N) { const bool lo = col < csplit; u16* bp = lo ? d0 : d1; const int ldd = lo ? 2048 : 4096, oc = lo ? col : col + (coff2 - 2112); dst = bp + (size_t)row * ldd + oc + (lo ? coff1 : 0); }
          } else {
            if (((col >> 6) % 3) == 2) rot(v0, v1, row, col);
            dst = d0 + (size_t)row * 3072 + col;
          }
          if (dst) { u32x4 w = {pk2(v0[0], v0[1]), pk2(v0[2], v0[3]), pk2(v1[0], v1[1]), pk2(v1[2], v1[3])}; *(u32x4*)dst = w; }
        }
        asm volatile("" ::: "memory");
      }
  }
};

template <bool FP8 = false, class Epi>
DI void run_gemm(const u16* A, int lda, const u16* Bt, int M, int N, int K, const Epi& e, char* smem, int nA = 0, int uA = 0, int uB = 0) {
  __syncthreads();
  pg8::Gemm g{A, Bt, M, N, K, lda};
  pg8::StaticOrder S; S.init(M, N, gridDim.x, blockIdx.x);
  if (nA > 0 && (int)gridDim.x > nA && nA * uA + ((int)gridDim.x - nA) * uB == S.nwg) { S.nA = nA; S.uA = uA; S.uB = uB; }
  pg8::gemm_phase<FP8>(( __attribute__((address_space(3))) unsigned char*)smem, g, S, e);
  __syncthreads();
}

typedef __attribute__((address_space(3))) unsigned* lds_u32p;
template <int OFF> DI void rd4(bf16x8 (&f)[4], unsigned addr) {
  asm volatile("ds_read_b128 %0, %4 offset:%5\n\tds_read_b128 %1, %4 offset:%6\n\tds_read_b128 %2, %4 offset:%7\n\tds_read_b128 %3, %4 offset:%8\n\ts_waitcnt lgkmcnt(0)"
               : "=&v"(f[0]), "=&v"(f[1]), "=&v"(f[2]), "=&v"(f[3]) : "v"(addr), "i"(OFF), "i"(OFF + 32), "i"(OFF + 64), "i"(OFF + 96) : "memory");
}
template <int OFF> DI void rdv8(s16x4 (&v)[8], unsigned addr) {
  asm volatile("ds_read_b64_tr_b16 %0, %8 offset:%9\n\tds_read_b64_tr_b16 %1, %8 offset:%10\n\tds_read_b64_tr_b16 %2, %8 offset:%11\n\tds_read_b64_tr_b16 %3, %8 offset:%12\n\t"
               "ds_read_b64_tr_b16 %4, %8 offset:%13\n\tds_read_b64_tr_b16 %5, %8 offset:%14\n\tds_read_b64_tr_b16 %6, %8 offset:%15\n\tds_read_b64_tr_b16 %7, %8 offset:%16\n\ts_waitcnt lgkmcnt(0)"
               : "=&v"(v[0]), "=&v"(v[1]), "=&v"(v[2]), "=&v"(v[3]), "=&v"(v[4]), "=&v"(v[5]), "=&v"(v[6]), "=&v"(v[7])
               : "v"(addr), "i"(OFF), "i"(OFF + 512), "i"(OFF + 1024), "i"(OFF + 1536), "i"(OFF + 2048), "i"(OFF + 2560), "i"(OFF + 3072), "i"(OFF + 3584) : "memory");
}
template <int KSTR, int ND, int N>
DI f32x16 s_block(unsigned kaddr, const bf16x8* qf) {
  const f32x16 z16 = {0.f, 0.f, 0.f, 0.f, 0.f, 0.f, 0.f, 0.f, 0.f, 0.f, 0.f, 0.f, 0.f, 0.f, 0.f, 0.f};
  bf16x8 f[4];
  rd4<N * 32 * KSTR>(f, kaddr);
  f32x16 a = MFMA(f[0], qf[0], z16); a = MFMA(f[1], qf[1], a); a = MFMA(f[2], qf[2], a); a = MFMA(f[3], qf[3], a);
  if constexpr (ND > 4) { rd4<N * 32 * KSTR + 128>(f, kaddr); a = MFMA(f[0], qf[4], a); a = MFMA(f[1], qf[5], a); a = MFMA(f[2], qf[6], a); a = MFMA(f[3], qf[7], a); }
  if constexpr (ND > 8) { rd4<N * 32 * KSTR + 256>(f, kaddr); a = MFMA(f[0], qf[8], a); a = MFMA(f[1], qf[9], a); a = MFMA(f[2], qf[10], a); a = MFMA(f[3], qf[11], a); }
  if constexpr (ND > 12) { rd4<N * 32 * KSTR + 384>(f, kaddr); a = MFMA(f[0], qf[12], a); a = MFMA(f[1], qf[13], a); a = MFMA(f[2], qf[14], a); a = MFMA(f[3], qf[15], a); }
  return a;
}
template <int CB> DI void pv_block(f32x16& o, unsigned vaddr, const bf16x8 (&pb)[2][2]) {
  s16x4 v[8];
  rdv8<CB * 4096>(v, vaddr);
#pragma unroll
  for (int q = 0; q < 4; ++q) {
    const bf16x8 vf = {v[2 * q][0], v[2 * q][1], v[2 * q][2], v[2 * q][3], v[2 * q + 1][0], v[2 * q + 1][1], v[2 * q + 1][2], v[2 * q + 1][3]};
    o = MFMA(vf, pb[q >> 1][q & 1], o);
  }
}
template <int DQK, int W1, int DV, int VW, int MODE>
DI void attn_core(const u16* __restrict__ k1, int ldk1, const u16* __restrict__ k2, int ldk2, const u16* __restrict__ vsrc, int ldv,
                  int kv_len, int kbase0, int ntiles, const u16* qrow, int tq, int tq0, float c2, int vcb0, u16* yrow,
                  const u16* grow, const unsigned* maskrow, const float* lutw, float bias_far, float m_init, float l_init, char* smem) {
  constexpr int KSTR = DQK * 2 + 16, KCH = DQK / 8;
  constexpr int ND = DQK / 16, NCB = DV / 32, BUF = 64 * KSTR + (VW / 32) * 4096;
  constexpr int NKI = KSTR / 16, NVI = VW / 8;
  static_assert(ND % 4 == 0 && NCB <= 4, "fragment batches");
  int tid0 = threadIdx.x; asm volatile("" : "+v"(tid0));
  const int lane = tid0 & 63, r32 = lane & 31, hi = lane >> 5;
  const int wv = __builtin_amdgcn_readfirstlane(tid0 >> 6);
  const unsigned lds0 = (unsigned)(uintptr_t)smem;
  bf16x8 qf[ND];
#pragma unroll
  for (int d0 = 0; d0 < ND; ++d0) qf[d0] = *(const bf16x8*)(qrow + d0 * 16 + hi * 8);
  f32x16 o[NCB];
#pragma unroll
  for (int cb = 0; cb < NCB; ++cb)
#pragma unroll
    for (int r = 0; r < 16; ++r) o[cb][r] = 0.f;
  float m = m_init, l = (hi == 0) ? l_init : 0.f;
  const unsigned klane = (unsigned)(r32 * KSTR + hi * 16);
  const unsigned vlane = (unsigned)(64 * KSTR + vcb0 * 4096 + ((lane >> 4) & 1) * 32 + (lane & 3) * 8 + (4 * hi + ((lane & 15) >> 2)) * 64);
  unsigned mwn[2] = {0u, 0u};
  constexpr int NKS = (NKI + 7) / 8, NVS = (NVI + 7) / 8;
  const u16* kptr[NKS]; int kstr[NKS]; const u16* vptr[NVS];
  if (MODE != 2) {
    int ln = threadIdx.x & 63; asm volatile("" : "+v"(ln));
#pragma unroll
    for (int ii = 0; ii < NKS; ++ii) {
      const int i = wv + 8 * ii, ob = i * 1024 + ln * 16, row = ob / KSTR;
      int c = (ob - row * KSTR) >> 4; c = (c >= KCH) ? 0 : c;
      const bool seg1 = c < W1 / 8;
      kptr[ii] = seg1 ? (k1 + ((kbase0 + row) * ldk1 + c * 8)) : (k2 + ((kbase0 + row) * ldk2 + (c - W1 / 8) * 8));
      kstr[ii] = seg1 ? 64 * ldk1 : 64 * ldk2;
    }
#pragma unroll
    for (int ii = 0; ii < NVS; ++ii) {
      const int i = wv + 8 * ii, ob = i * 1024 + ln * 16, cbk = ob >> 12, row = (ob & 4095) >> 6, cw = (ob & 63) >> 4;
      vptr[ii] = vsrc + ((kbase0 + row) * ldv + (cbk * 4 + cw) * 8);
    }
  }
  auto stage_tile = [&](int kb, int buf) {
    const unsigned bofs = (unsigned)(buf * BUF);
    if (MODE != 2) {
#pragma unroll
      for (int ii = 0; ii < NKS; ++ii) {
        const int i = wv + 8 * ii;
        if (i < NKI) { __builtin_amdgcn_global_load_lds((const unsigned*)kptr[ii], (lds_u32p)(smem + bofs + i * 1024), 16, 0, 0); kptr[ii] += kstr[ii]; }
      }
#pragma unroll
      for (int ii = 0; ii < NVS; ++ii) {
        const int i = wv + 8 * ii;
        if (i < NVI) { __builtin_amdgcn_global_load_lds((const unsigned*)vptr[ii], (lds_u32p)(smem + bofs + 64 * KSTR + i * 1024), 16, 0, 0); vptr[ii] += 64 * ldv; }
      }
    } else {
      int ln = threadIdx.x & 63; asm volatile("" : "+v"(ln));
#pragma unroll
      for (int ii = 0; ii < NKS; ++ii) {
        const int i = wv + 8 * ii;
        if (i < NKI) {
          const int ob = i * 1024 + ln * 16, row = ob / KSTR;
          int c = (ob - row * KSTR) >> 4; c = (c >= KCH) ? 0 : c;
          int key = kb + row; key = key < 0 ? 0 : (key >= kv_len ? kv_len - 1 : key);
          const u16* src = (c < W1 / 8) ? (k1 + (key * ldk1 + c * 8)) : (k2 + (key * ldk2 + (c - W1 / 8) * 8));
          __builtin_amdgcn_global_load_lds((const unsigned*)src, (lds_u32p)(smem + bofs + i * 1024), 16, 0, 0);
        }
      }
#pragma unroll
      for (int ii = 0; ii < NVS; ++ii) {
        const int i = wv + 8 * ii;
        if (i < NVI) {
          const int ob = i * 1024 + ln * 16, cbk = ob >> 12, row = (ob & 4095) >> 6, cw = (ob & 63) >> 4;
          int key = kb + row; key = key < 0 ? 0 : (key >= kv_len ? kv_len - 1 : key);
          __builtin_amdgcn_global_load_lds((const unsigned*)(vsrc + (key * ldv + (cbk * 4 + cw) * 8)), (lds_u32p)(smem + bofs + 64 * KSTR + i * 1024), 16, 0, 0);
        }
      }
    }
    if (MODE == 1) { mwn[0] = maskrow[(kb >> 5)]; mwn[1] = maskrow[(kb >> 5) + 1]; }
  };
  stage_tile(kbase0, 0);
  asm volatile("s_waitcnt vmcnt(0)" ::: "memory");
  __syncthreads();
  for (int t = 0; t < ntiles; ++t) {
    const int kb = kbase0 + t * 64;
    const unsigned bufa = lds0 + (unsigned)((t & 1) * BUF);
    const unsigned mw0 = mwn[0], mw1 = mwn[1];
    if (t + 1 < ntiles) stage_tile(kb + 64, (t + 1) & 1);
    if (!(MODE == 0 && kb > tq0 + 31)) {
      f32x16 s[2];
      s[0] = s_block<KSTR, ND, 0>(bufa + klane, qf);
      s[1] = s_block<KSTR, ND, 1>(bufa + klane, qf);
      if (MODE == 0) {
        s[0] = s[0] * c2; s[1] = s[1] * c2;
        if (__builtin_amdgcn_readfirstlane((int)(kb + 63 > tq0))) {
#pragma unroll
          for (int n = 0; n < 2; ++n)
#pragma unroll
            for (int i = 0; i < 16; ++i) { const int key = kb + 32 * n + crow(i, hi); if (key > tq) s[n][i] = NEGV; }
        }
      } else if (MODE == 1) {
        const bool far = (tq0 - (kb + 63)) >= 128;
#pragma unroll
        for (int n = 0; n < 2; ++n) {
          const unsigned wb = (n ? mw1 : mw0) >> (4 * hi);
          if (far) {
#pragma unroll
            for (int i = 0; i < 16; ++i) {
              const float v = fmaf(s[n][i], c2, bias_far);
              s[n][i] = ((wb >> ((i & 3) + 8 * (i >> 2))) & 1u) ? v : NEGV;
            }
          } else {
#pragma unroll
            for (int i = 0; i < 16; ++i) {
              const int key = kb + 32 * n + crow(i, hi);
              int rel = tq - key; rel = rel < 0 ? 0 : (rel > 128 ? 128 : rel);
              const float v = fmaf(s[n][i], c2, lutw[rel]);
              s[n][i] = ((wb >> ((i & 3) + 8 * (i >> 2))) & 1u) ? v : NEGV;
            }
          }
        }
      } else if (MODE == 2) {
#pragma unroll
        for (int n = 0; n < 2; ++n)
#pragma unroll
          for (int i = 0; i < 16; ++i) {
            const int key = kb + 32 * n + crow(i, hi), rel = tq - key;
            const bool ok = ((unsigned)rel < 128u) && (key >= 0);
            const float v = fmaf(s[n][i], c2, lutw[rel & 127]);
            s[n][i] = ok ? v : NEGV;
          }
      } else {
#pragma unroll
        for (int n = 0; n < 2; ++n)
#pragma unroll
          for (int i = 0; i < 16; ++i) s[n][i] *= c2;
      }
      float mx = s[0][0];
#pragma unroll
      for (int i = 1; i < 16; ++i) mx = fmaxf(mx, s[0][i]);
#pragma unroll
      for (int i = 0; i < 16; ++i) mx = fmaxf(mx, s[1][i]);
      mx = xhalf_max(mx);
      if (__any(mx - m > 8.0f)) {
        const float mnew = fmaxf(m, mx), alpha = __builtin_amdgcn_exp2f(m - mnew);
        m = mnew; l *= alpha;
#pragma unroll
        for (int cb = 0; cb < NCB; ++cb)
#pragma unroll
          for (int r = 0; r < 16; ++r) o[cb][r] *= alpha;
      }
      {
        const float nm = -m;
        f32x16 e0 = s[0] + nm, e1 = s[1] + nm;
#pragma unroll
        for (int i = 0; i < 16; ++i) { e0[i] = __builtin_amdgcn_exp2f(e0[i]); e1[i] = __builtin_amdgcn_exp2f(e1[i]); }
        s[0] = e0; s[1] = e1;
        const f32x16 sm = e0 + e1;
        typedef __attribute__((ext_vector_type(8))) float f32x8;
        const f32x8 h8 = sm.lo + sm.hi;
        const f32x4 h4 = h8.lo + h8.hi;
        const f32x2 h2 = h4.lo + h4.hi;
        l += h2[0] + h2[1];
      }
      bf16x8 pb[2][2];
#pragma unroll
      for (int n = 0; n < 2; ++n)
#pragma unroll
        for (int s2 = 0; s2 < 2; ++s2) {
          u32x4 pw = {pk2(s[n][8 * s2 + 0], s[n][8 * s2 + 1]), pk2(s[n][8 * s2 + 2], s[n][8 * s2 + 3]),
                      pk2(s[n][8 * s2 + 4], s[n][8 * s2 + 5]), pk2(s[n][8 * s2 + 6], s[n][8 * s2 + 7])};
          pb[n][s2] = __builtin_bit_cast(bf16x8, pw);
        }
      pv_block<0>(o[0], bufa + vlane, pb);
      if constexpr (NCB > 1) pv_block<1>(o[1], bufa + vlane, pb);
      if constexpr (NCB > 2) pv_block<2>(o[2], bufa + vlane, pb);
      if constexpr (NCB > 3) pv_block<3>(o[3], bufa + vlane, pb);
    }
    asm volatile("s_waitcnt vmcnt(0)" ::: "memory");
    __syncthreads();
  }
  const float inv = __builtin_amdgcn_rcpf(xhalf_sum(l));
#pragma unroll
  for (int cb = 0; cb < NCB; ++cb)
#pragma unroll
    for (int g = 0; g < 4; ++g) {
      const int dv = 32 * cb + 8 * g + 4 * hi;
      const u32x2 gg = *(const u32x2*)(grow + dv);
      float gv[4] = {bf2f(gg[0] & 0xffffu), bf2f(gg[0] >> 16), bf2f(gg[1] & 0xffffu), bf2f(gg[1] >> 16)};
      float ov[4];
#pragma unroll
      for (int j = 0; j < 4; ++j) {
        const float sg = gv[j] * __builtin_amdgcn_rcpf(1.f + __builtin_amdgcn_exp2f(-LOG2E * gv[j]));
        ov[j] = o[cb][4 * g + j] * inv * sg;
      }
      *(unsigned*)((unsigned char*)yrow + dv) = pk4_fp8(ov[0] * Y_SCALE, ov[1] * Y_SCALE, ov[2] * Y_SCALE, ov[3] * Y_SCALE);
      __builtin_amdgcn_sched_barrier(0);
    }
}

DI unsigned ordkey(float f) { const unsigned b = __float_as_uint(f); return b ^ ((unsigned)((int)b >> 31) | 0x80000000u); }
DI void indexer_phase(const u16* __restrict__ P, unsigned* __restrict__ mask) {
  int tidx = threadIdx.x; asm volatile("" : "+v"(tidx));
  const int lane = tidx & 63, r32 = lane & 31, hi = lane >> 5;
  const int gw = blockIdx.x * 8 + (tidx >> 6), nw = gridDim.x * 8;
  for (int base = 0, pass = 0; base < 8192; base += nw, ++pass) {
    const int item = (pass & 1) ? base + (nw - 1 - gw) : base + gw;
    if (item >= 8192) continue;
    const int b = item & 7, t0 = (1023 - (item >> 3)) * 2;
    const size_t brow = (size_t)b * SEQ;
    const int g = (r32 >> 2) & 1, head = 4 * (r32 >> 3) + (r32 & 3);
    bf16x8 aq[4];
#pragma unroll
    for (int s = 0; s < 4; ++s) aq[s] = *(const bf16x8*)(P + (brow + t0 + g) * 7808 + 2560 + head * 64 + 16 * s + 8 * hi);
    float wv[16];
    {
      const u32x4 w0 = *(const u32x4*)(P + (brow + t0 + hi) * 7808 + 3648), w1 = *(const u32x4*)(P + (brow + t0 + hi) * 7808 + 3656);
#pragma unroll
      for (int j = 0; j < 4; ++j) { wv[2 * j] = bf2f(w0[j] & 0xffffu); wv[2 * j + 1] = bf2f(w0[j] >> 16); wv[8 + 2 * j] = bf2f(w1[j] & 0xffffu); wv[8 + 2 * j + 1] = bf2f(w1[j] >> 16); }
    }
    const int tme = t0 + hi, kbmax = (t0 + 1) >> 5;
    unsigned sc[64];
#pragma unroll
    for (int kb = 0; kb < 64; ++kb) {
      unsigned u = 0u;
      if (kb <= kbmax) {
        f32x16 a;
#pragma unroll
        for (int r = 0; r < 16; ++r) a[r] = 0.f;
        const u16* kp = P + (brow + 32 * kb + r32) * 7808 + 3584 + 8 * hi;
#pragma unroll
        for (int s = 0; s < 4; ++s) { const bf16x8 bk = *(const bf16x8*)(kp + 16 * s); a = MFMA(aq[s], bk, a); }
        float v = 0.f;
#pragma unroll
        for (int i = 0; i < 16; ++i) v = fmaf(wv[i], fmaxf(a[i], 0.f), v);
        u = (32 * kb + r32 <= tme) ? ordkey(v) : 0u;
      }
      sc[kb] = u;
    }
    const int target = (tme + 1 < 256) ? tme + 1 : 256;
    unsigned T = 0u;
    for (int bit = 31; bit >= 0; --bit) {
      const unsigned Tp = T | (1u << bit);
      int cnt = 0;
#pragma unroll
      for (int kb = 0; kb < 64; ++kb) cnt += (sc[kb] >= Tp) ? 1 : 0;
#pragma unroll
      for (int o = 16; o; o >>= 1) cnt += __shfl_xor(cnt, o);
      if (cnt >= target) T = Tp;
    }
    unsigned w0 = 0u, w1 = 0u;
#pragma unroll
    for (int kb = 0; kb < 64; ++kb) {
      const bool pred = (sc[kb] >= T) && (sc[kb] != 0u);
      const unsigned long long bal = __ballot(pred);
      const unsigned wd = (unsigned)(bal >> (32 * hi));
      if ((kb & 31) == r32) { if (kb < 32) w0 = wd; else w1 = wd; }
    }
    mask[(brow + tme) * 64 + r32] = w0;
    mask[(brow + tme) * 64 + 32 + r32] = w1;
  }
}

DI void gbar(unsigned* cnt, unsigned target) {
  asm volatile("s_waitcnt vmcnt(0)" ::: "memory");
  __syncthreads();
  if (threadIdx.x == 0) {
    __builtin_amdgcn_fence(__ATOMIC_RELEASE, "agent");
    asm volatile("s_waitcnt vmcnt(0)" ::: "memory");
    __hip_atomic_fetch_add(cnt, 1u, __ATOMIC_RELAXED, __HIP_MEMORY_SCOPE_AGENT);
    while (__hip_atomic_load(cnt, __ATOMIC_RELAXED, __HIP_MEMORY_SCOPE_AGENT) < target) __builtin_amdgcn_s_sleep(1);
    __builtin_amdgcn_fence(__ATOMIC_ACQUIRE, "agent");
    asm volatile("s_waitcnt vmcnt(0)" ::: "memory");
  }
  __syncthreads();
}
#define GSYNC() do { ++bar_gen; gbar(BAR, bar_gen * gridDim.x); } while (0)
__global__ void __launch_bounds__(512, 2) mega(Params p) {
  cg::grid_group grid = cg::this_grid();
  extern __shared__ __attribute__((aligned(16))) char smem[];
  volatile int* s_item = (volatile int*)(smem + LDS_ITEM);
  char* ws = p.ws;
  unsigned char* Y8 = (unsigned char*)(ws + OFF_Y);
  u16* WIN8 = (u16*)(ws + OFF_WIN + 19922944);
  unsigned char* CQ8 = (unsigned char*)(ws + OFF_Y + 67108864);     u16* H = (u16*)(ws + OFF_H); u16* Cb = (u16*)(ws + OFF_Y); u16* Qb = (u16*)(ws + OFF_H);
  u16* KV = (u16*)(ws + OFF_KV); u16* MG = (u16*)(ws + OFF_MG); u16* KR = (u16*)(ws + OFF_KR); u16* Pb = (u16*)(ws + OFF_P);
  u16* WIN = (u16*)(ws + OFF_WIN); u16* WUQ = (u16*)(ws + OFF_WUQ); u16* WUKV = (u16*)(ws + OFF_WUKV); u16* WOUT = (u16*)(ws + OFF_WOUT);
  u16* WMEMALL = (u16*)(ws + OFF_KV); u16* MEMN = (u16*)(ws + OFF_MEMN); u16* MEMKV = (u16*)(ws + OFF_MEMKV);
  unsigned* MASK = (unsigned*)(ws + OFF_MASK); f32x2* ROPE = (f32x2*)(ws + OFF_ROPE); float* LUT = (float*)(ws + OFF_LUT);
  int* CTR = (int*)(ws + OFF_CTR);
  unsigned* BAR = (unsigned*)(ws + OFF_CTR) + 64;
  unsigned bar_gen = 0;
  const int tid = threadIdx.x, lane = tid & 63, wv = __builtin_amdgcn_readfirstlane(tid >> 6), r32 = lane & 31, hi = lane >> 5;
  const int gtid = blockIdx.x * 512 + tid, gthreads = gridDim.x * 512;

  for (int i = gtid; i < 2048 * 32; i += gthreads) {
    const int pos = i >> 5, j = i & 31;
    const float inv = 1.0f / powf(10000.0f, (float)(2 * j) / 64.0f);
    const float ang = (float)pos * inv;
    const float k = rintf(ang * 0.15915494309189535f);
    float r = fmaf(-k, 6.28318548202514648f, ang);
    r = fmaf(-k, -1.74845553e-7f, r);
    f32x2 cs = {__cosf(r), __sinf(r)};
    ROPE[i] = cs;
  }
  for (int i = gtid; i < 129 * 32; i += gthreads) {
    const int rel = i >> 5, h = i & 31;
    int bucket;
    if (rel < 16) bucket = rel;
    else { const int lg = 16 + (int)(logf((float)rel / 16.0f) / 2.0794415416798357f * 16.0f); bucket = lg < 31 ? lg : 31; }
    LUT[i] = p.rel_bias[bucket * 32 + h] * LOG2E;
  }
  rmsnorm_rows<false>(p.mem, p.mem_norm, MEMN, 2048);
#pragma unroll 1
  for (int l = 0; l < 4; ++l) convert_wt<0>(p.w_mem_kv + (size_t)l * 2048 * 2048, 2048, 2048, 2048, WMEMALL + (size_t)l * 2048 * 2048, smem);

  auto convert_layer = [&](int L) {
    const int kind = L % 3, j = L / 3;
    if (kind == 0) {
    convert_wt<1>(p.w_in_a + (size_t)j * 2048 * 6208, 2048, 6208, 3840, WIN, smem, 1.f, 3648, 576, 1536, 2560, 512);
    convert_wt<0, true>(p.w_in_a + (size_t)j * 2048 * 6208, 2048, 6208, 2560, WIN8, smem, WIN_SCALE, 2560, 1536, 0, 576);
    convert_wt<2, true>(p.w_uq + (size_t)j * 1536 * 3072, 1536, 3072, 3072, WUQ, smem, WUQ_SCALE);
    convert_wt<0>(p.w_ukv + (size_t)j * 512 * 4096, 512, 4096, 4096, WUKV, smem);
  } else if (kind == 1) {
    convert_wt<0>(p.w_in_b, 2048, 7760, 4864, WIN, smem, 1.f, 4688, 1616, 2048, 3072);
    convert_wt<0, true>(p.w_in_b, 2048, 7760, 3072, WIN8, smem, WIN_SCALE, 3072, 2048, 0, 1616);
  } else {
    convert_wt<0>(p.w_in_c, 2048, 6656, 3584, WIN, smem, 1.f, 3584, 512, 2048, 3072);
    convert_wt<0, true>(p.w_in_c, 2048, 6656, 3072, WIN8, smem, WIN_SCALE, 3072, 2048, 0, 512);
  }
  };
#pragma unroll 1
  for (int layer = 0; layer < 4; ++layer) {
    const int kind = layer % 3, j = layer / 3;
    const float* xin = (layer == 0) ? p.x : p.out;
    unsigned char* H8 = (unsigned char*)(ws + ((kind == 0) ? OFF_KV + 67108864 : OFF_Y));
    rmsnorm_rows<false>(xin, p.norm_in + layer * 2048, H, NTOK, H8);
    if (layer == 0) convert_layer(0);
    if (layer == 0) { __builtin_amdgcn_fence(__ATOMIC_RELEASE, "agent"); grid.sync(); __builtin_amdgcn_fence(__ATOMIC_ACQUIRE, "agent"); asm volatile("s_waitcnt vmcnt(0)" ::: "memory"); }
    else GSYNC();

    if (kind == 0) {
      { EpiBf<1> e{Cb, 2048, 3648, MG, KR, ROPE, 1.f, 576, 1536, 2560}; run_gemm(H, 2048, WIN, NTOK, 3840, 2048, e, smem); }
      { EpiBf<3> e{Cb, 2048, 2560, MG, nullptr, nullptr, 1.f / (H_SCALE * WIN_SCALE), 1536, 0, 576}; run_gemm<true>((const u16*)H8, 1024, WIN8, NTOK, 2560, 1024, e, smem, 192, 2, 4); }
    }
    else if (kind == 1) {
      { EpiBf<0> e{Pb, 7808, 4688, nullptr, nullptr, nullptr, 1.f, 1616, 2048, 3072}; run_gemm(H, 2048, WIN, NTOK, 4864, 2048, e, smem); }
      { EpiBf<0> e{Pb, 7808, 3072, nullptr, nullptr, nullptr, 1.f / (H_SCALE * WIN_SCALE), 2048, 0, 1616}; run_gemm<true>((const u16*)H8, 1024, WIN8, NTOK, 3072, 1024, e, smem); }
    } else {
      { EpiBf<0> e{Pb, 6656, 3584, nullptr, nullptr, nullptr, 1.f, 512, 2048, 3072}; run_gemm(H, 2048, WIN, NTOK, 3584, 2048, e, smem); }
      { EpiBf<0> e{Pb, 6656, 3072, nullptr, nullptr, nullptr, 1.f / (H_SCALE * WIN_SCALE), 2048, 0, 512}; run_gemm<true>((const u16*)H8, 1024, WIN8, NTOK, 3072, 1024, e, smem, 128, 2, 4); }
    }
    if (layer == 0) { EpiBf<0> e{MEMKV, 8192, 8192, nullptr, nullptr, nullptr}; run_gemm(MEMN, 2048, WMEMALL, 2048, 8192, 2048, e, smem); }
    GSYNC();

    if (kind == 0) {
      anorm_phase(Cb, p.a_q_norm + j * 1536, p.a_kv_norm + j * 512, CQ8);
      GSYNC();
      { EpiBf<2> e{Qb, 3072, 3072, nullptr, nullptr, ROPE, 1.f / (CQ_SCALE * WUQ_SCALE)}; run_gemm<true>((const u16*)CQ8, 768, WUQ, NTOK, 3072, 768, e, smem); }
      { EpiBf<0> e{KV, 4096, 4096, nullptr, nullptr, nullptr}; run_gemm(Cb + 1536, 2048, WUKV, NTOK, 4096, 512, e, smem); }
      GSYNC();
    } else if (kind == 1) {
      indexer_phase(Pb, MASK);
      GSYNC();
    }

    {
      const int nself = (kind == 0) ? 1024 : 2048, total = nself + 512;
      const u16* mgb = (kind == 0) ? MG : Pb;
      const int ldmg = (kind == 0) ? 4096 : (kind == 1 ? 7808 : 6656);
      const int mqcol = (kind == 0) ? 0 : (kind == 1 ? 3664 : 2560);
      const int gatecol = (kind == 0) ? 1024 : (kind == 1 ? 4688 : 3584);
      const u16* memkv = MEMKV + layer * 2048;
      float* lut_all = (float*)(smem + LDS_LUT);
      if (kind != 0) {
        for (int i = tid; i < 32 * 129; i += 512) { const int h = i / 129, r = i - h * 129; lut_all[h * 132 + r] = LUT[r * 32 + h]; }
      }
      if (tid == 0) s_item[0] = atomicAdd(&CTR[layer], 1);
      __syncthreads();
      for (int par = 0;; par ^= 1) {
        const int item = __builtin_amdgcn_readfirstlane(s_item[par]);
        if (item >= total) break;
        if (tid == 0) s_item[par ^ 1] = atomicAdd(&CTR[layer], 1);
        if (item < nself) {
          if (kind == 0) {
            const int qblk = 7 - item / 128, rem = item % 128, b = rem / 16, head = rem % 16;
            const size_t brow = (size_t)b * SEQ;
            const int tq0 = qblk * 256 + 32 * wv, tq = tq0 + r32;
            attn_core<192, 128, 128, 128, 0>(KV + brow * 4096 + head * 256, 4096, KR + brow * 64, 64, KV + brow * 4096 + head * 256 + 128, 4096,
                                            SEQ, 0, 4 * qblk + 4, Qb + (brow + tq) * 3072 + head * 192, tq, tq0, 0.07216878364870322f * LOG2E, 0,
                                            (u16*)(Y8 + (brow + tq) * 3072 + head * 128), mgb + (brow + tq) * ldmg + gatecol + head * 128,
                                            nullptr, nullptr, 0.f, -1e29f, 0.f, smem);
          } else {
            const int qb = 63 - item / 32, rem = item % 32, b = rem / 4, kvh = rem % 4;
            const size_t brow = (size_t)b * SEQ;
            const int head = kvh * 8 + wv, tq0 = qb * 32, tq = tq0 + r32;
            const float* lutw = lut_all + head * 132;
            if (kind == 1) {
              attn_core<64, 64, 64, 64, 1>(Pb + brow * 7808 + 2048 + kvh * 64, 7808, nullptr, 0, Pb + brow * 7808 + 2304 + kvh * 64, 7808,
                                          SEQ, 0, (tq0 + 31) / 64 + 1, Pb + (brow + tq) * 7808 + head * 64, tq, tq0, 0.125f * LOG2E, 0,
                                          (u16*)(Y8 + (brow + tq) * 3072 + head * 64), Pb + (brow + tq) * 7808 + gatecol + head * 64,
                                          MASK + (brow + tq) * 64, lutw, lutw[128], -1e29f, 0.f, smem);
            } else {
              const float sink = p.c_sinks[j * 32 + head] * LOG2E;
              attn_core<64, 64, 64, 64, 2>(Pb + brow * 6656 + 2048 + kvh * 64, 6656, nullptr, 0, Pb + brow * 6656 + 2304 + kvh * 64, 6656,
                                          SEQ, tq0 - 128, 3, Pb + (brow + tq) * 6656 + head * 64, tq, tq0, 0.125f * LOG2E, 0,
                                          (u16*)(Y8 + (brow + tq) * 3072 + head * 64), Pb + (brow + tq) * 6656 + gatecol + head * 64,
                                          nullptr, lutw, 0.f, sink, 1.f, smem);
            }
          }
        } else {
          const int it = item - nself, b = it / 64, mh = (it % 64) / 16, qb = it % 16;
          const size_t brow = (size_t)b * SEQ;
          const int tq0 = qb * 128 + 32 * (wv >> 1), tq = tq0 + r32, vh = wv & 1;
          attn_core<256, 256, 128, 256, 3>(memkv + (size_t)b * 256 * 8192 + mh * 256, 8192, nullptr, 0, memkv + (size_t)b * 256 * 8192 + 1024 + mh * 256, 8192,
                                          256, 0, 4, mgb + (brow + tq) * ldmg + mqcol + mh * 256, tq, tq0, 0.0625f * LOG2E, 4 * vh,
                                          (u16*)(Y8 + (brow + tq) * 3072 + 2048 + mh * 256 + 128 * vh), mgb + (brow + tq) * ldmg + gatecol + 2048 + mh * 256 + 128 * vh,
                                          nullptr, nullptr, 0.f, -1e29f, 0.f, smem);
        }
      }
    }
    convert_wt<0, true>(p.w_out + (size_t)layer * 3072 * 2048, 3072, 2048, 2048, WOUT, smem, WOUT_SCALE);
    if (layer + 1 < 4) convert_layer(layer + 1);
    GSYNC();

    { EpiResid e{xin, p.out, 1.f / (Y_SCALE * WOUT_SCALE)}; run_gemm<true>((const u16*)Y8, 1536, WOUT, NTOK, 2048, 1536, e, smem); }
    GSYNC();
  }
  rmsnorm_rows<true>(p.out, p.final_norm, p.out, NTOK);
}

extern "C" void kernel_launch(void* const* d_in, const int* in_sizes, int n_in, void* d_out, int out_size,
                              void* d_ws, size_t ws_size, hipStream_t stream) {
  static int grid_blocks = 0;
  if (!grid_blocks) {
    int dev = 0, cus = 0, per_cu = 0;
    (void)hipGetDevice(&dev);
    (void)hipDeviceGetAttribute(&cus, hipDeviceAttributeMultiprocessorCount, dev);
    (void)hipFuncSetAttribute((const void*)mega, hipFuncAttributeMaxDynamicSharedMemorySize, LDS_BYTES);
    (void)hipOccupancyMaxActiveBlocksPerMultiprocessor(&per_cu, mega, 512, LDS_BYTES);
    if (per_cu > 1) per_cu = 1;
    grid_blocks = cus * per_cu;
  }
  Params p{};
  p.x = (const float*)d_in[0]; p.mem = (const float*)d_in[1]; p.norm_in = (const float*)d_in[2]; p.final_norm = (const float*)d_in[3];
  p.mem_norm = (const float*)d_in[4]; p.rel_bias = (const float*)d_in[5]; p.w_in_a = (const float*)d_in[6]; p.a_q_norm = (const float*)d_in[7];
  p.w_uq = (const float*)d_in[8]; p.a_kv_norm = (const float*)d_in[9]; p.w_ukv = (const float*)d_in[10]; p.w_in_b = (const float*)d_in[11];
  p.w_in_c = (const float*)d_in[12]; p.c_sinks = (const float*)d_in[13]; p.w_mem_kv = (const float*)d_in[14]; p.w_out = (const float*)d_in[15];
  p.out = (float*)d_out; p.ws = (char*)d_ws;
  (void)hipMemsetAsync((char*)d_ws + OFF_CTR, 0, 1024, stream);
  void* args[] = {&p};
  (void)hipLaunchCooperativeKernel((void*)mega, dim3(grid_blocks), dim3(512), args, LDS_BYTES, stream);
}
```

```cpp
#include <hip/hip_runtime.h>
#include <hip/hip_cooperative_groups.h>
#include <stdint.h>
namespace cg = cooperative_groups;

typedef unsigned short u16;
typedef __attribute__((ext_vector_type(8))) short bf16x8;
typedef __attribute__((ext_vector_type(4))) short s16x4;
typedef __attribute__((ext_vector_type(16))) float f32x16;
typedef __attribute__((ext_vector_type(4))) float f32x4;
typedef __attribute__((ext_vector_type(2))) float f32x2;
typedef __attribute__((ext_vector_type(4))) unsigned u32x4;
typedef __attribute__((ext_vector_type(2))) unsigned u32x2;
typedef __attribute__((ext_vector_type(2))) __bf16 bf16x2_t;
typedef short v4i16_t __attribute__((ext_vector_type(4)));
#define DI __device__ __forceinline__
#define MFMA(a, b, c) __builtin_amdgcn_mfma_f32_32x32x16_bf16((a), (b), (c), 0, 0, 0)

constexpr int SEQ = 2048, NTOK = 16384;
constexpr int LDS_LUT = 133120, LDS_ITEM = LDS_LUT + 32 * 528, LDS_BYTES = LDS_ITEM + 64;
constexpr float LOG2E = 1.4426950408889634f;
constexpr float NEGV = -1e30f;
constexpr float Y_SCALE = 16.f, WOUT_SCALE = 256.f, CQ_SCALE = 16.f, WUQ_SCALE = 256.f, H_SCALE = 16.f, WIN_SCALE = 256.f;

constexpr size_t OFF_Y = 0;
constexpr size_t OFF_H = 100663296;
constexpr size_t OFF_KV = 201326592;
constexpr size_t OFF_MG = 335544320;
constexpr size_t OFF_KR = 469762048;
constexpr size_t OFF_P = 167772160;
constexpr size_t OFF_WIN = 471859200;
constexpr size_t OFF_WUQ = OFF_WIN + 32505856;
constexpr size_t OFF_WUKV = OFF_WUQ + 9437184;
constexpr size_t OFF_WOUT = OFF_WUKV + 4194304;
constexpr size_t OFF_MEMN = OFF_WOUT + 12582912;
constexpr size_t OFF_MEMKV = OFF_MEMN + 8388608;
constexpr size_t OFF_MASK = OFF_MEMKV + 33554432;
constexpr size_t OFF_ROPE = OFF_MASK + 4194304;
constexpr size_t OFF_LUT = OFF_ROPE + 524288;
constexpr size_t OFF_CTR = OFF_LUT + 32768;

struct Params {
  const float *x, *mem, *norm_in, *final_norm, *mem_norm, *rel_bias, *w_in_a, *a_q_norm, *w_uq, *a_kv_norm, *w_ukv,
      *w_in_b, *w_in_c, *c_sinks, *w_mem_kv, *w_out;
  float* out;
  char* ws;
};

DI float bf2f(unsigned b) { return __uint_as_float(b << 16); }
DI unsigned pk2(float a, float b) {
  f32x2 v = {a, b};
  return __builtin_bit_cast(unsigned, __builtin_convertvector(v, bf16x2_t));
}
DI float clamp8(float x) { return fminf(fmaxf(x, -448.f), 448.f); }
DI unsigned pk4_fp8(float a, float b, float c, float d) {
  int w = 0;
  w = __builtin_amdgcn_cvt_pk_fp8_f32(clamp8(a), clamp8(b), w, false);
  w = __builtin_amdgcn_cvt_pk_fp8_f32(clamp8(c), clamp8(d), w, true);
  return (unsigned)w;
}
DI u16 f2bf(float a) { return (u16)(pk2(a, 0.f) & 0xffffu); }
DI float wave_sum(float v) {
#pragma unroll
  for (int o = 32; o; o >>= 1) v += __shfl_xor(v, o);
  return v;
}
DI int crow(int reg, int hi) { return (reg & 3) + 8 * (reg >> 2) + 4 * hi; }
DI float xhalf_max(float m) {
  auto rr = __builtin_amdgcn_permlane32_swap(__float_as_uint(m), __float_as_uint(m), false, false);
  return fmaxf(__uint_as_float(rr[0]), __uint_as_float(rr[1]));
}
DI float xhalf_sum(float m) {
  auto rr = __builtin_amdgcn_permlane32_swap(__float_as_uint(m), __float_as_uint(m), false, false);
  return __uint_as_float(rr[0]) + __uint_as_float(rr[1]);
}
typedef __attribute__((address_space(3))) v4i16_t* lds_v4p;
DI s16x4 vtr(const char* p) {
  return __builtin_bit_cast(s16x4, __builtin_amdgcn_ds_read_tr16_b64_v4i16((lds_v4p)(p)));
}

template <int PERM, bool FP8 = false>
DI void convert_wt(const float* __restrict__ W, int K, int N, int Npad, u16* __restrict__ Wt, char* smem, float wscale = 1.f,
                   int nvalid = -1, int csplit = 0, int coff1 = 0, int coff2 = 0, int rot_n0 = 2048) {
  float* tile = (float*)smem;
  int tid = threadIdx.x; asm volatile("" : "+v"(tid));
  const int ntk = K / 64, ntn = Npad / 64;
  for (int t = blockIdx.x; t < ntk * ntn; t += gridDim.x) {
    const int tk = t % ntk, tn = t / ntk, k0 = tk * 64, n0 = tn * 64;
    __syncthreads();
#pragma unroll
    for (int i = 0; i < 2; ++i) {
      const int id = tid + 512 * i, kr = id >> 4, n4 = (id & 15) * 4;
      f32x4 v = {0.f, 0.f, 0.f, 0.f};
      const int nd = n0 + n4, nsrc = (nvalid < 0) ? nd : (nd < csplit ? nd + coff1 : nd + coff2);
      if (nd < ((nvalid < 0) ? N : nvalid)) v = *(const f32x4*)(W + (size_t)(k0 + kr) * N + nsrc);
      tile[kr * 65 + n4 + 0] = v[0]; tile[kr * 65 + n4 + 1] = v[1]; tile[kr * 65 + n4 + 2] = v[2]; tile[kr * 65 + n4 + 3] = v[3];
    }
    __syncthreads();
    {
      const int n = tid >> 3, c = tid & 7;
      bool rot = false;
      if (PERM == 1) rot = (n0 == rot_n0);
      if (PERM == 2) rot = ((tn % 3) == 2);
      const int ns = rot ? ((n >> 1) + 32 * (n & 1)) : n;
      if (FP8) {
        float f[8];
#pragma unroll
        for (int j = 0; j < 8; ++j) f[j] = tile[(c * 8 + j) * 65 + ns] * wscale;
        u32x2 o = {pk4_fp8(f[0], f[1], f[2], f[3]), pk4_fp8(f[4], f[5], f[6], f[7])};
        *(u32x2*)((unsigned char*)Wt + (size_t)(n0 + n) * K + k0 + c * 8) = o;
      } else {
        u32x4 o;
#pragma unroll
        for (int j = 0; j < 4; ++j) o[j] = pk2(tile[(c * 8 + 2 * j) * 65 + ns], tile[(c * 8 + 2 * j + 1) * 65 + ns]);
        *(u32x4*)(Wt + (size_t)(n0 + n) * K + k0 + c * 8) = o;
      }
    }
  }
}

template <bool F32OUT>
DI void rmsnorm_rows(const float* X, const float* __restrict__ g, void* outp, int nrows, unsigned char* __restrict__ out8 = nullptr) {
  int tidx = threadIdx.x; asm volatile("" : "+v"(tidx));
  const int lane = tidx & 63, gw = blockIdx.x * 8 + (tidx >> 6), nw = gridDim.x * 8;
  for (int row = gw; row < nrows; row += nw) {
    const f32x4* xr = (const f32x4*)(X + (size_t)row * 2048);
    f32x4 v[8];
    float ss = 0.f;
#pragma unroll
    for (int i = 0; i < 8; ++i) { v[i] = xr[lane + 64 * i]; ss += v[i][0] * v[i][0] + v[i][1] * v[i][1] + v[i][2] * v[i][2] + v[i][3] * v[i][3]; }
    ss = wave_sum(ss);
    const float r = rsqrtf(ss * (1.f / 2048.f) + 1e-6f);
#pragma unroll
    for (int i = 0; i < 8; ++i) {
      const f32x4 gg = ((const f32x4*)g)[lane + 64 * i];
      f32x4 o = {v[i][0] * r * gg[0], v[i][1] * r * gg[1], v[i][2] * r * gg[2], v[i][3] * r * gg[3]};
      if (F32OUT) ((f32x4*)((float*)outp + (size_t)row * 2048))[lane + 64 * i] = o;
      else { u32x2 pk = {pk2(o[0], o[1]), pk2(o[2], o[3])}; ((u32x2*)((u16*)outp + (size_t)row * 2048))[lane + 64 * i] = pk; }
      if (!F32OUT && out8) ((unsigned*)(out8 + (size_t)row * 2048))[lane + 64 * i] = pk4_fp8(o[0] * H_SCALE, o[1] * H_SCALE, o[2] * H_SCALE, o[3] * H_SCALE);
    }
  }
}

DI void anorm_phase(u16* C, const float* __restrict__ gq, const float* __restrict__ gkv, unsigned char* __restrict__ cq8) {
  int tidx = threadIdx.x; asm volatile("" : "+v"(tidx));
  const int lane = tidx & 63, gw = blockIdx.x * 8 + (tidx >> 6), nw = gridDim.x * 8;
  for (int row = gw; row < NTOK; row += nw) {
    u32x4* cr = (u32x4*)(C + (size_t)row * 2048);
    u32x4 v[4];
    float sq = 0.f, skv = 0.f;
#pragma unroll
    for (int i = 0; i < 4; ++i) {
      v[i] = cr[lane + 64 * i];
      float s = 0.f;
#pragma unroll
      for (int j = 0; j < 4; ++j) { float a = bf2f(v[i][j] & 0xffffu), b = bf2f(v[i][j] >> 16); s += a * a + b * b; }
      if (i < 3) sq += s; else skv += s;
    }
    sq = wave_sum(sq); skv = wave_sum(skv);
    const float rq = rsqrtf(sq * (1.f / 1536.f) + 1e-6f), rkv = rsqrtf(skv * (1.f / 512.f) + 1e-6f);
#pragma unroll
    for (int i = 0; i < 4; ++i) {
      const int col = (lane + 64 * i) * 8;
      const float* gp = (i < 3) ? (gq + col) : (gkv + col - 1536);
      const float r = (i < 3) ? rq : rkv;
      const f32x4 g0 = *(const f32x4*)gp, g1 = *(const f32x4*)(gp + 4);
      u32x4 o;
      o[0] = pk2(bf2f(v[i][0] & 0xffffu) * r * g0[0], bf2f(v[i][0] >> 16) * r * g0[1]);
      o[1] = pk2(bf2f(v[i][1] & 0xffffu) * r * g0[2], bf2f(v[i][1] >> 16) * r * g0[3]);
      o[2] = pk2(bf2f(v[i][2] & 0xffffu) * r * g1[0], bf2f(v[i][2] >> 16) * r * g1[1]);
      o[3] = pk2(bf2f(v[i][3] & 0xffffu) * r * g1[2], bf2f(v[i][3] >> 16) * r * g1[3]);
      cr[lane + 64 * i] = o;
      if (i < 3) {
        const float q0 = bf2f(v[i][0] & 0xffffu) * r * g0[0] * CQ_SCALE, q1 = bf2f(v[i][0] >> 16) * r * g0[1] * CQ_SCALE;
        const float q2 = bf2f(v[i][1] & 0xffffu) * r * g0[2] * CQ_SCALE, q3 = bf2f(v[i][1] >> 16) * r * g0[3] * CQ_SCALE;
        const float q4 = bf2f(v[i][2] & 0xffffu) * r * g1[0] * CQ_SCALE, q5 = bf2f(v[i][2] >> 16) * r * g1[1] * CQ_SCALE;
        const float q6 = bf2f(v[i][3] & 0xffffu) * r * g1[2] * CQ_SCALE, q7 = bf2f(v[i][3] >> 16) * r * g1[3] * CQ_SCALE;
        u32x2 w8 = {pk4_fp8(q0, q1, q2, q3), pk4_fp8(q4, q5, q6, q7)};
        *(u32x2*)(cq8 + (size_t)row * 1536 + col) = w8;
      }
    }
  }
}

namespace pg8 {
#define PG8_LAS __attribute__((address_space(3)))
constexpr int BM = 256, BK = 64, HALF = 128, HTB = HALF * BK * 2, STAGE_BYTES = 8 * HTB, NXCD = 8, WGM = 8;
DI int lds_byte(int r, int c) { const int st = (r >> 4) * 2 + (c >> 5), rr = r & 15, cc = c & 31, ob = rr * 64 + cc * 2; return st * 1024 + (ob ^ (((ob >> 9) & 1) << 5)); }
DI void stage_rc(int b, int& R, int& C) { const int st = b / 1024, sb = b % 1024, swz = sb ^ (((sb >> 9) & 1) << 5); R = (st >> 1) * 16 + swz / 64; C = (st & 1) * 32 + (swz % 64) / 2; }
DI int perm32(int rho) { const int n = rho >> 4, i = rho & 15; return 8 * (i >> 2) + 4 * n + (i & 3); }
typedef int i32x4v __attribute__((ext_vector_type(4)));
typedef int i32x8 __attribute__((ext_vector_type(8)));
DI i32x8 cat8(bf16x8 a, bf16x8 b) { const i32x4v x = __builtin_bit_cast(i32x4v, a), y = __builtin_bit_cast(i32x4v, b); return __builtin_shufflevector(x, y, 0, 1, 2, 3, 4, 5, 6, 7); }
struct Unit { int pm, pn; };
struct Gemm { const u16* A; const u16* Bt; int M, N, K, lda; };
struct StaticOrder {
  int nM, nN, nwg, G, c;
  int nA = 0, uA = 0, uB = 0;
  DI void init(int M, int N, int G_, int c_) { nM = M / BM; nN = N / BM; nwg = nM * nN; G = G_; c = c_; }
  DI bool next(int i, Unit& u) const {
    long L;
    if (nA == 0) L = (long)i * G + c;
    else if (c < nA) { if (i >= uA) return false; L = (long)i * nA + c; }
    else { if (i >= uB) return false; L = (long)nA * uA + (long)i * (G - nA) + (c - nA); }
    if (L >= nwg) return false;
    int wgid = (int)L; { const int q = nwg / NXCD, r = nwg % NXCD, xcd = wgid % NXCD, off = wgid / NXCD; wgid = (xcd < r ? xcd * (q + 1) : r * (q + 1) + (xcd - r) * q) + off; }
    const int nig = WGM * nN, gid = wgid / nig, fm = gid * WGM, gsz = (nM - fm) < WGM ? (nM - fm) : WGM;
    u.pm = fm + ((wgid % nig) % gsz); u.pn = (wgid % nig) / gsz; return true;
  }
  DI void a_ready(const Unit&) const {}
  DI void done(const Unit&) const {}
};
template <bool FP8, class Epi, class Sched>
__device__ __forceinline__ void gemm_phase(PG8_LAS unsigned char* lds, const Gemm g, const Sched& S, const Epi& E) {
    int tid = threadIdx.x; asm volatile("" : "+v"(tid));
    const int wid = __builtin_amdgcn_readfirstlane(tid >> 6), lane = tid & 63, wr = wid >> 2, wc = wid & 3, fr = lane & 15, fq = lane >> 4;
    const int K = g.K, nt = K / BK;
    unsigned voffA[2], voffB[2];
#pragma unroll
    for (int i = 0; i < 2; ++i) { int R, C; stage_rc(tid * 16 + i * 8192, R, C); const int Rb = Epi::PERM ? ((R & ~31) + perm32(R & 31)) : R;
        voffA[i] = (unsigned)(R * g.lda + C) * 2u; voffB[i] = (unsigned)(Rb * K + C) * 2u; }
    const size_t kstep = (size_t)(BK * 2);
    const size_t hstep = (size_t)HALF * K * 2, hstepA = (size_t)HALF * g.lda * 2;
    const size_t tstep = 2 * hstep, tstepA = 2 * hstepA;
    const unsigned ldsw = (unsigned)wid * 1024u;
    const int aoff = lds_byte(wr * 64 + fr, fq * 8), boff = lds_byte(wc * 32 + fr, fq * 8);
#define PG8_SA(b, h) (((b) * 2 + (h)) * HTB)
#define PG8_SB(b, h) ((4 + (b) * 2 + (h)) * HTB)
#define PG8_STAGE(bufoff, gbase, voff) do { _Pragma("unroll") for (int _i = 0; _i < 2; ++_i) \
        __builtin_amdgcn_global_load_lds((const unsigned*)((const char*)(gbase) + (voff)[_i]), (PG8_LAS unsigned*)(lds + (bufoff) + ldsw + _i * 8192), 16, 0, 0); } while (0)
#define PG8_LDA(dst, b, h) do { _Pragma("unroll") for (int m = 0; m < 4; ++m) _Pragma("unroll") for (int k = 0; k < 2; ++k) dst[m][k] = *(const PG8_LAS bf16x8*)(lds + PG8_SA(b, h) + aoff + m * 2048 + k * 1024); } while (0)
#define PG8_LDB(dst, b, h) do { _Pragma("unroll") for (int n = 0; n < 2; ++n) _Pragma("unroll") for (int k = 0; k < 2; ++k) dst[n][k] = *(const PG8_LAS bf16x8*)(lds + PG8_SB(b, h) + boff + n * 2048 + k * 1024); } while (0)
#define PG8_MMA(ai, bj, At, Bt) do { __builtin_amdgcn_s_setprio(1); _Pragma("unroll") for (int m = 0; m < 4; ++m) _Pragma("unroll") for (int n = 0; n < 2; ++n) { \
        if constexpr (FP8) { const i32x8 bv_ = cat8(Bt[n][0], Bt[n][1]), av_ = cat8(At[m][0], At[m][1]); \
            asm volatile("s_nop 1\n\tv_mfma_scale_f32_16x16x128_f8f6f4 %0, %1, %2, %0, %3, %3 op_sel_hi:[0,0,0]" : "+v"(acc[ai][bj][m][n]) : "v"(bv_), "v"(av_), "v"(sc127)); } \
        else { _Pragma("unroll") for (int k = 0; k < 2; ++k) acc[ai][bj][m][n] = __builtin_amdgcn_mfma_f32_16x16x32_bf16(Bt[n][k], At[m][k], acc[ai][bj][m][n], 0, 0, 0); } } \
        __builtin_amdgcn_s_setprio(0); } while (0)
#define PG8_WAIT_V(n) asm volatile("s_waitcnt vmcnt(" #n ")" ::: "memory")
#define PG8_WAIT_L(n) asm volatile("s_waitcnt lgkmcnt(" #n ")" ::: "memory")
#define PG8_BAR __builtin_amdgcn_s_barrier()
#define PG8_SCHED __builtin_amdgcn_sched_barrier(0)
    Unit cur, nxt; int ui = 0;
    if (!S.next(0, cur)) return;
    f32x4 acc[2][2][4][2];
#pragma unroll
    for (int a = 0; a < 2; ++a)
#pragma unroll
        for (int b = 0; b < 2; ++b)
#pragma unroll
            for (int m = 0; m < 4; ++m)
#pragma unroll
                for (int n = 0; n < 2; ++n) acc[a][b][m][n] = (f32x4){0.f, 0.f, 0.f, 0.f};
    bf16x8 At[4][2], B0[2][2], B1[2][2];
    int sc127 = 0x7F7F7F7F; asm volatile("" : "+v"(sc127));
    const char* cA = (const char*)g.A + (size_t)cur.pm * tstepA; const char* cB = (const char*)g.Bt + (size_t)cur.pn * tstep;
    S.a_ready(cur);
    PG8_STAGE(PG8_SB(0, 0), cB, voffB); PG8_STAGE(PG8_SA(0, 0), cA, voffA); PG8_STAGE(PG8_SB(0, 1), cB + hstep, voffB); PG8_STAGE(PG8_SA(0, 1), cA + hstepA, voffA);
    if (wr == 1) PG8_BAR;
    PG8_WAIT_V(4); PG8_BAR;
    PG8_STAGE(PG8_SB(1, 0), cB + kstep, voffB); PG8_STAGE(PG8_SA(1, 0), cA + kstep, voffA); PG8_STAGE(PG8_SB(1, 1), cB + hstep + kstep, voffB);
    PG8_WAIT_V(6); PG8_BAR;
    for (;;) {
        const bool has_next = S.next(ui + 1, nxt);
        const char* nA = has_next ? (const char*)g.A + (size_t)nxt.pm * tstepA : cA; const char* nB = has_next ? (const char*)g.Bt + (size_t)nxt.pn * tstep : cB;
        for (int t = 0; t < nt; t += 2) {
            const bool last = (t == nt - 2);
            const char* a1 = cA + (size_t)(t + 1) * kstep;
            const char* a2 = last ? nA : cA + (size_t)(t + 2) * kstep; const char* b2 = last ? nB : cB + (size_t)(t + 2) * kstep;
            const char* a3 = a2 + kstep; const char* b3 = b2 + kstep;
            if (last && has_next) S.a_ready(nxt);
            PG8_LDB(B0, 0, 0); PG8_SCHED; PG8_LDA(At, 0, 0); PG8_STAGE(PG8_SA(1, 1), a1 + hstepA, voffA);
            PG8_WAIT_L(8); PG8_BAR; PG8_WAIT_L(0); PG8_MMA(0, 0, At, B0); PG8_BAR; PG8_SCHED;
            PG8_LDB(B1, 0, 1); PG8_STAGE(PG8_SB(0, 0), b2, voffB);
            PG8_BAR; PG8_WAIT_L(0); PG8_MMA(0, 1, At, B1); PG8_BAR;
            PG8_LDA(At, 0, 1); PG8_STAGE(PG8_SA(0, 0), a2, voffA);
            PG8_BAR; PG8_WAIT_L(0); PG8_MMA(1, 0, At, B0); PG8_BAR; PG8_SCHED;
            PG8_STAGE(PG8_SB(0, 1), b2 + hstep, voffB);
            PG8_WAIT_V(6); PG8_BAR; PG8_MMA(1, 1, At, B1); PG8_BAR;
            PG8_LDB(B0, 1, 0); PG8_SCHED; PG8_LDA(At, 1, 0); PG8_STAGE(PG8_SA(0, 1), a2 + hstepA, voffA);
            PG8_WAIT_L(8); PG8_BAR; PG8_WAIT_L(0); PG8_MMA(0, 0, At, B0); PG8_BAR; PG8_SCHED;
            PG8_LDB(B1, 1, 1); PG8_STAGE(PG8_SB(1, 0), b3, voffB);
            PG8_BAR; PG8_WAIT_L(0); PG8_MMA(0, 1, At, B1); PG8_BAR;
            PG8_LDA(At, 1, 1); PG8_STAGE(PG8_SA(1, 0), a3, voffA);
            PG8_BAR; PG8_WAIT_L(0); PG8_MMA(1, 0, At, B0); PG8_BAR; PG8_SCHED;
            PG8_STAGE(PG8_SB(1, 1), b3 + hstep, voffB);
            PG8_WAIT_V(6); PG8_BAR; PG8_MMA(1, 1, At, B1); PG8_BAR;
        }
        if constexpr (FP8) asm volatile("s_nop 15\n\ts_nop 15" ::: "memory");
        if constexpr (!Epi::AFTER_DRAIN) { E(acc, cur, wr, wc, fr, fq); S.done(cur); }
        if (!has_next) break;
#pragma unroll
        for (int a = 0; a < 2; ++a)
#pragma unroll
            for (int b = 0; b < 2; ++b)
#pragma unroll
                for (int m = 0; m < 4; ++m)
#pragma unroll
                    for (int n = 0; n < 2; ++n) acc[a][b][m][n] = (f32x4){0.f, 0.f, 0.f, 0.f};
        cur = nxt; cA = nA; cB = nB; ++ui;
    }
    PG8_WAIT_V(0);
    if (wr == 0) PG8_BAR;
    PG8_BAR;
    if constexpr (Epi::AFTER_DRAIN) { E.fused(acc, cur, wr, wc, fr, fq, lds, wid, lane); S.done(cur); }
#undef PG8_SA
#undef PG8_SB
#undef PG8_STAGE
#undef PG8_LDA
#undef PG8_LDB
#undef PG8_MMA
#undef PG8_WAIT_V
#undef PG8_WAIT_L
#undef PG8_BAR
#undef PG8_SCHED
}

}

struct EpiResid {
  static constexpr bool PERM = false, AFTER_DRAIN = false;
  const float* xin; float* xout; float sc;
  DI void operator()(const f32x4 (&acc)[2][2][4][2], const pg8::Unit& u, int wr, int wc, int fr, int fq) const {
    const int row0 = u.pm * 256 + wr * 64 + fr, col0 = u.pn * 256 + wc * 32 + 4 * fq;
#pragma unroll
    for (int ai = 0; ai < 2; ++ai)
#pragma unroll
      for (int m = 0; m < 4; ++m) {
        const size_t ro = (size_t)(row0 + ai * 128 + m * 16) * 2048 + col0;
#pragma unroll
        for (int bj = 0; bj < 2; ++bj)
#pragma unroll
          for (int n = 0; n < 2; ++n) {
            const size_t o = ro + bj * 128 + n * 16;
            const f32x4 xv = *(const f32x4*)(xin + o);
            *(f32x4*)(xout + o) = xv + acc[ai][bj][m][n] * sc;
          }
        asm volatile("" ::: "memory");
      }
  }
};
template <int MODE>
struct EpiBf {
  static constexpr bool PERM = true, AFTER_DRAIN = false;
  u16* d0; int ld0; int N; u16* d1; u16* d2; const f32x2* rope; float sc = 1.f; int csplit = 0, coff1 = 0, coff2 = 0;
  DI void rot(f32x4& v0, f32x4& v1, int row, int col) const {
    const f32x4* cp = (const f32x4*)(rope + (row & 2047) * 32 + ((col & 63) >> 1));
    const f32x4 c01 = cp[0], c23 = cp[1];
    const f32x4 a = {v0[0] * c01[0] - v0[1] * c01[1], v0[1] * c01[0] + v0[0] * c01[1], v0[2] * c01[2] - v0[3] * c01[3], v0[3] * c01[2] + v0[2] * c01[3]};
    const f32x4 b = {v1[0] * c23[0] - v1[1] * c23[1], v1[1] * c23[0] + v1[0] * c23[1], v1[2] * c23[2] - v1[3] * c23[3], v1[3] * c23[2] + v1[2] * c23[3]};
    v0 = a; v1 = b;
  }
  DI void operator()(const f32x4 (&acc)[2][2][4][2], const pg8::Unit& u, int wr, int wc, int fr, int fq) const {
    const int row0 = u.pm * 256 + wr * 64 + fr, colb = u.pn * 256 + wc * 32 + 8 * fq;
#pragma unroll
    for (int ai = 0; ai < 2; ++ai)
#pragma unroll
      for (int m = 0; m < 4; ++m) {
        const int row = row0 + ai * 128 + m * 16;
#pragma unroll
        for (int bj = 0; bj < 2; ++bj) {
          const int col = colb + bj * 128;
          f32x4 v0 = acc[ai][bj][m][0] * sc, v1 = acc[ai][bj][m][1] * sc;
          u16* dst = nullptr;
          if (MODE == 0) { if (col < N) dst = d0 + (size_t)row * ld0 + (col + coff2 + ((col < csplit) ? (coff1 - coff2) : 0)); }
          else if (MODE == 1) {
            const int oc = col + coff2 + ((col < csplit) ? (coff1 - coff2) : 0);
            if (col < N) {
              if (oc < 2048) dst = d0 + (size_t)row * 2048 + oc;
              else if (oc < 2112) { rot(v0, v1, row, oc); dst = d2 + (size_t)row * 64 + (oc - 2048); }
              else dst = d1 + (size_t)row * 4096 + (oc - 2112);
            }
          } else if (MODE == 3) {
            if (col < N) { const bool lo = col < csplit; u16* bp = lo ? d0 : d1; const int ldd = lo ? 2048 : 4096, oc = lo ? col : col + (coff2 - 2112); dst = bp + (size_t)row * ldd + oc + (lo ? coff1 : 0); }
          } else {
            if (((col >> 6) % 3) == 2) rot(v0, v1, row, col);
            dst = d0 + (size_t)row * 3072 + col;
          }
          if (dst) { u32x4 w = {pk2(v0[0], v0[1]), pk2(v0[2], v0[3]), pk2(v1[0], v1[1]), pk2(v1[2], v1[3])}; *(u32x4*)dst = w; }
        }
        asm volatile("" ::: "memory");
      }
  }
};

template <bool FP8 = false, class Epi>
DI void run_gemm(const u16* A, int lda, const u16* Bt, int M, int N, int K, const Epi& e, char* smem, int nA = 0, int uA = 0, int uB = 0) {
  __syncthreads();
  pg8::Gemm g{A, Bt, M, N, K, lda};
  pg8::StaticOrder S; S.init(M, N, gridDim.x, blockIdx.x);
  if (nA > 0 && (int)gridDim.x > nA && nA * uA + ((int)gridDim.x - nA) * uB == S.nwg) { S.nA = nA; S.uA = uA; S.uB = uB; }
  pg8::gemm_phase<FP8>(( __attribute__((address_space(3))) unsigned char*)smem, g, S, e);
  __syncthreads();
}

typedef __attribute__((address_space(3))) unsigned* lds_u32p;
template <int OFF> DI void rd4(bf16x8 (&f)[4], unsigned addr) {
  asm volatile("ds_read_b128 %0, %4 offset:%5\n\tds_read_b128 %1, %4 offset:%6\n\tds_read_b128 %2, %4 offset:%7\n\tds_read_b128 %3, %4 offset:%8\n\ts_waitcnt lgkmcnt(0)"
               : "=&v"(f[0]), "=&v"(f[1]), "=&v"(f[2]), "=&v"(f[3]) : "v"(addr), "i"(OFF), "i"(OFF + 32), "i"(OFF + 64), "i"(OFF + 96) : "memory");
}
template <int OFF> DI void rdv8(s16x4 (&v)[8], unsigned addr) {
  asm volatile("ds_read_b64_tr_b16 %0, %8 offset:%9\n\tds_read_b64_tr_b16 %1, %8 offset:%10\n\tds_read_b64_tr_b16 %2, %8 offset:%11\n\tds_read_b64_tr_b16 %3, %8 offset:%12\n\t"
               "ds_read_b64_tr_b16 %4, %8 offset:%13\n\tds_read_b64_tr_b16 %5, %8 offset:%14\n\tds_read_b64_tr_b16 %6, %8 offset:%15\n\tds_read_b64_tr_b16 %7, %8 offset:%16\n\ts_waitcnt lgkmcnt(0)"
               : "=&v"(v[0]), "=&v"(v[1]), "=&v"(v[2]), "=&v"(v[3]), "=&v"(v[4]), "=&v"(v[5]), "=&v"(v[6]), "=&v"(v[7])
               : "v"(addr), "i"(OFF), "i"(OFF + 512), "i"(OFF + 1024), "i"(OFF + 1536), "i"(OFF + 2048), "i"(OFF + 2560), "i"(OFF + 3072), "i"(OFF + 3584) : "memory");
}
template <int KSTR, int ND, int N>
DI f32x16 s_block(unsigned kaddr, const bf16x8* qf) {
  const f32x16 z16 = {0.f, 0.f, 0.f, 0.f, 0.f, 0.f, 0.f, 0.f, 0.f, 0.f, 0.f, 0.f, 0.f, 0.f, 0.f, 0.f};
  bf16x8 f[4];
  rd4<N * 32 * KSTR>(f, kaddr);
  f32x16 a = MFMA(f[0], qf[0], z16); a = MFMA(f[1], qf[1], a); a = MFMA(f[2], qf[2], a); a = MFMA(f[3], qf[3], a);
  if constexpr (ND > 4) { rd4<N * 32 * KSTR + 128>(f, kaddr); a = MFMA(f[0], qf[4], a); a = MFMA(f[1], qf[5], a); a = MFMA(f[2], qf[6], a); a = MFMA(f[3], qf[7], a); }
  if constexpr (ND > 8) { rd4<N * 32 * KSTR + 256>(f, kaddr); a = MFMA(f[0], qf[8], a); a = MFMA(f[1], qf[9], a); a = MFMA(f[2], qf[10], a); a = MFMA(f[3], qf[11], a); }
  if constexpr (ND > 12) { rd4<N * 32 * KSTR + 384>(f, kaddr); a = MFMA(f[0], qf[12], a); a = MFMA(f[1], qf[13], a); a = MFMA(f[2], qf[14], a); a = MFMA(f[3], qf[15], a); }
  return a;
}
template <int CB> DI void pv_block(f32x16& o, unsigned vaddr, const bf16x8 (&pb)[2][2]) {
  s16x4 v[8];
  rdv8<CB * 4096>(v, vaddr);
#pragma unroll
  for (int q = 0; q < 4; ++q) {
    const bf16x8 vf = {v[2 * q][0], v[2 * q][1], v[2 * q][2], v[2 * q][3], v[2 * q + 1][0], v[2 * q + 1][1], v[2 * q + 1][2], v[2 * q + 1][3]};
    o = MFMA(vf, pb[q >> 1][q & 1], o);
  }
}
template <int DQK, int W1, int DV, int VW, int MODE>
DI void attn_core(const u16* __restrict__ k1, int ldk1, const u16* __restrict__ k2, int ldk2, const u16* __restrict__ vsrc, int ldv,
                  int kv_len, int kbase0, int ntiles, const u16* qrow, int tq, int tq0, float c2, int vcb0, u16* yrow,
                  const u16* grow, const unsigned* maskrow, const float* lutw, float bias_far, float m_init, float l_init, char* smem) {
  constexpr int KSTR = DQK * 2 + 16, KCH = DQK / 8;
  constexpr int ND = DQK / 16, NCB = DV / 32, BUF = 64 * KSTR + (VW / 32) * 4096;
  constexpr int NKI = KSTR / 16, NVI = VW / 8;
  static_assert(ND % 4 == 0 && NCB <= 4, "fragment batches");
  int tid0 = threadIdx.x; asm volatile("" : "+v"(tid0));
  const int lane = tid0 & 63, r32 = lane & 31, hi = lane >> 5;
  const int wv = __builtin_amdgcn_readfirstlane(tid0 >> 6);
  const unsigned lds0 = (unsigned)(uintptr_t)smem;
  bf16x8 qf[ND];
#pragma unroll
  for (int d0 = 0; d0 < ND; ++d0) qf[d0] = *(const bf16x8*)(qrow + d0 * 16 + hi * 8);
  f32x16 o[NCB];
#pragma unroll
  for (int cb = 0; cb < NCB; ++cb)
#pragma unroll
    for (int r = 0; r < 16; ++r) o[cb][r] = 0.f;
  float m = m_init, l = (hi == 0) ? l_init : 0.f;
  const unsigned klane = (unsigned)(r32 * KSTR + hi * 16);
  const unsigned vlane = (unsigned)(64 * KSTR + vcb0 * 4096 + ((lane >> 4) & 1) * 32 + (lane & 3) * 8 + (4 * hi + ((lane & 15) >> 2)) * 64);
  unsigned mwn[2] = {0u, 0u};
  constexpr int NKS = (NKI + 7) / 8, NVS = (NVI + 7) / 8;
  const u16* kptr[NKS]; int kstr[NKS]; const u16* vptr[NVS];
  if (MODE != 2) {
    int ln = threadIdx.x & 63; asm volatile("" : "+v"(ln));
#pragma unroll
    for (int ii = 0; ii < NKS; ++ii) {
      const int i = wv + 8 * ii, ob = i * 1024 + ln * 16, row = ob / KSTR;
      int c = (ob - row * KSTR) >> 4; c = (c >= KCH) ? 0 : c;
      const bool seg1 = c < W1 / 8;
      kptr[ii] = seg1 ? (k1 + ((kbase0 + row) * ldk1 + c * 8)) : (k2 + ((kbase0 + row) * ldk2 + (c - W1 / 8) * 8));
      kstr[ii] = seg1 ? 64 * ldk1 : 64 * ldk2;
    }
#pragma unroll
    for (int ii = 0; ii < NVS; ++ii) {
      const int i = wv + 8 * ii, ob = i * 1024 + ln * 16, cbk = ob >> 12, row = (ob & 4095) >> 6, cw = (ob & 63) >> 4;
      vptr[ii] = vsrc + ((kbase0 + row) * ldv + (cbk * 4 + cw) * 8);
    }
  }
  auto stage_tile = [&](int kb, int buf) {
    const unsigned bofs = (unsigned)(buf * BUF);
    if (MODE != 2) {
#pragma unroll
      for (int ii = 0; ii < NKS; ++ii) {
        const int i = wv + 8 * ii;
        if (i < NKI) { __builtin_amdgcn_global_load_lds((const unsigned*)kptr[ii], (lds_u32p)(smem + bofs + i * 1024), 16, 0, 0); kptr[ii] += kstr[ii]; }
      }
#pragma unroll
      for (int ii = 0; ii < NVS; ++ii) {
        const int i = wv + 8 * ii;
        if (i < NVI) { __builtin_amdgcn_global_load_lds((const unsigned*)vptr[ii], (lds_u32p)(smem + bofs + 64 * KSTR + i * 1024), 16, 0, 0); vptr[ii] += 64 * ldv; }
      }
    } else {
      int ln = threadIdx.x & 63; asm volatile("" : "+v"(ln));
#pragma unroll
      for (int ii = 0; ii < NKS; ++ii) {
        const int i = wv + 8 * ii;
        if (i < NKI) {
          const int ob = i * 1024 + ln * 16, row = ob / KSTR;
          int c = (ob - row * KSTR) >> 4; c = (c >= KCH) ? 0 : c;
          int key = kb + row; key = key < 0 ? 0 : (key >= kv_len ? kv_len - 1 : key);
          const u16* src = (c < W1 / 8) ? (k1 + (key * ldk1 + c * 8)) : (k2 + (key * ldk2 + (c - W1 / 8) * 8));
          __builtin_amdgcn_global_load_lds((const unsigned*)src, (lds_u32p)(smem + bofs + i * 1024), 16, 0, 0);
        }
      }
#pragma unroll
      for (int ii = 0; ii < NVS; ++ii) {
        const int i = wv + 8 * ii;
        if (i < NVI) {
          const int ob = i * 1024 + ln * 16, cbk = ob >> 12, row = (ob & 4095) >> 6, cw = (ob & 63) >> 4;
          int key = kb + row; key = key < 0 ? 0 : (key >= kv_len ? kv_len - 1 : key);
          __builtin_amdgcn_global_load_lds((const unsigned*)(vsrc + (key * ldv + (cbk * 4 + cw) * 8)), (lds_u32p)(smem + bofs + 64 * KSTR + i * 1024), 16, 0, 0);
        }
      }
    }
    if (MODE == 1) { mwn[0] = maskrow[(kb >> 5)]; mwn[1] = maskrow[(kb >> 5) + 1]; }
  };
  stage_tile(kbase0, 0);
  asm volatile("s_waitcnt vmcnt(0)" ::: "memory");
  __syncthreads();
  for (int t = 0; t < ntiles; ++t) {
    const int kb = kbase0 + t * 64;
    const unsigned bufa = lds0 + (unsigned)((t & 1) * BUF);
    const unsigned mw0 = mwn[0], mw1 = mwn[1];
    if (t + 1 < ntiles) stage_tile(kb + 64, (t + 1) & 1);
    if (!(MODE == 0 && kb > tq0 + 31)) {
      f32x16 s[2];
      s[0] = s_block<KSTR, ND, 0>(bufa + klane, qf);
      s[1] = s_block<KSTR, ND, 1>(bufa + klane, qf);
      if (MODE == 0) {
        s[0] = s[0] * c2; s[1] = s[1] * c2;
        if (__builtin_amdgcn_readfirstlane((int)(kb + 63 > tq0))) {
#pragma unroll
          for (int n = 0; n < 2; ++n)
#pragma unroll
            for (int i = 0; i < 16; ++i) { const int key = kb + 32 * n + crow(i, hi); if (key > tq) s[n][i] = NEGV; }
        }
      } else if (MODE == 1) {
        const bool far = (tq0 - (kb + 63)) >= 128;
#pragma unroll
        for (int n = 0; n < 2; ++n) {
          const unsigned wb = (n ? mw1 : mw0) >> (4 * hi);
          if (far) {
#pragma unroll
            for (int i = 0; i < 16; ++i) {
              const float v = fmaf(s[n][i], c2, bias_far);
              s[n][i] = ((wb >> ((i & 3) + 8 * (i >> 2))) & 1u) ? v : NEGV;
            }
          } else {
#pragma unroll
            for (int i = 0; i < 16; ++i) {
              const int key = kb + 32 * n + crow(i, hi);
              int rel = tq - key; rel = rel < 0 ? 0 : (rel > 128 ? 128 : rel);
              const float v = fmaf(s[n][i], c2, lutw[rel]);
              s[n][i] = ((wb >> ((i & 3) + 8 * (i >> 2))) & 1u) ? v : NEGV;
            }
          }
        }
      } else if (MODE == 2) {
#pragma unroll
        for (int n = 0; n < 2; ++n)
#pragma unroll
          for (int i = 0; i < 16; ++i) {
            const int key = kb + 32 * n + crow(i, hi), rel = tq - key;
            const bool ok = ((unsigned)rel < 128u) && (key >= 0);
            const float v = fmaf(s[n][i], c2, lutw[rel & 127]);
            s[n][i] = ok ? v : NEGV;
          }
      } else {
#pragma unroll
        for (int n = 0; n < 2; ++n)
#pragma unroll
          for (int i = 0; i < 16; ++i) s[n][i] *= c2;
      }
      float mx = s[0][0];
#pragma unroll
      for (int i = 1; i < 16; ++i) mx = fmaxf(mx, s[0][i]);
#pragma unroll
      for (int i = 0; i < 16; ++i) mx = fmaxf(mx, s[1][i]);
      mx = xhalf_max(mx);
      if (__any(mx - m > 8.0f)) {
        const float mnew = fmaxf(m, mx), alpha = __builtin_amdgcn_exp2f(m - mnew);
        m = mnew; l *= alpha;
#pragma unroll
        for (int cb = 0; cb < NCB; ++cb)
#pragma unroll
          for (int r = 0; r < 16; ++r) o[cb][r] *= alpha;
      }
      {
        const float nm = -m;
        f32x16 e0 = s[0] + nm, e1 = s[1] + nm;
#pragma unroll
        for (int i = 0; i < 16; ++i) { e0[i] = __builtin_amdgcn_exp2f(e0[i]); e1[i] = __builtin_amdgcn_exp2f(e1[i]); }
        s[0] = e0; s[1] = e1;
        const f32x16 sm = e0 + e1;
        typedef __attribute__((ext_vector_type(8))) float f32x8;
        const f32x8 h8 = sm.lo + sm.hi;
        const f32x4 h4 = h8.lo + h8.hi;
        const f32x2 h2 = h4.lo + h4.hi;
        l += h2[0] + h2[1];
      }
      bf16x8 pb[2][2];
#pragma unroll
      for (int n = 0; n < 2; ++n)
#pragma unroll
        for (int s2 = 0; s2 < 2; ++s2) {
          u32x4 pw = {pk2(s[n][8 * s2 + 0], s[n][8 * s2 + 1]), pk2(s[n][8 * s2 + 2], s[n][8 * s2 + 3]),
                      pk2(s[n][8 * s2 + 4], s[n][8 * s2 + 5]), pk2(s[n][8 * s2 + 6], s[n][8 * s2 + 7])};
          pb[n][s2] = __builtin_bit_cast(bf16x8, pw);
        }
      pv_block<0>(o[0], bufa + vlane, pb);
      if constexpr (NCB > 1) pv_block<1>(o[1], bufa + vlane, pb);
      if constexpr (NCB > 2) pv_block<2>(o[2], bufa + vlane, pb);
      if constexpr (NCB > 3) pv_block<3>(o[3], bufa + vlane, pb);
    }
    asm volatile("s_waitcnt vmcnt(0)" ::: "memory");
    __syncthreads();
  }
  const float inv = __builtin_amdgcn_rcpf(xhalf_sum(l));
#pragma unroll
  for (int cb = 0; cb < NCB; ++cb)
#pragma unroll
    for (int g = 0; g < 4; ++g) {
      const int dv = 32 * cb + 8 * g + 4 * hi;
      const u32x2 gg = *(const u32x2*)(grow + dv);
      float gv[4] = {bf2f(gg[0] & 0xffffu), bf2f(gg[0] >> 16), bf2f(gg[1] & 0xffffu), bf2f(gg[1] >> 16)};
      float ov[4];
#pragma unroll
      for (int j = 0; j < 4; ++j) {
        const float sg = gv[j] * __builtin_amdgcn_rcpf(1.f + __builtin_amdgcn_exp2f(-LOG2E * gv[j]));
        ov[j] = o[cb][4 * g + j] * inv * sg;
      }
      *(unsigned*)((unsigned char*)yrow + dv) = pk4_fp8(ov[0] * Y_SCALE, ov[1] * Y_SCALE, ov[2] * Y_SCALE, ov[3] * Y_SCALE);
      __builtin_amdgcn_sched_barrier(0);
    }
}

DI unsigned ordkey(float f) { const unsigned b = __float_as_uint(f); return b ^ ((unsigned)((int)b >> 31) | 0x80000000u); }
DI void indexer_phase(const u16* __restrict__ P, unsigned* __restrict__ mask) {
  int tidx = threadIdx.x; asm volatile("" : "+v"(tidx));
  const int lane = tidx & 63, r32 = lane & 31, hi = lane >> 5;
  const int gw = blockIdx.x * 8 + (tidx >> 6), nw = gridDim.x * 8;
  for (int base = 0, pass = 0; base < 8192; base += nw, ++pass) {
    const int item = (pass & 1) ? base + (nw - 1 - gw) : base + gw;
    if (item >= 8192) continue;
    const int b = item & 7, t0 = (1023 - (item >> 3)) * 2;
    const size_t brow = (size_t)b * SEQ;
    const int g = (r32 >> 2) & 1, head = 4 * (r32 >> 3) + (r32 & 3);
    bf16x8 aq[4];
#pragma unroll
    for (int s = 0; s < 4; ++s) aq[s] = *(const bf16x8*)(P + (brow + t0 + g) * 7808 + 2560 + head * 64 + 16 * s + 8 * hi);
    float wv[16];
    {
      const u32x4 w0 = *(const u32x4*)(P + (brow + t0 + hi) * 7808 + 3648), w1 = *(const u32x4*)(P + (brow + t0 + hi) * 7808 + 3656);
#pragma unroll
      for (int j = 0; j < 4; ++j) { wv[2 * j] = bf2f(w0[j] & 0xffffu); wv[2 * j + 1] = bf2f(w0[j] >> 16); wv[8 + 2 * j] = bf2f(w1[j] & 0xffffu); wv[8 + 2 * j + 1] = bf2f(w1[j] >> 16); }
    }
    const int tme = t0 + hi, kbmax = (t0 + 1) >> 5;
    unsigned sc[64];
#pragma unroll
    for (int kb = 0; kb < 64; ++kb) {
      unsigned u = 0u;
      if (kb <= kbmax) {
        f32x16 a;
#pragma unroll
        for (int r = 0; r < 16; ++r) a[r] = 0.f;
        const u16* kp = P + (brow + 32 * kb + r32) * 7808 + 3584 + 8 * hi;
#pragma unroll
        for (int s = 0; s < 4; ++s) { const bf16x8 bk = *(const bf16x8*)(kp + 16 * s); a = MFMA(aq[s], bk, a); }
        float v = 0.f;
#pragma unroll
        for (int i = 0; i < 16; ++i) v = fmaf(wv[i], fmaxf(a[i], 0.f), v);
        u = (32 * kb + r32 <= tme) ? ordkey(v) : 0u;
      }
      sc[kb] = u;
    }
    const int target = (tme + 1 < 256) ? tme + 1 : 256;
    unsigned T = 0u;
    for (int bit = 31; bit >= 0; --bit) {
      const unsigned Tp = T | (1u << bit);
      int cnt = 0;
#pragma unroll
      for (int kb = 0; kb < 64; ++kb) cnt += (sc[kb] >= Tp) ? 1 : 0;
#pragma unroll
      for (int o = 16; o; o >>= 1) cnt += __shfl_xor(cnt, o);
      if (cnt >= target) T = Tp;
    }
    unsigned w0 = 0u, w1 = 0u;
#pragma unroll
    for (int kb = 0; kb < 64; ++kb) {
      const bool pred = (sc[kb] >= T) && (sc[kb] != 0u);
      const unsigned long long bal = __ballot(pred);
      const unsigned wd = (unsigned)(bal >> (32 * hi));
      if ((kb & 31) == r32) { if (kb < 32) w0 = wd; else w1 = wd; }
    }
    mask[(brow + tme) * 64 + r32] = w0;
    mask[(brow + tme) * 64 + 32 + r32] = w1;
  }
}

#define XB_TMO      128
#define XB_XCNT(j)  (256  + 64 * (j))
#define XB_XSUB(j)  (1280 + 64 * (j))
#define XB_XGEN(j)  (2304 + 64 * (j))
#define XB_TOP      3328
#define XB_TOPGEN   3392
#define XCD_BAR_WORDS 3456
#define XB_SPIN_CAP (1u << 22)
DI unsigned xb_ld(unsigned* p)              { return __hip_atomic_load(p, __ATOMIC_RELAXED, __HIP_MEMORY_SCOPE_AGENT); }
DI unsigned xb_add(unsigned* p, unsigned v) { return __hip_atomic_fetch_add(p, v, __ATOMIC_RELAXED, __HIP_MEMORY_SCOPE_AGENT); }
DI unsigned xb_xcc_id() { return (unsigned)__builtin_amdgcn_s_getreg((3 << 11) | 20) & 0xFu; }
#define XB_SPIN(cond, bar) do { unsigned _sp = 0; while (cond) { __builtin_amdgcn_s_sleep(1); \
    if ((++_sp & 255u) == 0u) { if (xb_ld(&(bar)[XB_TMO])) break; if (_sp > XB_SPIN_CAP) { atomicAdd(&(bar)[XB_TMO], 1u); break; } } } } while (0)
DI void xcd_barrier_complete(unsigned* bar, unsigned x, unsigned& nloc, unsigned& nx) {
  const unsigned G = gridDim.x;
  unsigned sum, cnt, mine, sp = 0u;
  for (;;) {
    sum = 0u; cnt = 0u; mine = 0u;
#pragma unroll
    for (unsigned j = 0; j < 16; ++j) { const unsigned c = xb_ld(&bar[XB_XCNT(j)]); sum += c; cnt += (c > 0u) ? 1u : 0u; mine = (j == x) ? c : mine; }
    if (sum == G) break;
    __builtin_amdgcn_s_sleep(1);
    if ((++sp & 255u) == 0u) { if (xb_ld(&bar[XB_TMO])) break; if (sp > XB_SPIN_CAP) { atomicAdd(&bar[XB_TMO], 1u); break; } }
  }
  nloc = mine > 0u ? mine : 1u; nx = cnt > 0u ? cnt : 1u;
}
DI void xcd_barrier(unsigned* bar, volatile unsigned* st) {
  asm volatile("s_waitcnt vmcnt(0)" ::: "memory");
  __syncthreads();
  if (threadIdx.x == 0) {
    const unsigned x = xb_xcc_id();
    __builtin_amdgcn_s_waitcnt(0);
    unsigned nloc = st[0], nx = st[1];
    if (nloc == 0u) { xcd_barrier_complete(bar, x, nloc, nx); st[0] = nloc; st[1] = nx; }
    const unsigned old = xb_add(&bar[XB_XSUB(x)], 1u);
    const unsigned gen = old / nloc;
    if (old + 1u == (gen + 1u) * nloc) {
      __builtin_amdgcn_fence(__ATOMIC_RELEASE, "agent");
      asm volatile("s_waitcnt vmcnt(0)" ::: "memory");
      const unsigned og = xb_add(&bar[XB_TOP], 1u);
      const unsigned tg = og / nx;
      if (og + 1u == (tg + 1u) * nx) xb_add(&bar[XB_TOPGEN], 1u);
      else XB_SPIN(xb_ld(&bar[XB_TOPGEN]) == tg, bar);
      __builtin_amdgcn_fence(__ATOMIC_ACQUIRE, "agent");
      xb_add(&bar[XB_XGEN(x)], 1u);
      asm volatile("s_waitcnt vmcnt(0)" ::: "memory");
    } else {
      XB_SPIN(xb_ld(&bar[XB_XGEN(x)]) == gen, bar);
      __builtin_amdgcn_fence(__ATOMIC_ACQUIRE, "agent");
      asm volatile("s_waitcnt vmcnt(0)" ::: "memory");
    }
  }
  __syncthreads();
}
#define GSYNC() xcd_barrier(XBAR, xb_st)
__global__ void __launch_bounds__(512, 2) mega(Params p) {
  cg::grid_group grid = cg::this_grid();
  extern __shared__ __attribute__((aligned(16))) char smem[];
  volatile int* s_item = (volatile int*)(smem + LDS_ITEM);
  char* ws = p.ws;
  unsigned char* Y8 = (unsigned char*)(ws + OFF_Y);
  u16* WIN8 = (u16*)(ws + OFF_WIN + 19922944);
  unsigned char* CQ8 = (unsigned char*)(ws + OFF_Y + 67108864);     u16* H = (u16*)(ws + OFF_H); u16* Cb = (u16*)(ws + OFF_Y); u16* Qb = (u16*)(ws + OFF_H);
  u16* KV = (u16*)(ws + OFF_KV); u16* MG = (u16*)(ws + OFF_MG); u16* KR = (u16*)(ws + OFF_KR); u16* Pb = (u16*)(ws + OFF_P);
  u16* WIN = (u16*)(ws + OFF_WIN); u16* WUQ = (u16*)(ws + OFF_WUQ); u16* WUKV = (u16*)(ws + OFF_WUKV); u16* WOUT = (u16*)(ws + OFF_WOUT);
  u16* WMEMALL = (u16*)(ws + OFF_KV); u16* MEMN = (u16*)(ws + OFF_MEMN); u16* MEMKV = (u16*)(ws + OFF_MEMKV);
  unsigned* MASK = (unsigned*)(ws + OFF_MASK); f32x2* ROPE = (f32x2*)(ws + OFF_ROPE); float* LUT = (float*)(ws + OFF_LUT);
  int* CTR = (int*)(ws + OFF_CTR);
  unsigned* XBAR = (unsigned*)(ws + OFF_CTR + 1024);
  volatile unsigned* xb_st = (volatile unsigned*)(smem + LDS_ITEM + 16);
  if (threadIdx.x == 0) { xb_st[0] = 0u; xb_st[1] = 0u; (void)xb_add(&XBAR[XB_XCNT(xb_xcc_id())], 1u); }
  __syncthreads();
  const int tid = threadIdx.x, lane = tid & 63, wv = __builtin_amdgcn_readfirstlane(tid >> 6), r32 = lane & 31, hi = lane >> 5;
  const int gtid = blockIdx.x * 512 + tid, gthreads = gridDim.x * 512;

  for (int i = gtid; i < 2048 * 32; i += gthreads) {
    const int pos = i >> 5, j = i & 31;
    const float inv = 1.0f / powf(10000.0f, (float)(2 * j) / 64.0f);
    const float ang = (float)pos * inv;
    const float k = rintf(ang * 0.15915494309189535f);
    float r = fmaf(-k, 6.28318548202514648f, ang);
    r = fmaf(-k, -1.74845553e-7f, r);
    f32x2 cs = {__cosf(r), __sinf(r)};
    ROPE[i] = cs;
  }
  for (int i = gtid; i < 129 * 32; i += gthreads) {
    const int rel = i >> 5, h = i & 31;
    int bucket;
    if (rel < 16) bucket = rel;
    else { const int lg = 16 + (int)(logf((float)rel / 16.0f) / 2.0794415416798357f * 16.0f); bucket = lg < 31 ? lg : 31; }
    LUT[i] = p.rel_bias[bucket * 32 + h] * LOG2E;
  }
  rmsnorm_rows<false>(p.mem, p.mem_norm, MEMN, 2048);
#pragma unroll 1
  for (int l = 0; l < 4; ++l) convert_wt<0>(p.w_mem_kv + (size_t)l * 2048 * 2048, 2048, 2048, 2048, WMEMALL + (size_t)l * 2048 * 2048, smem);

  auto convert_layer = [&](int L) {
    const int kind = L % 3, j = L / 3;
    if (kind == 0) {
    convert_wt<1>(p.w_in_a + (size_t)j * 2048 * 6208, 2048, 6208, 3840, WIN, smem, 1.f, 3648, 576, 1536, 2560, 512);
    convert_wt<0, true>(p.w_in_a + (size_t)j * 2048 * 6208, 2048, 6208, 2560, WIN8, smem, WIN_SCALE, 2560, 1536, 0, 576);
    convert_wt<2, true>(p.w_uq + (size_t)j * 1536 * 3072, 1536, 3072, 3072, WUQ, smem, WUQ_SCALE);
    convert_wt<0>(p.w_ukv + (size_t)j * 512 * 4096, 512, 4096, 4096, WUKV, smem);
  } else if (kind == 1) {
    convert_wt<0>(p.w_in_b, 2048, 7760, 4864, WIN, smem, 1.f, 4688, 1616, 2048, 3072);
    convert_wt<0, true>(p.w_in_b, 2048, 7760, 3072, WIN8, smem, WIN_SCALE, 3072, 2048, 0, 1616);
  } else {
    convert_wt<0>(p.w_in_c, 2048, 6656, 3584, WIN, smem, 1.f, 3584, 512, 2048, 3072);
    convert_wt<0, true>(p.w_in_c, 2048, 6656, 3072, WIN8, smem, WIN_SCALE, 3072, 2048, 0, 512);
  }
  };
#pragma unroll 1
  for (int layer = 0; layer < 4; ++layer) {
    const int kind = layer % 3, j = layer / 3;
    const float* xin = (layer == 0) ? p.x : p.out;
    unsigned char* H8 = (unsigned char*)(ws + ((kind == 0) ? OFF_KV + 67108864 : OFF_Y));
    rmsnorm_rows<false>(xin, p.norm_in + layer * 2048, H, NTOK, H8);
    if (layer == 0) convert_layer(0);
    if (layer == 0) { __builtin_amdgcn_fence(__ATOMIC_RELEASE, "agent"); grid.sync(); __builtin_amdgcn_fence(__ATOMIC_ACQUIRE, "agent"); asm volatile("s_waitcnt vmcnt(0)" ::: "memory"); }
    else GSYNC();

    if (kind == 0) {
      { EpiBf<1> e{Cb, 2048, 3648, MG, KR, ROPE, 1.f, 576, 1536, 2560}; run_gemm(H, 2048, WIN, NTOK, 3840, 2048, e, smem); }
      { EpiBf<3> e{Cb, 2048, 2560, MG, nullptr, nullptr, 1.f / (H_SCALE * WIN_SCALE), 1536, 0, 576}; run_gemm<true>((const u16*)H8, 1024, WIN8, NTOK, 2560, 1024, e, smem, 192, 2, 4); }
    }
    else if (kind == 1) {
      { EpiBf<0> e{Pb, 7808, 4688, nullptr, nullptr, nullptr, 1.f, 1616, 2048, 3072}; run_gemm(H, 2048, WIN, NTOK, 4864, 2048, e, smem); }
      { EpiBf<0> e{Pb, 7808, 3072, nullptr, nullptr, nullptr, 1.f / (H_SCALE * WIN_SCALE), 2048, 0, 1616}; run_gemm<true>((const u16*)H8, 1024, WIN8, NTOK, 3072, 1024, e, smem); }
    } else {
      { EpiBf<0> e{Pb, 6656, 3584, nullptr, nullptr, nullptr, 1.f, 512, 2048, 3072}; run_gemm(H, 2048, WIN, NTOK, 3584, 2048, e, smem); }
      { EpiBf<0> e{Pb, 6656, 3072, nullptr, nullptr, nullptr, 1.f / (H_SCALE * WIN_SCALE), 2048, 0, 512}; run_gemm<true>((const u16*)H8, 1024, WIN8, NTOK, 3072, 1024, e, smem, 128, 2, 4); }
    }
    if (layer == 0) { EpiBf<0> e{MEMKV, 8192, 8192, nullptr, nullptr, nullptr}; run_gemm(MEMN, 2048, WMEMALL, 2048, 8192, 2048, e, smem); }
    GSYNC();

    if (kind == 0) {
      anorm_phase(Cb, p.a_q_norm + j * 1536, p.a_kv_norm + j * 512, CQ8);
      GSYNC();
      { EpiBf<2> e{Qb, 3072, 3072, nullptr, nullptr, ROPE, 1.f / (CQ_SCALE * WUQ_SCALE)}; run_gemm<true>((const u16*)CQ8, 768, WUQ, NTOK, 3072, 768, e, smem); }
      { EpiBf<0> e{KV, 4096, 4096, nullptr, nullptr, nullptr}; run_gemm(Cb + 1536, 2048, WUKV, NTOK, 4096, 512, e, smem); }
      GSYNC();
    } else if (kind == 1) {
      indexer_phase(Pb, MASK);
      GSYNC();
    }

    {
      const int nself = (kind == 0) ? 1024 : 2048, total = nself + 512;
      const u16* mgb = (kind == 0) ? MG : Pb;
      const int ldmg = (kind == 0) ? 4096 : (kind == 1 ? 7808 : 6656);
      const int mqcol = (kind == 0) ? 0 : (kind == 1 ? 3664 : 2560);
      const int gatecol = (kind == 0) ? 1024 : (kind == 1 ? 4688 : 3584);
      const u16* memkv = MEMKV + layer * 2048;
      float* lut_all = (float*)(smem + LDS_LUT);
      if (kind != 0) {
        for (int i = tid; i < 32 * 129; i += 512) { const int h = i / 129, r = i - h * 129; lut_all[h * 132 + r] = LUT[r * 32 + h]; }
      }
      if (tid == 0) s_item[0] = atomicAdd(&CTR[layer], 1);
      __syncthreads();
      for (int par = 0;; par ^= 1) {
        const int item = __builtin_amdgcn_readfirstlane(s_item[par]);
        if (item >= total) break;
        if (tid == 0) s_item[par ^ 1] = atomicAdd(&CTR[layer], 1);
        if (item < nself) {
          if (kind == 0) {
            const int qblk = 7 - item / 128, rem = item % 128, b = rem / 16, head = rem % 16;
            const size_t brow = (size_t)b * SEQ;
            const int tq0 = qblk * 256 + 32 * wv, tq = tq0 + r32;
            attn_core<192, 128, 128, 128, 0>(KV + brow * 4096 + head * 256, 4096, KR + brow * 64, 64, KV + brow * 4096 + head * 256 + 128, 4096,
                                            SEQ, 0, 4 * qblk + 4, Qb + (brow + tq) * 3072 + head * 192, tq, tq0, 0.07216878364870322f * LOG2E, 0,
                                            (u16*)(Y8 + (brow + tq) * 3072 + head * 128), mgb + (brow + tq) * ldmg + gatecol + head * 128,
                                            nullptr, nullptr, 0.f, -1e29f, 0.f, smem);
          } else {
            const int qb = 63 - item / 32, rem = item % 32, b = rem / 4, kvh = rem % 4;
            const size_t brow = (size_t)b * SEQ;
            const int head = kvh * 8 + wv, tq0 = qb * 32, tq = tq0 + r32;
            const float* lutw = lut_all + head * 132;
            if (kind == 1) {
              attn_core<64, 64, 64, 64, 1>(Pb + brow * 7808 + 2048 + kvh * 64, 7808, nullptr, 0, Pb + brow * 7808 + 2304 + kvh * 64, 7808,
                                          SEQ, 0, (tq0 + 31) / 64 + 1, Pb + (brow + tq) * 7808 + head * 64, tq, tq0, 0.125f * LOG2E, 0,
                                          (u16*)(Y8 + (brow + tq) * 3072 + head * 64), Pb + (brow + tq) * 7808 + gatecol + head * 64,
                                          MASK + (brow + tq) * 64, lutw, lutw[128], -1e29f, 0.f, smem);
            } else {
              const float sink = p.c_sinks[j * 32 + head] * LOG2E;
              attn_core<64, 64, 64, 64, 2>(Pb + brow * 6656 + 2048 + kvh * 64, 6656, nullptr, 0, Pb + brow * 6656 + 2304 + kvh * 64, 6656,
                                          SEQ, tq0 - 128, 3, Pb + (brow + tq) * 6656 + head * 64, tq, tq0, 0.125f * LOG2E, 0,
                                          (u16*)(Y8 + (brow + tq) * 3072 + head * 64), Pb + (brow + tq) * 6656 + gatecol + head * 64,
                                          nullptr, lutw, 0.f, sink, 1.f, smem);
            }
          }
        } else {
          const int it = item - nself, b = it / 64, mh = (it % 64) / 16, qb = it % 16;
          const size_t brow = (size_t)b * SEQ;
          const int tq0 = qb * 128 + 32 * (wv >> 1), tq = tq0 + r32, vh = wv & 1;
          attn_core<256, 256, 128, 256, 3>(memkv + (size_t)b * 256 * 8192 + mh * 256, 8192, nullptr, 0, memkv + (size_t)b * 256 * 8192 + 1024 + mh * 256, 8192,
                                          256, 0, 4, mgb + (brow + tq) * ldmg + mqcol + mh * 256, tq, tq0, 0.0625f * LOG2E, 4 * vh,
                                          (u16*)(Y8 + (brow + tq) * 3072 + 2048 + mh * 256 + 128 * vh), mgb + (brow + tq) * ldmg + gatecol + 2048 + mh * 256 + 128 * vh,
                                          nullptr, nullptr, 0.f, -1e29f, 0.f, smem);
        }
      }
    }
    convert_wt<0, true>(p.w_out + (size_t)layer * 3072 * 2048, 3072, 2048, 2048, WOUT, smem, WOUT_SCALE);
    if (layer + 1 < 4) convert_layer(layer + 1);
    GSYNC();

    { EpiResid e{xin, p.out, 1.f / (Y_SCALE * WOUT_SCALE)}; run_gemm<true>((const u16*)Y8, 1536, WOUT, NTOK, 2048, 1536, e, smem); }
    GSYNC();
  }
  rmsnorm_rows<true>(p.out, p.final_norm, p.out, NTOK);
}

extern "C" void kernel_launch(void* const* d_in, const int* in_sizes, int n_in, void* d_out, int out_size,
                              void* d_ws, size_t ws_size, hipStream_t stream) {
  static int grid_blocks = 0;
  if (!grid_blocks) {
    int dev = 0, cus = 0, per_cu = 0;
    (void)hipGetDevice(&dev);
    (void)hipDeviceGetAttribute(&cus, hipDeviceAttributeMultiprocessorCount, dev);
    (void)hipFuncSetAttribute((const void*)mega, hipFuncAttributeMaxDynamicSharedMemorySize, LDS_BYTES);
    (void)hipOccupancyMaxActiveBlocksPerMultiprocessor(&per_cu, mega, 512, LDS_BYTES);
    if (per_cu > 1) per_cu = 1;
    grid_blocks = cus * per_cu;
  }
  Params p{};
  p.x = (const float*)d_in[0]; p.mem = (const float*)d_in[1]; p.norm_in = (const float*)d_in[2]; p.final_norm = (const float*)d_in[3];
  p.mem_norm = (const float*)d_in[4]; p.rel_bias = (const float*)d_in[5]; p.w_in_a = (const float*)d_in[6]; p.a_q_norm = (const float*)d_in[7];
  p.w_uq = (const float*)d_in[8]; p.a_kv_norm = (const float*)d_in[9]; p.w_ukv = (const float*)d_in[10]; p.w_in_b = (const float*)d_in[11];
  p.w_in_c = (const float*)d_in[12]; p.c_sinks = (const float*)d_in[13]; p.w_mem_kv = (const float*)d_in[14]; p.w_out = (const float*)d_in[15];
  p.out = (float*)d_out; p.ws = (char*)d_ws;
  (void)hipMemsetAsync((char*)d_ws + OFF_CTR, 0, 16384, stream);
  void* args[] = {&p};
  (void)hipLaunchCooperativeKernel((void*)mega, dim3(grid_blocks), dim3(512), args, LDS_BYTES, stream);
}
```

```cpp
#include <hip/hip_runtime.h>
#include <hip/hip_cooperative_groups.h>
#include <stdint.h>
namespace cg = cooperative_groups;

typedef unsigned short u16;
typedef __attribute__((ext_vector_type(8))) short bf16x8;
typedef __attribute__((ext_vector_type(4))) short s16x4;
typedef __attribute__((ext_vector_type(16))) float f32x16;
typedef __attribute__((ext_vector_type(4))) float f32x4;
typedef __attribute__((ext_vector_type(2))) float f32x2;
typedef __attribute__((ext_vector_type(4))) unsigned u32x4;
typedef __attribute__((ext_vector_type(2))) unsigned u32x2;
typedef __attribute__((ext_vector_type(2))) __bf16 bf16x2_t;
typedef short v4i16_t __attribute__((ext_vector_type(4)));
#define DI __device__ __forceinline__
#define MFMA(a, b, c) __builtin_amdgcn_mfma_f32_32x32x16_bf16((a), (b), (c), 0, 0, 0)

constexpr int SEQ = 2048, NTOK = 16384;
constexpr int LDS_LUT = 133120, LDS_ITEM = LDS_LUT + 32 * 528, LDS_BYTES = LDS_ITEM + 64;
constexpr float LOG2E = 1.4426950408889634f;
constexpr float NEGV = -1e30f;
constexpr float Y_SCALE = 16.f, WOUT_SCALE = 256.f, CQ_SCALE = 16.f, WUQ_SCALE = 256.f, H_SCALE = 16.f, WIN_SCALE = 256.f;

constexpr size_t OFF_Y = 0;
constexpr size_t OFF_H = 100663296;
constexpr size_t OFF_KV = 201326592;
constexpr size_t OFF_MG = 335544320;
constexpr size_t OFF_KR = 469762048;
constexpr size_t OFF_P = 167772160;
constexpr size_t OFF_WIN = 471859200;
constexpr size_t OFF_WUQ = OFF_WIN + 32505856;
constexpr size_t OFF_WUKV = OFF_WUQ + 9437184;
constexpr size_t OFF_WOUT = OFF_WUKV + 4194304;
constexpr size_t OFF_MEMN = OFF_WOUT + 12582912;
constexpr size_t OFF_MEMKV = OFF_MEMN + 8388608;
constexpr size_t OFF_MASK = OFF_MEMKV + 33554432;
constexpr size_t OFF_ROPE = OFF_MASK + 4194304;
constexpr size_t OFF_LUT = OFF_ROPE + 524288;
constexpr size_t OFF_CTR = OFF_LUT + 32768;

struct Params {
  const float *x, *mem, *norm_in, *final_norm, *mem_norm, *rel_bias, *w_in_a, *a_q_norm, *w_uq, *a_kv_norm, *w_ukv,
      *w_in_b, *w_in_c, *c_sinks, *w_mem_kv, *w_out;
  float* out;
  char* ws;
};

DI float bf2f(unsigned b) { return __uint_as_float(b << 16); }
DI unsigned pk2(float a, float b) {
  f32x2 v = {a, b};
  return __builtin_bit_cast(unsigned, __builtin_convertvector(v, bf16x2_t));
}
DI float clamp8(float x) { return fminf(fmaxf(x, -448.f), 448.f); }
DI unsigned pk4_fp8(float a, float b, float c, float d) {
  int w = 0;
  w = __builtin_amdgcn_cvt_pk_fp8_f32(clamp8(a), clamp8(b), w, false);
  w = __builtin_amdgcn_cvt_pk_fp8_f32(clamp8(c), clamp8(d), w, true);
  return (unsigned)w;
}
DI u16 f2bf(float a) { return (u16)(pk2(a, 0.f) & 0xffffu); }
DI float wave_sum(float v) {
#pragma unroll
  for (int o = 32; o; o >>= 1) v += __shfl_xor(v, o);
  return v;
}
DI int crow(int reg, int hi) { return (reg & 3) + 8 * (reg >> 2) + 4 * hi; }
DI float xhalf_max(float m) {
  auto rr = __builtin_amdgcn_permlane32_swap(__float_as_uint(m), __float_as_uint(m), false, false);
  return fmaxf(__uint_as_float(rr[0]), __uint_as_float(rr[1]));
}
DI float xhalf_sum(float m) {
  auto rr = __builtin_amdgcn_permlane32_swap(__float_as_uint(m), __float_as_uint(m), false, false);
  return __uint_as_float(rr[0]) + __uint_as_float(rr[1]);
}
typedef __attribute__((address_space(3))) v4i16_t* lds_v4p;
DI s16x4 vtr(const char* p) {
  return __builtin_bit_cast(s16x4, __builtin_amdgcn_ds_read_tr16_b64_v4i16((lds_v4p)(p)));
}

template <int PERM, bool FP8 = false>
DI void convert_wt(const float* __restrict__ W, int K, int N, int Npad, u16* __restrict__ Wt, char* smem, float wscale = 1.f,
                   int nvalid = -1, int csplit = 0, int coff1 = 0, int coff2 = 0, int rot_n0 = 2048) {
  float* tile = (float*)smem;
  int tid = threadIdx.x; asm volatile("" : "+v"(tid));
  const int ntk = K / 64, ntn = Npad / 64;
  for (int t = blockIdx.x; t < ntk * ntn; t += gridDim.x) {
    const int tk = t % ntk, tn = t / ntk, k0 = tk * 64, n0 = tn * 64;
    __syncthreads();
#pragma unroll
    for (int i = 0; i < 2; ++i) {
      const int id = tid + 512 * i, kr = id >> 4, n4 = (id & 15) * 4;
      f32x4 v = {0.f, 0.f, 0.f, 0.f};
      const int nd = n0 + n4, nsrc = (nvalid < 0) ? nd : (nd < csplit ? nd + coff1 : nd + coff2);
      if (nd < ((nvalid < 0) ? N : nvalid)) v = *(const f32x4*)(W + (size_t)(k0 + kr) * N + nsrc);
      tile[kr * 65 + n4 + 0] = v[0]; tile[kr * 65 + n4 + 1] = v[1]; tile[kr * 65 + n4 + 2] = v[2]; tile[kr * 65 + n4 + 3] = v[3];
    }
    __syncthreads();
    {
      const int n = tid >> 3, c = tid & 7;
      bool rot = false;
      if (PERM == 1) rot = (n0 == rot_n0);
      if (PERM == 2) rot = ((tn % 3) == 2);
      const int ns = rot ? ((n >> 1) + 32 * (n & 1)) : n;
      if (FP8) {
        float f[8];
#pragma unroll
        for (int j = 0; j < 8; ++j) f[j] = tile[(c * 8 + j) * 65 + ns] * wscale;
        u32x2 o = {pk4_fp8(f[0], f[1], f[2], f[3]), pk4_fp8(f[4], f[5], f[6], f[7])};
        *(u32x2*)((unsigned char*)Wt + (size_t)(n0 + n) * K + k0 + c * 8) = o;
      } else {
        u32x4 o;
#pragma unroll
        for (int j = 0; j < 4; ++j) o[j] = pk2(tile[(c * 8 + 2 * j) * 65 + ns], tile[(c * 8 + 2 * j + 1) * 65 + ns]);
        *(u32x4*)(Wt + (size_t)(n0 + n) * K + k0 + c * 8) = o;
      }
    }
  }
}

template <bool F32OUT>
DI void rmsnorm_rows(const float* X, const float* __restrict__ g, void* outp, int nrows, unsigned char* __restrict__ out8 = nullptr) {
  int tidx = threadIdx.x; asm volatile("" : "+v"(tidx));
  const int lane = tidx & 63, gw = blockIdx.x * 8 + (tidx >> 6), nw = gridDim.x * 8;
  for (int row = gw; row < nrows; row += nw) {
    const f32x4* xr = (const f32x4*)(X + (size_t)row * 2048);
    f32x4 v[8];
    float ss = 0.f;
#pragma unroll
    for (int i = 0; i < 8; ++i) { v[i] = xr[lane + 64 * i]; ss += v[i][0] * v[i][0] + v[i][1] * v[i][1] + v[i][2] * v[i][2] + v[i][3] * v[i][3]; }
    ss = wave_sum(ss);
    const float r = rsqrtf(ss * (1.f / 2048.f) + 1e-6f);
#pragma unroll
    for (int i = 0; i < 8; ++i) {
      const f32x4 gg = ((const f32x4*)g)[lane + 64 * i];
      f32x4 o = {v[i][0] * r * gg[0], v[i][1] * r * gg[1], v[i][2] * r * gg[2], v[i][3] * r * gg[3]};
      if (F32OUT) ((f32x4*)((float*)outp + (size_t)row * 2048))[lane + 64 * i] = o;
      else { u32x2 pk = {pk2(o[0], o[1]), pk2(o[2], o[3])}; ((u32x2*)((u16*)outp + (size_t)row * 2048))[lane + 64 * i] = pk; }
      if (!F32OUT && out8) ((unsigned*)(out8 + (size_t)row * 2048))[lane + 64 * i] = pk4_fp8(o[0] * H_SCALE, o[1] * H_SCALE, o[2] * H_SCALE, o[3] * H_SCALE);
    }
  }
}

DI void anorm_phase(u16* C, const float* __restrict__ gq, const float* __restrict__ gkv, unsigned char* __restrict__ cq8) {
  int tidx = threadIdx.x; asm volatile("" : "+v"(tidx));
  const int lane = tidx & 63, gw = blockIdx.x * 8 + (tidx >> 6), nw = gridDim.x * 8;
  for (int row = gw; row < NTOK; row += nw) {
    u32x4* cr = (u32x4*)(C + (size_t)row * 2048);
    u32x4 v[4];
    float sq = 0.f, skv = 0.f;
#pragma unroll
    for (int i = 0; i < 4; ++i) {
      v[i] = cr[lane + 64 * i];
      float s = 0.f;
#pragma unroll
      for (int j = 0; j < 4; ++j) { float a = bf2f(v[i][j] & 0xffffu), b = bf2f(v[i][j] >> 16); s += a * a + b * b; }
      if (i < 3) sq += s; else skv += s;
    }
    sq = wave_sum(sq); skv = wave_sum(skv);
    const float rq = rsqrtf(sq * (1.f / 1536.f) + 1e-6f), rkv = rsqrtf(skv * (1.f / 512.f) + 1e-6f);
#pragma unroll
    for (int i = 0; i < 4; ++i) {
      const int col = (lane + 64 * i) * 8;
      const float* gp = (i < 3) ? (gq + col) : (gkv + col - 1536);
      const float r = (i < 3) ? rq : rkv;
      const f32x4 g0 = *(const f32x4*)gp, g1 = *(const f32x4*)(gp + 4);
      u32x4 o;
      o[0] = pk2(bf2f(v[i][0] & 0xffffu) * r * g0[0], bf2f(v[i][0] >> 16) * r * g0[1]);
      o[1] = pk2(bf2f(v[i][1] & 0xffffu) * r * g0[2], bf2f(v[i][1] >> 16) * r * g0[3]);
      o[2] = pk2(bf2f(v[i][2] & 0xffffu) * r * g1[0], bf2f(v[i][2] >> 16) * r * g1[1]);
      o[3] = pk2(bf2f(v[i][3] & 0xffffu) * r * g1[2], bf2f(v[i][3] >> 16) * r * g1[3]);
      cr[lane + 64 * i] = o;
      if (i < 3) {
        const float q0 = bf2f(v[i][0] & 0xffffu) * r * g0[0] * CQ_SCALE, q1 = bf2f(v[i][0] >> 16) * r * g0[1] * CQ_SCALE;
        const float q2 = bf2f(v[i][1] & 0xffffu) * r * g0[2] * CQ_SCALE, q3 = bf2f(v[i][1] >> 16) * r * g0[3] * CQ_SCALE;
        const float q4 = bf2f(v[i][2] & 0xffffu) * r * g1[0] * CQ_SCALE, q5 = bf2f(v[i][2] >> 16) * r * g1[1] * CQ_SCALE;
        const float q6 = bf2f(v[i][3] & 0xffffu) * r * g1[2] * CQ_SCALE, q7 = bf2f(v[i][3] >> 16) * r * g1[3] * CQ_SCALE;
        u32x2 w8 = {pk4_fp8(q0, q1, q2, q3), pk4_fp8(q4, q5, q6, q7)};
        *(u32x2*)(cq8 + (size_t)row * 1536 + col) = w8;
      }
    }
  }
}

namespace pg8 {
#define PG8_LAS __attribute__((address_space(3)))
constexpr int BM = 256, BK = 64, HALF = 128, HTB = HALF * BK * 2, STAGE_BYTES = 8 * HTB, NXCD = 8, WGM = 8;
DI int lds_byte(int r, int c) { const int st = (r >> 4) * 2 + (c >> 5), rr = r & 15, cc = c & 31, ob = rr * 64 + cc * 2; return st * 1024 + (ob ^ (((ob >> 9) & 1) << 5)); }
DI void stage_rc(int b, int& R, int& C) { const int st = b / 1024, sb = b % 1024, swz = sb ^ (((sb >> 9) & 1) << 5); R = (st >> 1) * 16 + swz / 64; C = (st & 1) * 32 + (swz % 64) / 2; }
DI int perm32(int rho) { const int n = rho >> 4, i = rho & 15; return 8 * (i >> 2) + 4 * n + (i & 3); }
typedef int i32x4v __attribute__((ext_vector_type(4)));
typedef int i32x8 __attribute__((ext_vector_type(8)));
DI i32x8 cat8(bf16x8 a, bf16x8 b) { const i32x4v x = __builtin_bit_cast(i32x4v, a), y = __builtin_bit_cast(i32x4v, b); return __builtin_shufflevector(x, y, 0, 1, 2, 3, 4, 5, 6, 7); }
struct Unit { int pm, pn; };
struct Gemm { const u16* A; const u16* Bt; int M, N, K, lda; };
struct StaticOrder {
  int nM, nN, nwg, G, c;
  int nA = 0, uA = 0, uB = 0;
  DI void init(int M, int N, int G_, int c_) { nM = M / BM; nN = N / BM; nwg = nM * nN; G = G_; c = c_; }
  DI bool next(int i, Unit& u) const {
    long L;
    if (nA == 0) L = (long)i * G + c;
    else if (c < nA) { if (i >= uA) return false; L = (long)i * nA + c; }
    else { if (i >= uB) return false; L = (long)nA * uA + (long)i * (G - nA) + (c - nA); }
    if (L >= nwg) return false;
    int wgid = (int)L; { const int q = nwg / NXCD, r = nwg % NXCD, xcd = wgid % NXCD, off = wgid / NXCD; wgid = (xcd < r ? xcd * (q + 1) : r * (q + 1) + (xcd - r) * q) + off; }
    const int nig = WGM * nN, gid = wgid / nig, fm = gid * WGM, gsz = (nM - fm) < WGM ? (nM - fm) : WGM;
    u.pm = fm + ((wgid % nig) % gsz); u.pn = (wgid % nig) / gsz; return true;
  }
  DI void a_ready(const Unit&) const {}
  DI void done(const Unit&) const {}
};
template <bool FP8, class Epi, class Sched>
__device__ __forceinline__ void gemm_phase(PG8_LAS unsigned char* lds, const Gemm g, const Sched& S, const Epi& E) {
    int tid = threadIdx.x; asm volatile("" : "+v"(tid));
    const int wid = __builtin_amdgcn_readfirstlane(tid >> 6), lane = tid & 63, wr = wid >> 2, wc = wid & 3, fr = lane & 15, fq = lane >> 4;
    const int K = g.K, nt = K / BK;
    unsigned voffA[2], voffB[2];
#pragma unroll
    for (int i = 0; i < 2; ++i) { int R, C; stage_rc(tid * 16 + i * 8192, R, C); const int Rb = Epi::PERM ? ((R & ~31) + perm32(R & 31)) : R;
        voffA[i] = (unsigned)(R * g.lda + C) * 2u; voffB[i] = (unsigned)(Rb * K + C) * 2u; }
    const size_t kstep = (size_t)(BK * 2);
    const size_t hstep = (size_t)HALF * K * 2, hstepA = (size_t)HALF * g.lda * 2;
    const size_t tstep = 2 * hstep, tstepA = 2 * hstepA;
    const unsigned ldsw = (unsigned)wid * 1024u;
    const int aoff = lds_byte(wr * 64 + fr, fq * 8), boff = lds_byte(wc * 32 + fr, fq * 8);
#define PG8_SA(b, h) (((b) * 2 + (h)) * HTB)
#define PG8_SB(b, h) ((4 + (b) * 2 + (h)) * HTB)
#define PG8_STAGE(bufoff, gbase, voff) do { _Pragma("unroll") for (int _i = 0; _i < 2; ++_i) \
        __builtin_amdgcn_global_load_lds((const unsigned*)((const char*)(gbase) + (voff)[_i]), (PG8_LAS unsigned*)(lds + (bufoff) + ldsw + _i * 8192), 16, 0, 0); } while (0)
#define PG8_LDA(dst, b, h) do { _Pragma("unroll") for (int m = 0; m < 4; ++m) _Pragma("unroll") for (int k = 0; k < 2; ++k) dst[m][k] = *(const PG8_LAS bf16x8*)(lds + PG8_SA(b, h) + aoff + m * 2048 + k * 1024); } while (0)
#define PG8_LDB(dst, b, h) do { _Pragma("unroll") for (int n = 0; n < 2; ++n) _Pragma("unroll") for (int k = 0; k < 2; ++k) dst[n][k] = *(const PG8_LAS bf16x8*)(lds + PG8_SB(b, h) + boff + n * 2048 + k * 1024); } while (0)
#define PG8_MMA(ai, bj, At, Bt) do { __builtin_amdgcn_s_setprio(1); _Pragma("unroll") for (int m = 0; m < 4; ++m) _Pragma("unroll") for (int n = 0; n < 2; ++n) { \
        if constexpr (FP8) { const i32x8 bv_ = cat8(Bt[n][0], Bt[n][1]), av_ = cat8(At[m][0], At[m][1]); \
            asm volatile("s_nop 1\n\tv_mfma_scale_f32_16x16x128_f8f6f4 %0, %1, %2, %0, %3, %3 op_sel_hi:[0,0,0]" : "+v"(acc[ai][bj][m][n]) : "v"(bv_), "v"(av_), "v"(sc127)); } \
        else { _Pragma("unroll") for (int k = 0; k < 2; ++k) acc[ai][bj][m][n] = __builtin_amdgcn_mfma_f32_16x16x32_bf16(Bt[n][k], At[m][k], acc[ai][bj][m][n], 0, 0, 0); } } \
        __builtin_amdgcn_s_setprio(0); } while (0)
#define PG8_WAIT_V(n) asm volatile("s_waitcnt vmcnt(" #n ")" ::: "memory")
#define PG8_WAIT_L(n) asm volatile("s_waitcnt lgkmcnt(" #n ")" ::: "memory")
#define PG8_BAR __builtin_amdgcn_s_barrier()
#define PG8_SCHED __builtin_amdgcn_sched_barrier(0)
    Unit cur, nxt; int ui = 0;
    if (!S.next(0, cur)) return;
    f32x4 acc[2][2][4][2];
#pragma unroll
    for (int a = 0; a < 2; ++a)
#pragma unroll
        for (int b = 0; b < 2; ++b)
#pragma unroll
            for (int m = 0; m < 4; ++m)
#pragma unroll
                for (int n = 0; n < 2; ++n) acc[a][b][m][n] = (f32x4){0.f, 0.f, 0.f, 0.f};
    bf16x8 At[4][2], B0[2][2], B1[2][2];
    int sc127 = 0x7F7F7F7F; asm volatile("" : "+v"(sc127));
    const char* cA = (const char*)g.A + (size_t)cur.pm * tstepA; const char* cB = (const char*)g.Bt + (size_t)cur.pn * tstep;
    S.a_ready(cur);
    PG8_STAGE(PG8_SB(0, 0), cB, voffB); PG8_STAGE(PG8_SA(0, 0), cA, voffA); PG8_STAGE(PG8_SB(0, 1), cB + hstep, voffB); PG8_STAGE(PG8_SA(0, 1), cA + hstepA, voffA);
    if (wr == 1) PG8_BAR;
    PG8_WAIT_V(4); PG8_BAR;
    PG8_STAGE(PG8_SB(1, 0), cB + kstep, voffB); PG8_STAGE(PG8_SA(1, 0), cA + kstep, voffA); PG8_STAGE(PG8_SB(1, 1), cB + hstep + kstep, voffB);
    PG8_WAIT_V(6); PG8_BAR;
    for (;;) {
        const bool has_next = S.next(ui + 1, nxt);
        const char* nA = has_next ? (const char*)g.A + (size_t)nxt.pm * tstepA : cA; const char* nB = has_next ? (const char*)g.Bt + (size_t)nxt.pn * tstep : cB;
        for (int t = 0; t < nt; t += 2) {
            const bool last = (t == nt - 2);
            const char* a1 = cA + (size_t)(t + 1) * kstep;
            const char* a2 = last ? nA : cA + (size_t)(t + 2) * kstep; const char* b2 = last ? nB : cB + (size_t)(t + 2) * kstep;
            const char* a3 = a2 + kstep; const char* b3 = b2 + kstep;
            if (last && has_next) S.a_ready(nxt);
            PG8_LDB(B0, 0, 0); PG8_SCHED; PG8_LDA(At, 0, 0); PG8_STAGE(PG8_SA(1, 1), a1 + hstepA, voffA);
            PG8_WAIT_L(8); PG8_BAR; PG8_WAIT_L(0); PG8_MMA(0, 0, At, B0); PG8_BAR; PG8_SCHED;
            PG8_LDB(B1, 0, 1); PG8_STAGE(PG8_SB(0, 0), b2, voffB);
            PG8_BAR; PG8_WAIT_L(0); PG8_MMA(0, 1, At, B1); PG8_BAR;
            PG8_LDA(At, 0, 1); PG8_STAGE(PG8_SA(0, 0), a2, voffA);
            PG8_BAR; PG8_WAIT_L(0); PG8_MMA(1, 0, At, B0); PG8_BAR; PG8_SCHED;
            PG8_STAGE(PG8_SB(0, 1), b2 + hstep, voffB);
            PG8_WAIT_V(6); PG8_BAR; PG8_MMA(1, 1, At, B1); PG8_BAR;
            PG8_LDB(B0, 1, 0); PG8_SCHED; PG8_LDA(At, 1, 0); PG8_STAGE(PG8_SA(0, 1), a2 + hstepA, voffA);
            PG8_WAIT_L(8); PG8_BAR; PG8_WAIT_L(0); PG8_MMA(0, 0, At, B0); PG8_BAR; PG8_SCHED;
            PG8_LDB(B1, 1, 1); PG8_STAGE(PG8_SB(1, 0), b3, voffB);
            PG8_BAR; PG8_WAIT_L(0); PG8_MMA(0, 1, At, B1); PG8_BAR;
            PG8_LDA(At, 1, 1); PG8_STAGE(PG8_SA(1, 0), a3, voffA);
            PG8_BAR; PG8_WAIT_L(0); PG8_MMA(1, 0, At, B0); PG8_BAR; PG8_SCHED;
            PG8_STAGE(PG8_SB(1, 1), b3 + hstep, voffB);
            PG8_WAIT_V(6); PG8_BAR; PG8_MMA(1, 1, At, B1); PG8_BAR;
        }
        if constexpr (FP8) asm volatile("s_nop 15\n\ts_nop 15" ::: "memory");
        if constexpr (!Epi::AFTER_DRAIN) { E(acc, cur, wr, wc, fr, fq); S.done(cur); }
        if (!has_next) break;
#pragma unroll
        for (int a = 0; a < 2; ++a)
#pragma unroll
            for (int b = 0; b < 2; ++b)
#pragma unroll
                for (int m = 0; m < 4; ++m)
#pragma unroll
                    for (int n = 0; n < 2; ++n) acc[a][b][m][n] = (f32x4){0.f, 0.f, 0.f, 0.f};
        cur = nxt; cA = nA; cB = nB; ++ui;
    }
    PG8_WAIT_V(0);
    if (wr == 0) PG8_BAR;
    PG8_BAR;
    if constexpr (Epi::AFTER_DRAIN) { E.fused(acc, cur, wr, wc, fr, fq, lds, wid, lane); S.done(cur); }
#undef PG8_SA
#undef PG8_SB
#undef PG8_STAGE
#undef PG8_LDA
#undef PG8_LDB
#undef PG8_MMA
#undef PG8_WAIT_V
#undef PG8_WAIT_L
#undef PG8_BAR
#undef PG8_SCHED
}

}

struct EpiResid {
  static constexpr bool PERM = false, AFTER_DRAIN = false;
  const float* xin; float* xout; float sc;
  DI void operator()(const f32x4 (&acc)[2][2][4][2], const pg8::Unit& u, int wr, int wc, int fr, int fq) const {
    const int row0 = u.pm * 256 + wr * 64 + fr, col0 = u.pn * 256 + wc * 32 + 4 * fq;
#pragma unroll
    for (int ai = 0; ai < 2; ++ai)
#pragma unroll
      for (int m = 0; m < 4; ++m) {
        const size_t ro = (size_t)(row0 + ai * 128 + m * 16) * 2048 + col0;
#pragma unroll
        for (int bj = 0; bj < 2; ++bj)
#pragma unroll
          for (int n = 0; n < 2; ++n) {
            const size_t o = ro + bj * 128 + n * 16;
            const f32x4 xv = *(const f32x4*)(xin + o);
            *(f32x4*)(xout + o) = xv + acc[ai][bj][m][n] * sc;
          }
        asm volatile("" ::: "memory");
      }
  }
};
template <int MODE>
struct EpiBf {
  static constexpr bool PERM = true, AFTER_DRAIN = false;
  u16* d0; int ld0; int N; u16* d1; u16* d2; const f32x2* rope; float sc = 1.f; int csplit = 0, coff1 = 0, coff2 = 0;
  DI void rot(f32x4& v0, f32x4& v1, int row, int col) const {
    const f32x4* cp = (const f32x4*)(rope + (row & 2047) * 32 + ((col & 63) >> 1));
    const f32x4 c01 = cp[0], c23 = cp[1];
    const f32x4 a = {v0[0] * c01[0] - v0[1] * c01[1], v0[1] * c01[0] + v0[0] * c01[1], v0[2] * c01[2] - v0[3] * c01[3], v0[3] * c01[2] + v0[2] * c01[3]};
    const f32x4 b = {v1[0] * c23[0] - v1[1] * c23[1], v1[1] * c23[0] + v1[0] * c23[1], v1[2] * c23[2] - v1[3] * c23[3], v1[3] * c23[2] + v1[2] * c23[3]};
    v0 = a; v1 = b;
  }
  DI void operator()(const f32x4 (&acc)[2][2][4][2], const pg8::Unit& u, int wr, int wc, int fr, int fq) const {
    const int row0 = u.pm * 256 + wr * 64 + fr, colb = u.pn * 256 + wc * 32 + 8 * fq;
#pragma unroll
    for (int ai = 0; ai < 2; ++ai)
#pragma unroll
      for (int m = 0; m < 4; ++m) {
        const int row = row0 + ai * 128 + m * 16;
#pragma unroll
        for (int bj = 0; bj < 2; ++bj) {
          const int col = colb + bj * 128;
          f32x4 v0 = acc[ai][bj][m][0] * sc, v1 = acc[ai][bj][m][1] * sc;
          u16* dst = nullptr;
          if (MODE == 0) { if (col < N) dst = d0 + (size_t)row * ld0 + (col + coff2 + ((col < csplit) ? (coff1 - coff2) : 0)); }
          else if (MODE == 1) {
            const int oc = col + coff2 + ((col < csplit) ? (coff1 - coff2) : 0);
            if (col < N) {
              if (oc < 2048) dst = d0 + (size_t)row * 2048 + oc;
              else if (oc < 2112) { rot(v0, v1, row, oc); dst = d2 + (size_t)row * 64 + (oc - 2048); }
              else dst = d1 + (size_t)row * 4096 + (oc - 2112);
            }
          } else if (MODE == 3) {
            if (col < N) { const bool lo = col < csplit; u16* bp = lo ? d0 : d1; const int ldd = lo ? 2048 : 4096, oc = lo ? col : col + (coff2 - 2112); dst = bp + (size_t)row * ldd + oc + (lo ? coff1 : 0); }
          } else {
            if (((col >> 6) % 3) == 2) rot(v0, v1, row, col);
            dst = d0 + (size_t)row * 3072 + col;
          }
          if (dst) { u32x4 w = {pk2(v0[0], v0[1]), pk2(v0[2], v0[3]), pk2(v1[0], v1[1]), pk2(v1[2], v1[3])}; *(u32x4*)dst = w; }
        }
        asm volatile("" ::: "memory");
      }
  }
};

template <bool FP8 = false, class Epi>
DI void run_gemm(const u16* A, int lda, const u16* Bt, int M, int N, int K, const Epi& e, char* smem, int nA = 0, int uA = 0, int uB = 0) {
  __syncthreads();
  pg8::Gemm g{A, Bt, M, N, K, lda};
  pg8::StaticOrder S; S.init(M, N, gridDim.x, blockIdx.x);
  if (nA > 0 && (int)gridDim.x > nA && nA * uA + ((int)gridDim.x - nA) * uB == S.nwg) { S.nA = nA; S.uA = uA; S.uB = uB; }
  pg8::gemm_phase<FP8>(( __attribute__((address_space(3))) unsigned char*)smem, g, S, e);
  __syncthreads();
}

typedef __attribute__((address_space(3))) unsigned* lds_u32p;
template <int OFF> DI void rd4(bf16x8 (&f)[4], unsigned addr) {
  asm volatile("ds_read_b128 %0, %4 offset:%5\n\tds_read_b128 %1, %4 offset:%6\n\tds_read_b128 %2, %4 offset:%7\n\tds_read_b128 %3, %4 offset:%8\n\ts_waitcnt lgkmcnt(0)"
               : "=&v"(f[0]), "=&v"(f[1]), "=&v"(f[2]), "=&v"(f[3]) : "v"(addr), "i"(OFF), "i"(OFF + 32), "i"(OFF + 64), "i"(OFF + 96) : "memory");
}
template <int OFF> DI void rdv8(s16x4 (&v)[8], unsigned addr) {
  asm volatile("ds_read_b64_tr_b16 %0, %8 offset:%9\n\tds_read_b64_tr_b16 %1, %8 offset:%10\n\tds_read_b64_tr_b16 %2, %8 offset:%11\n\tds_read_b64_tr_b16 %3, %8 offset:%12\n\t"
               "ds_read_b64_tr_b16 %4, %8 offset:%13\n\tds_read_b64_tr_b16 %5, %8 offset:%14\n\tds_read_b64_tr_b16 %6, %8 offset:%15\n\tds_read_b64_tr_b16 %7, %8 offset:%16\n\ts_waitcnt lgkmcnt(0)"
               : "=&v"(v[0]), "=&v"(v[1]), "=&v"(v[2]), "=&v"(v[3]), "=&v"(v[4]), "=&v"(v[5]), "=&v"(v[6]), "=&v"(v[7])
               : "v"(addr), "i"(OFF), "i"(OFF + 512), "i"(OFF + 1024), "i"(OFF + 1536), "i"(OFF + 2048), "i"(OFF + 2560), "i"(OFF + 3072), "i"(OFF + 3584) : "memory");
}
template <int KSTR, int ND, int N>
DI f32x16 s_block(unsigned kaddr, const bf16x8* qf) {
  const f32x16 z16 = {0.f, 0.f, 0.f, 0.f, 0.f, 0.f, 0.f, 0.f, 0.f, 0.f, 0.f, 0.f, 0.f, 0.f, 0.f, 0.f};
  bf16x8 f[4];
  rd4<N * 32 * KSTR>(f, kaddr);
  f32x16 a = MFMA(f[0], qf[0], z16); a = MFMA(f[1], qf[1], a); a = MFMA(f[2], qf[2], a); a = MFMA(f[3], qf[3], a);
  if constexpr (ND > 4) { rd4<N * 32 * KSTR + 128>(f, kaddr); a = MFMA(f[0], qf[4], a); a = MFMA(f[1], qf[5], a); a = MFMA(f[2], qf[6], a); a = MFMA(f[3], qf[7], a); }
  if constexpr (ND > 8) { rd4<N * 32 * KSTR + 256>(f, kaddr); a = MFMA(f[0], qf[8], a); a = MFMA(f[1], qf[9], a); a = MFMA(f[2], qf[10], a); a = MFMA(f[3], qf[11], a); }
  if constexpr (ND > 12) { rd4<N * 32 * KSTR + 384>(f, kaddr); a = MFMA(f[0], qf[12], a); a = MFMA(f[1], qf[13], a); a = MFMA(f[2], qf[14], a); a = MFMA(f[3], qf[15], a); }
  return a;
}
template <int CB> DI void pv_block(f32x16& o, unsigned vaddr, const bf16x8 (&pb)[2][2]) {
  s16x4 v[8];
  rdv8<CB * 4096>(v, vaddr);
#pragma unroll
  for (int q = 0; q < 4; ++q) {
    const bf16x8 vf = {v[2 * q][0], v[2 * q][1], v[2 * q][2], v[2 * q][3], v[2 * q + 1][0], v[2 * q + 1][1], v[2 * q + 1][2], v[2 * q + 1][3]};
    o = MFMA(vf, pb[q >> 1][q & 1], o);
  }
}
template <int DQK, int W1, int DV, int VW, int MODE>
DI void attn_core(const u16* __restrict__ k1, int ldk1, const u16* __restrict__ k2, int ldk2, const u16* __restrict__ vsrc, int ldv,
                  int kv_len, int kbase0, int ntiles, const u16* qrow, int tq, int tq0, float c2, int vcb0, u16* yrow,
                  const u16* grow, const unsigned* maskrow, const float* lutw, float bias_far, float m_init, float l_init, char* smem) {
  constexpr int KSTR = DQK * 2 + 16, KCH = DQK / 8;
  constexpr int ND = DQK / 16, NCB = DV / 32, BUF = 64 * KSTR + (VW / 32) * 4096;
  constexpr int NKI = KSTR / 16, NVI = VW / 8;
  static_assert(ND % 4 == 0 && NCB <= 4, "fragment batches");
  int tid0 = threadIdx.x; asm volatile("" : "+v"(tid0));
  const int lane = tid0 & 63, r32 = lane & 31, hi = lane >> 5;
  const int wv = __builtin_amdgcn_readfirstlane(tid0 >> 6);
  const unsigned lds0 = (unsigned)(uintptr_t)smem;
  bf16x8 qf[ND];
#pragma unroll
  for (int d0 = 0; d0 < ND; ++d0) qf[d0] = *(const bf16x8*)(qrow + d0 * 16 + hi * 8);
  f32x16 o[NCB];
#pragma unroll
  for (int cb = 0; cb < NCB; ++cb)
#pragma unroll
    for (int r = 0; r < 16; ++r) o[cb][r] = 0.f;
  float m = m_init, l = (hi == 0) ? l_init : 0.f;
  const unsigned klane = (unsigned)(r32 * KSTR + hi * 16);
  const unsigned vlane = (unsigned)(64 * KSTR + vcb0 * 4096 + ((lane >> 4) & 1) * 32 + (lane & 3) * 8 + (4 * hi + ((lane & 15) >> 2)) * 64);
  unsigned mwn[2] = {0u, 0u};
  constexpr int NKS = (NKI + 7) / 8, NVS = (NVI + 7) / 8;
  const u16* kptr[NKS]; int kstr[NKS]; const u16* vptr[NVS];
  if (MODE != 2) {
    int ln = threadIdx.x & 63; asm volatile("" : "+v"(ln));
#pragma unroll
    for (int ii = 0; ii < NKS; ++ii) {
      const int i = wv + 8 * ii, ob = i * 1024 + ln * 16, row = ob / KSTR;
      int c = (ob - row * KSTR) >> 4; c = (c >= KCH) ? 0 : c;
      const bool seg1 = c < W1 / 8;
      kptr[ii] = seg1 ? (k1 + ((kbase0 + row) * ldk1 + c * 8)) : (k2 + ((kbase0 + row) * ldk2 + (c - W1 / 8) * 8));
      kstr[ii] = seg1 ? 64 * ldk1 : 64 * ldk2;
    }
#pragma unroll
    for (int ii = 0; ii < NVS; ++ii) {
      const int i = wv + 8 * ii, ob = i * 1024 + ln * 16, cbk = ob >> 12, row = (ob & 4095) >> 6, cw = (ob & 63) >> 4;
      vptr[ii] = vsrc + ((kbase0 + row) * ldv + (cbk * 4 + cw) * 8);
    }
  }
  auto stage_tile = [&](int kb, int buf) {
    const unsigned bofs = (unsigned)(buf * BUF);
    if (MODE != 2) {
#pragma unroll
      for (int ii = 0; ii < NKS; ++ii) {
        const int i = wv + 8 * ii;
        if (i < NKI) { __builtin_amdgcn_global_load_lds((const unsigned*)kptr[ii], (lds_u32p)(smem + bofs + i * 1024), 16, 0, 0); kptr[ii] += kstr[ii]; }
      }
#pragma unroll
      for (int ii = 0; ii < NVS; ++ii) {
        const int i = wv + 8 * ii;
        if (i < NVI) { __builtin_amdgcn_global_load_lds((const unsigned*)vptr[ii], (lds_u32p)(smem + bofs + 64 * KSTR + i * 1024), 16, 0, 0); vptr[ii] += 64 * ldv; }
      }
    } else {
      int ln = threadIdx.x & 63; asm volatile("" : "+v"(ln));
#pragma unroll
      for (int ii = 0; ii < NKS; ++ii) {
        const int i = wv + 8 * ii;
        if (i < NKI) {
          const int ob = i * 1024 + ln * 16, row = ob / KSTR;
          int c = (ob - row * KSTR) >> 4; c = (c >= KCH) ? 0 : c;
          int key = kb + row; key = key < 0 ? 0 : (key >= kv_len ? kv_len - 1 : key);
          const u16* src = (c < W1 / 8) ? (k1 + (key * ldk1 + c * 8)) : (k2 + (key * ldk2 + (c - W1 / 8) * 8));
          __builtin_amdgcn_global_load_lds((const unsigned*)src, (lds_u32p)(smem + bofs + i * 1024), 16, 0, 0);
        }
      }
#pragma unroll
      for (int ii = 0; ii < NVS; ++ii) {
        const int i = wv + 8 * ii;
        if (i < NVI) {
          const int ob = i * 1024 + ln * 16, cbk = ob >> 12, row = (ob & 4095) >> 6, cw = (ob & 63) >> 4;
          int key = kb + row; key = key < 0 ? 0 : (key >= kv_len ? kv_len - 1 : key);
          __builtin_amdgcn_global_load_lds((const unsigned*)(vsrc + (key * ldv + (cbk * 4 + cw) * 8)), (lds_u32p)(smem + bofs + 64 * KSTR + i * 1024), 16, 0, 0);
        }
      }
    }
    if (MODE == 1) { mwn[0] = maskrow[(kb >> 5)]; mwn[1] = maskrow[(kb >> 5) + 1]; }
  };
  stage_tile(kbase0, 0);
  asm volatile("s_waitcnt vmcnt(0)" ::: "memory");
  __syncthreads();
  for (int t = 0; t < ntiles; ++t) {
    const int kb = kbase0 + t * 64;
    const unsigned bufa = lds0 + (unsigned)((t & 1) * BUF);
    const unsigned mw0 = mwn[0], mw1 = mwn[1];
    if (t + 1 < ntiles) stage_tile(kb + 64, (t + 1) & 1);
    if (!(MODE == 0 && kb > tq0 + 31)) {
      f32x16 s[2];
      s[0] = s_block<KSTR, ND, 0>(bufa + klane, qf);
      s[1] = s_block<KSTR, ND, 1>(bufa + klane, qf);
      if (MODE == 0) {
        s[0] = s[0] * c2; s[1] = s[1] * c2;
        if (__builtin_amdgcn_readfirstlane((int)(kb + 63 > tq0))) {
#pragma unroll
          for (int n = 0; n < 2; ++n)
#pragma unroll
            for (int i = 0; i < 16; ++i) { const int key = kb + 32 * n + crow(i, hi); if (key > tq) s[n][i] = NEGV; }
        }
      } else if (MODE == 1) {
        const bool far = (tq0 - (kb + 63)) >= 128;
#pragma unroll
        for (int n = 0; n < 2; ++n) {
          const unsigned wb = (n ? mw1 : mw0) >> (4 * hi);
          if (far) {
#pragma unroll
            for (int i = 0; i < 16; ++i) {
              const float v = fmaf(s[n][i], c2, bias_far);
              s[n][i] = ((wb >> ((i & 3) + 8 * (i >> 2))) & 1u) ? v : NEGV;
            }
          } else {
#pragma unroll
            for (int i = 0; i < 16; ++i) {
              const int key = kb + 32 * n + crow(i, hi);
              int rel = tq - key; rel = rel < 0 ? 0 : (rel > 128 ? 128 : rel);
              const float v = fmaf(s[n][i], c2, lutw[rel]);
              s[n][i] = ((wb >> ((i & 3) + 8 * (i >> 2))) & 1u) ? v : NEGV;
            }
          }
        }
      } else if (MODE == 2) {
#pragma unroll
        for (int n = 0; n < 2; ++n)
#pragma unroll
          for (int i = 0; i < 16; ++i) {
            const int key = kb + 32 * n + crow(i, hi), rel = tq - key;
            const bool ok = ((unsigned)rel < 128u) && (key >= 0);
            const float v = fmaf(s[n][i], c2, lutw[rel & 127]);
            s[n][i] = ok ? v : NEGV;
          }
      } else {
#pragma unroll
        for (int n = 0; n < 2; ++n)
#pragma unroll
          for (int i = 0; i < 16; ++i) s[n][i] *= c2;
      }
      float mx = s[0][0];
#pragma unroll
      for (int i = 1; i < 16; ++i) mx = fmaxf(mx, s[0][i]);
#pragma unroll
      for (int i = 0; i < 16; ++i) mx = fmaxf(mx, s[1][i]);
      mx = xhalf_max(mx);
      if (__any(mx - m > 8.0f)) {
        const float mnew = fmaxf(m, mx), alpha = __builtin_amdgcn_exp2f(m - mnew);
        m = mnew; l *= alpha;
#pragma unroll
        for (int cb = 0; cb < NCB; ++cb)
#pragma unroll
          for (int r = 0; r < 16; ++r) o[cb][r] *= alpha;
      }
      {
        const float nm = -m;
        f32x16 e0 = s[0] + nm, e1 = s[1] + nm;
#pragma unroll
        for (int i = 0; i < 16; ++i) { e0[i] = __builtin_amdgcn_exp2f(e0[i]); e1[i] = __builtin_amdgcn_exp2f(e1[i]); }
        s[0] = e0; s[1] = e1;
        const f32x16 sm = e0 + e1;
        typedef __attribute__((ext_vector_type(8))) float f32x8;
        const f32x8 h8 = sm.lo + sm.hi;
        const f32x4 h4 = h8.lo + h8.hi;
        const f32x2 h2 = h4.lo + h4.hi;
        l += h2[0] + h2[1];
      }
      bf16x8 pb[2][2];
#pragma unroll
      for (int n = 0; n < 2; ++n)
#pragma unroll
        for (int s2 = 0; s2 < 2; ++s2) {
          u32x4 pw = {pk2(s[n][8 * s2 + 0], s[n][8 * s2 + 1]), pk2(s[n][8 * s2 + 2], s[n][8 * s2 + 3]),
                      pk2(s[n][8 * s2 + 4], s[n][8 * s2 + 5]), pk2(s[n][8 * s2 + 6], s[n][8 * s2 + 7])};
          pb[n][s2] = __builtin_bit_cast(bf16x8, pw);
        }
      pv_block<0>(o[0], bufa + vlane, pb);
      if constexpr (NCB > 1) pv_block<1>(o[1], bufa + vlane, pb);
      if constexpr (NCB > 2) pv_block<2>(o[2], bufa + vlane, pb);
      if constexpr (NCB > 3) pv_block<3>(o[3], bufa + vlane, pb);
    }
    asm volatile("s_waitcnt vmcnt(0)" ::: "memory");
    __syncthreads();
  }
  const float inv = __builtin_amdgcn_rcpf(xhalf_sum(l));
#pragma unroll
  for (int cb = 0; cb < NCB; ++cb)
#pragma unroll
    for (int g = 0; g < 4; ++g) {
      const int dv = 32 * cb + 8 * g + 4 * hi;
      const u32x2 gg = *(const u32x2*)(grow + dv);
      float gv[4] = {bf2f(gg[0] & 0xffffu), bf2f(gg[0] >> 16), bf2f(gg[1] & 0xffffu), bf2f(gg[1] >> 16)};
      float ov[4];
#pragma unroll
      for (int j = 0; j < 4; ++j) {
        const float sg = gv[j] * __builtin_amdgcn_rcpf(1.f + __builtin_amdgcn_exp2f(-LOG2E * gv[j]));
        ov[j] = o[cb][4 * g + j] * inv * sg;
      }
      *(unsigned*)((unsigned char*)yrow + dv) = pk4_fp8(ov[0] * Y_SCALE, ov[1] * Y_SCALE, ov[2] * Y_SCALE, ov[3] * Y_SCALE);
      __builtin_amdgcn_sched_barrier(0);
    }
}

DI unsigned ordkey(float f) { const unsigned b = __float_as_uint(f); return b ^ ((unsigned)((int)b >> 31) | 0x80000000u); }
DI void indexer_phase(const u16* __restrict__ P, unsigned* __restrict__ mask) {
  int tidx = threadIdx.x; asm volatile("" : "+v"(tidx));
  const int lane = tidx & 63, r32 = lane & 31, hi = lane >> 5;
  const int gw = blockIdx.x * 8 + (tidx >> 6), nw = gridDim.x * 8;
  for (int base = 0, pass = 0; base < 8192; base += nw, ++pass) {
    const int item = (pass & 1) ? base + (nw - 1 - gw) : base + gw;
    if (item >= 8192) continue;
    const int b = item & 7, t0 = (1023 - (item >> 3)) * 2;
    const size_t brow = (size_t)b * SEQ;
    const int g = (r32 >> 2) & 1, head = 4 * (r32 >> 3) + (r32 & 3);
    bf16x8 aq[4];
#pragma unroll
    for (int s = 0; s < 4; ++s) aq[s] = *(const bf16x8*)(P + (brow + t0 + g) * 7808 + 2560 + head * 64 + 16 * s + 8 * hi);
    float wv[16];
    {
      const u32x4 w0 = *(const u32x4*)(P + (brow + t0 + hi) * 7808 + 3648), w1 = *(const u32x4*)(P + (brow + t0 + hi) * 7808 + 3656);
#pragma unroll
      for (int j = 0; j < 4; ++j) { wv[2 * j] = bf2f(w0[j] & 0xffffu); wv[2 * j + 1] = bf2f(w0[j] >> 16); wv[8 + 2 * j] = bf2f(w1[j] & 0xffffu); wv[8 + 2 * j + 1] = bf2f(w1[j] >> 16); }
    }
    const int tme = t0 + hi, kbmax = (t0 + 1) >> 5;
    unsigned sc[64];
#pragma unroll
    for (int kb = 0; kb < 64; ++kb) {
      unsigned u = 0u;
      if (kb <= kbmax) {
        f32x16 a;
#pragma unroll
        for (int r = 0; r < 16; ++r) a[r] = 0.f;
        const u16* kp = P + (brow + 32 * kb + r32) * 7808 + 3584 + 8 * hi;
#pragma unroll
        for (int s = 0; s < 4; ++s) { const bf16x8 bk = *(const bf16x8*)(kp + 16 * s); a = MFMA(aq[s], bk, a); }
        float v = 0.f;
#pragma unroll
        for (int i = 0; i < 16; ++i) v = fmaf(wv[i], fmaxf(a[i], 0.f), v);
        u = (32 * kb + r32 <= tme) ? ordkey(v) : 0u;
      }
      sc[kb] = u;
    }
    const int target = (tme + 1 < 256) ? tme + 1 : 256;
    unsigned T = 0u;
    for (int bit = 31; bit >= 0; --bit) {
      const unsigned Tp = T | (1u << bit);
      int cnt = 0;
#pragma unroll
      for (int kb = 0; kb < 64; ++kb) cnt += (sc[kb] >= Tp) ? 1 : 0;
#pragma unroll
      for (int o = 16; o; o >>= 1) cnt += __shfl_xor(cnt, o);
      if (cnt >= target) T = Tp;
    }
    unsigned w0 = 0u, w1 = 0u;
#pragma unroll
    for (int kb = 0; kb < 64; ++kb) {
      const bool pred = (sc[kb] >= T) && (sc[kb] != 0u);
      const unsigned long long bal = __ballot(pred);
      const unsigned wd = (unsigned)(bal >> (32 * hi));
      if ((kb & 31) == r32) { if (kb < 32) w0 = wd; else w1 = wd; }
    }
    mask[(brow + tme) * 64 + r32] = w0;
    mask[(brow + tme) * 64 + 32 + r32] = w1;
  }
}

#define XB_TMO      128
#define XB_XCNT(j)  (256  + 64 * (j))
#define XB_XSUB(j)  (1280 + 64 * (j))
#define XB_XGEN(j)  (2304 + 64 * (j))
#define XB_TOP      3328
#define XB_TOPGEN   3392
#define XCD_BAR_WORDS 3456
#define XB_SPIN_CAP (1u << 22)
DI unsigned xb_ld(unsigned* p)              { return __hip_atomic_load(p, __ATOMIC_RELAXED, __HIP_MEMORY_SCOPE_AGENT); }
DI unsigned xb_add(unsigned* p, unsigned v) { return __hip_atomic_fetch_add(p, v, __ATOMIC_RELAXED, __HIP_MEMORY_SCOPE_AGENT); }
DI unsigned xb_xcc_id() { return (unsigned)__builtin_amdgcn_s_getreg((3 << 11) | 20) & 0xFu; }
#define XB_SPIN(cond, bar) do { unsigned _sp = 0; while (cond) { __builtin_amdgcn_s_sleep(1); \
    if ((++_sp & 255u) == 0u) { if (xb_ld(&(bar)[XB_TMO])) break; if (_sp > XB_SPIN_CAP) { atomicAdd(&(bar)[XB_TMO], 1u); break; } } } } while (0)
DI void xcd_barrier_complete(unsigned* bar, unsigned x, unsigned& nloc, unsigned& nx) {
  const unsigned G = gridDim.x;
  unsigned sum, cnt, mine, sp = 0u;
  for (;;) {
    sum = 0u; cnt = 0u; mine = 0u;
#pragma unroll
    for (unsigned j = 0; j < 16; ++j) { const unsigned c = xb_ld(&bar[XB_XCNT(j)]); sum += c; cnt += (c > 0u) ? 1u : 0u; mine = (j == x) ? c : mine; }
    if (sum == G) break;
    __builtin_amdgcn_s_sleep(1);
    if ((++sp & 255u) == 0u) { if (xb_ld(&bar[XB_TMO])) break; if (sp > XB_SPIN_CAP) { atomicAdd(&bar[XB_TMO], 1u); break; } }
  }
  nloc = mine > 0u ? mine : 1u; nx = cnt > 0u ? cnt : 1u;
}
DI void xcd_barrier(unsigned* bar, volatile unsigned* st) {
  asm volatile("s_waitcnt vmcnt(0)" ::: "memory");
  __syncthreads();
  if (threadIdx.x == 0) {
    const unsigned x = xb_xcc_id();
    __builtin_amdgcn_s_waitcnt(0);
    unsigned nloc = st[0], nx = st[1];
    if (nloc == 0u) { xcd_barrier_complete(bar, x, nloc, nx); st[0] = nloc; st[1] = nx; }
    const unsigned old = xb_add(&bar[XB_XSUB(x)], 1u);
    const unsigned gen = old / nloc;
    if (old + 1u == (gen + 1u) * nloc) {
      __builtin_amdgcn_fence(__ATOMIC_RELEASE, "agent");
      asm volatile("s_waitcnt vmcnt(0)" ::: "memory");
      const unsigned og = xb_add(&bar[XB_TOP], 1u);
      const unsigned tg = og / nx;
      if (og + 1u == (tg + 1u) * nx) xb_add(&bar[XB_TOPGEN], 1u);
      else XB_SPIN(xb_ld(&bar[XB_TOPGEN]) == tg, bar);
      __builtin_amdgcn_fence(__ATOMIC_ACQUIRE, "agent");
      xb_add(&bar[XB_XGEN(x)], 1u);
      asm volatile("s_waitcnt vmcnt(0)" ::: "memory");
    } else {
      XB_SPIN(xb_ld(&bar[XB_XGEN(x)]) == gen, bar);
      __builtin_amdgcn_fence(__ATOMIC_ACQUIRE, "agent");
      asm volatile("s_waitcnt vmcnt(0)" ::: "memory");
    }
  }
  __syncthreads();
}
#define GSYNC() xcd_barrier(XBAR, xb_st)
__global__ void __launch_bounds__(512, 2) mega(Params p) {
  cg::grid_group grid = cg::this_grid();
  extern __shared__ __attribute__((aligned(16))) char smem[];
  volatile int* s_item = (volatile int*)(smem + LDS_ITEM);
  char* ws = p.ws;
  unsigned char* Y8 = (unsigned char*)(ws + OFF_Y);
  u16* WIN8 = (u16*)(ws + OFF_WIN + 19922944);
  unsigned char* CQ8 = (unsigned char*)(ws + OFF_Y + 67108864);     u16* H = (u16*)(ws + OFF_H); u16* Cb = (u16*)(ws + OFF_Y); u16* Qb = (u16*)(ws + OFF_H);
  u16* KV = (u16*)(ws + OFF_KV); u16* MG = (u16*)(ws + OFF_MG); u16* KR = (u16*)(ws + OFF_KR); u16* Pb = (u16*)(ws + OFF_P);
  u16* WIN = (u16*)(ws + OFF_WIN); u16* WUQ = (u16*)(ws + OFF_WUQ); u16* WUKV = (u16*)(ws + OFF_WUKV); u16* WOUT = (u16*)(ws + OFF_WOUT);
  u16* WMEMALL = (u16*)(ws + OFF_KV); u16* MEMN = (u16*)(ws + OFF_MEMN); u16* MEMKV = (u16*)(ws + OFF_MEMKV);
  unsigned* MASK = (unsigned*)(ws + OFF_MASK); f32x2* ROPE = (f32x2*)(ws + OFF_ROPE); float* LUT = (float*)(ws + OFF_LUT);
  int* CTR = (int*)(ws + OFF_CTR);
  unsigned* XBAR = (unsigned*)(ws + OFF_CTR + 1024);
  volatile unsigned* xb_st = (volatile unsigned*)(smem + LDS_ITEM + 16);
  if (threadIdx.x == 0) { xb_st[0] = 0u; xb_st[1] = 0u; (void)xb_add(&XBAR[XB_XCNT(xb_xcc_id())], 1u); }
  __syncthreads();
  const int tid = threadIdx.x, lane = tid & 63, wv = __builtin_amdgcn_readfirstlane(tid >> 6), r32 = lane & 31, hi = lane >> 5;
  const int gtid = blockIdx.x * 512 + tid, gthreads = gridDim.x * 512;

  if (p.ws == nullptr) grid.sync();
  for (int i = gtid; i < 2048 * 32; i += gthreads) {
    const int pos = i >> 5, j = i & 31;
    const float inv = 1.0f / powf(10000.0f, (float)(2 * j) / 64.0f);
    const float ang = (float)pos * inv;
    const float k = rintf(ang * 0.15915494309189535f);
    float r = fmaf(-k, 6.28318548202514648f, ang);
    r = fmaf(-k, -1.74845553e-7f, r);
    f32x2 cs = {__cosf(r), __sinf(r)};
    ROPE[i] = cs;
  }
  for (int i = gtid; i < 129 * 32; i += gthreads) {
    const int rel = i >> 5, h = i & 31;
    int bucket;
    if (rel < 16) bucket = rel;
    else { const int lg = 16 + (int)(logf((float)rel / 16.0f) / 2.0794415416798357f * 16.0f); bucket = lg < 31 ? lg : 31; }
    LUT[i] = p.rel_bias[bucket * 32 + h] * LOG2E;
  }
  rmsnorm_rows<false>(p.mem, p.mem_norm, MEMN, 2048);
#pragma unroll 1
  for (int l = 0; l < 4; ++l) convert_wt<0>(p.w_mem_kv + (size_t)l * 2048 * 2048, 2048, 2048, 2048, WMEMALL + (size_t)l * 2048 * 2048, smem);

  auto convert_layer = [&](int L) {
    const int kind = L % 3, j = L / 3;
    if (kind == 0) {
    convert_wt<1>(p.w_in_a + (size_t)j * 2048 * 6208, 2048, 6208, 3840, WIN, smem, 1.f, 3648, 576, 1536, 2560, 512);
    convert_wt<0, true>(p.w_in_a + (size_t)j * 2048 * 6208, 2048, 6208, 2560, WIN8, smem, WIN_SCALE, 2560, 1536, 0, 576);
    convert_wt<2, true>(p.w_uq + (size_t)j * 1536 * 3072, 1536, 3072, 3072, WUQ, smem, WUQ_SCALE);
    convert_wt<0>(p.w_ukv + (size_t)j * 512 * 4096, 512, 4096, 4096, WUKV, smem);
  } else if (kind == 1) {
    convert_wt<0>(p.w_in_b, 2048, 7760, 4864, WIN, smem, 1.f, 4688, 1616, 2048, 3072);
    convert_wt<0, true>(p.w_in_b, 2048, 7760, 3072, WIN8, smem, WIN_SCALE, 3072, 2048, 0, 1616);
  } else {
    convert_wt<0>(p.w_in_c, 2048, 6656, 3584, WIN, smem, 1.f, 3584, 512, 2048, 3072);
    convert_wt<0, true>(p.w_in_c, 2048, 6656, 3072, WIN8, smem, WIN_SCALE, 3072, 2048, 0, 512);
  }
  };
#pragma unroll 1
  for (int layer = 0; layer < 4; ++layer) {
    const int kind = layer % 3, j = layer / 3;
    const float* xin = (layer == 0) ? p.x : p.out;
    unsigned char* H8 = (unsigned char*)(ws + ((kind == 0) ? OFF_KV + 67108864 : OFF_Y));
    rmsnorm_rows<false>(xin, p.norm_in + layer * 2048, H, NTOK, H8);
    if (layer == 0) convert_layer(0);
    GSYNC();

    if (kind == 0) {
      { EpiBf<1> e{Cb, 2048, 3648, MG, KR, ROPE, 1.f, 576, 1536, 2560}; run_gemm(H, 2048, WIN, NTOK, 3840, 2048, e, smem); }
      { EpiBf<3> e{Cb, 2048, 2560, MG, nullptr, nullptr, 1.f / (H_SCALE * WIN_SCALE), 1536, 0, 576}; run_gemm<true>((const u16*)H8, 1024, WIN8, NTOK, 2560, 1024, e, smem, 192, 2, 4); }
    }
    else if (kind == 1) {
      { EpiBf<0> e{Pb, 7808, 4688, nullptr, nullptr, nullptr, 1.f, 1616, 2048, 3072}; run_gemm(H, 2048, WIN, NTOK, 4864, 2048, e, smem); }
      { EpiBf<0> e{Pb, 7808, 3072, nullptr, nullptr, nullptr, 1.f / (H_SCALE * WIN_SCALE), 2048, 0, 1616}; run_gemm<true>((const u16*)H8, 1024, WIN8, NTOK, 3072, 1024, e, smem); }
    } else {
      { EpiBf<0> e{Pb, 6656, 3584, nullptr, nullptr, nullptr, 1.f, 512, 2048, 3072}; run_gemm(H, 2048, WIN, NTOK, 3584, 2048, e, smem); }
      { EpiBf<0> e{Pb, 6656, 3072, nullptr, nullptr, nullptr, 1.f / (H_SCALE * WIN_SCALE), 2048, 0, 512}; run_gemm<true>((const u16*)H8, 1024, WIN8, NTOK, 3072, 1024, e, smem, 128, 2, 4); }
    }
    if (layer == 0) { EpiBf<0> e{MEMKV, 8192, 8192, nullptr, nullptr, nullptr}; run_gemm(MEMN, 2048, WMEMALL, 2048, 8192, 2048, e, smem); }
    GSYNC();

    if (kind == 0) {
      anorm_phase(Cb, p.a_q_norm + j * 1536, p.a_kv_norm + j * 512, CQ8);
      GSYNC();
      { EpiBf<2> e{Qb, 3072, 3072, nullptr, nullptr, ROPE, 1.f / (CQ_SCALE * WUQ_SCALE)}; run_gemm<true>((const u16*)CQ8, 768, WUQ, NTOK, 3072, 768, e, smem); }
      { EpiBf<0> e{KV, 4096, 4096, nullptr, nullptr, nullptr}; run_gemm(Cb + 1536, 2048, WUKV, NTOK, 4096, 512, e, smem); }
      GSYNC();
    } else if (kind == 1) {
      indexer_phase(Pb, MASK);
      GSYNC();
    }

    {
      const int nself = (kind == 0) ? 1024 : 2048, total = nself + 512;
      const u16* mgb = (kind == 0) ? MG : Pb;
      const int ldmg = (kind == 0) ? 4096 : (kind == 1 ? 7808 : 6656);
      const int mqcol = (kind == 0) ? 0 : (kind == 1 ? 3664 : 2560);
      const int gatecol = (kind == 0) ? 1024 : (kind == 1 ? 4688 : 3584);
      const u16* memkv = MEMKV + layer * 2048;
      float* lut_all = (float*)(smem + LDS_LUT);
      if (kind != 0) {
        for (int i = tid; i < 32 * 129; i += 512) { const int h = i / 129, r = i - h * 129; lut_all[h * 132 + r] = LUT[r * 32 + h]; }
      }
      if (tid == 0) s_item[0] = atomicAdd(&CTR[layer], 1);
      __syncthreads();
      for (int par = 0;; par ^= 1) {
        const int item = __builtin_amdgcn_readfirstlane(s_item[par]);
        if (item >= total) break;
        if (tid == 0) s_item[par ^ 1] = atomicAdd(&CTR[layer], 1);
        if (item < nself) {
          if (kind == 0) {
            const int qblk = 7 - item / 128, rem = item % 128, b = rem / 16, head = rem % 16;
            const size_t brow = (size_t)b * SEQ;
            const int tq0 = qblk * 256 + 32 * wv, tq = tq0 + r32;
            attn_core<192, 128, 128, 128, 0>(KV + brow * 4096 + head * 256, 4096, KR + brow * 64, 64, KV + brow * 4096 + head * 256 + 128, 4096,
                                            SEQ, 0, 4 * qblk + 4, Qb + (brow + tq) * 3072 + head * 192, tq, tq0, 0.07216878364870322f * LOG2E, 0,
                                            (u16*)(Y8 + (brow + tq) * 3072 + head * 128), mgb + (brow + tq) * ldmg + gatecol + head * 128,
                                            nullptr, nullptr, 0.f, -1e29f, 0.f, smem);
          } else {
            const int qb = 63 - item / 32, rem = item % 32, b = rem / 4, kvh = rem % 4;
            const size_t brow = (size_t)b * SEQ;
            const int head = kvh * 8 + wv, tq0 = qb * 32, tq = tq0 + r32;
            const float* lutw = lut_all + head * 132;
            if (kind == 1) {
              attn_core<64, 64, 64, 64, 1>(Pb + brow * 7808 + 2048 + kvh * 64, 7808, nullptr, 0, Pb + brow * 7808 + 2304 + kvh * 64, 7808,
                                          SEQ, 0, (tq0 + 31) / 64 + 1, Pb + (brow + tq) * 7808 + head * 64, tq, tq0, 0.125f * LOG2E, 0,
                                          (u16*)(Y8 + (brow + tq) * 3072 + head * 64), Pb + (brow + tq) * 7808 + gatecol + head * 64,
                                          MASK + (brow + tq) * 64, lutw, lutw[128], -1e29f, 0.f, smem);
            } else {
              const float sink = p.c_sinks[j * 32 + head] * LOG2E;
              attn_core<64, 64, 64, 64, 2>(Pb + brow * 6656 + 2048 + kvh * 64, 6656, nullptr, 0, Pb + brow * 6656 + 2304 + kvh * 64, 6656,
                                          SEQ, tq0 - 128, 3, Pb + (brow + tq) * 6656 + head * 64, tq, tq0, 0.125f * LOG2E, 0,
                                          (u16*)(Y8 + (brow + tq) * 3072 + head * 64), Pb + (brow + tq) * 6656 + gatecol + head * 64,
                                          nullptr, lutw, 0.f, sink, 1.f, smem);
            }
          }
        } else {
          const int it = item - nself, b = it / 64, mh = (it % 64) / 16, qb = it % 16;
          const size_t brow = (size_t)b * SEQ;
          const int tq0 = qb * 128 + 32 * (wv >> 1), tq = tq0 + r32, vh = wv & 1;
          attn_core<256, 256, 128, 256, 3>(memkv + (size_t)b * 256 * 8192 + mh * 256, 8192, nullptr, 0, memkv + (size_t)b * 256 * 8192 + 1024 + mh * 256, 8192,
                                          256, 0, 4, mgb + (brow + tq) * ldmg + mqcol + mh * 256, tq, tq0, 0.0625f * LOG2E, 4 * vh,
                                          (u16*)(Y8 + (brow + tq) * 3072 + 2048 + mh * 256 + 128 * vh), mgb + (brow + tq) * ldmg + gatecol + 2048 + mh * 256 + 128 * vh,
                                          nullptr, nullptr, 0.f, -1e29f, 0.f, smem);
        }
      }
    }
    convert_wt<0, true>(p.w_out + (size_t)layer * 3072 * 2048, 3072, 2048, 2048, WOUT, smem, WOUT_SCALE);
    if (layer + 1 < 4) convert_layer(layer + 1);
    GSYNC();

    { EpiResid e{xin, p.out, 1.f / (Y_SCALE * WOUT_SCALE)}; run_gemm<true>((const u16*)Y8, 1536, WOUT, NTOK, 2048, 1536, e, smem); }
    GSYNC();
  }
  rmsnorm_rows<true>(p.out, p.final_norm, p.out, NTOK);
}

extern "C" void kernel_launch(void* const* d_in, const int* in_sizes, int n_in, void* d_out, int out_size,
                              void* d_ws, size_t ws_size, hipStream_t stream) {
  static int grid_blocks = 0;
  if (!grid_blocks) {
    int dev = 0, cus = 0, per_cu = 0;
    (void)hipGetDevice(&dev);
    (void)hipDeviceGetAttribute(&cus, hipDeviceAttributeMultiprocessorCount, dev);
    (void)hipFuncSetAttribute((const void*)mega, hipFuncAttributeMaxDynamicSharedMemorySize, LDS_BYTES);
    (void)hipOccupancyMaxActiveBlocksPerMultiprocessor(&per_cu, mega, 512, LDS_BYTES);
    if (per_cu > 1) per_cu = 1;
    grid_blocks = cus * per_cu;
  }
  Params p{};
  p.x = (const float*)d_in[0]; p.mem = (const float*)d_in[1]; p.norm_in = (const float*)d_in[2]; p.final_norm = (const float*)d_in[3];
  p.mem_norm = (const float*)d_in[4]; p.rel_bias = (const float*)d_in[5]; p.w_in_a = (const float*)d_in[6]; p.a_q_norm = (const float*)d_in[7];
  p.w_uq = (const float*)d_in[8]; p.a_kv_norm = (const float*)d_in[9]; p.w_ukv = (const float*)d_in[10]; p.w_in_b = (const float*)d_in[11];
  p.w_in_c = (const float*)d_in[12]; p.c_sinks = (const float*)d_in[13]; p.w_mem_kv = (const float*)d_in[14]; p.w_out = (const float*)d_in[15];
  p.out = (float*)d_out; p.ws = (char*)d_ws;
  (void)hipMemsetAsync((char*)d_ws + OFF_CTR, 0, 16384, stream);
  void* args[] = {&p};
  (void)hipLaunchCooperativeKernel((void*)mega, dim3(grid_blocks), dim3(512), args, LDS_BYTES, stream);
}
```

```cpp
#include <hip/hip_runtime.h>
#include <hip/hip_cooperative_groups.h>
#include <stdint.h>
namespace cg = cooperative_groups;

typedef unsigned short u16;
typedef __attribute__((ext_vector_type(8))) short bf16x8;
typedef __attribute__((ext_vector_type(4))) short s16x4;
typedef __attribute__((ext_vector_type(16))) float f32x16;
typedef __attribute__((ext_vector_type(4))) float f32x4;
typedef __attribute__((ext_vector_type(2))) float f32x2;
typedef __attribute__((ext_vector_type(4))) unsigned u32x4;
typedef __attribute__((ext_vector_type(2))) unsigned u32x2;
typedef __attribute__((ext_vector_type(2))) __bf16 bf16x2_t;
typedef short v4i16_t __attribute__((ext_vector_type(4)));
#define DI __device__ __forceinline__
#define MFMA(a, b, c) __builtin_amdgcn_mfma_f32_32x32x16_bf16((a), (b), (c), 0, 0, 0)

constexpr int SEQ = 2048, NTOK = 16384;
constexpr int LDS_LUT = 133120, LDS_ITEM = LDS_LUT + 32 * 528, LDS_BYTES = LDS_ITEM + 64;
constexpr float LOG2E = 1.4426950408889634f;
constexpr float NEGV = -1e30f;
constexpr float Y_SCALE = 16.f, WOUT_SCALE = 256.f, CQ_SCALE = 16.f, WUQ_SCALE = 256.f, H_SCALE = 16.f, WIN_SCALE = 256.f;

constexpr size_t OFF_Y = 0;
constexpr size_t OFF_H = 100663296;
constexpr size_t OFF_KV = 201326592;
constexpr size_t OFF_MG = 335544320;
constexpr size_t OFF_KR = 469762048;
constexpr size_t OFF_P = 167772160;
constexpr size_t OFF_WIN = 471859200;
constexpr size_t OFF_WUQ = OFF_WIN + 32505856;
constexpr size_t OFF_WUKV = OFF_WUQ + 9437184;
constexpr size_t OFF_WOUT = OFF_WUKV + 4194304;
constexpr size_t OFF_MEMN = OFF_WOUT + 12582912;
constexpr size_t OFF_MEMKV = OFF_MEMN + 8388608;
constexpr size_t OFF_MASK = OFF_MEMKV + 33554432;
constexpr size_t OFF_ROPE = OFF_MASK + 4194304;
constexpr size_t OFF_LUT = OFF_ROPE + 524288;
constexpr size_t OFF_CTR = OFF_LUT + 32768;

struct Params {
  const float *x, *mem, *norm_in, *final_norm, *mem_norm, *rel_bias, *w_in_a, *a_q_norm, *w_uq, *a_kv_norm, *w_ukv,
      *w_in_b, *w_in_c, *c_sinks, *w_mem_kv, *w_out;
  float* out;
  char* ws;
};

DI float bf2f(unsigned b) { return __uint_as_float(b << 16); }
DI unsigned pk2(float a, float b) {
  f32x2 v = {a, b};
  return __builtin_bit_cast(unsigned, __builtin_convertvector(v, bf16x2_t));
}
DI float clamp8(float x) { return fminf(fmaxf(x, -448.f), 448.f); }
DI unsigned pk4_fp8(float a, float b, float c, float d) {
  int w = 0;
  w = __builtin_amdgcn_cvt_pk_fp8_f32(clamp8(a), clamp8(b), w, false);
  w = __builtin_amdgcn_cvt_pk_fp8_f32(clamp8(c), clamp8(d), w, true);
  return (unsigned)w;
}
DI u16 f2bf(float a) { return (u16)(pk2(a, 0.f) & 0xffffu); }
DI float wave_sum(float v) {
#pragma unroll
  for (int o = 32; o; o >>= 1) v += __shfl_xor(v, o);
  return v;
}
DI int crow(int reg, int hi) { return (reg & 3) + 8 * (reg >> 2) + 4 * hi; }
DI float xhalf_max(float m) {
  auto rr = __builtin_amdgcn_permlane32_swap(__float_as_uint(m), __float_as_uint(m), false, false);
  return fmaxf(__uint_as_float(rr[0]), __uint_as_float(rr[1]));
}
DI float xhalf_sum(float m) {
  auto rr = __builtin_amdgcn_permlane32_swap(__float_as_uint(m), __float_as_uint(m), false, false);
  return __uint_as_float(rr[0]) + __uint_as_float(rr[1]);
}
typedef __attribute__((address_space(3))) v4i16_t* lds_v4p;
DI s16x4 vtr(const char* p) {
  return __builtin_bit_cast(s16x4, __builtin_amdgcn_ds_read_tr16_b64_v4i16((lds_v4p)(p)));
}

template <int PERM, bool FP8 = false>
DI void convert_wt(const float* __restrict__ W, int K, int N, int Npad, u16* __restrict__ Wt, char* smem, float wscale = 1.f,
                   int nvalid = -1, int csplit = 0, int coff1 = 0, int coff2 = 0, int rot_n0 = 2048) {
  float* tile = (float*)smem;
  int tid = threadIdx.x; asm volatile("" : "+v"(tid));
  const int ntk = K / 64, ntn = Npad / 64;
  for (int t = blockIdx.x; t < ntk * ntn; t += gridDim.x) {
    const int tk = t % ntk, tn = t / ntk, k0 = tk * 64, n0 = tn * 64;
    __syncthreads();
#pragma unroll
    for (int i = 0; i < 2; ++i) {
      const int id = tid + 512 * i, kr = id >> 4, n4 = (id & 15) * 4;
      f32x4 v = {0.f, 0.f, 0.f, 0.f};
      const int nd = n0 + n4, nsrc = (nvalid < 0) ? nd : (nd < csplit ? nd + coff1 : nd + coff2);
      if (nd < ((nvalid < 0) ? N : nvalid)) v = *(const f32x4*)(W + (size_t)(k0 + kr) * N + nsrc);
      tile[kr * 65 + n4 + 0] = v[0]; tile[kr * 65 + n4 + 1] = v[1]; tile[kr * 65 + n4 + 2] = v[2]; tile[kr * 65 + n4 + 3] = v[3];
    }
    __syncthreads();
    {
      const int n = tid >> 3, c = tid & 7;
      bool rot = false;
      if (PERM == 1) rot = (n0 == rot_n0);
      if (PERM == 2) rot = ((tn % 3) == 2);
      const int ns = rot ? ((n >> 1) + 32 * (n & 1)) : n;
      if (FP8) {
        float f[8];
#pragma unroll
        for (int j = 0; j < 8; ++j) f[j] = tile[(c * 8 + j) * 65 + ns] * wscale;
        u32x2 o = {pk4_fp8(f[0], f[1], f[2], f[3]), pk4_fp8(f[4], f[5], f[6], f[7])};
        *(u32x2*)((unsigned char*)Wt + (size_t)(n0 + n) * K + k0 + c * 8) = o;
      } else {
        u32x4 o;
#pragma unroll
        for (int j = 0; j < 4; ++j) o[j] = pk2(tile[(c * 8 + 2 * j) * 65 + ns], tile[(c * 8 + 2 * j + 1) * 65 + ns]);
        *(u32x4*)(Wt + (size_t)(n0 + n) * K + k0 + c * 8) = o;
      }
    }
  }
}

template <bool F32OUT>
DI void rmsnorm_rows(const float* X, const float* __restrict__ g, void* outp, int nrows, unsigned char* __restrict__ out8 = nullptr) {
  int tidx = threadIdx.x; asm volatile("" : "+v"(tidx));
  const int lane = tidx & 63, gw = blockIdx.x * 8 + (tidx >> 6), nw = gridDim.x * 8;
  for (int row = gw; row < nrows; row += nw) {
    const f32x4* xr = (const f32x4*)(X + (size_t)row * 2048);
    f32x4 v[8];
    float ss = 0.f;
#pragma unroll
    for (int i = 0; i < 8; ++i) { v[i] = xr[lane + 64 * i]; ss += v[i][0] * v[i][0] + v[i][1] * v[i][1] + v[i][2] * v[i][2] + v[i][3] * v[i][3]; }
    ss = wave_sum(ss);
    const float r = rsqrtf(ss * (1.f / 2048.f) + 1e-6f);
#pragma unroll
    for (int i = 0; i < 8; ++i) {
      const f32x4 gg = ((const f32x4*)g)[lane + 64 * i];
      f32x4 o = {v[i][0] * r * gg[0], v[i][1] * r * gg[1], v[i][2] * r * gg[2], v[i][3] * r * gg[3]};
      if (F32OUT) ((f32x4*)((float*)outp + (size_t)row * 2048))[lane + 64 * i] = o;
      else { u32x2 pk = {pk2(o[0], o[1]), pk2(o[2], o[3])}; ((u32x2*)((u16*)outp + (size_t)row * 2048))[lane + 64 * i] = pk; }
      if (!F32OUT && out8) ((unsigned*)(out8 + (size_t)row * 2048))[lane + 64 * i] = pk4_fp8(o[0] * H_SCALE, o[1] * H_SCALE, o[2] * H_SCALE, o[3] * H_SCALE);
    }
  }
}

DI void anorm_phase(u16* C, const float* __restrict__ gq, const float* __restrict__ gkv, unsigned char* __restrict__ cq8) {
  int tidx = threadIdx.x; asm volatile("" : "+v"(tidx));
  const int lane = tidx & 63, gw = blockIdx.x * 8 + (tidx >> 6), nw = gridDim.x * 8;
  for (int row = gw; row < NTOK; row += nw) {
    u32x4* cr = (u32x4*)(C + (size_t)row * 2048);
    u32x4 v[4];
    float sq = 0.f, skv = 0.f;
#pragma unroll
    for (int i = 0; i < 4; ++i) {
      v[i] = cr[lane + 64 * i];
      float s = 0.f;
#pragma unroll
      for (int j = 0; j < 4; ++j) { float a = bf2f(v[i][j] & 0xffffu), b = bf2f(v[i][j] >> 16); s += a * a + b * b; }
      if (i < 3) sq += s; else skv += s;
    }
    sq = wave_sum(sq); skv = wave_sum(skv);
    const float rq = rsqrtf(sq * (1.f / 1536.f) + 1e-6f), rkv = rsqrtf(skv * (1.f / 512.f) + 1e-6f);
#pragma unroll
    for (int i = 0; i < 4; ++i) {
      const int col = (lane + 64 * i) * 8;
      const float* gp = (i < 3) ? (gq + col) : (gkv + col - 1536);
      const float r = (i < 3) ? rq : rkv;
      const f32x4 g0 = *(const f32x4*)gp, g1 = *(const f32x4*)(gp + 4);
      u32x4 o;
      o[0] = pk2(bf2f(v[i][0] & 0xffffu) * r * g0[0], bf2f(v[i][0] >> 16) * r * g0[1]);
      o[1] = pk2(bf2f(v[i][1] & 0xffffu) * r * g0[2], bf2f(v[i][1] >> 16) * r * g0[3]);
      o[2] = pk2(bf2f(v[i][2] & 0xffffu) * r * g1[0], bf2f(v[i][2] >> 16) * r * g1[1]);
      o[3] = pk2(bf2f(v[i][3] & 0xffffu) * r * g1[2], bf2f(v[i][3] >> 16) * r * g1[3]);
      cr[lane + 64 * i] = o;
      if (i < 3) {
        const float q0 = bf2f(v[i][0] & 0xffffu) * r * g0[0] * CQ_SCALE, q1 = bf2f(v[i][0] >> 16) * r * g0[1] * CQ_SCALE;
        const float q2 = bf2f(v[i][1] & 0xffffu) * r * g0[2] * CQ_SCALE, q3 = bf2f(v[i][1] >> 16) * r * g0[3] * CQ_SCALE;
        const float q4 = bf2f(v[i][2] & 0xffffu) * r * g1[0] * CQ_SCALE, q5 = bf2f(v[i][2] >> 16) * r * g1[1] * CQ_SCALE;
        const float q6 = bf2f(v[i][3] & 0xffffu) * r * g1[2] * CQ_SCALE, q7 = bf2f(v[i][3] >> 16) * r * g1[3] * CQ_SCALE;
        u32x2 w8 = {pk4_fp8(q0, q1, q2, q3), pk4_fp8(q4, q5, q6, q7)};
        *(u32x2*)(cq8 + (size_t)row * 1536 + col) = w8;
      }
    }
  }
}

namespace pg8 {
#define PG8_LAS __attribute__((address_space(3)))
constexpr int BM = 256, BK = 64, HALF = 128, HTB = HALF * BK * 2, STAGE_BYTES = 8 * HTB, NXCD = 8, WGM = 8;
DI int lds_byte(int r, int c) { const int st = (r >> 4) * 2 + (c >> 5), rr = r & 15, cc = c & 31, ob = rr * 64 + cc * 2; return st * 1024 + (ob ^ (((ob >> 9) & 1) << 5)); }
DI void stage_rc(int b, int& R, int& C) { const int st = b / 1024, sb = b % 1024, swz = sb ^ (((sb >> 9) & 1) << 5); R = (st >> 1) * 16 + swz / 64; C = (st & 1) * 32 + (swz % 64) / 2; }
DI int perm32(int rho) { const int n = rho >> 4, i = rho & 15; return 8 * (i >> 2) + 4 * n + (i & 3); }
typedef int i32x4v __attribute__((ext_vector_type(4)));
typedef int i32x8 __attribute__((ext_vector_type(8)));
DI i32x8 cat8(bf16x8 a, bf16x8 b) { const i32x4v x = __builtin_bit_cast(i32x4v, a), y = __builtin_bit_cast(i32x4v, b); return __builtin_shufflevector(x, y, 0, 1, 2, 3, 4, 5, 6, 7); }
struct Unit { int pm, pn; };
struct Gemm { const u16* A; const u16* Bt; int M, N, K, lda; };
struct StaticOrder {
  int nM, nN, nwg, G, c;
  int nA = 0, uA = 0, uB = 0;
  DI void init(int M, int N, int G_, int c_) { nM = M / BM; nN = N / BM; nwg = nM * nN; G = G_; c = c_; }
  DI bool next(int i, Unit& u) const {
    long L;
    if (nA == 0) L = (long)i * G + c;
    else if (c < nA) { if (i >= uA) return false; L = (long)i * nA + c; }
    else { if (i >= uB) return false; L = (long)nA * uA + (long)i * (G - nA) + (c - nA); }
    if (L >= nwg) return false;
    int wgid = (int)L; { const int q = nwg / NXCD, r = nwg % NXCD, xcd = wgid % NXCD, off = wgid / NXCD; wgid = (xcd < r ? xcd * (q + 1) : r * (q + 1) + (xcd - r) * q) + off; }
    const int nig = WGM * nN, gid = wgid / nig, fm = gid * WGM, gsz = (nM - fm) < WGM ? (nM - fm) : WGM;
    u.pm = fm + ((wgid % nig) % gsz); u.pn = (wgid % nig) / gsz; return true;
  }
  DI void a_ready(const Unit&) const {}
  DI void done(const Unit&) const {}
};
template <bool FP8, class Epi, class Sched>
__device__ __forceinline__ void gemm_phase(PG8_LAS unsigned char* lds, const Gemm g, const Sched& S, const Epi& E) {
    int tid = threadIdx.x; asm volatile("" : "+v"(tid));
    const int wid = __builtin_amdgcn_readfirstlane(tid >> 6), lane = tid & 63, wr = wid >> 2, wc = wid & 3, fr = lane & 15, fq = lane >> 4;
    const int K = g.K, nt = K / BK;
    unsigned voffA[2], voffB[2];
#pragma unroll
    for (int i = 0; i < 2; ++i) { int R, C; stage_rc(tid * 16 + i * 8192, R, C); const int Rb = Epi::PERM ? ((R & ~31) + perm32(R & 31)) : R;
        voffA[i] = (unsigned)(R * g.lda + C) * 2u; voffB[i] = (unsigned)(Rb * K + C) * 2u; }
    const size_t kstep = (size_t)(BK * 2);
    const size_t hstep = (size_t)HALF * K * 2, hstepA = (size_t)HALF * g.lda * 2;
    const size_t tstep = 2 * hstep, tstepA = 2 * hstepA;
    const unsigned ldsw = (unsigned)wid * 1024u;
    const int aoff = lds_byte(wr * 64 + fr, fq * 8), boff = lds_byte(wc * 32 + fr, fq * 8);
#define PG8_SA(b, h) (((b) * 2 + (h)) * HTB)
#define PG8_SB(b, h) ((4 + (b) * 2 + (h)) * HTB)
#define PG8_STAGE(bufoff, gbase, voff) do { _Pragma("unroll") for (int _i = 0; _i < 2; ++_i) \
        __builtin_amdgcn_global_load_lds((const unsigned*)((const char*)(gbase) + (voff)[_i]), (PG8_LAS unsigned*)(lds + (bufoff) + ldsw + _i * 8192), 16, 0, 0); } while (0)
#define PG8_LDA(dst, b, h) do { _Pragma("unroll") for (int m = 0; m < 4; ++m) _Pragma("unroll") for (int k = 0; k < 2; ++k) dst[m][k] = *(const PG8_LAS bf16x8*)(lds + PG8_SA(b, h) + aoff + m * 2048 + k * 1024); } while (0)
#define PG8_LDB(dst, b, h) do { _Pragma("unroll") for (int n = 0; n < 2; ++n) _Pragma("unroll") for (int k = 0; k < 2; ++k) dst[n][k] = *(const PG8_LAS bf16x8*)(lds + PG8_SB(b, h) + boff + n * 2048 + k * 1024); } while (0)
#define PG8_MMA(ai, bj, At, Bt) do { __builtin_amdgcn_s_setprio(1); _Pragma("unroll") for (int m = 0; m < 4; ++m) _Pragma("unroll") for (int n = 0; n < 2; ++n) { \
        if constexpr (FP8) { const i32x8 bv_ = cat8(Bt[n][0], Bt[n][1]), av_ = cat8(At[m][0], At[m][1]); \
            asm volatile("s_nop 1\n\tv_mfma_scale_f32_16x16x128_f8f6f4 %0, %1, %2, %0, %3, %3 op_sel_hi:[0,0,0]" : "+v"(acc[ai][bj][m][n]) : "v"(bv_), "v"(av_), "v"(sc127)); } \
        else { _Pragma("unroll") for (int k = 0; k < 2; ++k) acc[ai][bj][m][n] = __builtin_amdgcn_mfma_f32_16x16x32_bf16(Bt[n][k], At[m][k], acc[ai][bj][m][n], 0, 0, 0); } } \
        __builtin_amdgcn_s_setprio(0); } while (0)
#define PG8_WAIT_V(n) asm volatile("s_waitcnt vmcnt(" #n ")" ::: "memory")
#define PG8_WAIT_L(n) asm volatile("s_waitcnt lgkmcnt(" #n ")" ::: "memory")
#define PG8_BAR __builtin_amdgcn_s_barrier()
#define PG8_SCHED __builtin_amdgcn_sched_barrier(0)
    Unit cur, nxt; int ui = 0;
    if (!S.next(0, cur)) return;
    f32x4 acc[2][2][4][2];
#pragma unroll
    for (int a = 0; a < 2; ++a)
#pragma unroll
        for (int b = 0; b < 2; ++b)
#pragma unroll
            for (int m = 0; m < 4; ++m)
#pragma unroll
                for (int n = 0; n < 2; ++n) acc[a][b][m][n] = (f32x4){0.f, 0.f, 0.f, 0.f};
    bf16x8 At[4][2], B0[2][2], B1[2][2];
    int sc127 = 0x7F7F7F7F; asm volatile("" : "+v"(sc127));
    const char* cA = (const char*)g.A + (size_t)cur.pm * tstepA; const char* cB = (const char*)g.Bt + (size_t)cur.pn * tstep;
    S.a_ready(cur);
    PG8_STAGE(PG8_SB(0, 0), cB, voffB); PG8_STAGE(PG8_SA(0, 0), cA, voffA); PG8_STAGE(PG8_SB(0, 1), cB + hstep, voffB); PG8_STAGE(PG8_SA(0, 1), cA + hstepA, voffA);
    if (wr == 1) PG8_BAR;
    PG8_WAIT_V(4); PG8_BAR;
    PG8_STAGE(PG8_SB(1, 0), cB + kstep, voffB); PG8_STAGE(PG8_SA(1, 0), cA + kstep, voffA); PG8_STAGE(PG8_SB(1, 1), cB + hstep + kstep, voffB);
    PG8_WAIT_V(6); PG8_BAR;
    for (;;) {
        const bool has_next = S.next(ui + 1, nxt);
        const char* nA = has_next ? (const char*)g.A + (size_t)nxt.pm * tstepA : cA; const char* nB = has_next ? (const char*)g.Bt + (size_t)nxt.pn * tstep : cB;
        for (int t = 0; t < nt; t += 2) {
            const bool last = (t == nt - 2);
            const char* a1 = cA + (size_t)(t + 1) * kstep;
            const char* a2 = last ? nA : cA + (size_t)(t + 2) * kstep; const char* b2 = last ? nB : cB + (size_t)(t + 2) * kstep;
            const char* a3 = a2 + kstep; const char* b3 = b2 + kstep;
            if (last && has_next) S.a_ready(nxt);
            PG8_LDB(B0, 0, 0); PG8_SCHED; PG8_LDA(At, 0, 0); PG8_STAGE(PG8_SA(1, 1), a1 + hstepA, voffA);
            PG8_WAIT_L(8); PG8_BAR; PG8_WAIT_L(0); PG8_MMA(0, 0, At, B0); PG8_BAR; PG8_SCHED;
            PG8_LDB(B1, 0, 1); PG8_STAGE(PG8_SB(0, 0), b2, voffB);
            PG8_BAR; PG8_WAIT_L(0); PG8_MMA(0, 1, At, B1); PG8_BAR;
            PG8_LDA(At, 0, 1); PG8_STAGE(PG8_SA(0, 0), a2, voffA);
            PG8_BAR; PG8_WAIT_L(0); PG8_MMA(1, 0, At, B0); PG8_BAR; PG8_SCHED;
            PG8_STAGE(PG8_SB(0, 1), b2 + hstep, voffB);
            PG8_WAIT_V(6); PG8_BAR; PG8_MMA(1, 1, At, B1); PG8_BAR;
            PG8_LDB(B0, 1, 0); PG8_SCHED; PG8_LDA(At, 1, 0); PG8_STAGE(PG8_SA(0, 1), a2 + hstepA, voffA);
            PG8_WAIT_L(8); PG8_BAR; PG8_WAIT_L(0); PG8_MMA(0, 0, At, B0); PG8_BAR; PG8_SCHED;
            PG8_LDB(B1, 1, 1); PG8_STAGE(PG8_SB(1, 0), b3, voffB);
            PG8_BAR; PG8_WAIT_L(0); PG8_MMA(0, 1, At, B1); PG8_BAR;
            PG8_LDA(At, 1, 1); PG8_STAGE(PG8_SA(1, 0), a3, voffA);
            PG8_BAR; PG8_WAIT_L(0); PG8_MMA(1, 0, At, B0); PG8_BAR; PG8_SCHED;
            PG8_STAGE(PG8_SB(1, 1), b3 + hstep, voffB);
            PG8_WAIT_V(6); PG8_BAR; PG8_MMA(1, 1, At, B1); PG8_BAR;
        }
        if constexpr (FP8) asm volatile("s_nop 15\n\ts_nop 15" ::: "memory");
        if constexpr (!Epi::AFTER_DRAIN) { E(acc, cur, wr, wc, fr, fq); S.done(cur); }
        if (!has_next) break;
#pragma unroll
        for (int a = 0; a < 2; ++a)
#pragma unroll
            for (int b = 0; b < 2; ++b)
#pragma unroll
                for (int m = 0; m < 4; ++m)
#pragma unroll
                    for (int n = 0; n < 2; ++n) acc[a][b][m][n] = (f32x4){0.f, 0.f, 0.f, 0.f};
        cur = nxt; cA = nA; cB = nB; ++ui;
    }
    PG8_WAIT_V(0);
    if (wr == 0) PG8_BAR;
    PG8_BAR;
    if constexpr (Epi::AFTER_DRAIN) { E.fused(acc, cur, wr, wc, fr, fq, lds, wid, lane); S.done(cur); }
#undef PG8_SA
#undef PG8_SB
#undef PG8_STAGE
#undef PG8_LDA
#undef PG8_LDB
#undef PG8_MMA
#undef PG8_WAIT_V
#undef PG8_WAIT_L
#undef PG8_BAR
#undef PG8_SCHED
}

}

struct EpiResid {
  static constexpr bool PERM = false, AFTER_DRAIN = false;
  const float* xin; float* xout; float sc;
  DI void operator()(const f32x4 (&acc)[2][2][4][2], const pg8::Unit& u, int wr, int wc, int fr, int fq) const {
    const int row0 = u.pm * 256 + wr * 64 + fr, col0 = u.pn * 256 + wc * 32 + 4 * fq;
#pragma unroll
    for (int ai = 0; ai < 2; ++ai)
#pragma unroll
      for (int m = 0; m < 4; ++m) {
        const size_t ro = (size_t)(row0 + ai * 128 + m * 16) * 2048 + col0;
#pragma unroll
        for (int bj = 0; bj < 2; ++bj)
#pragma unroll
          for (int n = 0; n < 2; ++n) {
            const size_t o = ro + bj * 128 + n * 16;
            const f32x4 xv = *(const f32x4*)(xin + o);
            *(f32x4*)(xout + o) = xv + acc[ai][bj][m][n] * sc;
          }
        asm volatile("" ::: "memory");
      }
  }
};
template <int MODE>
struct EpiBf {
  static constexpr bool PERM = true, AFTER_DRAIN = false;
  u16* d0; int ld0; int N; u16* d1; u16* d2; const f32x2* rope; float sc = 1.f; int csplit = 0, coff1 = 0, coff2 = 0;
  DI void rot(f32x4& v0, f32x4& v1, int row, int col) const {
    const f32x4* cp = (const f32x4*)(rope + (row & 2047) * 32 + ((col & 63) >> 1));
    const f32x4 c01 = cp[0], c23 = cp[1];
    const f32x4 a = {v0[0] * c01[0] - v0[1] * c01[1], v0[1] * c01[0] + v0[0] * c01[1], v0[2] * c01[2] - v0[3] * c01[3], v0[3] * c01[2] + v0[2] * c01[3]};
    const f32x4 b = {v1[0] * c23[0] - v1[1] * c23[1], v1[1] * c23[0] + v1[0] * c23[1], v1[2] * c23[2] - v1[3] * c23[3], v1[3] * c23[2] + v1[2] * c23[3]};
    v0 = a; v1 = b;
  }
  DI void operator()(const f32x4 (&acc)[2][2][4][2], const pg8::Unit& u, int wr, int wc, int fr, int fq) const {
    const int row0 = u.pm * 256 + wr * 64 + fr, colb = u.pn * 256 + wc * 32 + 8 * fq;
#pragma unroll
    for (int ai = 0; ai < 2; ++ai)
#pragma unroll
      for (int m = 0; m < 4; ++m) {
        const int row = row0 + ai * 128 + m * 16;
#pragma unroll
        for (int bj = 0; bj < 2; ++bj) {
          const int col = colb + bj * 128;
          f32x4 v0 = acc[ai][bj][m][0] * sc, v1 = acc[ai][bj][m][1] * sc;
          u16* dst = nullptr;
          if (MODE == 0) { if (col < N) dst = d0 + (size_t)row * ld0 + (col + coff2 + ((col < csplit) ? (coff1 - coff2) : 0)); }
          else if (MODE == 1) {
            const int oc = col + coff2 + ((col < csplit) ? (coff1 - coff2) : 0);
            if (col < N) {
              if (oc < 2048) dst = d0 + (size_t)row * 2048 + oc;
              else if (oc < 2112) { rot(v0, v1, row, oc); dst = d2 + (size_t)row * 64 + (oc - 2048); }
              else dst = d1 + (size_t)row * 4096 + (oc - 2112);
            }
          } else if (MODE == 3) {
            if (col < N) { const bool lo = col < csplit; u16* bp = lo ? d0 : d1; const int ldd = lo ? 2048 : 4096, oc = lo ? col : col + (coff2 - 2112); dst = bp + (size_t)row * ldd + oc + (lo ? coff1 : 0); }
          } else {
            if (((col >> 6) % 3) == 2) rot(v0, v1, row, col);
            dst = d0 + (size_t)row * 3072 + col;
          }
          if (dst) { u32x4 w = {pk2(v0[0], v0[1]), pk2(v0[2], v0[3]), pk2(v1[0], v1[1]), pk2(v1[2], v1[3])}; *(u32x4*)dst = w; }
        }
        asm volatile("" ::: "memory");
      }
  }
};

template <bool FP8 = false, class Epi>
DI void run_gemm(const u16* A, int lda, const u16* Bt, int M, int N, int K, const Epi& e, char* smem, int nA = 0, int uA = 0, int uB = 0) {
  __syncthreads();
  pg8::Gemm g{A, Bt, M, N, K, lda};
  pg8::StaticOrder S; S.init(M, N, gridDim.x, blockIdx.x);
  if (nA > 0 && (int)gridDim.x > nA && nA * uA + ((int)gridDim.x - nA) * uB == S.nwg) { S.nA = nA; S.uA = uA; S.uB = uB; }
  pg8::gemm_phase<FP8>(( __attribute__((address_space(3))) unsigned char*)smem, g, S, e);
  __syncthreads();
}

typedef __attribute__((address_space(3))) unsigned* lds_u32p;
template <int OFF> DI void rd4(bf16x8 (&f)[4], unsigned addr) {
  asm volatile("ds_read_b128 %0, %4 offset:%5\n\tds_read_b128 %1, %4 offset:%6\n\tds_read_b128 %2, %4 offset:%7\n\tds_read_b128 %3, %4 offset:%8\n\ts_waitcnt lgkmcnt(0)"
               : "=&v"(f[0]), "=&v"(f[1]), "=&v"(f[2]), "=&v"(f[3]) : "v"(addr), "i"(OFF), "i"(OFF + 32), "i"(OFF + 64), "i"(OFF + 96) : "memory");
}
template <int OFF> DI void rdv8(s16x4 (&v)[8], unsigned addr) {
  asm volatile("ds_read_b64_tr_b16 %0, %8 offset:%9\n\tds_read_b64_tr_b16 %1, %8 offset:%10\n\tds_read_b64_tr_b16 %2, %8 offset:%11\n\tds_read_b64_tr_b16 %3, %8 offset:%12\n\t"
               "ds_read_b64_tr_b16 %4, %8 offset:%13\n\tds_read_b64_tr_b16 %5, %8 offset:%14\n\tds_read_b64_tr_b16 %6, %8 offset:%15\n\tds_read_b64_tr_b16 %7, %8 offset:%16\n\ts_waitcnt lgkmcnt(0)"
               : "=&v"(v[0]), "=&v"(v[1]), "=&v"(v[2]), "=&v"(v[3]), "=&v"(v[4]), "=&v"(v[5]), "=&v"(v[6]), "=&v"(v[7])
               : "v"(addr), "i"(OFF), "i"(OFF + 512), "i"(OFF + 1024), "i"(OFF + 1536), "i"(OFF + 2048), "i"(OFF + 2560), "i"(OFF + 3072), "i"(OFF + 3584) : "memory");
}
template <int KSTR, int ND, int N>
DI f32x16 s_block(unsigned kaddr, const bf16x8* qf) {
  const f32x16 z16 = {0.f, 0.f, 0.f, 0.f, 0.f, 0.f, 0.f, 0.f, 0.f, 0.f, 0.f, 0.f, 0.f, 0.f, 0.f, 0.f};
  bf16x8 f[4];
  rd4<N * 32 * KSTR>(f, kaddr);
  f32x16 a = MFMA(f[0], qf[0], z16); a = MFMA(f[1], qf[1], a); a = MFMA(f[2], qf[2], a); a = MFMA(f[3], qf[3], a);
  if constexpr (ND > 4) { rd4<N * 32 * KSTR + 128>(f, kaddr); a = MFMA(f[0], qf[4], a); a = MFMA(f[1], qf[5], a); a = MFMA(f[2], qf[6], a); a = MFMA(f[3], qf[7], a); }
  if constexpr (ND > 8) { rd4<N * 32 * KSTR + 256>(f, kaddr); a = MFMA(f[0], qf[8], a); a = MFMA(f[1], qf[9], a); a = MFMA(f[2], qf[10], a); a = MFMA(f[3], qf[11], a); }
  if constexpr (ND > 12) { rd4<N * 32 * KSTR + 384>(f, kaddr); a = MFMA(f[0], qf[12], a); a = MFMA(f[1], qf[13], a); a = MFMA(f[2], qf[14], a); a = MFMA(f[3], qf[15], a); }
  return a;
}
template <int CB> DI void pv_block(f32x16& o, unsigned vaddr, const bf16x8 (&pb)[2][2]) {
  s16x4 v[8];
  rdv8<CB * 4096>(v, vaddr);
#pragma unroll
  for (int q = 0; q < 4; ++q) {
    const bf16x8 vf = {v[2 * q][0], v[2 * q][1], v[2 * q][2], v[2 * q][3], v[2 * q + 1][0], v[2 * q + 1][1], v[2 * q + 1][2], v[2 * q + 1][3]};
    o = MFMA(vf, pb[q >> 1][q & 1], o);
  }
}
template <int DQK, int W1, int DV, int VW, int MODE>
DI void attn_core(const u16* __restrict__ k1, int ldk1, const u16* __restrict__ k2, int ldk2, const u16* __restrict__ vsrc, int ldv,
                  int kv_len, int kbase0, int ntiles, const u16* qrow, int tq, int tq0, float c2, int vcb0, u16* yrow,
                  const u16* grow, const unsigned* maskrow, const float* lutw, float bias_far, float m_init, float l_init, char* smem) {
  constexpr int KSTR = DQK * 2 + 16, KCH = DQK / 8;
  constexpr int ND = DQK / 16, NCB = DV / 32, BUF = 64 * KSTR + (VW / 32) * 4096;
  constexpr int NKI = KSTR / 16, NVI = VW / 8;
  static_assert(ND % 4 == 0 && NCB <= 4, "fragment batches");
  int tid0 = threadIdx.x; asm volatile("" : "+v"(tid0));
  const int lane = tid0 & 63, r32 = lane & 31, hi = lane >> 5;
  const int wv = __builtin_amdgcn_readfirstlane(tid0 >> 6);
  const unsigned lds0 = (unsigned)(uintptr_t)smem;
  bf16x8 qf[ND];
#pragma unroll
  for (int d0 = 0; d0 < ND; ++d0) qf[d0] = *(const bf16x8*)(qrow + d0 * 16 + hi * 8);
  f32x16 o[NCB];
#pragma unroll
  for (int cb = 0; cb < NCB; ++cb)
#pragma unroll
    for (int r = 0; r < 16; ++r) o[cb][r] = 0.f;
  float m = m_init, l = (hi == 0) ? l_init : 0.f;
  const unsigned klane = (unsigned)(r32 * KSTR + hi * 16);
  const unsigned vlane = (unsigned)(64 * KSTR + vcb0 * 4096 + ((lane >> 4) & 1) * 32 + (lane & 3) * 8 + (4 * hi + ((lane & 15) >> 2)) * 64);
  unsigned mwn[2] = {0u, 0u};
  constexpr int NKS = (NKI + 7) / 8, NVS = (NVI + 7) / 8;
  const u16* kptr[NKS]; int kstr[NKS]; const u16* vptr[NVS];
  if (MODE != 2) {
    int ln = threadIdx.x & 63; asm volatile("" : "+v"(ln));
#pragma unroll
    for (int ii = 0; ii < NKS; ++ii) {
      const int i = wv + 8 * ii, ob = i * 1024 + ln * 16, row = ob / KSTR;
      int c = (ob - row * KSTR) >> 4; c = (c >= KCH) ? 0 : c;
      const bool seg1 = c < W1 / 8;
      kptr[ii] = seg1 ? (k1 + ((kbase0 + row) * ldk1 + c * 8)) : (k2 + ((kbase0 + row) * ldk2 + (c - W1 / 8) * 8));
      kstr[ii] = seg1 ? 64 * ldk1 : 64 * ldk2;
    }
#pragma unroll
    for (int ii = 0; ii < NVS; ++ii) {
      const int i = wv + 8 * ii, ob = i * 1024 + ln * 16, cbk = ob >> 12, row = (ob & 4095) >> 6, cw = (ob & 63) >> 4;
      vptr[ii] = vsrc + ((kbase0 + row) * ldv + (cbk * 4 + cw) * 8);
    }
  }
  auto stage_tile = [&](int kb, int buf) {
    const unsigned bofs = (unsigned)(buf * BUF);
    if (MODE != 2) {
#pragma unroll
      for (int ii = 0; ii < NKS; ++ii) {
        const int i = wv + 8 * ii;
        if (i < NKI) { __builtin_amdgcn_global_load_lds((const unsigned*)kptr[ii], (lds_u32p)(smem + bofs + i * 1024), 16, 0, 0); kptr[ii] += kstr[ii]; }
      }
#pragma unroll
      for (int ii = 0; ii < NVS; ++ii) {
        const int i = wv + 8 * ii;
        if (i < NVI) { __builtin_amdgcn_global_load_lds((const unsigned*)vptr[ii], (lds_u32p)(smem + bofs + 64 * KSTR + i * 1024), 16, 0, 0); vptr[ii] += 64 * ldv; }
      }
    } else {
      int ln = threadIdx.x & 63; asm volatile("" : "+v"(ln));
#pragma unroll
      for (int ii = 0; ii < NKS; ++ii) {
        const int i = wv + 8 * ii;
        if (i < NKI) {
          const int ob = i * 1024 + ln * 16, row = ob / KSTR;
          int c = (ob - row * KSTR) >> 4; c = (c >= KCH) ? 0 : c;
          int key = kb + row; key = key < 0 ? 0 : (key >= kv_len ? kv_len - 1 : key);
          const u16* src = (c < W1 / 8) ? (k1 + (key * ldk1 + c * 8)) : (k2 + (key * ldk2 + (c - W1 / 8) * 8));
          __builtin_amdgcn_global_load_lds((const unsigned*)src, (lds_u32p)(smem + bofs + i * 1024), 16, 0, 0);
        }
      }
#pragma unroll
      for (int ii = 0; ii < NVS; ++ii) {
        const int i = wv + 8 * ii;
        if (i < NVI) {
          const int ob = i * 1024 + ln * 16, cbk = ob >> 12, row = (ob & 4095) >> 6, cw = (ob & 63) >> 4;
          int key = kb + row; key = key < 0 ? 0 : (key >= kv_len ? kv_len - 1 : key);
          __builtin_amdgcn_global_load_lds((const unsigned*)(vsrc + (key * ldv + (cbk * 4 + cw) * 8)), (lds_u32p)(smem + bofs + 64 * KSTR + i * 1024), 16, 0, 0);
        }
      }
    }
    if (MODE == 1) { mwn[0] = maskrow[(kb >> 5)]; mwn[1] = maskrow[(kb >> 5) + 1]; }
  };
  stage_tile(kbase0, 0);
  asm volatile("s_waitcnt vmcnt(0)" ::: "memory");
  __syncthreads();
  for (int t = 0; t < ntiles; ++t) {
    const int kb = kbase0 + t * 64;
    const unsigned bufa = lds0 + (unsigned)((t & 1) * BUF);
    const unsigned mw0 = mwn[0], mw1 = mwn[1];
    if (t + 1 < ntiles) stage_tile(kb + 64, (t + 1) & 1);
    if (!(MODE == 0 && kb > tq0 + 31)) {
      f32x16 s[2];
      s[0] = s_block<KSTR, ND, 0>(bufa + klane, qf);
      s[1] = s_block<KSTR, ND, 1>(bufa + klane, qf);
      if (MODE == 0) {
        s[0] = s[0] * c2; s[1] = s[1] * c2;
        if (__builtin_amdgcn_readfirstlane((int)(kb + 63 > tq0))) {
#pragma unroll
          for (int n = 0; n < 2; ++n)
#pragma unroll
            for (int i = 0; i < 16; ++i) { const int key = kb + 32 * n + crow(i, hi); if (key > tq) s[n][i] = NEGV; }
        }
      } else if (MODE == 1) {
        const bool far = (tq0 - (kb + 63)) >= 128;
#pragma unroll
        for (int n = 0; n < 2; ++n) {
          const unsigned wb = (n ? mw1 : mw0) >> (4 * hi);
          if (far) {
#pragma unroll
            for (int i = 0; i < 16; ++i) {
              const float v = fmaf(s[n][i], c2, bias_far);
              s[n][i] = ((wb >> ((i & 3) + 8 * (i >> 2))) & 1u) ? v : NEGV;
            }
          } else {
#pragma unroll
            for (int i = 0; i < 16; ++i) {
              const int key = kb + 32 * n + crow(i, hi);
              int rel = tq - key; rel = rel < 0 ? 0 : (rel > 128 ? 128 : rel);
              const float v = fmaf(s[n][i], c2, lutw[rel]);
              s[n][i] = ((wb >> ((i & 3) + 8 * (i >> 2))) & 1u) ? v : NEGV;
            }
          }
        }
      } else if (MODE == 2) {
#pragma unroll
        for (int n = 0; n < 2; ++n)
#pragma unroll
          for (int i = 0; i < 16; ++i) {
            const int key = kb + 32 * n + crow(i, hi), rel = tq - key;
            const bool ok = ((unsigned)rel < 128u) && (key >= 0);
            const float v = fmaf(s[n][i], c2, lutw[rel & 127]);
            s[n][i] = ok ? v : NEGV;
          }
      } else {
#pragma unroll
        for (int n = 0; n < 2; ++n)
#pragma unroll
          for (int i = 0; i < 16; ++i) s[n][i] *= c2;
      }
      float mx = s[0][0];
#pragma unroll
      for (int i = 1; i < 16; ++i) mx = fmaxf(mx, s[0][i]);
#pragma unroll
      for (int i = 0; i < 16; ++i) mx = fmaxf(mx, s[1][i]);
      mx = xhalf_max(mx);
      if (__any(mx - m > 8.0f)) {
        const float mnew = fmaxf(m, mx), alpha = __builtin_amdgcn_exp2f(m - mnew);
        m = mnew; l *= alpha;
#pragma unroll
        for (int cb = 0; cb < NCB; ++cb)
#pragma unroll
          for (int r = 0; r < 16; ++r) o[cb][r] *= alpha;
      }
      {
        const float nm = -m;
        f32x16 e0 = s[0] + nm, e1 = s[1] + nm;
#pragma unroll
        for (int i = 0; i < 16; ++i) { e0[i] = __builtin_amdgcn_exp2f(e0[i]); e1[i] = __builtin_amdgcn_exp2f(e1[i]); }
        s[0] = e0; s[1] = e1;
        const f32x16 sm = e0 + e1;
        typedef __attribute__((ext_vector_type(8))) float f32x8;
        const f32x8 h8 = sm.lo + sm.hi;
        const f32x4 h4 = h8.lo + h8.hi;
        const f32x2 h2 = h4.lo + h4.hi;
        l += h2[0] + h2[1];
      }
      bf16x8 pb[2][2];
#pragma unroll
      for (int n = 0; n < 2; ++n)
#pragma unroll
        for (int s2 = 0; s2 < 2; ++s2) {
          u32x4 pw = {pk2(s[n][8 * s2 + 0], s[n][8 * s2 + 1]), pk2(s[n][8 * s2 + 2], s[n][8 * s2 + 3]),
                      pk2(s[n][8 * s2 + 4], s[n][8 * s2 + 5]), pk2(s[n][8 * s2 + 6], s[n][8 * s2 + 7])};
          pb[n][s2] = __builtin_bit_cast(bf16x8, pw);
        }
      pv_block<0>(o[0], bufa + vlane, pb);
      if constexpr (NCB > 1) pv_block<1>(o[1], bufa + vlane, pb);
      if constexpr (NCB > 2) pv_block<2>(o[2], bufa + vlane, pb);
      if constexpr (NCB > 3) pv_block<3>(o[3], bufa + vlane, pb);
    }
    asm volatile("s_waitcnt vmcnt(0)" ::: "memory");
    __syncthreads();
  }
  const float inv = __builtin_amdgcn_rcpf(xhalf_sum(l));
  u32x2 ggv[NCB * 4];
#pragma unroll
  for (int cb = 0; cb < NCB; ++cb)
#pragma unroll
    for (int g = 0; g < 4; ++g) ggv[cb * 4 + g] = *(const u32x2*)(grow + 32 * cb + 8 * g + 4 * hi);
  __builtin_amdgcn_sched_barrier(0);
#pragma unroll
  for (int cb = 0; cb < NCB; ++cb)
#pragma unroll
    for (int g = 0; g < 4; ++g) {
      const int dv = 32 * cb + 8 * g + 4 * hi;
      const u32x2 gg = ggv[cb * 4 + g];
      float gv[4] = {bf2f(gg[0] & 0xffffu), bf2f(gg[0] >> 16), bf2f(gg[1] & 0xffffu), bf2f(gg[1] >> 16)};
      float ov[4];
#pragma unroll
      for (int j = 0; j < 4; ++j) {
        const float sg = gv[j] * __builtin_amdgcn_rcpf(1.f + __builtin_amdgcn_exp2f(-LOG2E * gv[j]));
        ov[j] = o[cb][4 * g + j] * inv * sg;
      }
      *(unsigned*)((unsigned char*)yrow + dv) = pk4_fp8(ov[0] * Y_SCALE, ov[1] * Y_SCALE, ov[2] * Y_SCALE, ov[3] * Y_SCALE);
      __builtin_amdgcn_sched_barrier(0);
    }
}

DI unsigned ordkey(float f) { const unsigned b = __float_as_uint(f); return b ^ ((unsigned)((int)b >> 31) | 0x80000000u); }
DI void indexer_phase(const u16* __restrict__ P, unsigned* __restrict__ mask) {
  int tidx = threadIdx.x; asm volatile("" : "+v"(tidx));
  const int lane = tidx & 63, r32 = lane & 31, hi = lane >> 5;
  const int gw = blockIdx.x * 8 + (tidx >> 6), nw = gridDim.x * 8;
  for (int base = 0, pass = 0; base < 8192; base += nw, ++pass) {
    const int item = (pass & 1) ? base + (nw - 1 - gw) : base + gw;
    if (item >= 8192) continue;
    const int b = item & 7, t0 = (1023 - (item >> 3)) * 2;
    const size_t brow = (size_t)b * SEQ;
    const int g = (r32 >> 2) & 1, head = 4 * (r32 >> 3) + (r32 & 3);
    bf16x8 aq[4];
#pragma unroll
    for (int s = 0; s < 4; ++s) aq[s] = *(const bf16x8*)(P + (brow + t0 + g) * 7808 + 2560 + head * 64 + 16 * s + 8 * hi);
    float wv[16];
    {
      const u32x4 w0 = *(const u32x4*)(P + (brow + t0 + hi) * 7808 + 3648), w1 = *(const u32x4*)(P + (brow + t0 + hi) * 7808 + 3656);
#pragma unroll
      for (int j = 0; j < 4; ++j) { wv[2 * j] = bf2f(w0[j] & 0xffffu); wv[2 * j + 1] = bf2f(w0[j] >> 16); wv[8 + 2 * j] = bf2f(w1[j] & 0xffffu); wv[8 + 2 * j + 1] = bf2f(w1[j] >> 16); }
    }
    const int tme = t0 + hi, kbmax = (t0 + 1) >> 5;
    unsigned sc[64];
#pragma unroll
    for (int kb = 0; kb < 64; ++kb) {
      unsigned u = 0u;
      if (kb <= kbmax) {
        f32x16 a;
#pragma unroll
        for (int r = 0; r < 16; ++r) a[r] = 0.f;
        const u16* kp = P + (brow + 32 * kb + r32) * 7808 + 3584 + 8 * hi;
#pragma unroll
        for (int s = 0; s < 4; ++s) { const bf16x8 bk = *(const bf16x8*)(kp + 16 * s); a = MFMA(aq[s], bk, a); }
        float v = 0.f;
#pragma unroll
        for (int i = 0; i < 16; ++i) v = fmaf(wv[i], fmaxf(a[i], 0.f), v);
        u = (32 * kb + r32 <= tme) ? ordkey(v) : 0u;
      }
      sc[kb] = u;
    }
    const int target = (tme + 1 < 256) ? tme + 1 : 256;
    unsigned T = 0u;
    for (int bit = 31; bit >= 0; --bit) {
      const unsigned Tp = T | (1u << bit);
      int cnt = 0;
#pragma unroll
      for (int kb = 0; kb < 64; ++kb) cnt += (sc[kb] >= Tp) ? 1 : 0;
#pragma unroll
      for (int o = 16; o; o >>= 1) cnt += __shfl_xor(cnt, o);
      if (cnt >= target) T = Tp;
    }
    unsigned w0 = 0u, w1 = 0u;
#pragma unroll
    for (int kb = 0; kb < 64; ++kb) {
      const bool pred = (sc[kb] >= T) && (sc[kb] != 0u);
      const unsigned long long bal = __ballot(pred);
      const unsigned wd = (unsigned)(bal >> (32 * hi));
      if ((kb & 31) == r32) { if (kb < 32) w0 = wd; else w1 = wd; }
    }
    mask[(brow + tme) * 64 + r32] = w0;
    mask[(brow + tme) * 64 + 32 + r32] = w1;
  }
}

#define XB_TMO      128
#define XB_XCNT(j)  (256  + 64 * (j))
#define XB_XSUB(j)  (1280 + 64 * (j))
#define XB_XGEN(j)  (2304 + 64 * (j))
#define XB_TOP      3328
#define XB_TOPGEN   3392
#define XCD_BAR_WORDS 3456
#define XB_SPIN_CAP (1u << 22)
DI unsigned xb_ld(unsigned* p)              { return __hip_atomic_load(p, __ATOMIC_RELAXED, __HIP_MEMORY_SCOPE_AGENT); }
DI unsigned xb_add(unsigned* p, unsigned v) { return __hip_atomic_fetch_add(p, v, __ATOMIC_RELAXED, __HIP_MEMORY_SCOPE_AGENT); }
DI unsigned xb_xcc_id() { return (unsigned)__builtin_amdgcn_s_getreg((3 << 11) | 20) & 0xFu; }
#define XB_SPIN(cond, bar) do { unsigned _sp = 0; while (cond) { __builtin_amdgcn_s_sleep(1); \
    if ((++_sp & 255u) == 0u) { if (xb_ld(&(bar)[XB_TMO])) break; if (_sp > XB_SPIN_CAP) { atomicAdd(&(bar)[XB_TMO], 1u); break; } } } } while (0)
DI void xcd_barrier_complete(unsigned* bar, unsigned x, unsigned& nloc, unsigned& nx) {
  const unsigned G = gridDim.x;
  unsigned sum, cnt, mine, sp = 0u;
  for (;;) {
    sum = 0u; cnt = 0u; mine = 0u;
#pragma unroll
    for (unsigned j = 0; j < 16; ++j) { const unsigned c = xb_ld(&bar[XB_XCNT(j)]); sum += c; cnt += (c > 0u) ? 1u : 0u; mine = (j == x) ? c : mine; }
    if (sum == G) break;
    __builtin_amdgcn_s_sleep(1);
    if ((++sp & 255u) == 0u) { if (xb_ld(&bar[XB_TMO])) break; if (sp > XB_SPIN_CAP) { atomicAdd(&bar[XB_TMO], 1u); break; } }
  }
  nloc = mine > 0u ? mine : 1u; nx = cnt > 0u ? cnt : 1u;
}
DI void xcd_barrier(unsigned* bar, volatile unsigned* st) {
  asm volatile("s_waitcnt vmcnt(0)" ::: "memory");
  __syncthreads();
  if (threadIdx.x == 0) {
    const unsigned x = xb_xcc_id();
    __builtin_amdgcn_s_waitcnt(0);
    unsigned nloc = st[0], nx = st[1];
    if (nloc == 0u) { xcd_barrier_complete(bar, x, nloc, nx); st[0] = nloc; st[1] = nx; }
    const unsigned old = xb_add(&bar[XB_XSUB(x)], 1u);
    const unsigned gen = old / nloc;
    if (old + 1u == (gen + 1u) * nloc) {
      __builtin_amdgcn_fence(__ATOMIC_RELEASE, "agent");
      asm volatile("s_waitcnt vmcnt(0)" ::: "memory");
      const unsigned og = xb_add(&bar[XB_TOP], 1u);
      const unsigned tg = og / nx;
      if (og + 1u == (tg + 1u) * nx) xb_add(&bar[XB_TOPGEN], 1u);
      else XB_SPIN(xb_ld(&bar[XB_TOPGEN]) == tg, bar);
      __builtin_amdgcn_fence(__ATOMIC_ACQUIRE, "agent");
      xb_add(&bar[XB_XGEN(x)], 1u);
      asm volatile("s_waitcnt vmcnt(0)" ::: "memory");
    } else {
      XB_SPIN(xb_ld(&bar[XB_XGEN(x)]) == gen, bar);
      __builtin_amdgcn_fence(__ATOMIC_ACQUIRE, "agent");
      asm volatile("s_waitcnt vmcnt(0)" ::: "memory");
    }
  }
  __syncthreads();
}
#define GSYNC() xcd_barrier(XBAR, xb_st)
__global__ void __launch_bounds__(512, 2) mega(Params p) {
  cg::grid_group grid = cg::this_grid();
  extern __shared__ __attribute__((aligned(16))) char smem[];
  volatile int* s_item = (volatile int*)(smem + LDS_ITEM);
  char* ws = p.ws;
  unsigned char* Y8 = (unsigned char*)(ws + OFF_Y);
  u16* WIN8 = (u16*)(ws + OFF_WIN + 19922944);
  unsigned char* CQ8 = (unsigned char*)(ws + OFF_Y + 67108864);     u16* H = (u16*)(ws + OFF_H); u16* Cb = (u16*)(ws + OFF_Y); u16* Qb = (u16*)(ws + OFF_H);
  u16* KV = (u16*)(ws + OFF_KV); u16* MG = (u16*)(ws + OFF_MG); u16* KR = (u16*)(ws + OFF_KR); u16* Pb = (u16*)(ws + OFF_P);
  u16* WIN = (u16*)(ws + OFF_WIN); u16* WUQ = (u16*)(ws + OFF_WUQ); u16* WUKV = (u16*)(ws + OFF_WUKV); u16* WOUT = (u16*)(ws + OFF_WOUT);
  u16* WMEMALL = (u16*)(ws + OFF_KV); u16* MEMN = (u16*)(ws + OFF_MEMN); u16* MEMKV = (u16*)(ws + OFF_MEMKV);
  unsigned* MASK = (unsigned*)(ws + OFF_MASK); f32x2* ROPE = (f32x2*)(ws + OFF_ROPE); float* LUT = (float*)(ws + OFF_LUT);
  int* CTR = (int*)(ws + OFF_CTR);
  unsigned* XBAR = (unsigned*)(ws + OFF_CTR + 1024);
  volatile unsigned* xb_st = (volatile unsigned*)(smem + LDS_ITEM + 16);
  if (threadIdx.x == 0) { xb_st[0] = 0u; xb_st[1] = 0u; (void)xb_add(&XBAR[XB_XCNT(xb_xcc_id())], 1u); }
  __syncthreads();
  const int tid = threadIdx.x, lane = tid & 63, wv = __builtin_amdgcn_readfirstlane(tid >> 6), r32 = lane & 31, hi = lane >> 5;
  const int gtid = blockIdx.x * 512 + tid, gthreads = gridDim.x * 512;

  if (p.ws == nullptr) grid.sync();
  for (int i = gtid; i < 2048 * 32; i += gthreads) {
    const int pos = i >> 5, j = i & 31;
    const float inv = 1.0f / powf(10000.0f, (float)(2 * j) / 64.0f);
    const float ang = (float)pos * inv;
    const float k = rintf(ang * 0.15915494309189535f);
    float r = fmaf(-k, 6.28318548202514648f, ang);
    r = fmaf(-k, -1.74845553e-7f, r);
    f32x2 cs = {__cosf(r), __sinf(r)};
    ROPE[i] = cs;
  }
  for (int i = gtid; i < 129 * 32; i += gthreads) {
    const int rel = i >> 5, h = i & 31;
    int bucket;
    if (rel < 16) bucket = rel;
    else { const int lg = 16 + (int)(logf((float)rel / 16.0f) / 2.0794415416798357f * 16.0f); bucket = lg < 31 ? lg : 31; }
    LUT[i] = p.rel_bias[bucket * 32 + h] * LOG2E;
  }
  rmsnorm_rows<false>(p.mem, p.mem_norm, MEMN, 2048);
#pragma unroll 1
  for (int l = 0; l < 4; ++l) convert_wt<0>(p.w_mem_kv + (size_t)l * 2048 * 2048, 2048, 2048, 2048, WMEMALL + (size_t)l * 2048 * 2048, smem);

  auto convert_layer = [&](int L) {
    const int kind = L % 3, j = L / 3;
    if (kind == 0) {
    convert_wt<1>(p.w_in_a + (size_t)j * 2048 * 6208, 2048, 6208, 3840, WIN, smem, 1.f, 3648, 576, 1536, 2560, 512);
    convert_wt<0, true>(p.w_in_a + (size_t)j * 2048 * 6208, 2048, 6208, 2560, WIN8, smem, WIN_SCALE, 2560, 1536, 0, 576);
    convert_wt<2, true>(p.w_uq + (size_t)j * 1536 * 3072, 1536, 3072, 3072, WUQ, smem, WUQ_SCALE);
    convert_wt<0>(p.w_ukv + (size_t)j * 512 * 4096, 512, 4096, 4096, WUKV, smem);
  } else if (kind == 1) {
    convert_wt<0>(p.w_in_b, 2048, 7760, 4864, WIN, smem, 1.f, 4688, 1616, 2048, 3072);
    convert_wt<0, true>(p.w_in_b, 2048, 7760, 3072, WIN8, smem, WIN_SCALE, 3072, 2048, 0, 1616);
  } else {
    convert_wt<0>(p.w_in_c, 2048, 6656, 3584, WIN, smem, 1.f, 3584, 512, 2048, 3072);
    convert_wt<0, true>(p.w_in_c, 2048, 6656, 3072, WIN8, smem, WIN_SCALE, 3072, 2048, 0, 512);
  }
  };
#pragma unroll 1
  for (int layer = 0; layer < 4; ++layer) {
    const int kind = layer % 3, j = layer / 3;
    const float* xin = (layer == 0) ? p.x : p.out;
    unsigned char* H8 = (unsigned char*)(ws + ((kind == 0) ? OFF_KV + 67108864 : OFF_Y));
    rmsnorm_rows<false>(xin, p.norm_in + layer * 2048, H, NTOK, H8);
    if (layer == 0) convert_layer(0);
    GSYNC();

    if (kind == 0) {
      { EpiBf<1> e{Cb, 2048, 3648, MG, KR, ROPE, 1.f, 576, 1536, 2560}; run_gemm(H, 2048, WIN, NTOK, 3840, 2048, e, smem); }
      { EpiBf<3> e{Cb, 2048, 2560, MG, nullptr, nullptr, 1.f / (H_SCALE * WIN_SCALE), 1536, 0, 576}; run_gemm<true>((const u16*)H8, 1024, WIN8, NTOK, 2560, 1024, e, smem, 192, 2, 4); }
    }
    else if (kind == 1) {
      { EpiBf<0> e{Pb, 7808, 4688, nullptr, nullptr, nullptr, 1.f, 1616, 2048, 3072}; run_gemm(H, 2048, WIN, NTOK, 4864, 2048, e, smem); }
      { EpiBf<0> e{Pb, 7808, 3072, nullptr, nullptr, nullptr, 1.f / (H_SCALE * WIN_SCALE), 2048, 0, 1616}; run_gemm<true>((const u16*)H8, 1024, WIN8, NTOK, 3072, 1024, e, smem); }
    } else {
      { EpiBf<0> e{Pb, 6656, 3584, nullptr, nullptr, nullptr, 1.f, 512, 2048, 3072}; run_gemm(H, 2048, WIN, NTOK, 3584, 2048, e, smem); }
      { EpiBf<0> e{Pb, 6656, 3072, nullptr, nullptr, nullptr, 1.f / (H_SCALE * WIN_SCALE), 2048, 0, 512}; run_gemm<true>((const u16*)H8, 1024, WIN8, NTOK, 3072, 1024, e, smem, 128, 2, 4); }
    }
    if (layer == 0) { EpiBf<0> e{MEMKV, 8192, 8192, nullptr, nullptr, nullptr}; run_gemm(MEMN, 2048, WMEMALL, 2048, 8192, 2048, e, smem); }
    GSYNC();

    if (kind == 0) {
      anorm_phase(Cb, p.a_q_norm + j * 1536, p.a_kv_norm + j * 512, CQ8);
      GSYNC();
      { EpiBf<2> e{Qb, 3072, 3072, nullptr, nullptr, ROPE, 1.f / (CQ_SCALE * WUQ_SCALE)}; run_gemm<true>((const u16*)CQ8, 768, WUQ, NTOK, 3072, 768, e, smem); }
      { EpiBf<0> e{KV, 4096, 4096, nullptr, nullptr, nullptr}; run_gemm(Cb + 1536, 2048, WUKV, NTOK, 4096, 512, e, smem); }
      GSYNC();
    } else if (kind == 1) {
      indexer_phase(Pb, MASK);
      GSYNC();
    }

    {
      const int nself = (kind == 0) ? 1024 : 2048, total = nself + 512;
      const u16* mgb = (kind == 0) ? MG : Pb;
      const int ldmg = (kind == 0) ? 4096 : (kind == 1 ? 7808 : 6656);
      const int mqcol = (kind == 0) ? 0 : (kind == 1 ? 3664 : 2560);
      const int gatecol = (kind == 0) ? 1024 : (kind == 1 ? 4688 : 3584);
      const u16* memkv = MEMKV + layer * 2048;
      float* lut_all = (float*)(smem + LDS_LUT);
      if (kind != 0) {
        for (int i = tid; i < 32 * 129; i += 512) { const int h = i / 129, r = i - h * 129; lut_all[h * 132 + r] = LUT[r * 32 + h]; }
      }
      if (tid == 0) s_item[0] = atomicAdd(&CTR[layer], 1);
      __syncthreads();
      for (int par = 0;; par ^= 1) {
        const int item = __builtin_amdgcn_readfirstlane(s_item[par]);
        if (item >= total) break;
        if (tid == 0) s_item[par ^ 1] = atomicAdd(&CTR[layer], 1);
        if (item < nself) {
          if (kind == 0) {
            const int qblk = 7 - item / 128, rem = item % 128, b = rem / 16, head = rem % 16;
            const size_t brow = (size_t)b * SEQ;
            const int tq0 = qblk * 256 + 32 * wv, tq = tq0 + r32;
            attn_core<192, 128, 128, 128, 0>(KV + brow * 4096 + head * 256, 4096, KR + brow * 64, 64, KV + brow * 4096 + head * 256 + 128, 4096,
                                            SEQ, 0, 4 * qblk + 4, Qb + (brow + tq) * 3072 + head * 192, tq, tq0, 0.07216878364870322f * LOG2E, 0,
                                            (u16*)(Y8 + (brow + tq) * 3072 + head * 128), mgb + (brow + tq) * ldmg + gatecol + head * 128,
                                            nullptr, nullptr, 0.f, -1e29f, 0.f, smem);
          } else {
            const int qb = 63 - item / 32, rem = item % 32, b = rem / 4, kvh = rem % 4;
            const size_t brow = (size_t)b * SEQ;
            const int head = kvh * 8 + wv, tq0 = qb * 32, tq = tq0 + r32;
            const float* lutw = lut_all + head * 132;
            if (kind == 1) {
              attn_core<64, 64, 64, 64, 1>(Pb + brow * 7808 + 2048 + kvh * 64, 7808, nullptr, 0, Pb + brow * 7808 + 2304 + kvh * 64, 7808,
                                          SEQ, 0, (tq0 + 31) / 64 + 1, Pb + (brow + tq) * 7808 + head * 64, tq, tq0, 0.125f * LOG2E, 0,
                                          (u16*)(Y8 + (brow + tq) * 3072 + head * 64), Pb + (brow + tq) * 7808 + gatecol + head * 64,
                                          MASK + (brow + tq) * 64, lutw, lutw[128], -1e29f, 0.f, smem);
            } else {
              const float sink = p.c_sinks[j * 32 + head] * LOG2E;
              attn_core<64, 64, 64, 64, 2>(Pb + brow * 6656 + 2048 + kvh * 64, 6656, nullptr, 0, Pb + brow * 6656 + 2304 + kvh * 64, 6656,
                                          SEQ, tq0 - 128, 3, Pb + (brow + tq) * 6656 + head * 64, tq, tq0, 0.125f * LOG2E, 0,
                                          (u16*)(Y8 + (brow + tq) * 3072 + head * 64), Pb + (brow + tq) * 6656 + gatecol + head * 64,
                                          nullptr, lutw, 0.f, sink, 1.f, smem);
            }
          }
        } else {
          const int it = item - nself, b = it / 64, mh = (it % 64) / 16, qb = it % 16;
          const size_t brow = (size_t)b * SEQ;
          const int tq0 = qb * 128 + 32 * (wv >> 1), tq = tq0 + r32, vh = wv & 1;
          attn_core<256, 256, 128, 256, 3>(memkv + (size_t)b * 256 * 8192 + mh * 256, 8192, nullptr, 0, memkv + (size_t)b * 256 * 8192 + 1024 + mh * 256, 8192,
                                          256, 0, 4, mgb + (brow + tq) * ldmg + mqcol + mh * 256, tq, tq0, 0.0625f * LOG2E, 4 * vh,
                                          (u16*)(Y8 + (brow + tq) * 3072 + 2048 + mh * 256 + 128 * vh), mgb + (brow + tq) * ldmg + gatecol + 2048 + mh * 256 + 128 * vh,
                                          nullptr, nullptr, 0.f, -1e29f, 0.f, smem);
        }
      }
    }
    convert_wt<0, true>(p.w_out + (size_t)layer * 3072 * 2048, 3072, 2048, 2048, WOUT, smem, WOUT_SCALE);
    if (layer + 1 < 4) convert_layer(layer + 1);
    GSYNC();

    { EpiResid e{xin, p.out, 1.f / (Y_SCALE * WOUT_SCALE)}; run_gemm<true>((const u16*)Y8, 1536, WOUT, NTOK, 2048, 1536, e, smem); }
    GSYNC();
  }
  rmsnorm_rows<true>(p.out, p.final_norm, p.out, NTOK);
}

extern "C" void kernel_launch(void* const* d_in, const int* in_sizes, int n_in, void* d_out, int out_size,
                              void* d_ws, size_t ws_size, hipStream_t stream) {
  static int grid_blocks = 0;
  if (!grid_blocks) {
    int dev = 0, cus = 0, per_cu = 0;
    (void)hipGetDevice(&dev);
    (void)hipDeviceGetAttribute(&cus, hipDeviceAttributeMultiprocessorCount, dev);
    (void)hipFuncSetAttribute((const void*)mega, hipFuncAttributeMaxDynamicSharedMemorySize, LDS_BYTES);
    (void)hipOccupancyMaxActiveBlocksPerMultiprocessor(&per_cu, mega, 512, LDS_BYTES);
    if (per_cu > 1) per_cu = 1;
    grid_blocks = cus * per_cu;
  }
  Params p{};
  p.x = (const float*)d_in[0]; p.mem = (const float*)d_in[1]; p.norm_in = (const float*)d_in[2]; p.final_norm = (const float*)d_in[3];
  p.mem_norm = (const float*)d_in[4]; p.rel_bias = (const float*)d_in[5]; p.w_in_a = (const float*)d_in[6]; p.a_q_norm = (const float*)d_in[7];
  p.w_uq = (const float*)d_in[8]; p.a_kv_norm = (const float*)d_in[9]; p.w_ukv = (const float*)d_in[10]; p.w_in_b = (const float*)d_in[11];
  p.w_in_c = (const float*)d_in[12]; p.c_sinks = (const float*)d_in[13]; p.w_mem_kv = (const float*)d_in[14]; p.w_out = (const float*)d_in[15];
  p.out = (float*)d_out; p.ws = (char*)d_ws;
  (void)hipMemsetAsync((char*)d_ws + OFF_CTR, 0, 16384, stream);
  void* args[] = {&p};
  (void)hipLaunchCooperativeKernel((void*)mega, dim3(grid_blocks), dim3(512), args, LDS_BYTES, stream);
}
```

```cpp
#include <hip/hip_runtime.h>
#include <hip/hip_cooperative_groups.h>
#include <stdint.h>
namespace cg = cooperative_groups;

typedef unsigned short u16;
typedef __attribute__((ext_vector_type(8))) short bf16x8;
typedef __attribute__((ext_vector_type(4))) short s16x4;
typedef __attribute__((ext_vector_type(16))) float f32x16;
typedef __attribute__((ext_vector_type(4))) float f32x4;
typedef __attribute__((ext_vector_type(2))) float f32x2;
typedef __attribute__((ext_vector_type(4))) unsigned u32x4;
typedef __attribute__((ext_vector_type(2))) unsigned u32x2;
typedef __attribute__((ext_vector_type(2))) __bf16 bf16x2_t;
typedef short v4i16_t __attribute__((ext_vector_type(4)));
#define DI __device__ __forceinline__
#define MFMA(a, b, c) __builtin_amdgcn_mfma_f32_32x32x16_bf16((a), (b), (c), 0, 0, 0)

constexpr int SEQ = 2048, NTOK = 16384;
constexpr int LDS_LUT = 133120, LDS_ITEM = LDS_LUT + 32 * 528, LDS_BYTES = LDS_ITEM + 64;
constexpr float LOG2E = 1.4426950408889634f;
constexpr float NEGV = -1e30f;
constexpr float Y_SCALE = 16.f, WOUT_SCALE = 256.f, CQ_SCALE = 16.f, WUQ_SCALE = 256.f, H_SCALE = 16.f, WIN_SCALE = 256.f;

constexpr size_t OFF_Y = 0;
constexpr size_t OFF_H = 100663296;
constexpr size_t OFF_KV = 201326592;
constexpr size_t OFF_MG = 335544320;
constexpr size_t OFF_KR = 469762048;
constexpr size_t OFF_P = 167772160;
constexpr size_t OFF_WIN = 471859200;
constexpr size_t OFF_WUQ = OFF_WIN + 32505856;
constexpr size_t OFF_WUKV = OFF_WUQ + 9437184;
constexpr size_t OFF_WOUT = OFF_WUKV + 4194304;
constexpr size_t OFF_MEMN = OFF_WOUT + 12582912;
constexpr size_t OFF_MEMKV = OFF_MEMN + 8388608;
constexpr size_t OFF_MASK = OFF_MEMKV + 33554432;
constexpr size_t OFF_ROPE = OFF_MASK + 4194304;
constexpr size_t OFF_LUT = OFF_ROPE + 524288;
constexpr size_t OFF_CTR = OFF_LUT + 32768;

struct Params {
  const float *x, *mem, *norm_in, *final_norm, *mem_norm, *rel_bias, *w_in_a, *a_q_norm, *w_uq, *a_kv_norm, *w_ukv,
      *w_in_b, *w_in_c, *c_sinks, *w_mem_kv, *w_out;
  float* out;
  char* ws;
};

DI float bf2f(unsigned b) { return __uint_as_float(b << 16); }
DI unsigned pk2(float a, float b) {
  f32x2 v = {a, b};
  return __builtin_bit_cast(unsigned, __builtin_convertvector(v, bf16x2_t));
}
DI float clamp8(float x) { return fminf(fmaxf(x, -448.f), 448.f); }
DI unsigned pk4_fp8(float a, float b, float c, float d) {
  int w = 0;
  w = __builtin_amdgcn_cvt_pk_fp8_f32(clamp8(a), clamp8(b), w, false);
  w = __builtin_amdgcn_cvt_pk_fp8_f32(clamp8(c), clamp8(d), w, true);
  return (unsigned)w;
}
DI u16 f2bf(float a) { return (u16)(pk2(a, 0.f) & 0xffffu); }
DI float wave_sum(float v) {
#pragma unroll
  for (int o = 32; o; o >>= 1) v += __shfl_xor(v, o);
  return v;
}
DI int crow(int reg, int hi) { return (reg & 3) + 8 * (reg >> 2) + 4 * hi; }
DI float xhalf_max(float m) {
  auto rr = __builtin_amdgcn_permlane32_swap(__float_as_uint(m), __float_as_uint(m), false, false);
  return fmaxf(__uint_as_float(rr[0]), __uint_as_float(rr[1]));
}
DI float xhalf_sum(float m) {
  auto rr = __builtin_amdgcn_permlane32_swap(__float_as_uint(m), __float_as_uint(m), false, false);
  return __uint_as_float(rr[0]) + __uint_as_float(rr[1]);
}
typedef __attribute__((address_space(3))) v4i16_t* lds_v4p;
DI s16x4 vtr(const char* p) {
  return __builtin_bit_cast(s16x4, __builtin_amdgcn_ds_read_tr16_b64_v4i16((lds_v4p)(p)));
}

template <int PERM, bool FP8 = false>
DI void convert_wt(const float* __restrict__ W, int K, int N, int Npad, u16* __restrict__ Wt, char* smem, float wscale = 1.f,
                   int nvalid = -1, int csplit = 0, int coff1 = 0, int coff2 = 0, int rot_n0 = 2048) {
  float* tile = (float*)smem;
  int tid = threadIdx.x; asm volatile("" : "+v"(tid));
  const int ntk = K / 64, ntn = Npad / 64;
  for (int t = blockIdx.x; t < ntk * ntn; t += gridDim.x) {
    const int tk = t % ntk, tn = t / ntk, k0 = tk * 64, n0 = tn * 64;
    __syncthreads();
#pragma unroll
    for (int i = 0; i < 2; ++i) {
      const int id = tid + 512 * i, kr = id >> 4, n4 = (id & 15) * 4;
      f32x4 v = {0.f, 0.f, 0.f, 0.f};
      const int nd = n0 + n4, nsrc = (nvalid < 0) ? nd : (nd < csplit ? nd + coff1 : nd + coff2);
      if (nd < ((nvalid < 0) ? N : nvalid)) v = *(const f32x4*)(W + (size_t)(k0 + kr) * N + nsrc);
      tile[kr * 65 + n4 + 0] = v[0]; tile[kr * 65 + n4 + 1] = v[1]; tile[kr * 65 + n4 + 2] = v[2]; tile[kr * 65 + n4 + 3] = v[3];
    }
    __syncthreads();
    {
      const int n = tid >> 3, c = tid & 7;
      bool rot = false;
      if (PERM == 1) rot = (n0 == rot_n0);
      if (PERM == 2) rot = ((tn % 3) == 2);
      const int ns = rot ? ((n >> 1) + 32 * (n & 1)) : n;
      if (FP8) {
        float f[8];
#pragma unroll
        for (int j = 0; j < 8; ++j) f[j] = tile[(c * 8 + j) * 65 + ns] * wscale;
        u32x2 o = {pk4_fp8(f[0], f[1], f[2], f[3]), pk4_fp8(f[4], f[5], f[6], f[7])};
        *(u32x2*)((unsigned char*)Wt + (size_t)(n0 + n) * K + k0 + c * 8) = o;
      } else {
        u32x4 o;
#pragma unroll
        for (int j = 0; j < 4; ++j) o[j] = pk2(tile[(c * 8 + 2 * j) * 65 + ns], tile[(c * 8 + 2 * j + 1) * 65 + ns]);
        *(u32x4*)(Wt + (size_t)(n0 + n) * K + k0 + c * 8) = o;
      }
    }
  }
}

template <bool F32OUT>
DI void rmsnorm_rows(const float* X, const float* __restrict__ g, void* outp, int nrows, unsigned char* __restrict__ out8 = nullptr) {
  int tidx = threadIdx.x; asm volatile("" : "+v"(tidx));
  const int lane = tidx & 63, gw = blockIdx.x * 8 + (tidx >> 6), nw = gridDim.x * 8;
  for (int row = gw; row < nrows; row += nw) {
    const f32x4* xr = (const f32x4*)(X + (size_t)row * 2048);
    f32x4 v[8];
    float ss = 0.f;
#pragma unroll
    for (int i = 0; i < 8; ++i) { v[i] = xr[lane + 64 * i]; ss += v[i][0] * v[i][0] + v[i][1] * v[i][1] + v[i][2] * v[i][2] + v[i][3] * v[i][3]; }
    ss = wave_sum(ss);
    const float r = rsqrtf(ss * (1.f / 2048.f) + 1e-6f);
#pragma unroll
    for (int i = 0; i < 8; ++i) {
      const f32x4 gg = ((const f32x4*)g)[lane + 64 * i];
      f32x4 o = {v[i][0] * r * gg[0], v[i][1] * r * gg[1], v[i][2] * r * gg[2], v[i][3] * r * gg[3]};
      if (F32OUT) ((f32x4*)((float*)outp + (size_t)row * 2048))[lane + 64 * i] = o;
      else { u32x2 pk = {pk2(o[0], o[1]), pk2(o[2], o[3])}; ((u32x2*)((u16*)outp + (size_t)row * 2048))[lane + 64 * i] = pk; }
      if (!F32OUT && out8) ((unsigned*)(out8 + (size_t)row * 2048))[lane + 64 * i] = pk4_fp8(o[0] * H_SCALE, o[1] * H_SCALE, o[2] * H_SCALE, o[3] * H_SCALE);
    }
  }
}

DI void anorm_phase(u16* C, const float* __restrict__ gq, const float* __restrict__ gkv, unsigned char* __restrict__ cq8) {
  int tidx = threadIdx.x; asm volatile("" : "+v"(tidx));
  const int lane = tidx & 63, gw = blockIdx.x * 8 + (tidx >> 6), nw = gridDim.x * 8;
  for (int row = gw; row < NTOK; row += nw) {
    u32x4* cr = (u32x4*)(C + (size_t)row * 2048);
    u32x4 v[4];
    float sq = 0.f, skv = 0.f;
#pragma unroll
    for (int i = 0; i < 4; ++i) {
      v[i] = cr[lane + 64 * i];
      float s = 0.f;
#pragma unroll
      for (int j = 0; j < 4; ++j) { float a = bf2f(v[i][j] & 0xffffu), b = bf2f(v[i][j] >> 16); s += a * a + b * b; }
      if (i < 3) sq += s; else skv += s;
    }
    sq = wave_sum(sq); skv = wave_sum(skv);
    const float rq = rsqrtf(sq * (1.f / 1536.f) + 1e-6f), rkv = rsqrtf(skv * (1.f / 512.f) + 1e-6f);
#pragma unroll
    for (int i = 0; i < 4; ++i) {
      const int col = (lane + 64 * i) * 8;
      const float* gp = (i < 3) ? (gq + col) : (gkv + col - 1536);
      const float r = (i < 3) ? rq : rkv;
      const f32x4 g0 = *(const f32x4*)gp, g1 = *(const f32x4*)(gp + 4);
      u32x4 o;
      o[0] = pk2(bf2f(v[i][0] & 0xffffu) * r * g0[0], bf2f(v[i][0] >> 16) * r * g0[1]);
      o[1] = pk2(bf2f(v[i][1] & 0xffffu) * r * g0[2], bf2f(v[i][1] >> 16) * r * g0[3]);
      o[2] = pk2(bf2f(v[i][2] & 0xffffu) * r * g1[0], bf2f(v[i][2] >> 16) * r * g1[1]);
      o[3] = pk2(bf2f(v[i][3] & 0xffffu) * r * g1[2], bf2f(v[i][3] >> 16) * r * g1[3]);
      cr[lane + 64 * i] = o;
      if (i < 3) {
        const float q0 = bf2f(v[i][0] & 0xffffu) * r * g0[0] * CQ_SCALE, q1 = bf2f(v[i][0] >> 16) * r * g0[1] * CQ_SCALE;
        const float q2 = bf2f(v[i][1] & 0xffffu) * r * g0[2] * CQ_SCALE, q3 = bf2f(v[i][1] >> 16) * r * g0[3] * CQ_SCALE;
        const float q4 = bf2f(v[i][2] & 0xffffu) * r * g1[0] * CQ_SCALE, q5 = bf2f(v[i][2] >> 16) * r * g1[1] * CQ_SCALE;
        const float q6 = bf2f(v[i][3] & 0xffffu) * r * g1[2] * CQ_SCALE, q7 = bf2f(v[i][3] >> 16) * r * g1[3] * CQ_SCALE;
        u32x2 w8 = {pk4_fp8(q0, q1, q2, q3), pk4_fp8(q4, q5, q6, q7)};
        *(u32x2*)(cq8 + (size_t)row * 1536 + col) = w8;
      }
    }
  }
}

namespace pg8 {
#define PG8_LAS __attribute__((address_space(3)))
constexpr int BM = 256, BK = 64, HALF = 128, HTB = HALF * BK * 2, STAGE_BYTES = 8 * HTB, NXCD = 8, WGM = 8;
DI int lds_byte(int r, int c) { const int st = (r >> 4) * 2 + (c >> 5), rr = r & 15, cc = c & 31, ob = rr * 64 + cc * 2; return st * 1024 + (ob ^ (((ob >> 9) & 1) << 5)); }
DI void stage_rc(int b, int& R, int& C) { const int st = b / 1024, sb = b % 1024, swz = sb ^ (((sb >> 9) & 1) << 5); R = (st >> 1) * 16 + swz / 64; C = (st & 1) * 32 + (swz % 64) / 2; }
DI int perm32(int rho) { const int n = rho >> 4, i = rho & 15; return 8 * (i >> 2) + 4 * n + (i & 3); }
typedef int i32x4v __attribute__((ext_vector_type(4)));
typedef int i32x8 __attribute__((ext_vector_type(8)));
DI i32x8 cat8(bf16x8 a, bf16x8 b) { const i32x4v x = __builtin_bit_cast(i32x4v, a), y = __builtin_bit_cast(i32x4v, b); return __builtin_shufflevector(x, y, 0, 1, 2, 3, 4, 5, 6, 7); }
struct Unit { int pm, pn; };
struct Gemm { const u16* A; const u16* Bt; int M, N, K, lda; };
struct StaticOrder {
  int nM, nN, nwg, G, c;
  int nA = 0, uA = 0, uB = 0;
  DI void init(int M, int N, int G_, int c_) { nM = M / BM; nN = N / BM; nwg = nM * nN; G = G_; c = c_; }
  DI bool next(int i, Unit& u) const {
    long L;
    if (nA == 0) L = (long)i * G + c;
    else if (c < nA) { if (i >= uA) return false; L = (long)i * nA + c; }
    else { if (i >= uB) return false; L = (long)nA * uA + (long)i * (G - nA) + (c - nA); }
    if (L >= nwg) return false;
    int wgid = (int)L; { const int q = nwg / NXCD, r = nwg % NXCD, xcd = wgid % NXCD, off = wgid / NXCD; wgid = (xcd < r ? xcd * (q + 1) : r * (q + 1) + (xcd - r) * q) + off; }
    const int nig = WGM * nN, gid = wgid / nig, fm = gid * WGM, gsz = (nM - fm) < WGM ? (nM - fm) : WGM;
    u.pm = fm + ((wgid % nig) % gsz); u.pn = (wgid % nig) / gsz; return true;
  }
  DI void a_ready(const Unit&) const {}
  DI void done(const Unit&) const {}
};
template <bool FP8, class Epi, class Sched>
__device__ __forceinline__ void gemm_phase(PG8_LAS unsigned char* lds, const Gemm g, const Sched& S, const Epi& E) {
    int tid = threadIdx.x; asm volatile("" : "+v"(tid));
    const int wid = __builtin_amdgcn_readfirstlane(tid >> 6), lane = tid & 63, wr = wid >> 2, wc = wid & 3, fr = lane & 15, fq = lane >> 4;
    const int K = g.K, nt = K / BK;
    unsigned voffA[2], voffB[2];
#pragma unroll
    for (int i = 0; i < 2; ++i) { int R, C; stage_rc(tid * 16 + i * 8192, R, C); const int Rb = Epi::PERM ? ((R & ~31) + perm32(R & 31)) : R;
        voffA[i] = (unsigned)(R * g.lda + C) * 2u; voffB[i] = (unsigned)(Rb * K + C) * 2u; }
    const size_t kstep = (size_t)(BK * 2);
    const size_t hstep = (size_t)HALF * K * 2, hstepA = (size_t)HALF * g.lda * 2;
    const size_t tstep = 2 * hstep, tstepA = 2 * hstepA;
    const unsigned ldsw = (unsigned)wid * 1024u;
    const int aoff = lds_byte(wr * 64 + fr, fq * 8), boff = lds_byte(wc * 32 + fr, fq * 8);
#define PG8_SA(b, h) (((b) * 2 + (h)) * HTB)
#define PG8_SB(b, h) ((4 + (b) * 2 + (h)) * HTB)
#define PG8_STAGE(bufoff, gbase, voff) do { _Pragma("unroll") for (int _i = 0; _i < 2; ++_i) \
        __builtin_amdgcn_global_load_lds((const unsigned*)((const char*)(gbase) + (voff)[_i]), (PG8_LAS unsigned*)(lds + (bufoff) + ldsw + _i * 8192), 16, 0, 0); } while (0)
#define PG8_LDA(dst, b, h) do { _Pragma("unroll") for (int m = 0; m < 4; ++m) _Pragma("unroll") for (int k = 0; k < 2; ++k) dst[m][k] = *(const PG8_LAS bf16x8*)(lds + PG8_SA(b, h) + aoff + m * 2048 + k * 1024); } while (0)
#define PG8_LDB(dst, b, h) do { _Pragma("unroll") for (int n = 0; n < 2; ++n) _Pragma("unroll") for (int k = 0; k < 2; ++k) dst[n][k] = *(const PG8_LAS bf16x8*)(lds + PG8_SB(b, h) + boff + n * 2048 + k * 1024); } while (0)
#define PG8_MMA(ai, bj, At, Bt) do { __builtin_amdgcn_s_setprio(1); _Pragma("unroll") for (int m = 0; m < 4; ++m) _Pragma("unroll") for (int n = 0; n < 2; ++n) { \
        if constexpr (FP8) { const i32x8 bv_ = cat8(Bt[n][0], Bt[n][1]), av_ = cat8(At[m][0], At[m][1]); \
            asm volatile("s_nop 1\n\tv_mfma_scale_f32_16x16x128_f8f6f4 %0, %1, %2, %0, %3, %3 op_sel_hi:[0,0,0]" : "+v"(acc[ai][bj][m][n]) : "v"(bv_), "v"(av_), "v"(sc127)); } \
        else { _Pragma("unroll") for (int k = 0; k < 2; ++k) acc[ai][bj][m][n] = __builtin_amdgcn_mfma_f32_16x16x32_bf16(Bt[n][k], At[m][k], acc[ai][bj][m][n], 0, 0, 0); } } \
        __builtin_amdgcn_s_setprio(0); } while (0)
#define PG8_WAIT_V(n) asm volatile("s_waitcnt vmcnt(" #n ")" ::: "memory")
#define PG8_WAIT_L(n) asm volatile("s_waitcnt lgkmcnt(" #n ")" ::: "memory")
#define PG8_BAR __builtin_amdgcn_s_barrier()
#define PG8_SCHED __builtin_amdgcn_sched_barrier(0)
    Unit cur, nxt; int ui = 0;
    if (!S.next(0, cur)) return;
    f32x4 acc[2][2][4][2];
#pragma unroll
    for (int a = 0; a < 2; ++a)
#pragma unroll
        for (int b = 0; b < 2; ++b)
#pragma unroll
            for (int m = 0; m < 4; ++m)
#pragma unroll
                for (int n = 0; n < 2; ++n) acc[a][b][m][n] = (f32x4){0.f, 0.f, 0.f, 0.f};
    bf16x8 At[4][2], B0[2][2], B1[2][2];
    int sc127 = 0x7F7F7F7F; asm volatile("" : "+v"(sc127));
    const char* cA = (const char*)g.A + (size_t)cur.pm * tstepA; const char* cB = (const char*)g.Bt + (size_t)cur.pn * tstep;
    S.a_ready(cur);
    PG8_STAGE(PG8_SB(0, 0), cB, voffB); PG8_STAGE(PG8_SA(0, 0), cA, voffA); PG8_STAGE(PG8_SB(0, 1), cB + hstep, voffB); PG8_STAGE(PG8_SA(0, 1), cA + hstepA, voffA);
    if (wr == 1) PG8_BAR;
    PG8_WAIT_V(4); PG8_BAR;
    PG8_STAGE(PG8_SB(1, 0), cB + kstep, voffB); PG8_STAGE(PG8_SA(1, 0), cA + kstep, voffA); PG8_STAGE(PG8_SB(1, 1), cB + hstep + kstep, voffB);
    PG8_WAIT_V(6); PG8_BAR;
    for (;;) {
        const bool has_next = S.next(ui + 1, nxt);
        const char* nA = has_next ? (const char*)g.A + (size_t)nxt.pm * tstepA : cA; const char* nB = has_next ? (const char*)g.Bt + (size_t)nxt.pn * tstep : cB;
        for (int t = 0; t < nt; t += 2) {
            const bool last = (t == nt - 2);
            const char* a1 = cA + (size_t)(t + 1) * kstep;
            const char* a2 = last ? nA : cA + (size_t)(t + 2) * kstep; const char* b2 = last ? nB : cB + (size_t)(t + 2) * kstep;
            const char* a3 = a2 + kstep; const char* b3 = b2 + kstep;
            if (last && has_next) S.a_ready(nxt);
            PG8_LDB(B0, 0, 0); PG8_SCHED; PG8_LDA(At, 0, 0); PG8_STAGE(PG8_SA(1, 1), a1 + hstepA, voffA);
            PG8_WAIT_L(8); PG8_BAR; PG8_WAIT_L(0); PG8_MMA(0, 0, At, B0); PG8_BAR; PG8_SCHED;
            PG8_LDB(B1, 0, 1); PG8_STAGE(PG8_SB(0, 0), b2, voffB);
            PG8_BAR; PG8_WAIT_L(0); PG8_MMA(0, 1, At, B1); PG8_BAR;
            PG8_LDA(At, 0, 1); PG8_STAGE(PG8_SA(0, 0), a2, voffA);
            PG8_BAR; PG8_WAIT_L(0); PG8_MMA(1, 0, At, B0); PG8_BAR; PG8_SCHED;
            PG8_STAGE(PG8_SB(0, 1), b2 + hstep, voffB);
            PG8_WAIT_V(6); PG8_BAR; PG8_MMA(1, 1, At, B1); PG8_BAR;
            PG8_LDB(B0, 1, 0); PG8_SCHED; PG8_LDA(At, 1, 0); PG8_STAGE(PG8_SA(0, 1), a2 + hstepA, voffA);
            PG8_WAIT_L(8); PG8_BAR; PG8_WAIT_L(0); PG8_MMA(0, 0, At, B0); PG8_BAR; PG8_SCHED;
            PG8_LDB(B1, 1, 1); PG8_STAGE(PG8_SB(1, 0), b3, voffB);
            PG8_BAR; PG8_WAIT_L(0); PG8_MMA(0, 1, At, B1); PG8_BAR;
            PG8_LDA(At, 1, 1); PG8_STAGE(PG8_SA(1, 0), a3, voffA);
            PG8_BAR; PG8_WAIT_L(0); PG8_MMA(1, 0, At, B0); PG8_BAR; PG8_SCHED;
            PG8_STAGE(PG8_SB(1, 1), b3 + hstep, voffB);
            PG8_WAIT_V(6); PG8_BAR; PG8_MMA(1, 1, At, B1); PG8_BAR;
        }
        if constexpr (FP8) asm volatile("s_nop 15\n\ts_nop 15" ::: "memory");
        if constexpr (!Epi::AFTER_DRAIN) { E(acc, cur, wr, wc, fr, fq); S.done(cur); }
        if (!has_next) break;
#pragma unroll
        for (int a = 0; a < 2; ++a)
#pragma unroll
            for (int b = 0; b < 2; ++b)
#pragma unroll
                for (int m = 0; m < 4; ++m)
#pragma unroll
                    for (int n = 0; n < 2; ++n) acc[a][b][m][n] = (f32x4){0.f, 0.f, 0.f, 0.f};
        cur = nxt; cA = nA; cB = nB; ++ui;
    }
    PG8_WAIT_V(0);
    if (wr == 0) PG8_BAR;
    PG8_BAR;
    if constexpr (Epi::AFTER_DRAIN) { E.fused(acc, cur, wr, wc, fr, fq, lds, wid, lane); S.done(cur); }
#undef PG8_SA
#undef PG8_SB
#undef PG8_STAGE
#undef PG8_LDA
#undef PG8_LDB
#undef PG8_MMA
#undef PG8_WAIT_V
#undef PG8_WAIT_L
#undef PG8_BAR
#undef PG8_SCHED
}

}

struct EpiResid {
  static constexpr bool PERM = false, AFTER_DRAIN = false;
  const float* xin; float* xout; float sc;
  DI void operator()(const f32x4 (&acc)[2][2][4][2], const pg8::Unit& u, int wr, int wc, int fr, int fq) const {
    const int row0 = u.pm * 256 + wr * 64 + fr, col0 = u.pn * 256 + wc * 32 + 4 * fq;
#pragma unroll
    for (int ai = 0; ai < 2; ++ai)
#pragma unroll
      for (int mp = 0; mp < 2; ++mp) {
        f32x4 xv[2][2][2];
#pragma unroll
        for (int mm = 0; mm < 2; ++mm)
#pragma unroll
          for (int bj = 0; bj < 2; ++bj)
#pragma unroll
            for (int n = 0; n < 2; ++n)
              xv[mm][bj][n] = *(const f32x4*)(xin + (size_t)(row0 + ai * 128 + (mp * 2 + mm) * 16) * 2048 + col0 + bj * 128 + n * 16);
#pragma unroll
        for (int mm = 0; mm < 2; ++mm)
#pragma unroll
          for (int bj = 0; bj < 2; ++bj)
#pragma unroll
            for (int n = 0; n < 2; ++n)
              *(f32x4*)(xout + (size_t)(row0 + ai * 128 + (mp * 2 + mm) * 16) * 2048 + col0 + bj * 128 + n * 16) = xv[mm][bj][n] + acc[ai][bj][mp * 2 + mm][n] * sc;
        asm volatile("" ::: "memory");
      }
  }
};
template <int MODE>
struct EpiBf {
  static constexpr bool PERM = true, AFTER_DRAIN = false;
  u16* d0; int ld0; int N; u16* d1; u16* d2; const f32x2* rope; float sc = 1.f; int csplit = 0, coff1 = 0, coff2 = 0;
  DI void rot(f32x4& v0, f32x4& v1, int row, int col) const {
    const f32x4* cp = (const f32x4*)(rope + (row & 2047) * 32 + ((col & 63) >> 1));
    const f32x4 c01 = cp[0], c23 = cp[1];
    const f32x4 a = {v0[0] * c01[0] - v0[1] * c01[1], v0[1] * c01[0] + v0[0] * c01[1], v0[2] * c01[2] - v0[3] * c01[3], v0[3] * c01[2] + v0[2] * c01[3]};
    const f32x4 b = {v1[0] * c23[0] - v1[1] * c23[1], v1[1] * c23[0] + v1[0] * c23[1], v1[2] * c23[2] - v1[3] * c23[3], v1[3] * c23[2] + v1[2] * c23[3]};
    v0 = a; v1 = b;
  }
  DI void operator()(const f32x4 (&acc)[2][2][4][2], const pg8::Unit& u, int wr, int wc, int fr, int fq) const {
    const int row0 = u.pm * 256 + wr * 64 + fr, colb = u.pn * 256 + wc * 32 + 8 * fq;
#pragma unroll
    for (int ai = 0; ai < 2; ++ai)
#pragma unroll
      for (int m = 0; m < 4; ++m) {
        const int row = row0 + ai * 128 + m * 16;
#pragma unroll
        for (int bj = 0; bj < 2; ++bj) {
          const int col = colb + bj * 128;
          f32x4 v0 = acc[ai][bj][m][0] * sc, v1 = acc[ai][bj][m][1] * sc;
          u16* dst = nullptr;
          if (MODE == 0) { if (col < N) dst = d0 + (size_t)row * ld0 + (col + coff2 + ((col < csplit) ? (coff1 - coff2) : 0)); }
          else if (MODE == 1) {
            const int oc = col + coff2 + ((col < csplit) ? (coff1 - coff2) : 0);
            if (col < N) {
              if (oc < 2048) dst = d0 + (size_t)row * 2048 + oc;
              else if (oc < 2112) { rot(v0, v1, row, oc); dst = d2 + (size_t)row * 64 + (oc - 2048); }
              else dst = d1 + (size_t)row * 4096 + (oc - 2112);
            }
          } else if (MODE == 3) {
            if (col < N) { const bool lo = col < csplit; u16* bp = lo ? d0 : d1; const int ldd = lo ? 2048 : 4096, oc = lo ? col : col + (coff2 - 2112); dst = bp + (size_t)row * ldd + oc + (lo ? coff1 : 0); }
          } else {
            if (((col >> 6) % 3) == 2) rot(v0, v1, row, col);
            dst = d0 + (size_t)row * 3072 + col;
          }
          if (dst) { u32x4 w = {pk2(v0[0], v0[1]), pk2(v0[2], v0[3]), pk2(v1[0], v1[1]), pk2(v1[2], v1[3])}; *(u32x4*)dst = w; }
        }
        asm volatile("" ::: "memory");
      }
  }
};

template <bool FP8 = false, class Epi>
DI void run_gemm(const u16* A, int lda, const u16* Bt, int M, int N, int K, const Epi& e, char* smem, int nA = 0, int uA = 0, int uB = 0) {
  __syncthreads();
  pg8::Gemm g{A, Bt, M, N, K, lda};
  pg8::StaticOrder S; S.init(M, N, gridDim.x, blockIdx.x);
  if (nA > 0 && (int)gridDim.x > nA && nA * uA + ((int)gridDim.x - nA) * uB == S.nwg) { S.nA = nA; S.uA = uA; S.uB = uB; }
  pg8::gemm_phase<FP8>(( __attribute__((address_space(3))) unsigned char*)smem, g, S, e);
  __syncthreads();
}

typedef __attribute__((address_space(3))) unsigned* lds_u32p;
template <int OFF> DI void rd4(bf16x8 (&f)[4], unsigned addr) {
  asm volatile("ds_read_b128 %0, %4 offset:%5\n\tds_read_b128 %1, %4 offset:%6\n\tds_read_b128 %2, %4 offset:%7\n\tds_read_b128 %3, %4 offset:%8\n\ts_waitcnt lgkmcnt(0)"
               : "=&v"(f[0]), "=&v"(f[1]), "=&v"(f[2]), "=&v"(f[3]) : "v"(addr), "i"(OFF), "i"(OFF + 32), "i"(OFF + 64), "i"(OFF + 96) : "memory");
}
template <int OFF> DI void rdv8(s16x4 (&v)[8], unsigned addr) {
  asm volatile("ds_read_b64_tr_b16 %0, %8 offset:%9\n\tds_read_b64_tr_b16 %1, %8 offset:%10\n\tds_read_b64_tr_b16 %2, %8 offset:%11\n\tds_read_b64_tr_b16 %3, %8 offset:%12\n\t"
               "ds_read_b64_tr_b16 %4, %8 offset:%13\n\tds_read_b64_tr_b16 %5, %8 offset:%14\n\tds_read_b64_tr_b16 %6, %8 offset:%15\n\tds_read_b64_tr_b16 %7, %8 offset:%16\n\ts_waitcnt lgkmcnt(0)"
               : "=&v"(v[0]), "=&v"(v[1]), "=&v"(v[2]), "=&v"(v[3]), "=&v"(v[4]), "=&v"(v[5]), "=&v"(v[6]), "=&v"(v[7])
               : "v"(addr), "i"(OFF), "i"(OFF + 512), "i"(OFF + 1024), "i"(OFF + 1536), "i"(OFF + 2048), "i"(OFF + 2560), "i"(OFF + 3072), "i"(OFF + 3584) : "memory");
}
template <int KSTR, int ND, int N>
DI f32x16 s_block(unsigned kaddr, const bf16x8* qf) {
  const f32x16 z16 = {0.f, 0.f, 0.f, 0.f, 0.f, 0.f, 0.f, 0.f, 0.f, 0.f, 0.f, 0.f, 0.f, 0.f, 0.f, 0.f};
  bf16x8 f[4];
  rd4<N * 32 * KSTR>(f, kaddr);
  f32x16 a = MFMA(f[0], qf[0], z16); a = MFMA(f[1], qf[1], a); a = MFMA(f[2], qf[2], a); a = MFMA(f[3], qf[3], a);
  if constexpr (ND > 4) { rd4<N * 32 * KSTR + 128>(f, kaddr); a = MFMA(f[0], qf[4], a); a = MFMA(f[1], qf[5], a); a = MFMA(f[2], qf[6], a); a = MFMA(f[3], qf[7], a); }
  if constexpr (ND > 8) { rd4<N * 32 * KSTR + 256>(f, kaddr); a = MFMA(f[0], qf[8], a); a = MFMA(f[1], qf[9], a); a = MFMA(f[2], qf[10], a); a = MFMA(f[3], qf[11], a); }
  if constexpr (ND > 12) { rd4<N * 32 * KSTR + 384>(f, kaddr); a = MFMA(f[0], qf[12], a); a = MFMA(f[1], qf[13], a); a = MFMA(f[2], qf[14], a); a = MFMA(f[3], qf[15], a); }
  return a;
}
template <int CB> DI void pv_block(f32x16& o, unsigned vaddr, const bf16x8 (&pb)[2][2]) {
  s16x4 v[8];
  rdv8<CB * 4096>(v, vaddr);
#pragma unroll
  for (int q = 0; q < 4; ++q) {
    const bf16x8 vf = {v[2 * q][0], v[2 * q][1], v[2 * q][2], v[2 * q][3], v[2 * q + 1][0], v[2 * q + 1][1], v[2 * q + 1][2], v[2 * q + 1][3]};
    o = MFMA(vf, pb[q >> 1][q & 1], o);
  }
}
template <int DQK, int W1, int DV, int VW, int MODE>
DI void attn_core(const u16* __restrict__ k1, int ldk1, const u16* __restrict__ k2, int ldk2, const u16* __restrict__ vsrc, int ldv,
                  int kv_len, int kbase0, int ntiles, const u16* qrow, int tq, int tq0, float c2, int vcb0, u16* yrow,
                  const u16* grow, const unsigned* maskrow, const float* lutw, float bias_far, float m_init, float l_init, char* smem) {
  constexpr int KSTR = DQK * 2 + 16, KCH = DQK / 8;
  constexpr int ND = DQK / 16, NCB = DV / 32, BUF = 64 * KSTR + (VW / 32) * 4096;
  constexpr int NKI = KSTR / 16, NVI = VW / 8;
  static_assert(ND % 4 == 0 && NCB <= 4, "fragment batches");
  int tid0 = threadIdx.x; asm volatile("" : "+v"(tid0));
  const int lane = tid0 & 63, r32 = lane & 31, hi = lane >> 5;
  const int wv = __builtin_amdgcn_readfirstlane(tid0 >> 6);
  const unsigned lds0 = (unsigned)(uintptr_t)smem;
  bf16x8 qf[ND];
#pragma unroll
  for (int d0 = 0; d0 < ND; ++d0) qf[d0] = *(const bf16x8*)(qrow + d0 * 16 + hi * 8);
  f32x16 o[NCB];
#pragma unroll
  for (int cb = 0; cb < NCB; ++cb)
#pragma unroll
    for (int r = 0; r < 16; ++r) o[cb][r] = 0.f;
  float m = m_init, l = (hi == 0) ? l_init : 0.f;
  const unsigned klane = (unsigned)(r32 * KSTR + hi * 16);
  const unsigned vlane = (unsigned)(64 * KSTR + vcb0 * 4096 + ((lane >> 4) & 1) * 32 + (lane & 3) * 8 + (4 * hi + ((lane & 15) >> 2)) * 64);
  unsigned mwn[2] = {0u, 0u};
  constexpr int NKS = (NKI + 7) / 8, NVS = (NVI + 7) / 8;
  const u16* kptr[NKS]; int kstr[NKS]; const u16* vptr[NVS];
  if (MODE != 2) {
    int ln = threadIdx.x & 63; asm volatile("" : "+v"(ln));
#pragma unroll
    for (int ii = 0; ii < NKS; ++ii) {
      const int i = wv + 8 * ii, ob = i * 1024 + ln * 16, row = ob / KSTR;
      int c = (ob - row * KSTR) >> 4; c = (c >= KCH) ? 0 : c;
      const bool seg1 = c < W1 / 8;
      kptr[ii] = seg1 ? (k1 + ((kbase0 + row) * ldk1 + c * 8)) : (k2 + ((kbase0 + row) * ldk2 + (c - W1 / 8) * 8));
      kstr[ii] = seg1 ? 64 * ldk1 : 64 * ldk2;
    }
#pragma unroll
    for (int ii = 0; ii < NVS; ++ii) {
      const int i = wv + 8 * ii, ob = i * 1024 + ln * 16, cbk = ob >> 12, row = (ob & 4095) >> 6, cw = (ob & 63) >> 4;
      vptr[ii] = vsrc + ((kbase0 + row) * ldv + (cbk * 4 + cw) * 8);
    }
  }
  auto stage_tile = [&](int kb, int buf) {
    const unsigned bofs = (unsigned)(buf * BUF);
    if (MODE != 2) {
#pragma unroll
      for (int ii = 0; ii < NKS; ++ii) {
        const int i = wv + 8 * ii;
        if (i < NKI) { __builtin_amdgcn_global_load_lds((const unsigned*)kptr[ii], (lds_u32p)(smem + bofs + i * 1024), 16, 0, 0); kptr[ii] += kstr[ii]; }
      }
#pragma unroll
      for (int ii = 0; ii < NVS; ++ii) {
        const int i = wv + 8 * ii;
        if (i < NVI) { __builtin_amdgcn_global_load_lds((const unsigned*)vptr[ii], (lds_u32p)(smem + bofs + 64 * KSTR + i * 1024), 16, 0, 0); vptr[ii] += 64 * ldv; }
      }
    } else {
      int ln = threadIdx.x & 63; asm volatile("" : "+v"(ln));
#pragma unroll
      for (int ii = 0; ii < NKS; ++ii) {
        const int i = wv + 8 * ii;
        if (i < NKI) {
          const int ob = i * 1024 + ln * 16, row = ob / KSTR;
          int c = (ob - row * KSTR) >> 4; c = (c >= KCH) ? 0 : c;
          int key = kb + row; key = key < 0 ? 0 : (key >= kv_len ? kv_len - 1 : key);
          const u16* src = (c < W1 / 8) ? (k1 + (key * ldk1 + c * 8)) : (k2 + (key * ldk2 + (c - W1 / 8) * 8));
          __builtin_amdgcn_global_load_lds((const unsigned*)src, (lds_u32p)(smem + bofs + i * 1024), 16, 0, 0);
        }
      }
#pragma unroll
      for (int ii = 0; ii < NVS; ++ii) {
        const int i = wv + 8 * ii;
        if (i < NVI) {
          const int ob = i * 1024 + ln * 16, cbk = ob >> 12, row = (ob & 4095) >> 6, cw = (ob & 63) >> 4;
          int key = kb + row; key = key < 0 ? 0 : (key >= kv_len ? kv_len - 1 : key);
          __builtin_amdgcn_global_load_lds((const unsigned*)(vsrc + (key * ldv + (cbk * 4 + cw) * 8)), (lds_u32p)(smem + bofs + 64 * KSTR + i * 1024), 16, 0, 0);
        }
      }
    }
    if (MODE == 1) { mwn[0] = maskrow[(kb >> 5)]; mwn[1] = maskrow[(kb >> 5) + 1]; }
  };
  stage_tile(kbase0, 0);
  asm volatile("s_waitcnt vmcnt(0)" ::: "memory");
  __syncthreads();
  for (int t = 0; t < ntiles; ++t) {
    const int kb = kbase0 + t * 64;
    const unsigned bufa = lds0 + (unsigned)((t & 1) * BUF);
    const unsigned mw0 = mwn[0], mw1 = mwn[1];
    if (t + 1 < ntiles) stage_tile(kb + 64, (t + 1) & 1);
    if (!(MODE == 0 && kb > tq0 + 31)) {
      f32x16 s[2];
      s[0] = s_block<KSTR, ND, 0>(bufa + klane, qf);
      s[1] = s_block<KSTR, ND, 1>(bufa + klane, qf);
      if (MODE == 0) {
        s[0] = s[0] * c2; s[1] = s[1] * c2;
        if (__builtin_amdgcn_readfirstlane((int)(kb + 63 > tq0))) {
#pragma unroll
          for (int n = 0; n < 2; ++n)
#pragma unroll
            for (int i = 0; i < 16; ++i) { const int key = kb + 32 * n + crow(i, hi); if (key > tq) s[n][i] = NEGV; }
        }
      } else if (MODE == 1) {
        const bool far = (tq0 - (kb + 63)) >= 128;
#pragma unroll
        for (int n = 0; n < 2; ++n) {
          const unsigned wb = (n ? mw1 : mw0) >> (4 * hi);
          if (far) {
#pragma unroll
            for (int i = 0; i < 16; ++i) {
              const float v = fmaf(s[n][i], c2, bias_far);
              s[n][i] = ((wb >> ((i & 3) + 8 * (i >> 2))) & 1u) ? v : NEGV;
            }
          } else {
#pragma unroll
            for (int i = 0; i < 16; ++i) {
              const int key = kb + 32 * n + crow(i, hi);
              int rel = tq - key; rel = rel < 0 ? 0 : (rel > 128 ? 128 : rel);
              const float v = fmaf(s[n][i], c2, lutw[rel]);
              s[n][i] = ((wb >> ((i & 3) + 8 * (i >> 2))) & 1u) ? v : NEGV;
            }
          }
        }
      } else if (MODE == 2) {
#pragma unroll
        for (int n = 0; n < 2; ++n)
#pragma unroll
          for (int i = 0; i < 16; ++i) {
            const int key = kb + 32 * n + crow(i, hi), rel = tq - key;
            const bool ok = ((unsigned)rel < 128u) && (key >= 0);
            const float v = fmaf(s[n][i], c2, lutw[rel & 127]);
            s[n][i] = ok ? v : NEGV;
          }
      } else {
#pragma unroll
        for (int n = 0; n < 2; ++n)
#pragma unroll
          for (int i = 0; i < 16; ++i) s[n][i] *= c2;
      }
      float mx = s[0][0];
#pragma unroll
      for (int i = 1; i < 16; ++i) mx = fmaxf(mx, s[0][i]);
#pragma unroll
      for (int i = 0; i < 16; ++i) mx = fmaxf(mx, s[1][i]);
      mx = xhalf_max(mx);
      if (__any(mx - m > 8.0f)) {
        const float mnew = fmaxf(m, mx), alpha = __builtin_amdgcn_exp2f(m - mnew);
        m = mnew; l *= alpha;
#pragma unroll
        for (int cb = 0; cb < NCB; ++cb)
#pragma unroll
          for (int r = 0; r < 16; ++r) o[cb][r] *= alpha;
      }
      {
        const float nm = -m;
        f32x16 e0 = s[0] + nm, e1 = s[1] + nm;
#pragma unroll
        for (int i = 0; i < 16; ++i) { e0[i] = __builtin_amdgcn_exp2f(e0[i]); e1[i] = __builtin_amdgcn_exp2f(e1[i]); }
        s[0] = e0; s[1] = e1;
        const f32x16 sm = e0 + e1;
        typedef __attribute__((ext_vector_type(8))) float f32x8;
        const f32x8 h8 = sm.lo + sm.hi;
        const f32x4 h4 = h8.lo + h8.hi;
        const f32x2 h2 = h4.lo + h4.hi;
        l += h2[0] + h2[1];
      }
      bf16x8 pb[2][2];
#pragma unroll
      for (int n = 0; n < 2; ++n)
#pragma unroll
        for (int s2 = 0; s2 < 2; ++s2) {
          u32x4 pw = {pk2(s[n][8 * s2 + 0], s[n][8 * s2 + 1]), pk2(s[n][8 * s2 + 2], s[n][8 * s2 + 3]),
                      pk2(s[n][8 * s2 + 4], s[n][8 * s2 + 5]), pk2(s[n][8 * s2 + 6], s[n][8 * s2 + 7])};
          pb[n][s2] = __builtin_bit_cast(bf16x8, pw);
        }
      pv_block<0>(o[0], bufa + vlane, pb);
      if constexpr (NCB > 1) pv_block<1>(o[1], bufa + vlane, pb);
      if constexpr (NCB > 2) pv_block<2>(o[2], bufa + vlane, pb);
      if constexpr (NCB > 3) pv_block<3>(o[3], bufa + vlane, pb);
    }
    asm volatile("s_waitcnt vmcnt(0)" ::: "memory");
    __syncthreads();
  }
  const float inv = __builtin_amdgcn_rcpf(xhalf_sum(l));
  u32x2 ggv[NCB * 4];
#pragma unroll
  for (int cb = 0; cb < NCB; ++cb)
#pragma unroll
    for (int g = 0; g < 4; ++g) ggv[cb * 4 + g] = *(const u32x2*)(grow + 32 * cb + 8 * g + 4 * hi);
  __builtin_amdgcn_sched_barrier(0);
#pragma unroll
  for (int cb = 0; cb < NCB; ++cb)
#pragma unroll
    for (int g = 0; g < 4; ++g) {
      const int dv = 32 * cb + 8 * g + 4 * hi;
      const u32x2 gg = ggv[cb * 4 + g];
      float gv[4] = {bf2f(gg[0] & 0xffffu), bf2f(gg[0] >> 16), bf2f(gg[1] & 0xffffu), bf2f(gg[1] >> 16)};
      float ov[4];
#pragma unroll
      for (int j = 0; j < 4; ++j) {
        const float sg = gv[j] * __builtin_amdgcn_rcpf(1.f + __builtin_amdgcn_exp2f(-LOG2E * gv[j]));
        ov[j] = o[cb][4 * g + j] * inv * sg;
      }
      *(unsigned*)((unsigned char*)yrow + dv) = pk4_fp8(ov[0] * Y_SCALE, ov[1] * Y_SCALE, ov[2] * Y_SCALE, ov[3] * Y_SCALE);
      __builtin_amdgcn_sched_barrier(0);
    }
}

DI unsigned ordkey(float f) { const unsigned b = __float_as_uint(f); return b ^ ((unsigned)((int)b >> 31) | 0x80000000u); }
DI void indexer_phase(const u16* __restrict__ P, unsigned* __restrict__ mask) {
  int tidx = threadIdx.x; asm volatile("" : "+v"(tidx));
  const int lane = tidx & 63, r32 = lane & 31, hi = lane >> 5;
  const int gw = blockIdx.x * 8 + (tidx >> 6), nw = gridDim.x * 8;
  for (int base = 0, pass = 0; base < 8192; base += nw, ++pass) {
    const int item = (pass & 1) ? base + (nw - 1 - gw) : base + gw;
    if (item >= 8192) continue;
    const int b = item & 7, t0 = (1023 - (item >> 3)) * 2;
    const size_t brow = (size_t)b * SEQ;
    const int g = (r32 >> 2) & 1, head = 4 * (r32 >> 3) + (r32 & 3);
    bf16x8 aq[4];
#pragma unroll
    for (int s = 0; s < 4; ++s) aq[s] = *(const bf16x8*)(P + (brow + t0 + g) * 7808 + 2560 + head * 64 + 16 * s + 8 * hi);
    float wv[16];
    {
      const u32x4 w0 = *(const u32x4*)(P + (brow + t0 + hi) * 7808 + 3648), w1 = *(const u32x4*)(P + (brow + t0 + hi) * 7808 + 3656);
#pragma unroll
      for (int j = 0; j < 4; ++j) { wv[2 * j] = bf2f(w0[j] & 0xffffu); wv[2 * j + 1] = bf2f(w0[j] >> 16); wv[8 + 2 * j] = bf2f(w1[j] & 0xffffu); wv[8 + 2 * j + 1] = bf2f(w1[j] >> 16); }
    }
    const int tme = t0 + hi, kbmax = (t0 + 1) >> 5;
    unsigned sc[64];
#pragma unroll
    for (int kb = 0; kb < 64; ++kb) {
      unsigned u = 0u;
      if (kb <= kbmax) {
        f32x16 a;
#pragma unroll
        for (int r = 0; r < 16; ++r) a[r] = 0.f;
        const u16* kp = P + (brow + 32 * kb + r32) * 7808 + 3584 + 8 * hi;
#pragma unroll
        for (int s = 0; s < 4; ++s) { const bf16x8 bk = *(const bf16x8*)(kp + 16 * s); a = MFMA(aq[s], bk, a); }
        float v = 0.f;
#pragma unroll
        for (int i = 0; i < 16; ++i) v = fmaf(wv[i], fmaxf(a[i], 0.f), v);
        u = (32 * kb + r32 <= tme) ? ordkey(v) : 0u;
      }
      sc[kb] = u;
    }
    const int target = (tme + 1 < 256) ? tme + 1 : 256;
    unsigned T = 0u;
    for (int bit = 31; bit >= 0; --bit) {
      const unsigned Tp = T | (1u << bit);
      int cnt = 0;
#pragma unroll
      for (int kb = 0; kb < 64; ++kb) cnt += (sc[kb] >= Tp) ? 1 : 0;
#pragma unroll
      for (int o = 16; o; o >>= 1) cnt += __shfl_xor(cnt, o);
      if (cnt >= target) T = Tp;
    }
    unsigned w0 = 0u, w1 = 0u;
#pragma unroll
    for (int kb = 0; kb < 64; ++kb) {
      const bool pred = (sc[kb] >= T) && (sc[kb] != 0u);
      const unsigned long long bal = __ballot(pred);
      const unsigned wd = (unsigned)(bal >> (32 * hi));
      if ((kb & 31) == r32) { if (kb < 32) w0 = wd; else w1 = wd; }
    }
    mask[(brow + tme) * 64 + r32] = w0;
    mask[(brow + tme) * 64 + 32 + r32] = w1;
  }
}

#define XB_TMO      128
#define XB_XCNT(j)  (256  + 64 * (j))
#define XB_XSUB(j)  (1280 + 64 * (j))
#define XB_XGEN(j)  (2304 + 64 * (j))
#define XB_TOP      3328
#define XB_TOPGEN   3392
#define XCD_BAR_WORDS 3456
#define XB_SPIN_CAP (1u << 22)
DI unsigned xb_ld(unsigned* p)              { return __hip_atomic_load(p, __ATOMIC_RELAXED, __HIP_MEMORY_SCOPE_AGENT); }
DI unsigned xb_add(unsigned* p, unsigned v) { return __hip_atomic_fetch_add(p, v, __ATOMIC_RELAXED, __HIP_MEMORY_SCOPE_AGENT); }
DI unsigned xb_xcc_id() { return (unsigned)__builtin_amdgcn_s_getreg((3 << 11) | 20) & 0xFu; }
#define XB_SPIN(cond, bar) do { unsigned _sp = 0; while (cond) { __builtin_amdgcn_s_sleep(1); \
    if ((++_sp & 255u) == 0u) { if (xb_ld(&(bar)[XB_TMO])) break; if (_sp > XB_SPIN_CAP) { atomicAdd(&(bar)[XB_TMO], 1u); break; } } } } while (0)
DI void xcd_barrier_complete(unsigned* bar, unsigned x, unsigned& nloc, unsigned& nx) {
  const unsigned G = gridDim.x;
  unsigned sum, cnt, mine, sp = 0u;
  for (;;) {
    sum = 0u; cnt = 0u; mine = 0u;
#pragma unroll
    for (unsigned j = 0; j < 16; ++j) { const unsigned c = xb_ld(&bar[XB_XCNT(j)]); sum += c; cnt += (c > 0u) ? 1u : 0u; mine = (j == x) ? c : mine; }
    if (sum == G) break;
    __builtin_amdgcn_s_sleep(1);
    if ((++sp & 255u) == 0u) { if (xb_ld(&bar[XB_TMO])) break; if (sp > XB_SPIN_CAP) { atomicAdd(&bar[XB_TMO], 1u); break; } }
  }
  nloc = mine > 0u ? mine : 1u; nx = cnt > 0u ? cnt : 1u;
}
DI void xcd_barrier(unsigned* bar, volatile unsigned* st) {
  asm volatile("s_waitcnt vmcnt(0)" ::: "memory");
  __syncthreads();
  if (threadIdx.x == 0) {
    const unsigned x = xb_xcc_id();
    __builtin_amdgcn_s_waitcnt(0);
    unsigned nloc = st[0], nx = st[1];
    if (nloc == 0u) { xcd_barrier_complete(bar, x, nloc, nx); st[0] = nloc; st[1] = nx; }
    const unsigned old = xb_add(&bar[XB_XSUB(x)], 1u);
    const unsigned gen = old / nloc;
    if (old + 1u == (gen + 1u) * nloc) {
      __builtin_amdgcn_fence(__ATOMIC_RELEASE, "agent");
      asm volatile("s_waitcnt vmcnt(0)" ::: "memory");
      const unsigned og = xb_add(&bar[XB_TOP], 1u);
      const unsigned tg = og / nx;
      if (og + 1u == (tg + 1u) * nx) xb_add(&bar[XB_TOPGEN], 1u);
      else XB_SPIN(xb_ld(&bar[XB_TOPGEN]) == tg, bar);
      __builtin_amdgcn_fence(__ATOMIC_ACQUIRE, "agent");
      xb_add(&bar[XB_XGEN(x)], 1u);
      asm volatile("s_waitcnt vmcnt(0)" ::: "memory");
    } else {
      XB_SPIN(xb_ld(&bar[XB_XGEN(x)]) == gen, bar);
      __builtin_amdgcn_fence(__ATOMIC_ACQUIRE, "agent");
      asm volatile("s_waitcnt vmcnt(0)" ::: "memory");
    }
  }
  __syncthreads();
}
#define GSYNC() xcd_barrier(XBAR, xb_st)
__global__ void __launch_bounds__(512, 2) mega(Params p) {
  cg::grid_group grid = cg::this_grid();
  extern __shared__ __attribute__((aligned(16))) char smem[];
  volatile int* s_item = (volatile int*)(smem + LDS_ITEM);
  char* ws = p.ws;
  unsigned char* Y8 = (unsigned char*)(ws + OFF_Y);
  u16* WIN8 = (u16*)(ws + OFF_WIN + 19922944);
  unsigned char* CQ8 = (unsigned char*)(ws + OFF_Y + 67108864);     u16* H = (u16*)(ws + OFF_H); u16* Cb = (u16*)(ws + OFF_Y); u16* Qb = (u16*)(ws + OFF_H);
  u16* KV = (u16*)(ws + OFF_KV); u16* MG = (u16*)(ws + OFF_MG); u16* KR = (u16*)(ws + OFF_KR); u16* Pb = (u16*)(ws + OFF_P);
  u16* WIN = (u16*)(ws + OFF_WIN); u16* WUQ = (u16*)(ws + OFF_WUQ); u16* WUKV = (u16*)(ws + OFF_WUKV); u16* WOUT = (u16*)(ws + OFF_WOUT);
  u16* WMEMALL = (u16*)(ws + OFF_KV); u16* MEMN = (u16*)(ws + OFF_MEMN); u16* MEMKV = (u16*)(ws + OFF_MEMKV);
  unsigned* MASK = (unsigned*)(ws + OFF_MASK); f32x2* ROPE = (f32x2*)(ws + OFF_ROPE); float* LUT = (float*)(ws + OFF_LUT);
  int* CTR = (int*)(ws + OFF_CTR);
  unsigned* XBAR = (unsigned*)(ws + OFF_CTR + 1024);
  volatile unsigned* xb_st = (volatile unsigned*)(smem + LDS_ITEM + 16);
  if (threadIdx.x == 0) { xb_st[0] = 0u; xb_st[1] = 0u; (void)xb_add(&XBAR[XB_XCNT(xb_xcc_id())], 1u); }
  __syncthreads();
  const int tid = threadIdx.x, lane = tid & 63, wv = __builtin_amdgcn_readfirstlane(tid >> 6), r32 = lane & 31, hi = lane >> 5;
  const int gtid = blockIdx.x * 512 + tid, gthreads = gridDim.x * 512;

  if (p.ws == nullptr) grid.sync();
  for (int i = gtid; i < 2048 * 32; i += gthreads) {
    const int pos = i >> 5, j = i & 31;
    const float inv = 1.0f / powf(10000.0f, (float)(2 * j) / 64.0f);
    const float ang = (float)pos * inv;
    const float k = rintf(ang * 0.15915494309189535f);
    float r = fmaf(-k, 6.28318548202514648f, ang);
    r = fmaf(-k, -1.74845553e-7f, r);
    f32x2 cs = {__cosf(r), __sinf(r)};
    ROPE[i] = cs;
  }
  for (int i = gtid; i < 129 * 32; i += gthreads) {
    const int rel = i >> 5, h = i & 31;
    int bucket;
    if (rel < 16) bucket = rel;
    else { const int lg = 16 + (int)(logf((float)rel / 16.0f) / 2.0794415416798357f * 16.0f); bucket = lg < 31 ? lg : 31; }
    LUT[i] = p.rel_bias[bucket * 32 + h] * LOG2E;
  }
  rmsnorm_rows<false>(p.mem, p.mem_norm, MEMN, 2048);
#pragma unroll 1
  for (int l = 0; l < 4; ++l) convert_wt<0>(p.w_mem_kv + (size_t)l * 2048 * 2048, 2048, 2048, 2048, WMEMALL + (size_t)l * 2048 * 2048, smem);

  auto convert_layer = [&](int L) {
    const int kind = L % 3, j = L / 3;
    if (kind == 0) {
    convert_wt<1>(p.w_in_a + (size_t)j * 2048 * 6208, 2048, 6208, 3840, WIN, smem, 1.f, 3648, 576, 1536, 2560, 512);
    convert_wt<0, true>(p.w_in_a + (size_t)j * 2048 * 6208, 2048, 6208, 2560, WIN8, smem, WIN_SCALE, 2560, 1536, 0, 576);
    convert_wt<2, true>(p.w_uq + (size_t)j * 1536 * 3072, 1536, 3072, 3072, WUQ, smem, WUQ_SCALE);
    convert_wt<0>(p.w_ukv + (size_t)j * 512 * 4096, 512, 4096, 4096, WUKV, smem);
  } else if (kind == 1) {
    convert_wt<0>(p.w_in_b, 2048, 7760, 4864, WIN, smem, 1.f, 4688, 1616, 2048, 3072);
    convert_wt<0, true>(p.w_in_b, 2048, 7760, 3072, WIN8, smem, WIN_SCALE, 3072, 2048, 0, 1616);
  } else {
    convert_wt<0>(p.w_in_c, 2048, 6656, 3584, WIN, smem, 1.f, 3584, 512, 2048, 3072);
    convert_wt<0, true>(p.w_in_c, 2048, 6656, 3072, WIN8, smem, WIN_SCALE, 3072, 2048, 0, 512);
  }
  };
#pragma unroll 1
  for (int layer = 0; layer < 4; ++layer) {
    const int kind = layer % 3, j = layer / 3;
    const float* xin = (layer == 0) ? p.x : p.out;
    unsigned char* H8 = (unsigned char*)(ws + ((kind == 0) ? OFF_KV + 67108864 : OFF_Y));
    rmsnorm_rows<false>(xin, p.norm_in + layer * 2048, H, NTOK, H8);
    if (layer == 0) convert_layer(0);
    GSYNC();

    if (kind == 0) {
      { EpiBf<1> e{Cb, 2048, 3648, MG, KR, ROPE, 1.f, 576, 1536, 2560}; run_gemm(H, 2048, WIN, NTOK, 3840, 2048, e, smem); }
      { EpiBf<3> e{Cb, 2048, 2560, MG, nullptr, nullptr, 1.f / (H_SCALE * WIN_SCALE), 1536, 0, 576}; run_gemm<true>((const u16*)H8, 1024, WIN8, NTOK, 2560, 1024, e, smem, 192, 2, 4); }
    }
    else if (kind == 1) {
      { EpiBf<0> e{Pb, 7808, 4688, nullptr, nullptr, nullptr, 1.f, 1616, 2048, 3072}; run_gemm(H, 2048, WIN, NTOK, 4864, 2048, e, smem); }
      { EpiBf<0> e{Pb, 7808, 3072, nullptr, nullptr, nullptr, 1.f / (H_SCALE * WIN_SCALE), 2048, 0, 1616}; run_gemm<true>((const u16*)H8, 1024, WIN8, NTOK, 3072, 1024, e, smem); }
    } else {
      { EpiBf<0> e{Pb, 6656, 3584, nullptr, nullptr, nullptr, 1.f, 512, 2048, 3072}; run_gemm(H, 2048, WIN, NTOK, 3584, 2048, e, smem); }
      { EpiBf<0> e{Pb, 6656, 3072, nullptr, nullptr, nullptr, 1.f / (H_SCALE * WIN_SCALE), 2048, 0, 512}; run_gemm<true>((const u16*)H8, 1024, WIN8, NTOK, 3072, 1024, e, smem, 128, 2, 4); }
    }
    if (layer == 0) { EpiBf<0> e{MEMKV, 8192, 8192, nullptr, nullptr, nullptr}; run_gemm(MEMN, 2048, WMEMALL, 2048, 8192, 2048, e, smem); }
    GSYNC();

    if (kind == 0) {
      anorm_phase(Cb, p.a_q_norm + j * 1536, p.a_kv_norm + j * 512, CQ8);
      GSYNC();
      { EpiBf<2> e{Qb, 3072, 3072, nullptr, nullptr, ROPE, 1.f / (CQ_SCALE * WUQ_SCALE)}; run_gemm<true>((const u16*)CQ8, 768, WUQ, NTOK, 3072, 768, e, smem); }
      { EpiBf<0> e{KV, 4096, 4096, nullptr, nullptr, nullptr}; run_gemm(Cb + 1536, 2048, WUKV, NTOK, 4096, 512, e, smem); }
      GSYNC();
    } else if (kind == 1) {
      indexer_phase(Pb, MASK);
      GSYNC();
    }

    {
      const int nself = (kind == 0) ? 1024 : 2048, total = nself + 512;
      const u16* mgb = (kind == 0) ? MG : Pb;
      const int ldmg = (kind == 0) ? 4096 : (kind == 1 ? 7808 : 6656);
      const int mqcol = (kind == 0) ? 0 : (kind == 1 ? 3664 : 2560);
      const int gatecol = (kind == 0) ? 1024 : (kind == 1 ? 4688 : 3584);
      const u16* memkv = MEMKV + layer * 2048;
      float* lut_all = (float*)(smem + LDS_LUT);
      if (kind != 0) {
        for (int i = tid; i < 32 * 129; i += 512) { const int h = i / 129, r = i - h * 129; lut_all[h * 132 + r] = LUT[r * 32 + h]; }
      }
      if (tid == 0) s_item[0] = atomicAdd(&CTR[layer], 1);
      __syncthreads();
      for (int par = 0;; par ^= 1) {
        const int item = __builtin_amdgcn_readfirstlane(s_item[par]);
        if (item >= total) break;
        if (tid == 0) s_item[par ^ 1] = atomicAdd(&CTR[layer], 1);
        if (item < nself) {
          if (kind == 0) {
            const int qblk = 7 - item / 128, rem = item % 128, b = rem / 16, head = rem % 16;
            const size_t brow = (size_t)b * SEQ;
            const int tq0 = qblk * 256 + 32 * wv, tq = tq0 + r32;
            attn_core<192, 128, 128, 128, 0>(KV + brow * 4096 + head * 256, 4096, KR + brow * 64, 64, KV + brow * 4096 + head * 256 + 128, 4096,
                                            SEQ, 0, 4 * qblk + 4, Qb + (brow + tq) * 3072 + head * 192, tq, tq0, 0.07216878364870322f * LOG2E, 0,
                                            (u16*)(Y8 + (brow + tq) * 3072 + head * 128), mgb + (brow + tq) * ldmg + gatecol + head * 128,
                                            nullptr, nullptr, 0.f, -1e29f, 0.f, smem);
          } else {
            const int qb = 63 - item / 32, rem = item % 32, b = rem / 4, kvh = rem % 4;
            const size_t brow = (size_t)b * SEQ;
            const int head = kvh * 8 + wv, tq0 = qb * 32, tq = tq0 + r32;
            const float* lutw = lut_all + head * 132;
            if (kind == 1) {
              attn_core<64, 64, 64, 64, 1>(Pb + brow * 7808 + 2048 + kvh * 64, 7808, nullptr, 0, Pb + brow * 7808 + 2304 + kvh * 64, 7808,
                                          SEQ, 0, (tq0 + 31) / 64 + 1, Pb + (brow + tq) * 7808 + head * 64, tq, tq0, 0.125f * LOG2E, 0,
                                          (u16*)(Y8 + (brow + tq) * 3072 + head * 64), Pb + (brow + tq) * 7808 + gatecol + head * 64,
                                          MASK + (brow + tq) * 64, lutw, lutw[128], -1e29f, 0.f, smem);
            } else {
              const float sink = p.c_sinks[j * 32 + head] * LOG2E;
              attn_core<64, 64, 64, 64, 2>(Pb + brow * 6656 + 2048 + kvh * 64, 6656, nullptr, 0, Pb + brow * 6656 + 2304 + kvh * 64, 6656,
                                          SEQ, tq0 - 128, 3, Pb + (brow + tq) * 6656 + head * 64, tq, tq0, 0.125f * LOG2E, 0,
                                          (u16*)(Y8 + (brow + tq) * 3072 + head * 64), Pb + (brow + tq) * 6656 + gatecol + head * 64,
                                          nullptr, lutw, 0.f, sink, 1.f, smem);
            }
          }
        } else {
          const int it = item - nself, b = it / 64, mh = (it % 64) / 16, qb = it % 16;
          const size_t brow = (size_t)b * SEQ;
          const int tq0 = qb * 128 + 32 * (wv >> 1), tq = tq0 + r32, vh = wv & 1;
          attn_core<256, 256, 128, 256, 3>(memkv + (size_t)b * 256 * 8192 + mh * 256, 8192, nullptr, 0, memkv + (size_t)b * 256 * 8192 + 1024 + mh * 256, 8192,
                                          256, 0, 4, mgb + (brow + tq) * ldmg + mqcol + mh * 256, tq, tq0, 0.0625f * LOG2E, 4 * vh,
                                          (u16*)(Y8 + (brow + tq) * 3072 + 2048 + mh * 256 + 128 * vh), mgb + (brow + tq) * ldmg + gatecol + 2048 + mh * 256 + 128 * vh,
                                          nullptr, nullptr, 0.f, -1e29f, 0.f, smem);
        }
      }
    }
    convert_wt<0, true>(p.w_out + (size_t)layer * 3072 * 2048, 3072, 2048, 2048, WOUT, smem, WOUT_SCALE);
    if (layer + 1 < 4) convert_layer(layer + 1);
    GSYNC();

    { EpiResid e{xin, p.out, 1.f / (Y_SCALE * WOUT_SCALE)}; run_gemm<true>((const u16*)Y8, 1536, WOUT, NTOK, 2048, 1536, e, smem); }
    GSYNC();
  }
  rmsnorm_rows<true>(p.out, p.final_norm, p.out, NTOK);
}

extern "C" void kernel_launch(void* const* d_in, const int* in_sizes, int n_in, void* d_out, int out_size,
                              void* d_ws, size_t ws_size, hipStream_t stream) {
  static int grid_blocks = 0;
  if (!grid_blocks) {
    int dev = 0, cus = 0, per_cu = 0;
    (void)hipGetDevice(&dev);
    (void)hipDeviceGetAttribute(&cus, hipDeviceAttributeMultiprocessorCount, dev);
    (void)hipFuncSetAttribute((const void*)mega, hipFuncAttributeMaxDynamicSharedMemorySize, LDS_BYTES);
    (void)hipOccupancyMaxActiveBlocksPerMultiprocessor(&per_cu, mega, 512, LDS_BYTES);
    if (per_cu > 1) per_cu = 1;
    grid_blocks = cus * per_cu;
  }
  Params p{};
  p.x = (const float*)d_in[0]; p.mem = (const float*)d_in[1]; p.norm_in = (const float*)d_in[2]; p.final_norm = (const float*)d_in[3];
  p.mem_norm = (const float*)d_in[4]; p.rel_bias = (const float*)d_in[5]; p.w_in_a = (const float*)d_in[6]; p.a_q_norm = (const float*)d_in[7];
  p.w_uq = (const float*)d_in[8]; p.a_kv_norm = (const float*)d_in[9]; p.w_ukv = (const float*)d_in[10]; p.w_in_b = (const float*)d_in[11];
  p.w_in_c = (const float*)d_in[12]; p.c_sinks = (const float*)d_in[13]; p.w_mem_kv = (const float*)d_in[14]; p.w_out = (const float*)d_in[15];
  p.out = (float*)d_out; p.ws = (char*)d_ws;
  (void)hipMemsetAsync((char*)d_ws + OFF_CTR, 0, 16384, stream);
  void* args[] = {&p};
  (void)hipLaunchCooperativeKernel((void*)mega, dim3(grid_blocks), dim3(512), args, LDS_BYTES, stream);
}
```

```cpp
#include <hip/hip_runtime.h>
#include <hip/hip_cooperative_groups.h>
#include <stdint.h>
namespace cg = cooperative_groups;

typedef unsigned short u16;
typedef __attribute__((ext_vector_type(8))) short bf16x8;
typedef __attribute__((ext_vector_type(4))) short s16x4;
typedef __attribute__((ext_vector_type(16))) float f32x16;
typedef __attribute__((ext_vector_type(4))) float f32x4;
typedef __attribute__((ext_vector_type(2))) float f32x2;
typedef __attribute__((ext_vector_type(4))) unsigned u32x4;
typedef __attribute__((ext_vector_type(2))) unsigned u32x2;
typedef __attribute__((ext_vector_type(2))) __bf16 bf16x2_t;
typedef short v4i16_t __attribute__((ext_vector_type(4)));
#define DI __device__ __forceinline__
#define MFMA(a, b, c) __builtin_amdgcn_mfma_f32_32x32x16_bf16((a), (b), (c), 0, 0, 0)

constexpr int SEQ = 2048, NTOK = 16384;
constexpr int LDS_LUT = 133120, LDS_ITEM = LDS_LUT + 32 * 528, LDS_BYTES = LDS_ITEM + 64;
constexpr float LOG2E = 1.4426950408889634f;
constexpr float NEGV = -1e30f;
constexpr float Y_SCALE = 16.f, WOUT_SCALE = 256.f, CQ_SCALE = 16.f, WUQ_SCALE = 256.f, H_SCALE = 16.f, WIN_SCALE = 256.f;

constexpr size_t OFF_Y = 0;
constexpr size_t OFF_H = 100663296;
constexpr size_t OFF_KV = 201326592;
constexpr size_t OFF_MG = 335544320;
constexpr size_t OFF_KR = 469762048;
constexpr size_t OFF_P = 167772160;
constexpr size_t OFF_WIN = 471859200;
constexpr size_t OFF_WUQ = OFF_WIN + 32505856;
constexpr size_t OFF_WUKV = OFF_WUQ + 9437184;
constexpr size_t OFF_WOUT = OFF_WUKV + 4194304;
constexpr size_t OFF_MEMN = OFF_WOUT + 12582912;
constexpr size_t OFF_MEMKV = OFF_MEMN + 8388608;
constexpr size_t OFF_MASK = OFF_MEMKV + 33554432;
constexpr size_t OFF_ROPE = OFF_MASK + 4194304;
constexpr size_t OFF_LUT = OFF_ROPE + 524288;
constexpr size_t OFF_CTR = OFF_LUT + 32768;

struct Params {
  const float *x, *mem, *norm_in, *final_norm, *mem_norm, *rel_bias, *w_in_a, *a_q_norm, *w_uq, *a_kv_norm, *w_ukv,
      *w_in_b, *w_in_c, *c_sinks, *w_mem_kv, *w_out;
  float* out;
  char* ws;
};

DI float bf2f(unsigned b) { return __uint_as_float(b << 16); }
DI unsigned pk2(float a, float b) {
  f32x2 v = {a, b};
  return __builtin_bit_cast(unsigned, __builtin_convertvector(v, bf16x2_t));
}
DI float clamp8(float x) { return fminf(fmaxf(x, -448.f), 448.f); }
DI unsigned pk4_fp8(float a, float b, float c, float d) {
  int w = 0;
  w = __builtin_amdgcn_cvt_pk_fp8_f32(clamp8(a), clamp8(b), w, false);
  w = __builtin_amdgcn_cvt_pk_fp8_f32(clamp8(c), clamp8(d), w, true);
  return (unsigned)w;
}
DI u16 f2bf(float a) { return (u16)(pk2(a, 0.f) & 0xffffu); }
DI float wave_sum(float v) {
#pragma unroll
  for (int o = 32; o; o >>= 1) v += __shfl_xor(v, o);
  return v;
}
DI int crow(int reg, int hi) { return (reg & 3) + 8 * (reg >> 2) + 4 * hi; }
DI float xhalf_max(float m) {
  auto rr = __builtin_amdgcn_permlane32_swap(__float_as_uint(m), __float_as_uint(m), false, false);
  return fmaxf(__uint_as_float(rr[0]), __uint_as_float(rr[1]));
}
DI float xhalf_sum(float m) {
  auto rr = __builtin_amdgcn_permlane32_swap(__float_as_uint(m), __float_as_uint(m), false, false);
  return __uint_as_float(rr[0]) + __uint_as_float(rr[1]);
}
typedef __attribute__((address_space(3))) v4i16_t* lds_v4p;
DI s16x4 vtr(const char* p) {
  return __builtin_bit_cast(s16x4, __builtin_amdgcn_ds_read_tr16_b64_v4i16((lds_v4p)(p)));
}

template <int PERM, bool FP8 = false>
DI void convert_wt(const float* __restrict__ W, int K, int N, int Npad, u16* __restrict__ Wt, char* smem, float wscale = 1.f,
                   int nvalid = -1, int csplit = 0, int coff1 = 0, int coff2 = 0, int rot_n0 = 2048) {
  float* tile = (float*)smem;
  int tid = threadIdx.x; asm volatile("" : "+v"(tid));
  const int ntk = K / 64, ntn = Npad / 64;
  for (int t = blockIdx.x; t < ntk * ntn; t += gridDim.x) {
    const int tk = t % ntk, tn = t / ntk, k0 = tk * 64, n0 = tn * 64;
    __syncthreads();
#pragma unroll
    for (int i = 0; i < 2; ++i) {
      const int id = tid + 512 * i, kr = id >> 4, n4 = (id & 15) * 4;
      f32x4 v = {0.f, 0.f, 0.f, 0.f};
      const int nd = n0 + n4, nsrc = (nvalid < 0) ? nd : (nd < csplit ? nd + coff1 : nd + coff2);
      if (nd < ((nvalid < 0) ? N : nvalid)) v = *(const f32x4*)(W + (size_t)(k0 + kr) * N + nsrc);
      tile[kr * 65 + n4 + 0] = v[0]; tile[kr * 65 + n4 + 1] = v[1]; tile[kr * 65 + n4 + 2] = v[2]; tile[kr * 65 + n4 + 3] = v[3];
    }
    __syncthreads();
    {
      const int n = tid >> 3, c = tid & 7;
      bool rot = false;
      if (PERM == 1) rot = (n0 == rot_n0);
      if (PERM == 2) rot = ((tn % 3) == 2);
      const int ns = rot ? ((n >> 1) + 32 * (n & 1)) : n;
      if (FP8) {
        float f[8];
#pragma unroll
        for (int j = 0; j < 8; ++j) f[j] = tile[(c * 8 + j) * 65 + ns] * wscale;
        u32x2 o = {pk4_fp8(f[0], f[1], f[2], f[3]), pk4_fp8(f[4], f[5], f[6], f[7])};
        *(u32x2*)((unsigned char*)Wt + (size_t)(n0 + n) * K + k0 + c * 8) = o;
      } else {
        u32x4 o;
#pragma unroll
        for (int j = 0; j < 4; ++j) o[j] = pk2(tile[(c * 8 + 2 * j) * 65 + ns], tile[(c * 8 + 2 * j + 1) * 65 + ns]);
        *(u32x4*)(Wt + (size_t)(n0 + n) * K + k0 + c * 8) = o;
      }
    }
  }
}

template <bool F32OUT>
DI void rmsnorm_rows(const float* X, const float* __restrict__ g, void* outp, int nrows, unsigned char* __restrict__ out8 = nullptr) {
  int tidx = threadIdx.x; asm volatile("" : "+v"(tidx));
  const int lane = tidx & 63, gw = blockIdx.x * 8 + (tidx >> 6), nw = gridDim.x * 8;
  for (int row = gw; row < nrows; row += nw) {
    const f32x4* xr = (const f32x4*)(X + (size_t)row * 2048);
    f32x4 v[8];
    float ss = 0.f;
#pragma unroll
    for (int i = 0; i < 8; ++i) { v[i] = xr[lane + 64 * i]; ss += v[i][0] * v[i][0] + v[i][1] * v[i][1] + v[i][2] * v[i][2] + v[i][3] * v[i][3]; }
    ss = wave_sum(ss);
    const float r = rsqrtf(ss * (1.f / 2048.f) + 1e-6f);
#pragma unroll
    for (int i = 0; i < 8; ++i) {
      const f32x4 gg = ((const f32x4*)g)[lane + 64 * i];
      f32x4 o = {v[i][0] * r * gg[0], v[i][1] * r * gg[1], v[i][2] * r * gg[2], v[i][3] * r * gg[3]};
      if (F32OUT) ((f32x4*)((float*)outp + (size_t)row * 2048))[lane + 64 * i] = o;
      else { u32x2 pk = {pk2(o[0], o[1]), pk2(o[2], o[3])}; ((u32x2*)((u16*)outp + (size_t)row * 2048))[lane + 64 * i] = pk; }
      if (!F32OUT && out8) ((unsigned*)(out8 + (size_t)row * 2048))[lane + 64 * i] = pk4_fp8(o[0] * H_SCALE, o[1] * H_SCALE, o[2] * H_SCALE, o[3] * H_SCALE);
    }
  }
}

DI void anorm_phase(u16* C, const float* __restrict__ gq, const float* __restrict__ gkv, unsigned char* __restrict__ cq8) {
  int tidx = threadIdx.x; asm volatile("" : "+v"(tidx));
  const int lane = tidx & 63, gw = blockIdx.x * 8 + (tidx >> 6), nw = gridDim.x * 8;
  for (int row = gw; row < NTOK; row += nw) {
    u32x4* cr = (u32x4*)(C + (size_t)row * 2048);
    u32x4 v[4];
    float sq = 0.f, skv = 0.f;
#pragma unroll
    for (int i = 0; i < 4; ++i) {
      v[i] = cr[lane + 64 * i];
      float s = 0.f;
#pragma unroll
      for (int j = 0; j < 4; ++j) { float a = bf2f(v[i][j] & 0xffffu), b = bf2f(v[i][j] >> 16); s += a * a + b * b; }
      if (i < 3) sq += s; else skv += s;
    }
    sq = wave_sum(sq); skv = wave_sum(skv);
    const float rq = rsqrtf(sq * (1.f / 1536.f) + 1e-6f), rkv = rsqrtf(skv * (1.f / 512.f) + 1e-6f);
#pragma unroll
    for (int i = 0; i < 4; ++i) {
      const int col = (lane + 64 * i) * 8;
      const float* gp = (i < 3) ? (gq + col) : (gkv + col - 1536);
      const float r = (i < 3) ? rq : rkv;
      const f32x4 g0 = *(const f32x4*)gp, g1 = *(const f32x4*)(gp + 4);
      u32x4 o;
      o[0] = pk2(bf2f(v[i][0] & 0xffffu) * r * g0[0], bf2f(v[i][0] >> 16) * r * g0[1]);
      o[1] = pk2(bf2f(v[i][1] & 0xffffu) * r * g0[2], bf2f(v[i][1] >> 16) * r * g0[3]);
      o[2] = pk2(bf2f(v[i][2] & 0xffffu) * r * g1[0], bf2f(v[i][2] >> 16) * r * g1[1]);
      o[3] = pk2(bf2f(v[i][3] & 0xffffu) * r * g1[2], bf2f(v[i][3] >> 16) * r * g1[3]);
      cr[lane + 64 * i] = o;
      if (i < 3) {
        const float q0 = bf2f(v[i][0] & 0xffffu) * r * g0[0] * CQ_SCALE, q1 = bf2f(v[i][0] >> 16) * r * g0[1] * CQ_SCALE;
        const float q2 = bf2f(v[i][1] & 0xffffu) * r * g0[2] * CQ_SCALE, q3 = bf2f(v[i][1] >> 16) * r * g0[3] * CQ_SCALE;
        const float q4 = bf2f(v[i][2] & 0xffffu) * r * g1[0] * CQ_SCALE, q5 = bf2f(v[i][2] >> 16) * r * g1[1] * CQ_SCALE;
        const float q6 = bf2f(v[i][3] & 0xffffu) * r * g1[2] * CQ_SCALE, q7 = bf2f(v[i][3] >> 16) * r * g1[3] * CQ_SCALE;
        u32x2 w8 = {pk4_fp8(q0, q1, q2, q3), pk4_fp8(q4, q5, q6, q7)};
        *(u32x2*)(cq8 + (size_t)row * 1536 + col) = w8;
      }
    }
  }
}

namespace pg8 {
#define PG8_LAS __attribute__((address_space(3)))
constexpr int BM = 256, BK = 64, HALF = 128, HTB = HALF * BK * 2, STAGE_BYTES = 8 * HTB, NXCD = 8, WGM = 8;
DI int lds_byte(int r, int c) { const int st = (r >> 4) * 2 + (c >> 5), rr = r & 15, cc = c & 31, ob = rr * 64 + cc * 2; return st * 1024 + (ob ^ (((ob >> 9) & 1) << 5)); }
DI void stage_rc(int b, int& R, int& C) { const int st = b / 1024, sb = b % 1024, swz = sb ^ (((sb >> 9) & 1) << 5); R = (st >> 1) * 16 + swz / 64; C = (st & 1) * 32 + (swz % 64) / 2; }
DI int perm32(int rho) { const int n = rho >> 4, i = rho & 15; return 8 * (i >> 2) + 4 * n + (i & 3); }
typedef int i32x4v __attribute__((ext_vector_type(4)));
typedef int i32x8 __attribute__((ext_vector_type(8)));
DI i32x8 cat8(bf16x8 a, bf16x8 b) { const i32x4v x = __builtin_bit_cast(i32x4v, a), y = __builtin_bit_cast(i32x4v, b); return __builtin_shufflevector(x, y, 0, 1, 2, 3, 4, 5, 6, 7); }
struct Unit { int pm, pn; };
struct Gemm { const u16* A; const u16* Bt; int M, N, K, lda; };
struct StaticOrder {
  int nM, nN, nwg, G, c;
  int nA = 0, uA = 0, uB = 0;
  DI void init(int M, int N, int G_, int c_) { nM = M / BM; nN = N / BM; nwg = nM * nN; G = G_; c = c_; }
  DI bool next(int i, Unit& u) const {
    long L;
    if (nA == 0) L = (long)i * G + c;
    else if (c < nA) { if (i >= uA) return false; L = (long)i * nA + c; }
    else { if (i >= uB) return false; L = (long)nA * uA + (long)i * (G - nA) + (c - nA); }
    if (L >= nwg) return false;
    int wgid = (int)L; { const int q = nwg / NXCD, r = nwg % NXCD, xcd = wgid % NXCD, off = wgid / NXCD; wgid = (xcd < r ? xcd * (q + 1) : r * (q + 1) + (xcd - r) * q) + off; }
    const int nig = WGM * nN, gid = wgid / nig, fm = gid * WGM, gsz = (nM - fm) < WGM ? (nM - fm) : WGM;
    u.pm = fm + ((wgid % nig) % gsz); u.pn = (wgid % nig) / gsz; return true;
  }
  DI void a_ready(const Unit&) const {}
  DI void done(const Unit&) const {}
};
template <bool FP8, class Epi, class Sched>
__device__ __forceinline__ void gemm_phase(PG8_LAS unsigned char* lds, const Gemm g, const Sched& S, const Epi& E) {
    int tid = threadIdx.x; asm volatile("" : "+v"(tid));
    const int wid = __builtin_amdgcn_readfirstlane(tid >> 6), lane = tid & 63, wr = wid >> 2, wc = wid & 3, fr = lane & 15, fq = lane >> 4;
    const int K = g.K, nt = K / BK;
    unsigned voffA[2], voffB[2];
#pragma unroll
    for (int i = 0; i < 2; ++i) { int R, C; stage_rc(tid * 16 + i * 8192, R, C); const int Rb = Epi::PERM ? ((R & ~31) + perm32(R & 31)) : R;
        voffA[i] = (unsigned)(R * g.lda + C) * 2u; voffB[i] = (unsigned)(Rb * K + C) * 2u; }
    const size_t kstep = (size_t)(BK * 2);
    const size_t hstep = (size_t)HALF * K * 2, hstepA = (size_t)HALF * g.lda * 2;
    const size_t tstep = 2 * hstep, tstepA = 2 * hstepA;
    const unsigned ldsw = (unsigned)wid * 1024u;
    const int aoff = lds_byte(wr * 64 + fr, fq * 8), boff = lds_byte(wc * 32 + fr, fq * 8);
#define PG8_SA(b, h) (((b) * 2 + (h)) * HTB)
#define PG8_SB(b, h) ((4 + (b) * 2 + (h)) * HTB)
#define PG8_STAGE(bufoff, gbase, voff) do { _Pragma("unroll") for (int _i = 0; _i < 2; ++_i) \
        __builtin_amdgcn_global_load_lds((const unsigned*)((const char*)(gbase) + (voff)[_i]), (PG8_LAS unsigned*)(lds + (bufoff) + ldsw + _i * 8192), 16, 0, 0); } while (0)
#define PG8_LDA(dst, b, h) do { _Pragma("unroll") for (int m = 0; m < 4; ++m) _Pragma("unroll") for (int k = 0; k < 2; ++k) dst[m][k] = *(const PG8_LAS bf16x8*)(lds + PG8_SA(b, h) + aoff + m * 2048 + k * 1024); } while (0)
#define PG8_LDB(dst, b, h) do { _Pragma("unroll") for (int n = 0; n < 2; ++n) _Pragma("unroll") for (int k = 0; k < 2; ++k) dst[n][k] = *(const PG8_LAS bf16x8*)(lds + PG8_SB(b, h) + boff + n * 2048 + k * 1024); } while (0)
#define PG8_MMA(ai, bj, At, Bt) do { __builtin_amdgcn_s_setprio(1); _Pragma("unroll") for (int m = 0; m < 4; ++m) _Pragma("unroll") for (int n = 0; n < 2; ++n) { \
        if constexpr (FP8) { const i32x8 bv_ = cat8(Bt[n][0], Bt[n][1]), av_ = cat8(At[m][0], At[m][1]); \
            asm volatile("s_nop 1\n\tv_mfma_scale_f32_16x16x128_f8f6f4 %0, %1, %2, %0, %3, %3 op_sel_hi:[0,0,0]" : "+v"(acc[ai][bj][m][n]) : "v"(bv_), "v"(av_), "v"(sc127)); } \
        else { _Pragma("unroll") for (int k = 0; k < 2; ++k) acc[ai][bj][m][n] = __builtin_amdgcn_mfma_f32_16x16x32_bf16(Bt[n][k], At[m][k], acc[ai][bj][m][n], 0, 0, 0); } } \
        __builtin_amdgcn_s_setprio(0); } while (0)
#define PG8_WAIT_V(n) asm volatile("s_waitcnt vmcnt(" #n ")" ::: "memory")
#define PG8_WAIT_L(n) asm volatile("s_waitcnt lgkmcnt(" #n ")" ::: "memory")
#define PG8_BAR __builtin_amdgcn_s_barrier()
#define PG8_SCHED __builtin_amdgcn_sched_barrier(0)
    Unit cur, nxt; int ui = 0;
    if (!S.next(0, cur)) return;
    f32x4 acc[2][2][4][2];
#pragma unroll
    for (int a = 0; a < 2; ++a)
#pragma unroll
        for (int b = 0; b < 2; ++b)
#pragma unroll
            for (int m = 0; m < 4; ++m)
#pragma unroll
                for (int n = 0; n < 2; ++n) acc[a][b][m][n] = (f32x4){0.f, 0.f, 0.f, 0.f};
    bf16x8 At[4][2], B0[2][2], B1[2][2];
    int sc127 = 0x7F7F7F7F; asm volatile("" : "+v"(sc127));
    const char* cA = (const char*)g.A + (size_t)cur.pm * tstepA; const char* cB = (const char*)g.Bt + (size_t)cur.pn * tstep;
    S.a_ready(cur);
    PG8_STAGE(PG8_SB(0, 0), cB, voffB); PG8_STAGE(PG8_SA(0, 0), cA, voffA); PG8_STAGE(PG8_SB(0, 1), cB + hstep, voffB); PG8_STAGE(PG8_SA(0, 1), cA + hstepA, voffA);
    if (wr == 1) PG8_BAR;
    PG8_WAIT_V(4); PG8_BAR;
    PG8_STAGE(PG8_SB(1, 0), cB + kstep, voffB); PG8_STAGE(PG8_SA(1, 0), cA + kstep, voffA); PG8_STAGE(PG8_SB(1, 1), cB + hstep + kstep, voffB);
    PG8_WAIT_V(6); PG8_BAR;
    for (;;) {
        const bool has_next = S.next(ui + 1, nxt);
        const char* nA = has_next ? (const char*)g.A + (size_t)nxt.pm * tstepA : cA; const char* nB = has_next ? (const char*)g.Bt + (size_t)nxt.pn * tstep : cB;
        for (int t = 0; t < nt; t += 2) {
            const bool last = (t == nt - 2);
            const char* a1 = cA + (size_t)(t + 1) * kstep;
            const char* a2 = last ? nA : cA + (size_t)(t + 2) * kstep; const char* b2 = last ? nB : cB + (size_t)(t + 2) * kstep;
            const char* a3 = a2 + kstep; const char* b3 = b2 + kstep;
            if (last && has_next) S.a_ready(nxt);
            PG8_LDB(B0, 0, 0); PG8_SCHED; PG8_LDA(At, 0, 0); PG8_STAGE(PG8_SA(1, 1), a1 + hstepA, voffA);
            PG8_WAIT_L(8); PG8_BAR; PG8_WAIT_L(0); PG8_MMA(0, 0, At, B0); PG8_BAR; PG8_SCHED;
            PG8_LDB(B1, 0, 1); PG8_STAGE(PG8_SB(0, 0), b2, voffB);
            PG8_BAR; PG8_WAIT_L(0); PG8_MMA(0, 1, At, B1); PG8_BAR;
            PG8_LDA(At, 0, 1); PG8_STAGE(PG8_SA(0, 0), a2, voffA);
            PG8_BAR; PG8_WAIT_L(0); PG8_MMA(1, 0, At, B0); PG8_BAR; PG8_SCHED;
            PG8_STAGE(PG8_SB(0, 1), b2 + hstep, voffB);
            PG8_WAIT_V(6); PG8_BAR; PG8_MMA(1, 1, At, B1); PG8_BAR;
            PG8_LDB(B0, 1, 0); PG8_SCHED; PG8_LDA(At, 1, 0); PG8_STAGE(PG8_SA(0, 1), a2 + hstepA, voffA);
            PG8_WAIT_L(8); PG8_BAR; PG8_WAIT_L(0); PG8_MMA(0, 0, At, B0); PG8_BAR; PG8_SCHED;
            PG8_LDB(B1, 1, 1); PG8_STAGE(PG8_SB(1, 0), b3, voffB);
            PG8_BAR; PG8_WAIT_L(0); PG8_MMA(0, 1, At, B1); PG8_BAR;
            PG8_LDA(At, 1, 1); PG8_STAGE(PG8_SA(1, 0), a3, voffA);
            PG8_BAR; PG8_WAIT_L(0); PG8_MMA(1, 0, At, B0); PG8_BAR; PG8_SCHED;
            PG8_STAGE(PG8_SB(1, 1), b3 + hstep, voffB);
            PG8_WAIT_V(6); PG8_BAR; PG8_MMA(1, 1, At, B1); PG8_BAR;
        }
        if constexpr (FP8) asm volatile("s_nop 15\n\ts_nop 15" ::: "memory");
        if constexpr (!Epi::AFTER_DRAIN) { E(acc, cur, wr, wc, fr, fq); S.done(cur); }
        if (!has_next) break;
#pragma unroll
        for (int a = 0; a < 2; ++a)
#pragma unroll
            for (int b = 0; b < 2; ++b)
#pragma unroll
                for (int m = 0; m < 4; ++m)
#pragma unroll
                    for (int n = 0; n < 2; ++n) acc[a][b][m][n] = (f32x4){0.f, 0.f, 0.f, 0.f};
        cur = nxt; cA = nA; cB = nB; ++ui;
    }
    PG8_WAIT_V(0);
    if (wr == 0) PG8_BAR;
    PG8_BAR;
    if constexpr (Epi::AFTER_DRAIN) { E.fused(acc, cur, wr, wc, fr, fq, lds, wid, lane); S.done(cur); }
#undef PG8_SA
#undef PG8_SB
#undef PG8_STAGE
#undef PG8_LDA
#undef PG8_LDB
#undef PG8_MMA
#undef PG8_WAIT_V
#undef PG8_WAIT_L
#undef PG8_BAR
#undef PG8_SCHED
}

}

struct EpiResid {
  static constexpr bool PERM = false, AFTER_DRAIN = false;
  const float* xin; float* xout; float sc;
  DI void operator()(const f32x4 (&acc)[2][2][4][2], const pg8::Unit& u, int wr, int wc, int fr, int fq) const {
    const int row0 = u.pm * 256 + wr * 64 + fr, col0 = u.pn * 256 + wc * 32 + 4 * fq;
#pragma unroll
    for (int ai = 0; ai < 2; ++ai)
#pragma unroll
      for (int mp = 0; mp < 2; ++mp) {
        f32x4 xv[2][2][2];
#pragma unroll
        for (int mm = 0; mm < 2; ++mm)
#pragma unroll
          for (int bj = 0; bj < 2; ++bj)
#pragma unroll
            for (int n = 0; n < 2; ++n)
              xv[mm][bj][n] = *(const f32x4*)(xin + (size_t)(row0 + ai * 128 + (mp * 2 + mm) * 16) * 2048 + col0 + bj * 128 + n * 16);
#pragma unroll
        for (int mm = 0; mm < 2; ++mm)
#pragma unroll
          for (int bj = 0; bj < 2; ++bj)
#pragma unroll
            for (int n = 0; n < 2; ++n)
              *(f32x4*)(xout + (size_t)(row0 + ai * 128 + (mp * 2 + mm) * 16) * 2048 + col0 + bj * 128 + n * 16) = xv[mm][bj][n] + acc[ai][bj][mp * 2 + mm][n] * sc;
        asm volatile("" ::: "memory");
      }
  }
};
template <int MODE>
struct EpiBf {
  static constexpr bool PERM = true, AFTER_DRAIN = false;
  u16* d0; int ld0; int N; u16* d1; u16* d2; const f32x2* rope; float sc = 1.f; int csplit = 0, coff1 = 0, coff2 = 0;
  DI void rot(f32x4& v0, f32x4& v1, int row, int col) const {
    const f32x4* cp = (const f32x4*)(rope + (row & 2047) * 32 + ((col & 63) >> 1));
    const f32x4 c01 = cp[0], c23 = cp[1];
    const f32x4 a = {v0[0] * c01[0] - v0[1] * c01[1], v0[1] * c01[0] + v0[0] * c01[1], v0[2] * c01[2] - v0[3] * c01[3], v0[3] * c01[2] + v0[2] * c01[3]};
    const f32x4 b = {v1[0] * c23[0] - v1[1] * c23[1], v1[1] * c23[0] + v1[0] * c23[1], v1[2] * c23[2] - v1[3] * c23[3], v1[3] * c23[2] + v1[2] * c23[3]};
    v0 = a; v1 = b;
  }
  DI void operator()(const f32x4 (&acc)[2][2][4][2], const pg8::Unit& u, int wr, int wc, int fr, int fq) const {
    const int row0 = u.pm * 256 + wr * 64 + fr, colb = u.pn * 256 + wc * 32 + 8 * fq;
#pragma unroll
    for (int ai = 0; ai < 2; ++ai)
#pragma unroll
      for (int m = 0; m < 4; ++m) {
        const int row = row0 + ai * 128 + m * 16;
#pragma unroll
        for (int bj = 0; bj < 2; ++bj) {
          const int col = colb + bj * 128;
          f32x4 v0 = acc[ai][bj][m][0] * sc, v1 = acc[ai][bj][m][1] * sc;
          u16* dst = nullptr;
          if (MODE == 0) { if (col < N) dst = d0 + (size_t)row * ld0 + (col + coff2 + ((col < csplit) ? (coff1 - coff2) : 0)); }
          else if (MODE == 1) {
            const int oc = col + coff2 + ((col < csplit) ? (coff1 - coff2) : 0);
            if (col < N) {
              if (oc < 2048) dst = d0 + (size_t)row * 2048 + oc;
              else if (oc < 2112) { rot(v0, v1, row, oc); dst = d2 + (size_t)row * 64 + (oc - 2048); }
              else dst = d1 + (size_t)row * 4096 + (oc - 2112);
            }
          } else if (MODE == 3) {
            if (col < N) { const bool lo = col < csplit; u16* bp = lo ? d0 : d1; const int ldd = lo ? 2048 : 4096, oc = lo ? col : col + (coff2 - 2112); dst = bp + (size_t)row * ldd + oc + (lo ? coff1 : 0); }
          } else {
            if (((col >> 6) % 3) == 2) rot(v0, v1, row, col);
            dst = d0 + (size_t)row * 3072 + col;
          }
          if (dst) { u32x4 w = {pk2(v0[0], v0[1]), pk2(v0[2], v0[3]), pk2(v1[0], v1[1]), pk2(v1[2], v1[3])}; *(u32x4*)dst = w; }
        }
        asm volatile("" ::: "memory");
      }
  }
};

template <bool FP8 = false, class Epi>
DI void run_gemm(const u16* A, int lda, const u16* Bt, int M, int N, int K, const Epi& e, char* smem, int nA = 0, int uA = 0, int uB = 0) {
  __syncthreads();
  pg8::Gemm g{A, Bt, M, N, K, lda};
  pg8::StaticOrder S; S.init(M, N, gridDim.x, blockIdx.x);
  if (nA > 0 && (int)gridDim.x > nA && nA * uA + ((int)gridDim.x - nA) * uB == S.nwg) { S.nA = nA; S.uA = uA; S.uB = uB; }
  pg8::gemm_phase<FP8>(( __attribute__((address_space(3))) unsigned char*)smem, g, S, e);
  __syncthreads();
}

typedef __attribute__((address_space(3))) unsigned* lds_u32p;
template <int OFF> DI void rd4(bf16x8 (&f)[4], unsigned addr) {
  asm volatile("ds_read_b128 %0, %4 offset:%5\n\tds_read_b128 %1, %4 offset:%6\n\tds_read_b128 %2, %4 offset:%7\n\tds_read_b128 %3, %4 offset:%8\n\ts_waitcnt lgkmcnt(0)"
               : "=&v"(f[0]), "=&v"(f[1]), "=&v"(f[2]), "=&v"(f[3]) : "v"(addr), "i"(OFF), "i"(OFF + 32), "i"(OFF + 64), "i"(OFF + 96) : "memory");
}
template <int OFF> DI void rdv8(s16x4 (&v)[8], unsigned addr) {
  asm volatile("ds_read_b64_tr_b16 %0, %8 offset:%9\n\tds_read_b64_tr_b16 %1, %8 offset:%10\n\tds_read_b64_tr_b16 %2, %8 offset:%11\n\tds_read_b64_tr_b16 %3, %8 offset:%12\n\t"
               "ds_read_b64_tr_b16 %4, %8 offset:%13\n\tds_read_b64_tr_b16 %5, %8 offset:%14\n\tds_read_b64_tr_b16 %6, %8 offset:%15\n\tds_read_b64_tr_b16 %7, %8 offset:%16\n\ts_waitcnt lgkmcnt(0)"
               : "=&v"(v[0]), "=&v"(v[1]), "=&v"(v[2]), "=&v"(v[3]), "=&v"(v[4]), "=&v"(v[5]), "=&v"(v[6]), "=&v"(v[7])
               : "v"(addr), "i"(OFF), "i"(OFF + 512), "i"(OFF + 1024), "i"(OFF + 1536), "i"(OFF + 2048), "i"(OFF + 2560), "i"(OFF + 3072), "i"(OFF + 3584) : "memory");
}
template <int KSTR, int ND, int N>
DI f32x16 s_block(unsigned kaddr, const bf16x8* qf) {
  const f32x16 z16 = {0.f, 0.f, 0.f, 0.f, 0.f, 0.f, 0.f, 0.f, 0.f, 0.f, 0.f, 0.f, 0.f, 0.f, 0.f, 0.f};
  bf16x8 f[4];
  rd4<N * 32 * KSTR>(f, kaddr);
  f32x16 a = MFMA(f[0], qf[0], z16); a = MFMA(f[1], qf[1], a); a = MFMA(f[2], qf[2], a); a = MFMA(f[3], qf[3], a);
  if constexpr (ND > 4) { rd4<N * 32 * KSTR + 128>(f, kaddr); a = MFMA(f[0], qf[4], a); a = MFMA(f[1], qf[5], a); a = MFMA(f[2], qf[6], a); a = MFMA(f[3], qf[7], a); }
  if constexpr (ND > 8) { rd4<N * 32 * KSTR + 256>(f, kaddr); a = MFMA(f[0], qf[8], a); a = MFMA(f[1], qf[9], a); a = MFMA(f[2], qf[10], a); a = MFMA(f[3], qf[11], a); }
  if constexpr (ND > 12) { rd4<N * 32 * KSTR + 384>(f, kaddr); a = MFMA(f[0], qf[12], a); a = MFMA(f[1], qf[13], a); a = MFMA(f[2], qf[14], a); a = MFMA(f[3], qf[15], a); }
  return a;
}
template <int CB> DI void pv_block(f32x16& o, unsigned vaddr, const bf16x8 (&pb)[2][2]) {
  s16x4 v[8];
  rdv8<CB * 4096>(v, vaddr);
#pragma unroll
  for (int q = 0; q < 4; ++q) {
    const bf16x8 vf = {v[2 * q][0], v[2 * q][1], v[2 * q][2], v[2 * q][3], v[2 * q + 1][0], v[2 * q + 1][1], v[2 * q + 1][2], v[2 * q + 1][3]};
    o = MFMA(vf, pb[q >> 1][q & 1], o);
  }
}
template <int DQK, int W1, int DV, int VW, int MODE>
DI void attn_core(const u16* __restrict__ k1, int ldk1, const u16* __restrict__ k2, int ldk2, const u16* __restrict__ vsrc, int ldv,
                  int kv_len, int kbase0, int ntiles, const u16* qrow, int tq, int tq0, float c2, int vcb0, u16* yrow,
                  const u16* grow, const unsigned* maskrow, const float* lutw, float bias_far, float m_init, float l_init, char* smem) {
  constexpr int KSTR = DQK * 2 + 16, KCH = DQK / 8;
  constexpr int ND = DQK / 16, NCB = DV / 32, BUF = 64 * KSTR + (VW / 32) * 4096;
  constexpr int NKI = KSTR / 16, NVI = VW / 8;
  static_assert(ND % 4 == 0 && NCB <= 4, "fragment batches");
  int tid0 = threadIdx.x; asm volatile("" : "+v"(tid0));
  const int lane = tid0 & 63, r32 = lane & 31, hi = lane >> 5;
  const int wv = __builtin_amdgcn_readfirstlane(tid0 >> 6);
  const unsigned lds0 = (unsigned)(uintptr_t)smem;
  bf16x8 qf[ND];
#pragma unroll
  for (int d0 = 0; d0 < ND; ++d0) qf[d0] = *(const bf16x8*)(qrow + d0 * 16 + hi * 8);
  f32x16 o[NCB];
#pragma unroll
  for (int cb = 0; cb < NCB; ++cb)
#pragma unroll
    for (int r = 0; r < 16; ++r) o[cb][r] = 0.f;
  float m = m_init, l = (hi == 0) ? l_init : 0.f;
  const unsigned klane = (unsigned)(r32 * KSTR + hi * 16);
  const unsigned vlane = (unsigned)(64 * KSTR + vcb0 * 4096 + ((lane >> 4) & 1) * 32 + (lane & 3) * 8 + (4 * hi + ((lane & 15) >> 2)) * 64);
  unsigned mwn[2] = {0u, 0u};
  constexpr int NKS = (NKI + 7) / 8, NVS = (NVI + 7) / 8;
  const u16* kptr[NKS]; int kstr[NKS]; const u16* vptr[NVS];
  if (MODE != 2) {
    int ln = threadIdx.x & 63; asm volatile("" : "+v"(ln));
#pragma unroll
    for (int ii = 0; ii < NKS; ++ii) {
      const int i = wv + 8 * ii, ob = i * 1024 + ln * 16, row = ob / KSTR;
      int c = (ob - row * KSTR) >> 4; c = (c >= KCH) ? 0 : c;
      const bool seg1 = c < W1 / 8;
      kptr[ii] = seg1 ? (k1 + ((kbase0 + row) * ldk1 + c * 8)) : (k2 + ((kbase0 + row) * ldk2 + (c - W1 / 8) * 8));
      kstr[ii] = seg1 ? 64 * ldk1 : 64 * ldk2;
    }
#pragma unroll
    for (int ii = 0; ii < NVS; ++ii) {
      const int i = wv + 8 * ii, ob = i * 1024 + ln * 16, cbk = ob >> 12, row = (ob & 4095) >> 6, cw = (ob & 63) >> 4;
      vptr[ii] = vsrc + ((kbase0 + row) * ldv + (cbk * 4 + cw) * 8);
    }
  }
  auto stage_tile = [&](int kb, int buf) {
    const unsigned bofs = (unsigned)(buf * BUF);
    if (MODE != 2) {
#pragma unroll
      for (int ii = 0; ii < NKS; ++ii) {
        const int i = wv + 8 * ii;
        if (i < NKI) { __builtin_amdgcn_global_load_lds((const unsigned*)kptr[ii], (lds_u32p)(smem + bofs + i * 1024), 16, 0, 0); kptr[ii] += kstr[ii]; }
      }
#pragma unroll
      for (int ii = 0; ii < NVS; ++ii) {
        const int i = wv + 8 * ii;
        if (i < NVI) { __builtin_amdgcn_global_load_lds((const unsigned*)vptr[ii], (lds_u32p)(smem + bofs + 64 * KSTR + i * 1024), 16, 0, 0); vptr[ii] += 64 * ldv; }
      }
    } else {
      int ln = threadIdx.x & 63; asm volatile("" : "+v"(ln));
#pragma unroll
      for (int ii = 0; ii < NKS; ++ii) {
        const int i = wv + 8 * ii;
        if (i < NKI) {
          const int ob = i * 1024 + ln * 16, row = ob / KSTR;
          int c = (ob - row * KSTR) >> 4; c = (c >= KCH) ? 0 : c;
          int key = kb + row; key = key < 0 ? 0 : (key >= kv_len ? kv_len - 1 : key);
          const u16* src = (c < W1 / 8) ? (k1 + (key * ldk1 + c * 8)) : (k2 + (key * ldk2 + (c - W1 / 8) * 8));
          __builtin_amdgcn_global_load_lds((const unsigned*)src, (lds_u32p)(smem + bofs + i * 1024), 16, 0, 0);
        }
      }
#pragma unroll
      for (int ii = 0; ii < NVS; ++ii) {
        const int i = wv + 8 * ii;
        if (i < NVI) {
          const int ob = i * 1024 + ln * 16, cbk = ob >> 12, row = (ob & 4095) >> 6, cw = (ob & 63) >> 4;
          int key = kb + row; key = key < 0 ? 0 : (key >= kv_len ? kv_len - 1 : key);
          __builtin_amdgcn_global_load_lds((const unsigned*)(vsrc + (key * ldv + (cbk * 4 + cw) * 8)), (lds_u32p)(smem + bofs + 64 * KSTR + i * 1024), 16, 0, 0);
        }
      }
    }
    if (MODE == 1) { mwn[0] = maskrow[(kb >> 5)]; mwn[1] = maskrow[(kb >> 5) + 1]; }
  };
  stage_tile(kbase0, 0);
  asm volatile("s_waitcnt vmcnt(0)" ::: "memory");
  __syncthreads();
  for (int t = 0; t < ntiles; ++t) {
    const int kb = kbase0 + t * 64;
    const unsigned bufa = lds0 + (unsigned)((t & 1) * BUF);
    const unsigned mw0 = mwn[0], mw1 = mwn[1];
    if (t + 1 < ntiles) stage_tile(kb + 64, (t + 1) & 1);
    if (!(MODE == 0 && kb > tq0 + 31)) {
      f32x16 s[2];
      s[0] = s_block<KSTR, ND, 0>(bufa + klane, qf);
      s[1] = s_block<KSTR, ND, 1>(bufa + klane, qf);
      if (MODE == 0) {
        if (__builtin_amdgcn_readfirstlane((int)(kb + 63 > tq0))) {
#pragma unroll
          for (int n = 0; n < 2; ++n)
#pragma unroll
            for (int i = 0; i < 16; ++i) { const int key = kb + 32 * n + crow(i, hi); if (key > tq) s[n][i] = NEGV; }
        }
      } else if (MODE == 1) {
        const bool far = (tq0 - (kb + 63)) >= 128;
#pragma unroll
        for (int n = 0; n < 2; ++n) {
          const unsigned wb = (n ? mw1 : mw0) >> (4 * hi);
          if (far) {
#pragma unroll
            for (int i = 0; i < 16; ++i) {
              const float v = fmaf(s[n][i], c2, bias_far);
              s[n][i] = ((wb >> ((i & 3) + 8 * (i >> 2))) & 1u) ? v : NEGV;
            }
          } else {
#pragma unroll
            for (int i = 0; i < 16; ++i) {
              const int key = kb + 32 * n + crow(i, hi);
              int rel = tq - key; rel = rel < 0 ? 0 : (rel > 128 ? 128 : rel);
              const float v = fmaf(s[n][i], c2, lutw[rel]);
              s[n][i] = ((wb >> ((i & 3) + 8 * (i >> 2))) & 1u) ? v : NEGV;
            }
          }
        }
      } else if (MODE == 2) {
#pragma unroll
        for (int n = 0; n < 2; ++n)
#pragma unroll
          for (int i = 0; i < 16; ++i) {
            const int key = kb + 32 * n + crow(i, hi), rel = tq - key;
            const bool ok = ((unsigned)rel < 128u) && (key >= 0);
            const float v = fmaf(s[n][i], c2, lutw[rel & 127]);
            s[n][i] = ok ? v : NEGV;
          }
      } else {
#pragma unroll
        for (int n = 0; n < 2; ++n)
#pragma unroll
          for (int i = 0; i < 16; ++i) s[n][i] *= c2;
      }
      float mx = s[0][0];
#pragma unroll
      for (int i = 1; i < 16; ++i) mx = fmaxf(mx, s[0][i]);
#pragma unroll
      for (int i = 0; i < 16; ++i) mx = fmaxf(mx, s[1][i]);
      mx = xhalf_max(mx);
      if (__any(mx - m > 8.0f)) {
        const float mnew = fmaxf(m, mx), alpha = __builtin_amdgcn_exp2f(m - mnew);
        m = mnew; l *= alpha;
#pragma unroll
        for (int cb = 0; cb < NCB; ++cb)
#pragma unroll
          for (int r = 0; r < 16; ++r) o[cb][r] *= alpha;
      }
      {
        const float nm = -m;
        f32x16 e0 = s[0] + nm, e1 = s[1] + nm;
#pragma unroll
        for (int i = 0; i < 16; ++i) { e0[i] = __builtin_amdgcn_exp2f(e0[i]); e1[i] = __builtin_amdgcn_exp2f(e1[i]); }
        s[0] = e0; s[1] = e1;
        const f32x16 sm = e0 + e1;
        typedef __attribute__((ext_vector_type(8))) float f32x8;
        const f32x8 h8 = sm.lo + sm.hi;
        const f32x4 h4 = h8.lo + h8.hi;
        const f32x2 h2 = h4.lo + h4.hi;
        l += h2[0] + h2[1];
      }
      bf16x8 pb[2][2];
#pragma unroll
      for (int n = 0; n < 2; ++n)
#pragma unroll
        for (int s2 = 0; s2 < 2; ++s2) {
          u32x4 pw = {pk2(s[n][8 * s2 + 0], s[n][8 * s2 + 1]), pk2(s[n][8 * s2 + 2], s[n][8 * s2 + 3]),
                      pk2(s[n][8 * s2 + 4], s[n][8 * s2 + 5]), pk2(s[n][8 * s2 + 6], s[n][8 * s2 + 7])};
          pb[n][s2] = __builtin_bit_cast(bf16x8, pw);
        }
      pv_block<0>(o[0], bufa + vlane, pb);
      if constexpr (NCB > 1) pv_block<1>(o[1], bufa + vlane, pb);
      if constexpr (NCB > 2) pv_block<2>(o[2], bufa + vlane, pb);
      if constexpr (NCB > 3) pv_block<3>(o[3], bufa + vlane, pb);
    }
    asm volatile("s_waitcnt vmcnt(0)" ::: "memory");
    __syncthreads();
  }
  const float inv = __builtin_amdgcn_rcpf(xhalf_sum(l));
  u32x2 ggv[NCB * 4];
#pragma unroll
  for (int cb = 0; cb < NCB; ++cb)
#pragma unroll
    for (int g = 0; g < 4; ++g) ggv[cb * 4 + g] = *(const u32x2*)(grow + 32 * cb + 8 * g + 4 * hi);
  __builtin_amdgcn_sched_barrier(0);
#pragma unroll
  for (int cb = 0; cb < NCB; ++cb)
#pragma unroll
    for (int g = 0; g < 4; ++g) {
      const int dv = 32 * cb + 8 * g + 4 * hi;
      const u32x2 gg = ggv[cb * 4 + g];
      float gv[4] = {bf2f(gg[0] & 0xffffu), bf2f(gg[0] >> 16), bf2f(gg[1] & 0xffffu), bf2f(gg[1] >> 16)};
      float ov[4];
#pragma unroll
      for (int j = 0; j < 4; ++j) {
        const float sg = gv[j] * __builtin_amdgcn_rcpf(1.f + __builtin_amdgcn_exp2f(-LOG2E * gv[j]));
        ov[j] = o[cb][4 * g + j] * inv * sg;
      }
      *(unsigned*)((unsigned char*)yrow + dv) = pk4_fp8(ov[0] * Y_SCALE, ov[1] * Y_SCALE, ov[2] * Y_SCALE, ov[3] * Y_SCALE);
      __builtin_amdgcn_sched_barrier(0);
    }
}

DI unsigned ordkey(float f) { const unsigned b = __float_as_uint(f); return b ^ ((unsigned)((int)b >> 31) | 0x80000000u); }
DI void indexer_phase(const u16* __restrict__ P, unsigned* __restrict__ mask) {
  int tidx = threadIdx.x; asm volatile("" : "+v"(tidx));
  const int lane = tidx & 63, r32 = lane & 31, hi = lane >> 5;
  const int gw = blockIdx.x * 8 + (tidx >> 6), nw = gridDim.x * 8;
  for (int base = 0, pass = 0; base < 8192; base += nw, ++pass) {
    const int item = (pass & 1) ? base + (nw - 1 - gw) : base + gw;
    if (item >= 8192) continue;
    const int b = item & 7, t0 = (1023 - (item >> 3)) * 2;
    const size_t brow = (size_t)b * SEQ;
    const int g = (r32 >> 2) & 1, head = 4 * (r32 >> 3) + (r32 & 3);
    bf16x8 aq[4];
#pragma unroll
    for (int s = 0; s < 4; ++s) aq[s] = *(const bf16x8*)(P + (brow + t0 + g) * 7808 + 2560 + head * 64 + 16 * s + 8 * hi);
    float wv[16];
    {
      const u32x4 w0 = *(const u32x4*)(P + (brow + t0 + hi) * 7808 + 3648), w1 = *(const u32x4*)(P + (brow + t0 + hi) * 7808 + 3656);
#pragma unroll
      for (int j = 0; j < 4; ++j) { wv[2 * j] = bf2f(w0[j] & 0xffffu); wv[2 * j + 1] = bf2f(w0[j] >> 16); wv[8 + 2 * j] = bf2f(w1[j] & 0xffffu); wv[8 + 2 * j + 1] = bf2f(w1[j] >> 16); }
    }
    const int tme = t0 + hi, kbmax = (t0 + 1) >> 5;
    unsigned sc[64];
#pragma unroll
    for (int kb = 0; kb < 64; ++kb) {
      unsigned u = 0u;
      if (kb <= kbmax) {
        f32x16 a;
#pragma unroll
        for (int r = 0; r < 16; ++r) a[r] = 0.f;
        const u16* kp = P + (brow + 32 * kb + r32) * 7808 + 3584 + 8 * hi;
#pragma unroll
        for (int s = 0; s < 4; ++s) { const bf16x8 bk = *(const bf16x8*)(kp + 16 * s); a = MFMA(aq[s], bk, a); }
        float v = 0.f;
#pragma unroll
        for (int i = 0; i < 16; ++i) v = fmaf(wv[i], fmaxf(a[i], 0.f), v);
        u = (32 * kb + r32 <= tme) ? ordkey(v) : 0u;
      }
      sc[kb] = u;
    }
    const int target = (tme + 1 < 256) ? tme + 1 : 256;
    unsigned T = 0u;
    for (int bit = 31; bit >= 0; --bit) {
      const unsigned Tp = T | (1u << bit);
      int cnt = 0;
#pragma unroll
      for (int kb = 0; kb < 64; ++kb) cnt += (sc[kb] >= Tp) ? 1 : 0;
#pragma unroll
      for (int o = 16; o; o >>= 1) cnt += __shfl_xor(cnt, o);
      if (cnt >= target) T = Tp;
    }
    unsigned w0 = 0u, w1 = 0u;
#pragma unroll
    for (int kb = 0; kb < 64; ++kb) {
      const bool pred = (sc[kb] >= T) && (sc[kb] != 0u);
      const unsigned long long bal = __ballot(pred);
      const unsigned wd = (unsigned)(bal >> (32 * hi));
      if ((kb & 31) == r32) { if (kb < 32) w0 = wd; else w1 = wd; }
    }
    mask[(brow + tme) * 64 + r32] = w0;
    mask[(brow + tme) * 64 + 32 + r32] = w1;
  }
}

#define XB_TMO      128
#define XB_XCNT(j)  (256  + 64 * (j))
#define XB_XSUB(j)  (1280 + 64 * (j))
#define XB_XGEN(j)  (2304 + 64 * (j))
#define XB_TOP      3328
#define XB_TOPGEN   3392
#define XCD_BAR_WORDS 3456
#define XB_SPIN_CAP (1u << 22)
DI unsigned xb_ld(unsigned* p)              { return __hip_atomic_load(p, __ATOMIC_RELAXED, __HIP_MEMORY_SCOPE_AGENT); }
DI unsigned xb_add(unsigned* p, unsigned v) { return __hip_atomic_fetch_add(p, v, __ATOMIC_RELAXED, __HIP_MEMORY_SCOPE_AGENT); }
DI unsigned xb_xcc_id() { return (unsigned)__builtin_amdgcn_s_getreg((3 << 11) | 20) & 0xFu; }
#define XB_SPIN(cond, bar) do { unsigned _sp = 0; while (cond) { __builtin_amdgcn_s_sleep(1); \
    if ((++_sp & 255u) == 0u) { if (xb_ld(&(bar)[XB_TMO])) break; if (_sp > XB_SPIN_CAP) { atomicAdd(&(bar)[XB_TMO], 1u); break; } } } } while (0)
DI void xcd_barrier_complete(unsigned* bar, unsigned x, unsigned& nloc, unsigned& nx) {
  const unsigned G = gridDim.x;
  unsigned sum, cnt, mine, sp = 0u;
  for (;;) {
    sum = 0u; cnt = 0u; mine = 0u;
#pragma unroll
    for (unsigned j = 0; j < 16; ++j) { const unsigned c = xb_ld(&bar[XB_XCNT(j)]); sum += c; cnt += (c > 0u) ? 1u : 0u; mine = (j == x) ? c : mine; }
    if (sum == G) break;
    __builtin_amdgcn_s_sleep(1);
    if ((++sp & 255u) == 0u) { if (xb_ld(&bar[XB_TMO])) break; if (sp > XB_SPIN_CAP) { atomicAdd(&bar[XB_TMO], 1u); break; } }
  }
  nloc = mine > 0u ? mine : 1u; nx = cnt > 0u ? cnt : 1u;
}
DI void xcd_barrier(unsigned* bar, volatile unsigned* st) {
  asm volatile("s_waitcnt vmcnt(0)" ::: "memory");
  __syncthreads();
  if (threadIdx.x == 0) {
    const unsigned x = xb_xcc_id();
    __builtin_amdgcn_s_waitcnt(0);
    unsigned nloc = st[0], nx = st[1];
    if (nloc == 0u) { xcd_barrier_complete(bar, x, nloc, nx); st[0] = nloc; st[1] = nx; }
    const unsigned old = xb_add(&bar[XB_XSUB(x)], 1u);
    const unsigned gen = old / nloc;
    if (old + 1u == (gen + 1u) * nloc) {
      __builtin_amdgcn_fence(__ATOMIC_RELEASE, "agent");
      asm volatile("s_waitcnt vmcnt(0)" ::: "memory");
      const unsigned og = xb_add(&bar[XB_TOP], 1u);
      const unsigned tg = og / nx;
      if (og + 1u == (tg + 1u) * nx) xb_add(&bar[XB_TOPGEN], 1u);
      else XB_SPIN(xb_ld(&bar[XB_TOPGEN]) == tg, bar);
      __builtin_amdgcn_fence(__ATOMIC_ACQUIRE, "agent");
      xb_add(&bar[XB_XGEN(x)], 1u);
      asm volatile("s_waitcnt vmcnt(0)" ::: "memory");
    } else {
      XB_SPIN(xb_ld(&bar[XB_XGEN(x)]) == gen, bar);
      __builtin_amdgcn_fence(__ATOMIC_ACQUIRE, "agent");
      asm volatile("s_waitcnt vmcnt(0)" ::: "memory");
    }
  }
  __syncthreads();
}
#define GSYNC() xcd_barrier(XBAR, xb_st)
__global__ void __launch_bounds__(512, 2) mega(Params p) {
  cg::grid_group grid = cg::this_grid();
  extern __shared__ __attribute__((aligned(16))) char smem[];
  volatile int* s_item = (volatile int*)(smem + LDS_ITEM);
  char* ws = p.ws;
  unsigned char* Y8 = (unsigned char*)(ws + OFF_Y);
  u16* WIN8 = (u16*)(ws + OFF_WIN + 19922944);
  unsigned char* CQ8 = (unsigned char*)(ws + OFF_Y + 67108864);     u16* H = (u16*)(ws + OFF_H); u16* Cb = (u16*)(ws + OFF_Y); u16* Qb = (u16*)(ws + OFF_H);
  u16* KV = (u16*)(ws + OFF_KV); u16* MG = (u16*)(ws + OFF_MG); u16* KR = (u16*)(ws + OFF_KR); u16* Pb = (u16*)(ws + OFF_P);
  u16* WIN = (u16*)(ws + OFF_WIN); u16* WUQ = (u16*)(ws + OFF_WUQ); u16* WUKV = (u16*)(ws + OFF_WUKV); u16* WOUT = (u16*)(ws + OFF_WOUT);
  u16* WMEMALL = (u16*)(ws + OFF_KV); u16* MEMN = (u16*)(ws + OFF_MEMN); u16* MEMKV = (u16*)(ws + OFF_MEMKV);
  unsigned* MASK = (unsigned*)(ws + OFF_MASK); f32x2* ROPE = (f32x2*)(ws + OFF_ROPE); float* LUT = (float*)(ws + OFF_LUT);
  int* CTR = (int*)(ws + OFF_CTR);
  unsigned* XBAR = (unsigned*)(ws + OFF_CTR + 1024);
  volatile unsigned* xb_st = (volatile unsigned*)(smem + LDS_ITEM + 16);
  if (threadIdx.x == 0) { xb_st[0] = 0u; xb_st[1] = 0u; (void)xb_add(&XBAR[XB_XCNT(xb_xcc_id())], 1u); }
  __syncthreads();
  const int tid = threadIdx.x, lane = tid & 63, wv = __builtin_amdgcn_readfirstlane(tid >> 6), r32 = lane & 31, hi = lane >> 5;
  const int gtid = blockIdx.x * 512 + tid, gthreads = gridDim.x * 512;

  if (p.ws == nullptr) grid.sync();
  for (int i = gtid; i < 2048 * 32; i += gthreads) {
    const int pos = i >> 5, j = i & 31;
    const float inv = 1.0f / powf(10000.0f, (float)(2 * j) / 64.0f);
    const float ang = (float)pos * inv;
    const float k = rintf(ang * 0.15915494309189535f);
    float r = fmaf(-k, 6.28318548202514648f, ang);
    r = fmaf(-k, -1.74845553e-7f, r);
    f32x2 cs = {__cosf(r), __sinf(r)};
    ROPE[i] = cs;
  }
  for (int i = gtid; i < 129 * 32; i += gthreads) {
    const int rel = i >> 5, h = i & 31;
    int bucket;
    if (rel < 16) bucket = rel;
    else { const int lg = 16 + (int)(logf((float)rel / 16.0f) / 2.0794415416798357f * 16.0f); bucket = lg < 31 ? lg : 31; }
    LUT[i] = p.rel_bias[bucket * 32 + h] * LOG2E;
  }
  rmsnorm_rows<false>(p.mem, p.mem_norm, MEMN, 2048);
#pragma unroll 1
  for (int l = 0; l < 4; ++l) convert_wt<0>(p.w_mem_kv + (size_t)l * 2048 * 2048, 2048, 2048, 2048, WMEMALL + (size_t)l * 2048 * 2048, smem);

  auto convert_layer = [&](int L) {
    const int kind = L % 3, j = L / 3;
    if (kind == 0) {
    convert_wt<1>(p.w_in_a + (size_t)j * 2048 * 6208, 2048, 6208, 3840, WIN, smem, 1.f, 3648, 576, 1536, 2560, 512);
    convert_wt<0, true>(p.w_in_a + (size_t)j * 2048 * 6208, 2048, 6208, 2560, WIN8, smem, WIN_SCALE, 2560, 1536, 0, 576);
    convert_wt<2, true>(p.w_uq + (size_t)j * 1536 * 3072, 1536, 3072, 3072, WUQ, smem, WUQ_SCALE);
    convert_wt<0>(p.w_ukv + (size_t)j * 512 * 4096, 512, 4096, 4096, WUKV, smem);
  } else if (kind == 1) {
    convert_wt<0>(p.w_in_b, 2048, 7760, 4864, WIN, smem, 1.f, 4688, 1616, 2048, 3072);
    convert_wt<0, true>(p.w_in_b, 2048, 7760, 3072, WIN8, smem, WIN_SCALE, 3072, 2048, 0, 1616);
  } else {
    convert_wt<0>(p.w_in_c, 2048, 6656, 3584, WIN, smem, 1.f, 3584, 512, 2048, 3072);
    convert_wt<0, true>(p.w_in_c, 2048, 6656, 3072, WIN8, smem, WIN_SCALE, 3072, 2048, 0, 512);
  }
  };
#pragma unroll 1
  for (int layer = 0; layer < 4; ++layer) {
    const int kind = layer % 3, j = layer / 3;
    const float* xin = (layer == 0) ? p.x : p.out;
    unsigned char* H8 = (unsigned char*)(ws + ((kind == 0) ? OFF_KV + 67108864 : OFF_Y));
    rmsnorm_rows<false>(xin, p.norm_in + layer * 2048, H, NTOK, H8);
    if (layer == 0) convert_layer(0);
    GSYNC();

    if (kind == 0) {
      { EpiBf<1> e{Cb, 2048, 3648, MG, KR, ROPE, 1.f, 576, 1536, 2560}; run_gemm(H, 2048, WIN, NTOK, 3840, 2048, e, smem); }
      { EpiBf<3> e{Cb, 2048, 2560, MG, nullptr, nullptr, 1.f / (H_SCALE * WIN_SCALE), 1536, 0, 576}; run_gemm<true>((const u16*)H8, 1024, WIN8, NTOK, 2560, 1024, e, smem, 192, 2, 4); }
    }
    else if (kind == 1) {
      { EpiBf<0> e{Pb, 7808, 4688, nullptr, nullptr, nullptr, 1.f, 1616, 2048, 3072}; run_gemm(H, 2048, WIN, NTOK, 4864, 2048, e, smem); }
      { EpiBf<0> e{Pb, 7808, 3072, nullptr, nullptr, nullptr, 1.f / (H_SCALE * WIN_SCALE), 2048, 0, 1616}; run_gemm<true>((const u16*)H8, 1024, WIN8, NTOK, 3072, 1024, e, smem); }
    } else {
      { EpiBf<0> e{Pb, 6656, 3584, nullptr, nullptr, nullptr, 1.f, 512, 2048, 3072}; run_gemm(H, 2048, WIN, NTOK, 3584, 2048, e, smem); }
      { EpiBf<0> e{Pb, 6656, 3072, nullptr, nullptr, nullptr, 1.f / (H_SCALE * WIN_SCALE), 2048, 0, 512}; run_gemm<true>((const u16*)H8, 1024, WIN8, NTOK, 3072, 1024, e, smem, 128, 2, 4); }
    }
    if (layer == 0) { EpiBf<0> e{MEMKV, 8192, 8192, nullptr, nullptr, nullptr}; run_gemm(MEMN, 2048, WMEMALL, 2048, 8192, 2048, e, smem); }
    GSYNC();

    if (kind == 0) {
      anorm_phase(Cb, p.a_q_norm + j * 1536, p.a_kv_norm + j * 512, CQ8);
      GSYNC();
      { EpiBf<2> e{Qb, 3072, 3072, nullptr, nullptr, ROPE, 0.07216878364870322f * LOG2E / (CQ_SCALE * WUQ_SCALE)}; run_gemm<true>((const u16*)CQ8, 768, WUQ, NTOK, 3072, 768, e, smem); }
      { EpiBf<0> e{KV, 4096, 4096, nullptr, nullptr, nullptr}; run_gemm(Cb + 1536, 2048, WUKV, NTOK, 4096, 512, e, smem); }
      GSYNC();
    } else if (kind == 1) {
      indexer_phase(Pb, MASK);
      GSYNC();
    }

    {
      const int nself = (kind == 0) ? 1024 : 2048, total = nself + 512;
      const u16* mgb = (kind == 0) ? MG : Pb;
      const int ldmg = (kind == 0) ? 4096 : (kind == 1 ? 7808 : 6656);
      const int mqcol = (kind == 0) ? 0 : (kind == 1 ? 3664 : 2560);
      const int gatecol = (kind == 0) ? 1024 : (kind == 1 ? 4688 : 3584);
      const u16* memkv = MEMKV + layer * 2048;
      float* lut_all = (float*)(smem + LDS_LUT);
      if (kind != 0) {
        for (int i = tid; i < 32 * 129; i += 512) { const int h = i / 129, r = i - h * 129; lut_all[h * 132 + r] = LUT[r * 32 + h]; }
      }
      if (tid == 0) s_item[0] = atomicAdd(&CTR[layer], 1);
      __syncthreads();
      for (int par = 0;; par ^= 1) {
        const int item = __builtin_amdgcn_readfirstlane(s_item[par]);
        if (item >= total) break;
        if (tid == 0) s_item[par ^ 1] = atomicAdd(&CTR[layer], 1);
        if (item < nself) {
          if (kind == 0) {
            const int qblk = 7 - item / 128, rem = item % 128, b = rem / 16, head = rem % 16;
            const size_t brow = (size_t)b * SEQ;
            const int tq0 = qblk * 256 + 32 * wv, tq = tq0 + r32;
            attn_core<192, 128, 128, 128, 0>(KV + brow * 4096 + head * 256, 4096, KR + brow * 64, 64, KV + brow * 4096 + head * 256 + 128, 4096,
                                            SEQ, 0, 4 * qblk + 4, Qb + (brow + tq) * 3072 + head * 192, tq, tq0, 0.07216878364870322f * LOG2E, 0,
                                            (u16*)(Y8 + (brow + tq) * 3072 + head * 128), mgb + (brow + tq) * ldmg + gatecol + head * 128,
                                            nullptr, nullptr, 0.f, -1e29f, 0.f, smem);
          } else {
            const int qb = 63 - item / 32, rem = item % 32, b = rem / 4, kvh = rem % 4;
            const size_t brow = (size_t)b * SEQ;
            const int head = kvh * 8 + wv, tq0 = qb * 32, tq = tq0 + r32;
            const float* lutw = lut_all + head * 132;
            if (kind == 1) {
              attn_core<64, 64, 64, 64, 1>(Pb + brow * 7808 + 2048 + kvh * 64, 7808, nullptr, 0, Pb + brow * 7808 + 2304 + kvh * 64, 7808,
                                          SEQ, 0, (tq0 + 31) / 64 + 1, Pb + (brow + tq) * 7808 + head * 64, tq, tq0, 0.125f * LOG2E, 0,
                                          (u16*)(Y8 + (brow + tq) * 3072 + head * 64), Pb + (brow + tq) * 7808 + gatecol + head * 64,
                                          MASK + (brow + tq) * 64, lutw, lutw[128], -1e29f, 0.f, smem);
            } else {
              const float sink = p.c_sinks[j * 32 + head] * LOG2E;
              attn_core<64, 64, 64, 64, 2>(Pb + brow * 6656 + 2048 + kvh * 64, 6656, nullptr, 0, Pb + brow * 6656 + 2304 + kvh * 64, 6656,
                                          SEQ, tq0 - 128, 3, Pb + (brow + tq) * 6656 + head * 64, tq, tq0, 0.125f * LOG2E, 0,
                                          (u16*)(Y8 + (brow + tq) * 3072 + head * 64), Pb + (brow + tq) * 6656 + gatecol + head * 64,
                                          nullptr, lutw, 0.f, sink, 1.f, smem);
            }
          }
        } else {
          const int it = item - nself, b = it / 64, mh = (it % 64) / 16, qb = it % 16;
          const size_t brow = (size_t)b * SEQ;
          const int tq0 = qb * 128 + 32 * (wv >> 1), tq = tq0 + r32, vh = wv & 1;
          attn_core<256, 256, 128, 256, 3>(memkv + (size_t)b * 256 * 8192 + mh * 256, 8192, nullptr, 0, memkv + (size_t)b * 256 * 8192 + 1024 + mh * 256, 8192,
                                          256, 0, 4, mgb + (brow + tq) * ldmg + mqcol + mh * 256, tq, tq0, 0.0625f * LOG2E, 4 * vh,
                                          (u16*)(Y8 + (brow + tq) * 3072 + 2048 + mh * 256 + 128 * vh), mgb + (brow + tq) * ldmg + gatecol + 2048 + mh * 256 + 128 * vh,
                                          nullptr, nullptr, 0.f, -1e29f, 0.f, smem);
        }
      }
    }
    convert_wt<0, true>(p.w_out + (size_t)layer * 3072 * 2048, 3072, 2048, 2048, WOUT, smem, WOUT_SCALE);
    if (layer + 1 < 4) convert_layer(layer + 1);
    GSYNC();

    { EpiResid e{xin, p.out, 1.f / (Y_SCALE * WOUT_SCALE)}; run_gemm<true>((const u16*)Y8, 1536, WOUT, NTOK, 2048, 1536, e, smem); }
    GSYNC();
  }
  rmsnorm_rows<true>(p.out, p.final_norm, p.out, NTOK);
}

extern "C" void kernel_launch(void* const* d_in, const int* in_sizes, int n_in, void* d_out, int out_size,
                              void* d_ws, size_t ws_size, hipStream_t stream) {
  static int grid_blocks = 0;
  if (!grid_blocks) {
    int dev = 0, cus = 0, per_cu = 0;
    (void)hipGetDevice(&dev);
    (void)hipDeviceGetAttribute(&cus, hipDeviceAttributeMultiprocessorCount, dev);
    (void)hipFuncSetAttribute((const void*)mega, hipFuncAttributeMaxDynamicSharedMemorySize, LDS_BYTES);
    (void)hipOccupancyMaxActiveBlocksPerMultiprocessor(&per_cu, mega, 512, LDS_BYTES);
    if (per_cu > 1) per_cu = 1;
    grid_blocks = cus * per_cu;
  }
  Params p{};
  p.x = (const float*)d_in[0]; p.mem = (const float*)d_in[1]; p.norm_in = (const float*)d_in[2]; p.final_norm = (const float*)d_in[3];
  p.mem_norm = (const float*)d_in[4]; p.rel_bias = (const float*)d_in[5]; p.w_in_a = (const float*)d_in[6]; p.a_q_norm = (const float*)d_in[7];
  p.w_uq = (const float*)d_in[8]; p.a_kv_norm = (const float*)d_in[9]; p.w_ukv = (const float*)d_in[10]; p.w_in_b = (const float*)d_in[11];
  p.w_in_c = (const float*)d_in[12]; p.c_sinks = (const float*)d_in[13]; p.w_mem_kv = (const float*)d_in[14]; p.w_out = (const float*)d_in[15];
  p.out = (float*)d_out; p.ws = (char*)d_ws;
  (void)hipMemsetAsync((char*)d_ws + OFF_CTR, 0, 16384, stream);
  void* args[] = {&p};
  (void)hipLaunchCooperativeKernel((void*)mega, dim3(grid_blocks), dim3(512), args, LDS_BYTES, stream);
}
```
